# Optimizing an MI355X kernel written in HIP

```python
import math
import jax
import jax.numpy as jnp
from jax import lax
import numpy as np

D_MODEL = 1024
BATCH = 4
SEQ = 8192
DEPTH = 1

GRID_W = 64
CTX_LEN = 256
S5_WIDTH = 256
S5_GROUP = 16
S5_GROUPS = S5_WIDTH // S5_GROUP
S5_STATE = 64
DT_MIN = 1e-3
DT_MAX = 1e-1
HG_HEADS = 6
HG_DK = 128
HG_DV = 128
HG_WIDTH = HG_HEADS * HG_DK
HG_CHUNK = 64
N_BRANCH = 2
IN_WIDTH = S5_WIDTH + 5 * HG_WIDTH + N_BRANCH * D_MODEL
N_EXPERTS = 64
ROUTE_GROUPS = 8
TOPK_GROUPS = 4
TOP_K = 8
EXPERT_HIDDEN = 256
SHARED_HIDDEN = 256
ROUTED_SCALE = 2.5
MOE_BLOCK = 128
EPS = 1e-6

kernel_name = 'hybrid_s5_hgrn2_moe_prefix_block'


def rms_norm(t, g):
    tf = t.astype(jnp.float32)
    y = tf * lax.rsqrt(jnp.mean(tf * tf, axis=-1, keepdims=True) + EPS)
    return (y * g.astype(jnp.float32)).astype(t.dtype)


def to_colmajor(t, rows):
    b, l, f = t.shape
    return t.reshape(b, rows, GRID_W, f).transpose(0, 2, 1, 3).reshape(b, l, f)


def from_colmajor(t, rows):
    b, l, f = t.shape
    return t.reshape(b, GRID_W, rows, f).transpose(0, 2, 1, 3).reshape(b, l, f)


def split_in(z):
    sizes = (S5_WIDTH,) + (HG_WIDTH,) * 5 + (D_MODEL,) * N_BRANCH
    idx = [int(v) for v in np.cumsum(sizes)[:-1]]
    return jnp.split(z, idx, axis=-1)


def s5_discretise(lam_re, lam_im, log_dt, b_re, b_im):
    lam = lax.complex(jnp.minimum(lam_re.astype(jnp.float32), -1e-4), lam_im.astype(jnp.float32))
    dt = jnp.exp(log_dt.astype(jnp.float32))[:, None]
    lam_dt = lam * dt
    b = lax.complex(b_re.astype(jnp.float32), b_im.astype(jnp.float32))
    b_bar = ((jnp.exp(lam_dt) - 1.0) / lam)[..., None] * b
    return lam_dt, b_bar


def s5_prepare(lp):
    lam_f, bbar_f = s5_discretise(lp['s5_lam_re'][0], lp['s5_lam_im'][0], lp['s5_log_dt'][0],
                                  lp['s5_b_re'][0], lp['s5_b_im'][0])
    lam_b, bbar_b = s5_discretise(lp['s5_lam_re'][1], lp['s5_lam_im'][1], lp['s5_log_dt'][1],
                                  lp['s5_b_re'][1], lp['s5_b_im'][1])
    return {'lam_f': lam_f, 'bbar_f': bbar_f, 'lam_b': lam_b, 'bbar_b': bbar_b,
            'c': lax.complex(lp['s5_c_re'].astype(jnp.float32), lp['s5_c_im'].astype(jnp.float32)),
            'd': lp['s5_d'].astype(jnp.float32).reshape(S5_GROUPS, S5_GROUP)}


def s5_drive(u, b_bar):
    return jnp.einsum('blgc,gpc->blgp', u.astype(jnp.complex64), b_bar)


def _linear_recurrence_op(e1, e2):
    a1, b1 = e1
    a2, b2 = e2
    return a2 * a1, a2 * b1 + b2


def s5_scan(bu, lam_dt, h0, reverse):
    l = bu.shape[1]
    a = jnp.broadcast_to(jnp.exp(lam_dt), bu.shape)
    _, states = lax.associative_scan(_linear_recurrence_op, (a, bu), axis=1, reverse=reverse)
    pos = jnp.arange(l, dtype=jnp.float32)
    steps = (l - pos) if reverse else (pos + 1.0)
    return states + jnp.exp(steps[:, None, None] * lam_dt)[None] * h0[:, None]


def s5_final_state(bu, lam_dt, reverse):
    l = bu.shape[1]
    pos = jnp.arange(l, dtype=jnp.float32)
    steps = pos if reverse else (l - 1.0) - pos
    decay = jnp.exp(steps[:, None, None] * lam_dt)
    return jnp.einsum('lgp,blgp->bgp', decay, bu)


def hgrn_forget(zf, lb):
    f = lb + (1.0 - lb) * jax.nn.sigmoid(zf)
    return jnp.log(f), (1.0 - lb) * jax.nn.sigmoid(-zf)


def split_heads(t):
    b, l, _ = t.shape
    return t.reshape(b, l, HG_HEADS, -1).transpose(0, 2, 1, 3)


def merge_heads(t):
    b, h, l, d = t.shape
    return t.transpose(0, 2, 1, 3).reshape(b, l, h * d)


def gla_chunkwise(q, k, v, log_f, s0):
    b, h, l, dk = q.shape
    n = l // HG_CHUNK
    rs = lambda t: t.reshape(b, h, n, HG_CHUNK, t.shape[-1])
    q, k, v, log_f = rs(q), rs(k), rs(v), rs(log_f)
    cum = jnp.cumsum(log_f, axis=3)
    ref = cum[:, :, :, HG_CHUNK // 2:HG_CHUNK // 2 + 1]
    qi = q * jnp.exp(cum - ref)
    ki = k * jnp.exp(ref - cum)
    mask = jnp.tril(jnp.ones((HG_CHUNK, HG_CHUNK), dtype=bool))
    scores = jnp.where(mask, jnp.einsum('bhnti,bhnsi->bhnts', qi, ki), 0.0)
    o_intra = jnp.einsum('bhnts,bhnsv->bhntv', scores, v)
    total = cum[:, :, :, -1]
    q_in = q * jnp.exp(cum)
    kv = jnp.einsum('bhnsi,bhnsv->bhniv', k * jnp.exp(total[:, :, :, None] - cum), v)

    def step(s, inp):
        q_c, dec, kv_c = inp
        o = jnp.einsum('bhti,bhiv->bhtv', q_c, s)
        return dec[..., None] * s + kv_c, o

    _, o_inter = lax.scan(step, s0, (jnp.moveaxis(q_in, 2, 0), jnp.moveaxis(jnp.exp(total), 2, 0),
                                     jnp.moveaxis(kv, 2, 0)))
    o = o_intra + jnp.moveaxis(o_inter, 0, 2)
    return o.reshape(b, h, l, v.shape[-1])


def gla_final_state(k, v, log_f):
    cum = jnp.cumsum(log_f, axis=2)
    return jnp.einsum('bhli,bhlv->bhiv', k * jnp.exp(cum[:, :, -1:] - cum), v)


def context_states(zc, s5, lb):
    u, _, ff, fb, i, _, _, _ = split_in(zc)
    b, l, _ = zc.shape
    uc = u.astype(jnp.float32).reshape(b, l, S5_GROUPS, S5_GROUP)
    h_f = s5_final_state(s5_drive(uc, s5['bbar_f']), s5['lam_f'], reverse=False)
    h_b = s5_final_state(s5_drive(uc, s5['bbar_b']), s5['lam_b'], reverse=True)
    logf_f, k_f = hgrn_forget(ff.astype(jnp.float32), lb)
    logf_b, k_b = hgrn_forget(fb.astype(jnp.float32), lb)
    vh = split_heads(i.astype(jnp.float32))
    s_f = gla_final_state(split_heads(k_f), vh, split_heads(logf_f))
    flip = lambda t: jnp.flip(t, axis=2)
    s_b = gla_final_state(flip(split_heads(k_b)), flip(vh), flip(split_heads(logf_b)))
    return h_f, h_b, s_f, s_b


def token_mixer(z, states, s5, lp, lb, rows):
    h_f, h_b, s_f, s_b = states
    u, q, ff, fb, i, g_out, gate_a, gate_b = split_in(z)
    b, l, _ = z.shape
    uf = u.astype(jnp.float32).reshape(b, l, S5_GROUPS, S5_GROUP)
    xs = (s5_scan(s5_drive(uf, s5['bbar_f']), s5['lam_f'], h_f, reverse=False)
          + s5_scan(s5_drive(uf, s5['bbar_b']), s5['lam_b'], h_b, reverse=True))
    y = jnp.einsum('blgp,gcp->blgc', xs, s5['c']).real + s5['d'] * uf
    y = jax.nn.gelu(y.reshape(b, l, S5_WIDTH)).astype(z.dtype)
    y_a = y * jax.nn.sigmoid(y @ lp['s5_w_glu'])
    q, ff, fb, i = [t.astype(jnp.float32) for t in (q, ff, fb, i)]
    if rows is not None:
        q, ff, fb, i = [to_colmajor(t, rows) for t in (q, ff, fb, i)]
    logf_f, k_f = hgrn_forget(ff, lb)
    logf_b, k_b = hgrn_forget(fb, lb)
    qh, vh = split_heads(q), split_heads(i)
    flip = lambda t: jnp.flip(t, axis=2)
    o = gla_chunkwise(qh, split_heads(k_f), vh, split_heads(logf_f), s_f)
    o = o + flip(gla_chunkwise(flip(qh), flip(split_heads(k_b)), flip(vh), flip(split_heads(logf_b)), s_b))
    o = merge_heads(rms_norm(o, lp['hg_norm_g']))
    if rows is not None:
        o = from_colmajor(o, rows)
    y_b = o.astype(z.dtype) * jax.nn.silu(g_out)
    merged = jax.nn.sigmoid(gate_a) * (y_a @ lp['p_a']) + jax.nn.sigmoid(gate_b) * (y_b @ lp['p_b'])
    return merged @ lp['w_out']


def moe_ffn(h, lp):
    b, l, dm = h.shape
    xt = h.reshape(-1, dm)
    n_tok = xt.shape[0]
    scores = jax.nn.sigmoid((xt @ lp['moe_w_router']).astype(jnp.float32))
    biased = scores + lp['moe_b_router'].astype(jnp.float32)
    per_group = N_EXPERTS // ROUTE_GROUPS
    grp_score = lax.top_k(biased.reshape(n_tok, ROUTE_GROUPS, per_group), 2)[0].sum(-1)
    _, top_groups = lax.top_k(grp_score, TOPK_GROUPS)
    group_ok = jnp.any(top_groups[:, :, None] == jnp.arange(ROUTE_GROUPS)[None, None, :], axis=1)
    expert_ok = jnp.repeat(group_ok, per_group, axis=1)
    _, eidx = lax.top_k(jnp.where(expert_ok, biased, -jnp.inf), TOP_K)
    wts = jnp.take_along_axis(scores, eidx, axis=1)
    wts = wts / jnp.sum(wts, axis=-1, keepdims=True) * ROUTED_SCALE
    n_assign = n_tok * TOP_K
    e_flat = eidx.reshape(-1).astype(jnp.int32)
    tok_flat = jnp.arange(n_assign, dtype=jnp.int32) // TOP_K
    w_flat = wts.reshape(-1)
    order = jnp.argsort(e_flat)
    e_sorted = e_flat[order]
    counts = jnp.bincount(e_flat, length=N_EXPERTS)
    starts = jnp.cumsum(counts) - counts
    padded = (counts + MOE_BLOCK - 1) // MOE_BLOCK * MOE_BLOCK
    pends = jnp.cumsum(padded)
    pstarts = pends - padded
    dest = pstarts[e_sorted] + jnp.arange(n_assign, dtype=jnp.int32) - starts[e_sorted]
    n_blocks = (n_assign + N_EXPERTS * (MOE_BLOCK - 1) + MOE_BLOCK - 1) // MOE_BLOCK
    cap = n_blocks * MOE_BLOCK
    row_tok = jnp.full((cap,), n_tok, jnp.int32).at[dest].set(tok_flat[order])
    row_w = jnp.zeros((cap,), jnp.float32).at[dest].set(w_flat[order])
    block_e = jnp.minimum(jnp.searchsorted(pends, jnp.arange(n_blocks) * MOE_BLOCK, side='right'),
                          N_EXPERTS - 1).astype(jnp.int32)
    x_pad = jnp.concatenate([xt, jnp.zeros((1, dm), xt.dtype)], axis=0)
    w1, w3, w2 = lp['moe_w1'], lp['moe_w3'], lp['moe_w2']

    def expert_block(acc, blk):
        toks, wr, e = blk
        xb = x_pad[toks]
        hid = jax.nn.silu(xb @ w1[e]) * (xb @ w3[e])
        return acc.at[toks].add((hid @ w2[e]) * wr[:, None].astype(xb.dtype)), None

    acc, _ = lax.scan(expert_block, jnp.zeros((n_tok + 1, dm), xt.dtype),
                      (row_tok.reshape(n_blocks, MOE_BLOCK), row_w.reshape(n_blocks, MOE_BLOCK), block_e))
    shared = (jax.nn.silu(xt @ lp['moe_ws1']) * (xt @ lp['moe_ws3'])) @ lp['moe_ws2']
    return (acc[:n_tok] + shared).reshape(b, l, dm)


def layer_forward(x, ctx, c, c_ctx, lp, lb, rows, last):
    mod = (jax.nn.silu(c) @ lp['w_ada'] + lp['b_ada'])[:, None, :]
    mod_c = jax.nn.silu(c_ctx) @ lp['w_ada'] + lp['b_ada']
    sh1, sc1, g1, sh2, sc2, g2 = jnp.split(mod, 6, axis=-1)
    csh1, csc1, cg1, csh2, csc2, cg2 = jnp.split(mod_c, 6, axis=-1)
    s5 = s5_prepare(lp)
    h = rms_norm(x, lp['norm1_g']) * (1.0 + sc1) + sh1
    hc = rms_norm(ctx, lp['norm1_g']) * (1.0 + csc1) + csh1
    z = h @ lp['w_in']
    zc = hc @ lp['w_in']
    states = context_states(zc, s5, lb)
    x = x + g1 * token_mixer(z, states, s5, lp, lb, rows)
    x = x + g2 * moe_ffn(rms_norm(x, lp['norm2_g']) * (1.0 + sc2) + sh2, lp)
    if not last:
        b = ctx.shape[0]
        zero_states = (jnp.zeros((b, S5_GROUPS, S5_STATE), jnp.complex64),
                       jnp.zeros((b, S5_GROUPS, S5_STATE), jnp.complex64),
                       jnp.zeros((b, HG_HEADS, HG_DK, HG_DV), jnp.float32),
                       jnp.zeros((b, HG_HEADS, HG_DK, HG_DV), jnp.float32))
        ctx = ctx + cg1 * token_mixer(zc, zero_states, s5, lp, lb, None)
        ctx = ctx + cg2 * moe_ffn(rms_norm(ctx, lp['norm2_g']) * (1.0 + csc2) + csh2, lp)
    return x, ctx


def setup_inputs(seed: int = 0) -> dict:
    key = jax.random.key(seed)
    ks = iter(jax.random.split(key, 40))

    def nrm(shape, scale):
        return jax.random.normal(next(ks), shape, jnp.float32) * scale

    d = D_MODEL
    g, cc, p = S5_GROUPS, S5_GROUP, S5_STATE
    e, f = N_EXPERTS, EXPERT_HIDDEN
    n_idx = jnp.arange(p, dtype=jnp.float32)
    return {
        'x': nrm((BATCH, SEQ, d), 1.0),
        'c': nrm((BATCH, d), 1.0),
        'ctx': nrm((BATCH, CTX_LEN, d), 1.0),
        'c_ctx': nrm((d,), 1.0),
        'w_ada': nrm((DEPTH, d, 6 * d), 0.5 * d ** -0.5),
        'b_ada': nrm((DEPTH, 6 * d), 0.01),
        'norm1_g': 1.0 + nrm((DEPTH, d), 0.01),
        'norm2_g': 1.0 + nrm((DEPTH, d), 0.01),
        'w_in': nrm((DEPTH, d, IN_WIDTH), d ** -0.5),
        's5_lam_re': -0.5 + nrm((DEPTH, 2, g, p), 0.01),
        's5_lam_im': math.pi * n_idx + nrm((DEPTH, 2, g, p), 0.01),
        's5_log_dt': jax.random.uniform(next(ks), (DEPTH, 2, g), jnp.float32,
                                        math.log(DT_MIN), math.log(DT_MAX)),
        's5_b_re': nrm((DEPTH, 2, g, p, cc), (2 * cc) ** -0.5),
        's5_b_im': nrm((DEPTH, 2, g, p, cc), (2 * cc) ** -0.5),
        's5_c_re': nrm((DEPTH, g, cc, p), (2 * p) ** -0.5),
        's5_c_im': nrm((DEPTH, g, cc, p), (2 * p) ** -0.5),
        's5_d': nrm((DEPTH, S5_WIDTH), 1.0),
        's5_w_glu': nrm((DEPTH, S5_WIDTH, S5_WIDTH), S5_WIDTH ** -0.5),
        'hg_lb_logits': nrm((DEPTH + 1, HG_WIDTH), 0.1),
        'hg_norm_g': 1.0 + nrm((DEPTH, HG_DV), 0.01),
        'p_a': nrm((DEPTH, S5_WIDTH, d), S5_WIDTH ** -0.5),
        'p_b': nrm((DEPTH, HG_WIDTH, d), HG_WIDTH ** -0.5),
        'w_out': nrm((DEPTH, d, d), d ** -0.5),
        'moe_w_router': nrm((DEPTH, d, e), d ** -0.5),
        'moe_b_router': nrm((DEPTH, e), 0.01),
        'moe_w1': nrm((DEPTH, e, d, f), d ** -0.5),
        'moe_w3': nrm((DEPTH, e, d, f), d ** -0.5),
        'moe_w2': nrm((DEPTH, e, f, d), f ** -0.5),
        'moe_ws1': nrm((DEPTH, d, SHARED_HIDDEN), d ** -0.5),
        'moe_ws3': nrm((DEPTH, d, SHARED_HIDDEN), d ** -0.5),
        'moe_ws2': nrm((DEPTH, SHARED_HIDDEN, d), SHARED_HIDDEN ** -0.5),
        'final_norm_g': 1.0 + nrm((d,), 0.01),
    }


def reference(x, c, ctx, c_ctx, w_ada, b_ada, norm1_g, norm2_g, w_in, s5_lam_re, s5_lam_im,
              s5_log_dt, s5_b_re, s5_b_im, s5_c_re, s5_c_im, s5_d, s5_w_glu, hg_lb_logits,
              hg_norm_g, p_a, p_b, w_out, moe_w_router, moe_b_router, moe_w1, moe_w3, moe_w2,
              moe_ws1, moe_ws3, moe_ws2, final_norm_g):
    rows = x.shape[1] // GRID_W
    lb_all = jnp.cumsum(jax.nn.softmax(hg_lb_logits.astype(jnp.float32), axis=0), axis=0)
    for layer in range(DEPTH):
        lp = {'w_ada': w_ada[layer], 'b_ada': b_ada[layer], 'norm1_g': norm1_g[layer],
              'norm2_g': norm2_g[layer], 'w_in': w_in[layer],
              's5_lam_re': s5_lam_re[layer], 's5_lam_im': s5_lam_im[layer], 's5_log_dt': s5_log_dt[layer],
              's5_b_re': s5_b_re[layer], 's5_b_im': s5_b_im[layer], 's5_c_re': s5_c_re[layer],
              's5_c_im': s5_c_im[layer], 's5_d': s5_d[layer], 's5_w_glu': s5_w_glu[layer],
              'hg_norm_g': hg_norm_g[layer], 'p_a': p_a[layer], 'p_b': p_b[layer], 'w_out': w_out[layer],
              'moe_w_router': moe_w_router[layer], 'moe_b_router': moe_b_router[layer],
              'moe_w1': moe_w1[layer], 'moe_w3': moe_w3[layer], 'moe_w2': moe_w2[layer],
              'moe_ws1': moe_ws1[layer], 'moe_ws3': moe_ws3[layer], 'moe_ws2': moe_ws2[layer]}
        x, ctx = layer_forward(x, ctx, c, c_ctx, lp, lb_all[layer], rows, layer == DEPTH - 1)
    return rms_norm(x, final_norm_g)
```

```cpp
#include <hip/hip_runtime.h>
#include <stdint.h>
#include <stdio.h>

#define LAS __attribute__((address_space(3)))
typedef unsigned short bf16_t;
typedef short bf16x8 __attribute__((ext_vector_type(8)));
typedef float f32x4 __attribute__((ext_vector_type(4)));
typedef float f32x2 __attribute__((ext_vector_type(2)));
typedef unsigned u32x4 __attribute__((ext_vector_type(4)));
typedef unsigned u32x2 __attribute__((ext_vector_type(2)));

constexpr int NB = 4, SEQ = 8192, DM = 1024, NTOK = NB * SEQ, CTXL = 256, NCTX = NB * CTXL, NROWS = NTOK + NCTX;
constexpr int NIN = 6144, ZC = 5888;
constexpr int ZQ = 0, ZFF = 768, ZFB = 1536, ZI = 2304, ZGO = 3072, ZGA = 3840, ZGB = 4864;
constexpr int NEXP = 64, TOPK = 8, EH = 256;
constexpr int CAP_ROUTED = NTOK * TOPK + NEXP * 256;
constexpr int CAP_ROWS = CAP_ROUTED + NTOK;
constexpr int HID1_RB = 1024;
constexpr float EPSF = 1e-6f;

__device__ __forceinline__ unsigned cvt_pk_bf16(float lo, float hi) { unsigned r; asm volatile("v_cvt_pk_bf16_f32 %0, %1, %2" : "=v"(r) : "v"(lo), "v"(hi)); return r; }
__device__ __forceinline__ float bf_lo(unsigned w) { return __uint_as_float(w << 16); }
__device__ __forceinline__ float bf_hi(unsigned w) { return __uint_as_float(w & 0xffff0000u); }
__device__ __forceinline__ float bf2f(bf16_t b) { return __uint_as_float(((unsigned)b) << 16); }
__device__ __forceinline__ bf16_t f2bf(float f) { return (bf16_t)(cvt_pk_bf16(f, 0.f) & 0xffffu); }
__device__ __forceinline__ float sigmoidf_(float x) { return 1.0f / (1.0f + __expf(-x)); }
__device__ __forceinline__ float siluf_(float x) { return x / (1.0f + __expf(-x)); }
__device__ __forceinline__ float wave_sum(float v) {
#pragma unroll
    for (int o = 32; o >= 1; o >>= 1) v += __shfl_xor(v, o);
    return v;
}
__device__ __forceinline__ float gelu_tanh(float y) {
    const float u = 0.7978845608028654f * (y + 0.044715f * y * y * y);
    const float e = __expf(2.0f * u);
    const float t = 1.0f - 2.0f / (e + 1.0f);
    return 0.5f * y * (1.0f + t);
}
namespace ge {
constexpr int BM = 256, BK = 64, HALF = 128, HTB = HALF * BK * 2, STAGE_BYTES = 8 * HTB, NXCD = 8, WGM = 8;
__host__ __device__ __forceinline__ int lds_byte(int r, int c) { const int st = (r >> 4) * 2 + (c >> 5), rr = r & 15, cc = c & 31, ob = rr * 64 + cc * 2; return st * 1024 + (ob ^ (((ob >> 9) & 1) << 5)); }
__host__ __device__ __forceinline__ void stage_rc(int b, int& R, int& C) { const int st = b / 1024, sb = b % 1024, swz = sb ^ (((sb >> 9) & 1) << 5); R = (st >> 1) * 16 + swz / 64; C = (st & 1) * 32 + (swz % 64) / 2; }
__host__ __device__ __forceinline__ int perm32(int rho) { const int n = rho >> 4, i = rho & 15; return 8 * (i >> 2) + 4 * n + (i & 3); }

struct Unit { int pm, pn, e; };

struct GridOrder {
    int nM, nN, nwg, G, c;
    __device__ void init(int nM_, int nN_, int G_, int c_) { nM = nM_; nN = nN_; nwg = nM * nN; G = G_; c = c_; }
    __device__ bool tile(int i, int& pm, int& pn) const {
        const long L = (long)i * G + c; if (L >= nwg) return false;
        int wgid = (int)L; { const int q = nwg / NXCD, r = nwg % NXCD, xcd = wgid % NXCD, off = wgid / NXCD; wgid = (xcd < r ? xcd * (q + 1) : r * (q + 1) + (xcd - r) * q) + off; }
        const int nig = WGM * nN, gid = wgid / nig, fm = gid * WGM, gsz = (nM - fm) < WGM ? (nM - fm) : WGM;
        pm = fm + ((wgid % nig) % gsz); pn = (wgid % nig) / gsz; return true;
    }
};

template <class Epi, class Sched, bool GATHER>
__device__ __forceinline__ void gemm_phase(LAS unsigned char* lds, const int K, const int lda, const int ldb, const Sched& S, const Epi& E) {
    const int tid = threadIdx.x, wid = __builtin_amdgcn_readfirstlane(tid >> 6), lane = tid & 63, wr = wid >> 2, wc = wid & 3, fr = lane & 15, fq = lane >> 4;
    const int nt = K / BK;
    int Rr[2], Cc[2]; unsigned voffB[2];
#pragma unroll
    for (int i = 0; i < 2; ++i) { int R, C; stage_rc(tid * 16 + i * 8192, R, C); Rr[i] = R; Cc[i] = C; const int Rb = Epi::PERM ? ((R & ~31) + perm32(R & 31)) : R; voffB[i] = (unsigned)(Rb * ldb + C) * 2u; }
    const size_t kstep = (size_t)(BK * 2);
    const size_t hstepB = (size_t)HALF * ldb * 2;
    const unsigned ldsw = (unsigned)wid * 1024u;
    const int aoff = lds_byte(wr * 64 + fr, fq * 8), boff = lds_byte(wc * 32 + fr, fq * 8);
#define GE_SA(b, h) (((b) * 2 + (h)) * HTB)
#define GE_SB(b, h) ((4 + (b) * 2 + (h)) * HTB)
#define GE_STAGE(bufoff, gbase, v0, v1) do { \
        __builtin_amdgcn_global_load_lds((const unsigned*)((const char*)(gbase) + (v0)), (LAS unsigned*)(lds + (bufoff) + ldsw), 16, 0, 0); \
        __builtin_amdgcn_global_load_lds((const unsigned*)((const char*)(gbase) + (v1)), (LAS unsigned*)(lds + (bufoff) + ldsw + 8192), 16, 0, 0); } while (0)
#define GE_STAGE_B(bufoff, gbase) GE_STAGE(bufoff, gbase, voffB[0], voffB[1])
#define GE_LDA(dst, b, h) do { _Pragma("unroll") for (int m = 0; m < 4; ++m) _Pragma("unroll") for (int k = 0; k < 2; ++k) dst[m][k] = *(const LAS bf16x8*)(lds + GE_SA(b, h) + aoff + m * 2048 + k * 1024); } while (0)
#define GE_LDB(dst, b, h) do { _Pragma("unroll") for (int n = 0; n < 2; ++n) _Pragma("unroll") for (int k = 0; k < 2; ++k) dst[n][k] = *(const LAS bf16x8*)(lds + GE_SB(b, h) + boff + n * 2048 + k * 1024); } while (0)
#define GE_MMA(ai, bj, At, Bt) do { __builtin_amdgcn_s_setprio(1); _Pragma("unroll") for (int m = 0; m < 4; ++m) _Pragma("unroll") for (int n = 0; n < 2; ++n) _Pragma("unroll") for (int k = 0; k < 2; ++k) \
        acc[ai][bj][m][n] = __builtin_amdgcn_mfma_f32_16x16x32_bf16(Bt[n][k], At[m][k], acc[ai][bj][m][n], 0, 0, 0); __builtin_amdgcn_s_setprio(0); } while (0)
#define GE_WAIT_V(n) asm volatile("s_waitcnt vmcnt(" #n ")" ::: "memory")
#define GE_WAIT_L(n) asm volatile("s_waitcnt lgkmcnt(" #n ")" ::: "memory")
#define GE_BAR __builtin_amdgcn_s_barrier()
#define GE_SCHED __builtin_amdgcn_sched_barrier(0)
    Unit cur, nxt; int ui = 0;
    if (!S.next(0, cur)) return;
    unsigned c00, c01, c10, c11, n00, n01, n10, n11;
    if constexpr (GATHER) {
        c00 = (unsigned)(S.a_row(cur, Rr[0]) * lda + Cc[0]) * 2u; c01 = (unsigned)(S.a_row(cur, Rr[1]) * lda + Cc[1]) * 2u;
        c10 = (unsigned)(S.a_row(cur, HALF + Rr[0]) * lda + Cc[0]) * 2u; c11 = (unsigned)(S.a_row(cur, HALF + Rr[1]) * lda + Cc[1]) * 2u;
    } else {
        c00 = (unsigned)(Rr[0] * lda + Cc[0]) * 2u; c01 = (unsigned)(Rr[1] * lda + Cc[1]) * 2u;
        c10 = c00 + (unsigned)(HALF * lda * 2); c11 = c01 + (unsigned)(HALF * lda * 2);
    }
    n00 = c00; n01 = c01; n10 = c10; n11 = c11;
    f32x4 acc[2][2][4][2];
#pragma unroll
    for (int a = 0; a < 2; ++a)
#pragma unroll
        for (int b = 0; b < 2; ++b)
#pragma unroll
            for (int m = 0; m < 4; ++m)
#pragma unroll
                for (int n = 0; n < 2; ++n) acc[a][b][m][n] = (f32x4){0.f, 0.f, 0.f, 0.f};
    bf16x8 At[4][2], B0[2][2], B1[2][2];
    const char* cA = S.a_base(cur); const char* cB = S.b_base(cur);
    GE_STAGE_B(GE_SB(0, 0), cB); GE_STAGE(GE_SA(0, 0), cA, c00, c01); GE_STAGE_B(GE_SB(0, 1), cB + hstepB); GE_STAGE(GE_SA(0, 1), cA, c10, c11);
    if (wr == 1) GE_BAR;
    GE_WAIT_V(4); GE_BAR;
    GE_STAGE_B(GE_SB(1, 0), cB + kstep); GE_STAGE(GE_SA(1, 0), cA + kstep, c00, c01); GE_STAGE_B(GE_SB(1, 1), cB + hstepB + kstep);
    GE_WAIT_V(6); GE_BAR;
    for (;;) {
        const bool has_next = S.next(ui + 1, nxt);
        const char* nA = has_next ? S.a_base(nxt) : cA; const char* nB = has_next ? S.b_base(nxt) : cB;
        if constexpr (GATHER) {
            if (has_next) {
                n00 = (unsigned)(S.a_row(nxt, Rr[0]) * lda + Cc[0]) * 2u; n01 = (unsigned)(S.a_row(nxt, Rr[1]) * lda + Cc[1]) * 2u;
                n10 = (unsigned)(S.a_row(nxt, HALF + Rr[0]) * lda + Cc[0]) * 2u; n11 = (unsigned)(S.a_row(nxt, HALF + Rr[1]) * lda + Cc[1]) * 2u;
            } else { n00 = c00; n01 = c01; n10 = c10; n11 = c11; }
        }
#pragma unroll 1
        for (int t = 0; t < nt; t += 2) {
            const bool last = (t == nt - 2);
            const char* a1 = cA + (size_t)(t + 1) * kstep;
            const char* a2 = last ? nA : cA + (size_t)(t + 2) * kstep; const char* b2 = last ? nB : cB + (size_t)(t + 2) * kstep;
            const char* a3 = a2 + kstep; const char* b3 = b2 + kstep;
            unsigned x00 = c00, x01 = c01, x10 = c10, x11 = c11;
            if constexpr (GATHER) { if (last) { x00 = n00; x01 = n01; x10 = n10; x11 = n11; } }
            GE_LDB(B0, 0, 0); GE_SCHED; GE_LDA(At, 0, 0); GE_STAGE(GE_SA(1, 1), a1, c10, c11);
            GE_WAIT_L(8); GE_BAR; GE_WAIT_L(0); GE_MMA(0, 0, At, B0); GE_BAR; GE_SCHED;
            GE_LDB(B1, 0, 1); GE_STAGE_B(GE_SB(0, 0), b2);
            GE_BAR; GE_WAIT_L(0); GE_MMA(0, 1, At, B1); GE_BAR;
            GE_LDA(At, 0, 1); GE_STAGE(GE_SA(0, 0), a2, x00, x01);
            GE_BAR; GE_WAIT_L(0); GE_MMA(1, 0, At, B0); GE_BAR; GE_SCHED;
            GE_STAGE_B(GE_SB(0, 1), b2 + hstepB);
            GE_WAIT_V(6); GE_BAR; GE_MMA(1, 1, At, B1); GE_BAR;
            GE_LDB(B0, 1, 0); GE_SCHED; GE_LDA(At, 1, 0); GE_STAGE(GE_SA(0, 1), a2, x10, x11);
            GE_WAIT_L(8); GE_BAR; GE_WAIT_L(0); GE_MMA(0, 0, At, B0); GE_BAR; GE_SCHED;
            GE_LDB(B1, 1, 1); GE_STAGE_B(GE_SB(1, 0), b3);
            GE_BAR; GE_WAIT_L(0); GE_MMA(0, 1, At, B1); GE_BAR;
            GE_LDA(At, 1, 1); GE_STAGE(GE_SA(1, 0), a3, x00, x01);
            GE_BAR; GE_WAIT_L(0); GE_MMA(1, 0, At, B0); GE_BAR; GE_SCHED;
            GE_STAGE_B(GE_SB(1, 1), b3 + hstepB);
            GE_WAIT_V(6); GE_BAR; GE_MMA(1, 1, At, B1); GE_BAR;
        }
        E(acc, cur, wr, wc, fr, fq);
        if (!has_next) break;
#pragma unroll
        for (int a = 0; a < 2; ++a)
#pragma unroll
            for (int b = 0; b < 2; ++b)
#pragma unroll
                for (int m = 0; m < 4; ++m)
#pragma unroll
                    for (int n = 0; n < 2; ++n) acc[a][b][m][n] = (f32x4){0.f, 0.f, 0.f, 0.f};
        cur = nxt; cA = nA; cB = nB; ++ui;
        if constexpr (GATHER) { c00 = n00; c01 = n01; c10 = n10; c11 = n11; }
    }
    GE_WAIT_V(0);
    if (wr == 0) GE_BAR;
    GE_BAR;
#undef GE_SA
#undef GE_SB
#undef GE_STAGE
#undef GE_STAGE_B
#undef GE_LDA
#undef GE_LDB
#undef GE_MMA
#undef GE_WAIT_V
#undef GE_WAIT_L
#undef GE_BAR
#undef GE_SCHED
}
}
constexpr size_t MiB = (size_t)1 << 20;
constexpr size_t OFF_BAR    = 0;
constexpr size_t OFF_CNT    = 16 * 1024;
constexpr size_t OFF_BLKE   = 32 * 1024;
constexpr size_t OFF_MOD    = 64 * 1024;
constexpr size_t OFF_EIDX   = 1 * MiB;
constexpr size_t OFF_WTS    = 2 * MiB;
constexpr size_t OFF_APOS   = 3 * MiB;
constexpr size_t OFF_ROWTOK = 4 * MiB;
constexpr size_t OFF_WINT   = 8 * MiB;
constexpr size_t OFF_GLUT   = 20 * MiB;
constexpr size_t OFF_PAT    = OFF_GLUT + 128 * 1024;
constexpr size_t OFF_PBT    = OFF_PAT + 512 * 1024;
constexpr size_t OFF_WOUTT  = OFF_PBT + 1536 * 1024;
constexpr size_t OFF_U      = 34 * MiB;
constexpr size_t OFF_H      = 62 * MiB;
constexpr size_t OFF_Z      = 128 * MiB;
constexpr size_t OFF_YPART  = 62 * MiB;
constexpr size_t OFF_YA     = 26 * MiB;
constexpr size_t OFF_YB     = 42 * MiB;
constexpr size_t OFF_BT2    = 40 * MiB;
constexpr size_t OFF_X1     = 80 * MiB;
constexpr size_t OFF_HID2   = 208 * MiB;
constexpr size_t OFF_H2     = 232 * MiB;
constexpr size_t OFF_BT1    = 297 * MiB;
constexpr size_t OFF_Y2     = 232 * MiB;
constexpr size_t DO_OF = 0, DO_OB = 48 * MiB, DO_Y = 96 * MiB, DO_MERGED = 0, DO_HID1 = 0;

struct Params {
    const float *x, *c, *ctx, *c_ctx, *w_ada, *b_ada, *norm1_g, *norm2_g, *w_in, *lam_re, *lam_im, *log_dt, *b_re, *b_im, *c_re, *c_im, *s5_d, *w_glu, *lb_logits, *hg_norm_g,
                *p_a, *p_b, *w_out, *w_router, *b_router, *w1, *w3, *w2, *ws1, *ws3, *ws2, *final_g;
    unsigned char* ws; unsigned char* out;
};
__device__ __forceinline__ void ada_phase(const Params& p, LAS unsigned char* lds) {
    LAS float* sc = (LAS float*)lds;
    LAS float* red = (LAS float*)(lds + 5 * 1024 * 4);
    const int tid = threadIdx.x;
    float* mod = (float*)(p.ws + OFF_MOD);
    bool loaded = false;
    for (int item = blockIdx.x; item < 192; item += gridDim.x) {
        if (!loaded) {
            for (int i = tid; i < 5 * 1024; i += 512) { const int r = i >> 10, k = i & 1023; const float v = (r < 4) ? p.c[r * 1024 + k] : p.c_ctx[k]; sc[i] = siluf_(v); }
            loaded = true; __syncthreads();
        }
        const int n0 = item * 32, ks = tid >> 5, col = tid & 31;
        float a0 = 0.f, a1 = 0.f, a2 = 0.f, a3 = 0.f, a4 = 0.f;
        for (int k = ks * 64; k < ks * 64 + 64; ++k) {
            const float w = p.w_ada[(size_t)k * NIN + n0 + col];
            a0 += sc[k] * w; a1 += sc[1024 + k] * w; a2 += sc[2048 + k] * w; a3 += sc[3072 + k] * w; a4 += sc[4096 + k] * w;
        }
        red[(ks * 5 + 0) * 32 + col] = a0; red[(ks * 5 + 1) * 32 + col] = a1; red[(ks * 5 + 2) * 32 + col] = a2; red[(ks * 5 + 3) * 32 + col] = a3; red[(ks * 5 + 4) * 32 + col] = a4;
        __syncthreads();
        if (tid < 160) { const int r = tid >> 5, cc = tid & 31; float s = 0.f;
            for (int q = 0; q < 16; ++q) s += red[(q * 5 + r) * 32 + cc];
            mod[r * NIN + n0 + cc] = s + p.b_ada[n0 + cc]; }
        __syncthreads();
    }
}

template <class F>
__device__ __forceinline__ void cvt_tile(const float* src, int ld, int k0, int n0, bf16_t* dst, int ldd, int kdst0, F rowmap, LAS unsigned char* lds) {
    LAS float* t = (LAS float*)lds;
    const int tid = threadIdx.x;
#pragma unroll
    for (int j = 0; j < 2; ++j) { const int kr = (tid >> 4) + 32 * j, nc = (tid & 15) * 4;
        const f32x4 v = *(const f32x4*)(src + (size_t)(k0 + kr) * ld + n0 + nc);
        t[kr * 65 + nc] = v[0]; t[kr * 65 + nc + 1] = v[1]; t[kr * 65 + nc + 2] = v[2]; t[kr * 65 + nc + 3] = v[3]; }
    __syncthreads();
    { const int n = tid >> 3, kc = (tid & 7) * 8; float v[8];
#pragma unroll
      for (int j = 0; j < 8; ++j) v[j] = t[(kc + j) * 65 + n];
      u32x4 w; w.x = cvt_pk_bf16(v[0], v[1]); w.y = cvt_pk_bf16(v[2], v[3]); w.z = cvt_pk_bf16(v[4], v[5]); w.w = cvt_pk_bf16(v[6], v[7]);
      *(u32x4*)(dst + (size_t)rowmap(n0 + n) * ldd + kdst0 + k0 + kc) = w; }
    __syncthreads();
}

__device__ __forceinline__ void cvt_dense_phase(const Params& p, LAS unsigned char* lds) {
    bf16_t* WinT = (bf16_t*)(p.ws + OFF_WINT); bf16_t* gluT = (bf16_t*)(p.ws + OFF_GLUT); bf16_t* PaT = (bf16_t*)(p.ws + OFF_PAT); bf16_t* PbT = (bf16_t*)(p.ws + OFF_PBT); bf16_t* WoutT = (bf16_t*)(p.ws + OFF_WOUTT);
    auto id = [](int n) { return n; };
    constexpr int T_WIN = 16 * 96, T_GLU = 4 * 4, T_PA = 4 * 16, T_PB = 12 * 16, T_WO = 16 * 16, T_ALL = T_WIN + T_GLU + T_PA + T_PB + T_WO;
    for (int it = blockIdx.x; it < T_ALL; it += gridDim.x) {
        int i = it;
        if (i < T_WIN) { cvt_tile(p.w_in, NIN, (i / 96) * 64, (i % 96) * 64, WinT, 1024, 0, id, lds); continue; } i -= T_WIN;
        if (i < T_GLU) { cvt_tile(p.w_glu, 256, (i / 4) * 64, (i % 4) * 64, gluT, 256, 0, id, lds); continue; } i -= T_GLU;
        if (i < T_PA) { cvt_tile(p.p_a, 1024, (i / 16) * 64, (i % 16) * 64, PaT, 256, 0, id, lds); continue; } i -= T_PA;
        if (i < T_PB) { cvt_tile(p.p_b, 1024, (i / 16) * 64, (i % 16) * 64, PbT, 768, 0, id, lds); continue; } i -= T_PB;
        cvt_tile(p.w_out, 1024, (i / 16) * 64, (i % 16) * 64, WoutT, 1024, 0, id, lds);
    }
}

__device__ __forceinline__ void cvt_moe_phase(const Params& p, LAS unsigned char* lds) {
    bf16_t* Bt1 = (bf16_t*)(p.ws + OFF_BT1); bf16_t* Bt2 = (bf16_t*)(p.ws + OFF_BT2);
    auto m1 = [](int n) { return (n >> 7) * 256 + (n & 127); };
    auto m3 = [](int n) { return (n >> 7) * 256 + 128 + (n & 127); };
    auto id = [](int n) { return n; };
    constexpr int PER_E = 64 * 3;
    for (int it = blockIdx.x; it < 65 * PER_E; it += gridDim.x) {
        const int e = it / PER_E, j = it % PER_E, which = j / 64, t = j % 64;
        if (which == 0) { const float* s = (e < 64) ? p.w1 + (size_t)e * 1024 * 256 : p.ws1; cvt_tile(s, 256, (t / 4) * 64, (t % 4) * 64, Bt1 + (size_t)e * 512 * 1024, 1024, 0, m1, lds); }
        else if (which == 1) { const float* s = (e < 64) ? p.w3 + (size_t)e * 1024 * 256 : p.ws3; cvt_tile(s, 256, (t / 4) * 64, (t % 4) * 64, Bt1 + (size_t)e * 512 * 1024, 1024, 0, m3, lds); }
        else { const float* s = (e < 64) ? p.w2 + (size_t)e * 256 * 1024 : p.ws2; cvt_tile(s, 1024, (t / 16) * 64, (t % 16) * 64, Bt2 + (size_t)e * 1024 * 256, 256, 0, id, lds); }
    }
}

__device__ __forceinline__ void norm1_phase(const Params& p) {
    const int wid = threadIdx.x >> 6, lane = threadIdx.x & 63;
    const float* mod = (const float*)(p.ws + OFF_MOD); bf16_t* H = (bf16_t*)(p.ws + OFF_H);
    for (int r = blockIdx.x * 8 + wid; r < NROWS; r += gridDim.x * 8) {
        const float* src = (r < NTOK) ? p.x + (size_t)r * 1024 : p.ctx + (size_t)(r - NTOK) * 1024;
        const float* mr = mod + ((r < NTOK) ? (r / SEQ) : 4) * NIN;
        f32x4 v[4]; float ss = 0.f;
#pragma unroll
        for (int j = 0; j < 4; ++j) { v[j] = *(const f32x4*)(src + j * 256 + lane * 4); ss += v[j][0] * v[j][0] + v[j][1] * v[j][1] + v[j][2] * v[j][2] + v[j][3] * v[j][3]; }
        ss = wave_sum(ss);
        const float rstd = rsqrtf(ss * (1.0f / 1024.0f) + EPSF);
#pragma unroll
        for (int j = 0; j < 4; ++j) { const int k = j * 256 + lane * 4;
            const f32x4 g = *(const f32x4*)(p.norm1_g + k), sh = *(const f32x4*)(mr + k), scv = *(const f32x4*)(mr + 1024 + k);
            float o[4];
#pragma unroll
            for (int q = 0; q < 4; ++q) o[q] = v[j][q] * rstd * g[q] * (1.0f + scv[q]) + sh[q];
            u32x2 w; w.x = cvt_pk_bf16(o[0], o[1]); w.y = cvt_pk_bf16(o[2], o[3]);
            *(u32x2*)(H + (size_t)r * 1024 + k) = w; }
    }
}
struct PlainSched {
    ge::GridOrder go; const char* A; const char* B; size_t atile, btile;
    __device__ void init(const void* A_, int lda, const void* B_, int ldb, int nM, int nN) { A = (const char*)A_; B = (const char*)B_; atile = (size_t)256 * lda * 2; btile = (size_t)256 * ldb * 2; go.init(nM, nN, (int)gridDim.x, (int)blockIdx.x); }
    __device__ __forceinline__ bool next(int i, ge::Unit& u) const { u.e = 0; return go.tile(i, u.pm, u.pn); }
    __device__ __forceinline__ const char* a_base(const ge::Unit& u) const { return A + (size_t)u.pm * atile; }
    __device__ __forceinline__ const char* b_base(const ge::Unit& u) const { return B + (size_t)u.pn * btile; }
    __device__ __forceinline__ int a_row(const ge::Unit&, int) const { return 0; }
};

struct EpiZ {
    static constexpr bool PERM = true;
    bf16_t* U; bf16_t* Z;
    __device__ __forceinline__ void operator()(const f32x4 (&acc)[2][2][4][2], const ge::Unit& u, int wr, int wc, int fr, int fq) const {
        const int row0 = u.pm * 256 + wr * 64 + fr, cl = wc * 32 + 8 * fq;
        bf16_t* base; int ld;
        if (u.pn == 0) { base = U + cl; ld = 256; } else { base = Z + (u.pn - 1) * 256 + cl; ld = ZC; }
#pragma unroll
        for (int ai = 0; ai < 2; ++ai)
#pragma unroll
            for (int m = 0; m < 4; ++m) { bf16_t* rowp = base + (size_t)(row0 + ai * 128 + m * 16) * ld;
#pragma unroll
                for (int bj = 0; bj < 2; ++bj) { const f32x4 v0 = acc[ai][bj][m][0], v1 = acc[ai][bj][m][1];
                    u32x4 w; w.x = cvt_pk_bf16(v0[0], v0[1]); w.y = cvt_pk_bf16(v0[2], v0[3]); w.z = cvt_pk_bf16(v1[0], v1[1]); w.w = cvt_pk_bf16(v1[2], v1[3]);
                    *(u32x4*)(rowp + bj * 128) = w; } }
    }
};

struct EpiYa {
    static constexpr bool PERM = true;
    const bf16_t* Y; bf16_t* Ya;
    __device__ __forceinline__ void operator()(const f32x4 (&acc)[2][2][4][2], const ge::Unit& u, int wr, int wc, int fr, int fq) const {
        const int row0 = u.pm * 256 + wr * 64 + fr, col0 = u.pn * 256 + wc * 32 + 8 * fq;
#pragma unroll
        for (int ai = 0; ai < 2; ++ai)
#pragma unroll
            for (int m = 0; m < 4; ++m) { const size_t ro = (size_t)(row0 + ai * 128 + m * 16) * 256 + col0;
#pragma unroll
                for (int bj = 0; bj < 2; ++bj) { f32x4 v0 = acc[ai][bj][m][0], v1 = acc[ai][bj][m][1];
                    asm volatile("" : "+v"(v0), "+v"(v1));
                    const u32x4 yv = *(const u32x4*)(Y + ro + bj * 128);
                    float o[8];
                    o[0] = bf_lo(yv.x) * sigmoidf_(v0[0]); o[1] = bf_hi(yv.x) * sigmoidf_(v0[1]); o[2] = bf_lo(yv.y) * sigmoidf_(v0[2]); o[3] = bf_hi(yv.y) * sigmoidf_(v0[3]);
                    o[4] = bf_lo(yv.z) * sigmoidf_(v1[0]); o[5] = bf_hi(yv.z) * sigmoidf_(v1[1]); o[6] = bf_lo(yv.w) * sigmoidf_(v1[2]); o[7] = bf_hi(yv.w) * sigmoidf_(v1[3]);
                    u32x4 w; w.x = cvt_pk_bf16(o[0], o[1]); w.y = cvt_pk_bf16(o[2], o[3]); w.z = cvt_pk_bf16(o[4], o[5]); w.w = cvt_pk_bf16(o[6], o[7]);
                    *(u32x4*)(Ya + ro + bj * 128) = w; asm volatile("" ::: "memory"); } }
    }
};

template <bool ADD> struct EpiMerge {
    static constexpr bool PERM = true;
    const bf16_t* Z; int gcol0; bf16_t* Mg;
    __device__ __forceinline__ void operator()(const f32x4 (&acc)[2][2][4][2], const ge::Unit& u, int wr, int wc, int fr, int fq) const {
        const int row0 = u.pm * 256 + wr * 64 + fr, col0 = u.pn * 256 + wc * 32 + 8 * fq;
#pragma unroll
        for (int ai = 0; ai < 2; ++ai)
#pragma unroll
            for (int m = 0; m < 4; ++m) { const size_t row = (size_t)(row0 + ai * 128 + m * 16);
#pragma unroll
                for (int bj = 0; bj < 2; ++bj) { f32x4 v0 = acc[ai][bj][m][0], v1 = acc[ai][bj][m][1];
                    asm volatile("" : "+v"(v0), "+v"(v1));
                    const u32x4 gv = *(const u32x4*)(Z + row * ZC + gcol0 + col0 + bj * 128);
                    float o[8];
                    o[0] = sigmoidf_(bf_lo(gv.x)) * v0[0]; o[1] = sigmoidf_(bf_hi(gv.x)) * v0[1]; o[2] = sigmoidf_(bf_lo(gv.y)) * v0[2]; o[3] = sigmoidf_(bf_hi(gv.y)) * v0[3];
                    o[4] = sigmoidf_(bf_lo(gv.z)) * v1[0]; o[5] = sigmoidf_(bf_hi(gv.z)) * v1[1]; o[6] = sigmoidf_(bf_lo(gv.w)) * v1[2]; o[7] = sigmoidf_(bf_hi(gv.w)) * v1[3];
                    bf16_t* dst = Mg + row * 1024 + col0 + bj * 128;
                    if (ADD) { const u32x4 pv = *(const u32x4*)dst;
                        o[0] += bf_lo(pv.x); o[1] += bf_hi(pv.x); o[2] += bf_lo(pv.y); o[3] += bf_hi(pv.y); o[4] += bf_lo(pv.z); o[5] += bf_hi(pv.z); o[6] += bf_lo(pv.w); o[7] += bf_hi(pv.w); }
                    u32x4 w; w.x = cvt_pk_bf16(o[0], o[1]); w.y = cvt_pk_bf16(o[2], o[3]); w.z = cvt_pk_bf16(o[4], o[5]); w.w = cvt_pk_bf16(o[6], o[7]);
                    *(u32x4*)dst = w; asm volatile("" ::: "memory"); } }
    }
};

struct EpiX1 {
    static constexpr bool PERM = false;
    const float* X; const float* mod; float* X1;
    __device__ __forceinline__ void operator()(const f32x4 (&acc)[2][2][4][2], const ge::Unit& u, int wr, int wc, int fr, int fq) const {
        const int row0 = u.pm * 256 + wr * 64 + fr, col0 = u.pn * 256 + wc * 32 + 4 * fq;
        const float* g1 = mod + (size_t)((u.pm * 256) / SEQ) * NIN + 2048;
        f32x4 gv[2][2];
#pragma unroll
        for (int bj = 0; bj < 2; ++bj)
#pragma unroll
            for (int n = 0; n < 2; ++n) gv[bj][n] = *(const f32x4*)(g1 + col0 + bj * 128 + n * 16);
#pragma unroll
        for (int ai = 0; ai < 2; ++ai)
#pragma unroll
            for (int m = 0; m < 4; ++m) { const size_t off = (size_t)(row0 + ai * 128 + m * 16) * 1024 + col0;
#pragma unroll
                for (int bj = 0; bj < 2; ++bj)
#pragma unroll
                    for (int n = 0; n < 2; ++n) { const f32x4 xv = *(const f32x4*)(X + off + bj * 128 + n * 16);
                        *(f32x4*)(X1 + off + bj * 128 + n * 16) = xv + gv[bj][n] * acc[ai][bj][m][n]; } asm volatile("" ::: "memory"); }
    }
};

__device__ __forceinline__ bf16_t* hid_rows(unsigned char* ws, unsigned char* out, int rb) {
    return (rb < HID1_RB) ? (bf16_t*)(out + DO_HID1) + (size_t)rb * 256 * EH : (bf16_t*)(ws + OFF_HID2) + (size_t)(rb - HID1_RB) * 256 * EH;
}
struct MoeSched1 {
    const int* blk_e; const int* nblk; const int* row_tok; const char* h2; const char* bt1; int G, c;
    __device__ __forceinline__ bool next(int i, ge::Unit& u) const { const int L = i * G + c, nb = *nblk; if (L >= nb * 2) return false; u.pm = L >> 1; u.pn = L & 1; u.e = blk_e[u.pm]; return true; }
    __device__ __forceinline__ const char* a_base(const ge::Unit&) const { return h2; }
    __device__ __forceinline__ const char* b_base(const ge::Unit& u) const { return bt1 + ((size_t)u.e * 512 + (size_t)u.pn * 256) * 1024 * 2; }
    __device__ __forceinline__ int a_row(const ge::Unit& u, int r) const { return row_tok[u.pm * 256 + r]; }
};
struct EpiHid {
    static constexpr bool PERM = true;
    unsigned char* ws; unsigned char* out;
    __device__ __forceinline__ void operator()(const f32x4 (&acc)[2][2][4][2], const ge::Unit& u, int wr, int wc, int fr, int fq) const {
        bf16_t* base = hid_rows(ws, out, u.pm) + (size_t)(wr * 64 + fr) * EH + u.pn * 128 + wc * 32 + 8 * fq;
#pragma unroll
        for (int ai = 0; ai < 2; ++ai)
#pragma unroll
            for (int m = 0; m < 4; ++m) { const f32x4 a0 = acc[ai][0][m][0], a1 = acc[ai][0][m][1], b0 = acc[ai][1][m][0], b1 = acc[ai][1][m][1];
                u32x4 w; w.x = cvt_pk_bf16(siluf_(a0[0]) * b0[0], siluf_(a0[1]) * b0[1]); w.y = cvt_pk_bf16(siluf_(a0[2]) * b0[2], siluf_(a0[3]) * b0[3]);
                w.z = cvt_pk_bf16(siluf_(a1[0]) * b1[0], siluf_(a1[1]) * b1[1]); w.w = cvt_pk_bf16(siluf_(a1[2]) * b1[2], siluf_(a1[3]) * b1[3]);
                *(u32x4*)(base + (size_t)(ai * 128 + m * 16) * EH) = w; }
    }
};
struct MoeSched2 {
    const int* blk_e; const int* nblk; unsigned char* ws; unsigned char* out; const char* bt2; int half, G, c;
    __device__ __forceinline__ bool next(int i, ge::Unit& u) const { const int L = i * G + c, nb = *nblk; if (L >= nb * 2) return false; u.pm = L >> 1; u.pn = half * 2 + (L & 1); u.e = blk_e[u.pm]; return true; }
    __device__ __forceinline__ const char* a_base(const ge::Unit& u) const { return (const char*)hid_rows(ws, out, u.pm); }
    __device__ __forceinline__ const char* b_base(const ge::Unit& u) const { return bt2 + ((size_t)u.e * 1024 + (size_t)u.pn * 256) * EH * 2; }
    __device__ __forceinline__ int a_row(const ge::Unit&, int) const { return 0; }
};
struct EpiY2 {
    static constexpr bool PERM = true;
    bf16_t* Y2; float* X1; const float* mod; const int* pstart; int half;
    __device__ __forceinline__ void operator()(const f32x4 (&acc)[2][2][4][2], const ge::Unit& u, int wr, int wc, int fr, int fq) const {
        const int r0 = u.pm * 256 + wr * 64 + fr, colg = u.pn * 256 + wc * 32 + 8 * fq;
        if (u.e < NEXP) {
            bf16_t* base = Y2 + (size_t)r0 * 512 + (colg - half * 512);
#pragma unroll
            for (int ai = 0; ai < 2; ++ai)
#pragma unroll
                for (int m = 0; m < 4; ++m)
#pragma unroll
                    for (int bj = 0; bj < 2; ++bj) { const f32x4 v0 = acc[ai][bj][m][0], v1 = acc[ai][bj][m][1];
                        u32x4 w; w.x = cvt_pk_bf16(v0[0], v0[1]); w.y = cvt_pk_bf16(v0[2], v0[3]); w.z = cvt_pk_bf16(v1[0], v1[1]); w.w = cvt_pk_bf16(v1[2], v1[3]);
                        *(u32x4*)(base + (size_t)(ai * 128 + m * 16) * 512 + bj * 128) = w; }
        } else {
            const int t0 = r0 - pstart[NEXP];
            const float* g2 = mod + (size_t)((u.pm * 256 - pstart[NEXP]) / SEQ) * NIN + 5120;
#pragma unroll
            for (int ai = 0; ai < 2; ++ai)
#pragma unroll
                for (int m = 0; m < 4; ++m)
#pragma unroll
                    for (int bj = 0; bj < 2; ++bj) { float* dst = X1 + (size_t)(t0 + ai * 128 + m * 16) * 1024 + colg + bj * 128;
                        const f32x4 g0 = *(const f32x4*)(g2 + colg + bj * 128), g1v = *(const f32x4*)(g2 + colg + bj * 128 + 4);
                        *(f32x4*)dst = *(const f32x4*)dst + g0 * acc[ai][bj][m][0]; *(f32x4*)(dst + 4) = *(const f32x4*)(dst + 4) + g1v * acc[ai][bj][m][1]; asm volatile("" ::: "memory"); }
        }
    }
};
__device__ __forceinline__ void s5_naive_phase(const Params& p, LAS unsigned char* lds) {
    const int tid = threadIdx.x, wid = tid >> 6, lane = tid & 63;
    const bf16_t* U = (const bf16_t*)(p.ws + OFF_U); float* ypart = (float*)(p.ws + OFF_YPART);
    LAS f32x2* Cs = (LAS f32x2*)lds;
    LAS f32x2* ring = (LAS f32x2*)(lds + 16 * 64 * 8);
    for (int item = blockIdx.x; item < NB * 16; item += gridDim.x) {
        const int b = item >> 4, g = item & 15;
        __syncthreads();
        for (int i = tid; i < 16 * 64; i += blockDim.x) { const int cc = i >> 6, pp = i & 63; Cs[i] = (f32x2){p.c_re[(g * 16 + cc) * 64 + pp], p.c_im[(g * 16 + cc) * 64 + pp]}; }
        __syncthreads();
        if (wid < 2) {
            const int dir = wid;
            const int pi = (dir * 16 + g) * 64 + lane;
            const double lre = fmin((double)p.lam_re[pi], -1e-4), lim = (double)p.lam_im[pi], dt = exp((double)p.log_dt[dir * 16 + g]);
            const double er = exp(lre * dt), th = lim * dt, lbr = er * cos(th), lbi = er * sin(th);
            const double den = lre * lre + lim * lim, nr = lbr - 1.0, ni = lbi;
            const double cfr = (nr * lre + ni * lim) / den, cfi = (ni * lre - nr * lim) / den;
            float Br[16], Bi[16];
#pragma unroll
            for (int cc = 0; cc < 16; ++cc) { const double br = p.b_re[(size_t)pi * 16 + cc], bi = p.b_im[(size_t)pi * 16 + cc]; Br[cc] = (float)(cfr * br - cfi * bi); Bi[cc] = (float)(cfr * bi + cfi * br); }
            const float ar = (float)lbr, ai = (float)lbi;
            float xr = 0.f, xi = 0.f;
            LAS f32x2* rg = ring + wid * 16 * 64;
            const int oc = lane & 15, oq = lane >> 4;
            for (int s = 0; s < CTXL + SEQ; ++s) {
                int row, l = 0;
                if (s < CTXL) { const int lc = dir ? (CTXL - 1 - s) : s; row = NTOK + b * CTXL + lc; }
                else { l = dir ? (SEQ - 1 - (s - CTXL)) : (s - CTXL); row = b * SEQ + l; }
                const u32x4 u0 = *(const u32x4*)(U + (size_t)row * 256 + g * 16), u1 = *(const u32x4*)(U + (size_t)row * 256 + g * 16 + 8);
                float uu[16];
                uu[0] = bf_lo(u0.x); uu[1] = bf_hi(u0.x); uu[2] = bf_lo(u0.y); uu[3] = bf_hi(u0.y); uu[4] = bf_lo(u0.z); uu[5] = bf_hi(u0.z); uu[6] = bf_lo(u0.w); uu[7] = bf_hi(u0.w);
                uu[8] = bf_lo(u1.x); uu[9] = bf_hi(u1.x); uu[10] = bf_lo(u1.y); uu[11] = bf_hi(u1.y); uu[12] = bf_lo(u1.z); uu[13] = bf_hi(u1.z); uu[14] = bf_lo(u1.w); uu[15] = bf_hi(u1.w);
                float bur = 0.f, bui = 0.f;
#pragma unroll
                for (int cc = 0; cc < 16; ++cc) { bur += Br[cc] * uu[cc]; bui += Bi[cc] * uu[cc]; }
                const float nxr = ar * xr - ai * xi + bur, nxi = ar * xi + ai * xr + bui;
                xr = nxr; xi = nxi;
                if (s >= CTXL) {
                    const int k = (s - CTXL) & 15;
                    rg[k * 64 + lane] = (f32x2){xr, xi};
                    if (k == 15) {
                        asm volatile("s_waitcnt lgkmcnt(0)" ::: "memory");
#pragma unroll
                        for (int q = 0; q < 4; ++q) { const int kk = oq * 4 + q; float y = 0.f;
                            for (int pp = 0; pp < 64; ++pp) { const f32x2 xv = rg[kk * 64 + pp], cv = Cs[oc * 64 + pp]; y += xv.x * cv.x - xv.y * cv.y; }
                            const int lt = dir ? (l + 15 - kk) : (l - 15 + kk);
                            ypart[((size_t)dir * NTOK + (size_t)b * SEQ + lt) * 256 + g * 16 + oc] = y; }
                        asm volatile("s_waitcnt lgkmcnt(0)" ::: "memory");
                    }
                }
            }
        }
    }
}
__device__ __forceinline__ void s5_fin_phase(const Params& p) {
    const bf16_t* U = (const bf16_t*)(p.ws + OFF_U); const float* ypart = (const float*)(p.ws + OFF_YPART); bf16_t* Y = (bf16_t*)(p.out + DO_Y);
    for (size_t i = (size_t)blockIdx.x * blockDim.x + threadIdx.x; i < (size_t)NTOK * 256; i += (size_t)gridDim.x * blockDim.x) {
        const float v = ypart[i] + ypart[(size_t)NTOK * 256 + i] + p.s5_d[i & 255] * bf2f(U[i]);
        Y[i] = f2bf(gelu_tanh(v));
    }
}

__device__ __forceinline__ void gla_naive_phase(const Params& p, LAS unsigned char* lds) {
    const int tid = threadIdx.x;
    const bf16_t* Z = (const bf16_t*)(p.ws + OFF_Z);
    LAS float* buf = (LAS float*)lds;
    for (int item = blockIdx.x; item < NB * 6 * 2; item += gridDim.x) {
        const int dir = item & 1, h = (item >> 1) % 6, b = item / 12;
        bf16_t* O = (bf16_t*)(p.out + (dir ? DO_OB : DO_OF));
        const int v = tid >> 2, iq = tid & 3;
        float S[32];
#pragma unroll
        for (int j = 0; j < 32; ++j) S[j] = 0.f;
        const int role = tid >> 7, ii = tid & 127;
        float lbv = 0.f;
        if (role == 0) { const float l0 = p.lb_logits[h * 128 + ii], l1 = p.lb_logits[768 + h * 128 + ii]; lbv = 1.0f / (1.0f + __expf(l1 - l0)); }
        const int colsel = (role == 0) ? ((dir ? ZFB : ZFF) + h * 128 + ii) : (role == 1) ? (ZQ + h * 128 + ii) : (ZI + h * 128 + ii);
        auto rowof = [&](int s, int& l) -> size_t {
            if (s < CTXL) { const int lc = dir ? (CTXL - 1 - s) : s; l = -1; return (size_t)(NTOK + b * CTXL + lc); }
            const int j = dir ? (SEQ - 1 - (s - CTXL)) : (s - CTXL); l = (j & 127) * 64 + (j >> 7); return (size_t)(b * SEQ + l);
        };
        int lcur; float pre = 0.f;
        { const size_t r0 = rowof(0, lcur); if (role < 3) pre = bf2f(Z[r0 * ZC + colsel]); }
        __syncthreads();
        for (int s = 0; s < CTXL + SEQ; ++s) {
            LAS float* bb = buf + (s & 1) * 512;
            int lthis; (void)rowof(s, lthis);
            if (role == 0) { const float sg = sigmoidf_(pre); bb[ii] = lbv + (1.0f - lbv) * sg; bb[128 + ii] = (1.0f - lbv) * (1.0f - sg); }
            else if (role == 1) bb[256 + ii] = pre;
            else if (role == 2) bb[384 + ii] = pre;
            if (s + 1 < CTXL + SEQ) { int ln; const size_t rn = rowof(s + 1, ln); if (role < 3) pre = bf2f(Z[rn * ZC + colsel]); }
            __syncthreads();
            const float vv = bb[384 + v];
            float o = 0.f;
#pragma unroll
            for (int j4 = 0; j4 < 8; ++j4) {
                const f32x4 f4 = *(const LAS f32x4*)(bb + iq * 32 + j4 * 4), k4 = *(const LAS f32x4*)(bb + 128 + iq * 32 + j4 * 4), q4 = *(const LAS f32x4*)(bb + 256 + iq * 32 + j4 * 4);
#pragma unroll
                for (int e = 0; e < 4; ++e) { const float sn = f4[e] * S[j4 * 4 + e] + k4[e] * vv; S[j4 * 4 + e] = sn; o += sn * q4[e]; }
            }
            o += __shfl_xor(o, 1); o += __shfl_xor(o, 2);
            if (lthis >= 0 && iq == 0) O[(size_t)(b * SEQ + lthis) * 768 + h * 128 + v] = f2bf(o);
        }
        __syncthreads();
    }
}
__device__ __forceinline__ void yb_phase(const Params& p) {
    const int wid = threadIdx.x >> 6, lane = threadIdx.x & 63;
    const bf16_t* Of = (const bf16_t*)(p.out + DO_OF); const bf16_t* Ob = (const bf16_t*)(p.out + DO_OB); const bf16_t* Z = (const bf16_t*)(p.ws + OFF_Z); bf16_t* Yb = (bf16_t*)(p.ws + OFF_YB);
    const float gn0 = p.hg_norm_g[lane * 2], gn1 = p.hg_norm_g[lane * 2 + 1];
    for (int t = blockIdx.x * 8 + wid; t < NTOK; t += gridDim.x * 8) {
#pragma unroll
        for (int h = 0; h < 6; ++h) {
            const int col = h * 128 + lane * 2;
            const unsigned a = *(const unsigned*)(Of + (size_t)t * 768 + col), bb = *(const unsigned*)(Ob + (size_t)t * 768 + col), gw = *(const unsigned*)(Z + (size_t)t * ZC + ZGO + col);
            const float o0 = bf_lo(a) + bf_lo(bb), o1 = bf_hi(a) + bf_hi(bb);
            const float ss = wave_sum(o0 * o0 + o1 * o1);
            const float rstd = rsqrtf(ss * (1.0f / 128.0f) + EPSF);
            *(unsigned*)(Yb + (size_t)t * 768 + col) = cvt_pk_bf16(o0 * rstd * gn0 * siluf_(bf_lo(gw)), o1 * rstd * gn1 * siluf_(bf_hi(gw)));
        }
    }
}

__device__ __forceinline__ void route_phase(const Params& p, LAS unsigned char* lds) {
    const int tid = threadIdx.x, wid = tid >> 6, lane = tid & 63;
    LAS float* hs = (LAS float*)lds;
    LAS float* part = (LAS float*)(lds + 32768);
    const float* X1 = (const float*)(p.ws + OFF_X1); const float* mod = (const float*)(p.ws + OFF_MOD);
    bf16_t* H2 = (bf16_t*)(p.ws + OFF_H2); int* eidx = (int*)(p.ws + OFF_EIDX); float* wts = (float*)(p.ws + OFF_WTS); int* counts = (int*)(p.ws + OFF_CNT);
    if (blockIdx.x == 0) for (int i = tid; i < 512; i += blockDim.x) *(unsigned*)(H2 + (size_t)NTOK * 1024 + i * 2) = 0u;
    for (int grp = blockIdx.x; grp < NTOK / 8; grp += gridDim.x) {
        { const int t = grp * 8 + wid; const float* src = X1 + (size_t)t * 1024; const float* mr = mod + (size_t)(t / SEQ) * NIN;
          f32x4 v[4]; float ss = 0.f;
#pragma unroll
          for (int j = 0; j < 4; ++j) { v[j] = *(const f32x4*)(src + j * 256 + lane * 4); ss += v[j][0] * v[j][0] + v[j][1] * v[j][1] + v[j][2] * v[j][2] + v[j][3] * v[j][3]; }
          ss = wave_sum(ss); const float rstd = rsqrtf(ss * (1.0f / 1024.0f) + EPSF);
#pragma unroll
          for (int j = 0; j < 4; ++j) { const int k = j * 256 + lane * 4;
              const f32x4 g = *(const f32x4*)(p.norm2_g + k), sh = *(const f32x4*)(mr + 3072 + k), scv = *(const f32x4*)(mr + 4096 + k);
              f32x4 o;
#pragma unroll
              for (int q = 0; q < 4; ++q) o[q] = v[j][q] * rstd * g[q] * (1.0f + scv[q]) + sh[q];
              *(LAS f32x4*)(hs + wid * 1024 + k) = o;
              u32x2 w; w.x = cvt_pk_bf16(o[0], o[1]); w.y = cvt_pk_bf16(o[2], o[3]); *(u32x2*)(H2 + (size_t)t * 1024 + k) = w; } }
        __syncthreads();
        { float a[8];
#pragma unroll
          for (int q = 0; q < 8; ++q) a[q] = 0.f;
          for (int k = wid * 128; k < wid * 128 + 128; ++k) { const float w = p.w_router[k * 64 + lane];
#pragma unroll
              for (int q = 0; q < 8; ++q) a[q] += hs[q * 1024 + k] * w; }
#pragma unroll
          for (int q = 0; q < 8; ++q) part[(wid * 8 + q) * 64 + lane] = a[q]; }
        __syncthreads();
        { const int t = grp * 8 + wid; float logit = 0.f;
#pragma unroll
          for (int w = 0; w < 8; ++w) logit += part[(w * 8 + wid) * 64 + lane];
          const float sc = 1.0f / (1.0f + expf(-logit)), bs = sc + p.b_router[lane];
          float m1 = bs;
          m1 = fmaxf(m1, __shfl_xor(m1, 1)); m1 = fmaxf(m1, __shfl_xor(m1, 2)); m1 = fmaxf(m1, __shfl_xor(m1, 4));
          const unsigned long long ism = __ballot(bs == m1);
          const int gbase = lane & ~7; const unsigned gm = (unsigned)((ism >> gbase) & 0xffull);
          const int first = gbase + __builtin_ctz(gm);
          float m2 = (lane == first) ? -INFINITY : bs;
          m2 = fmaxf(m2, __shfl_xor(m2, 1)); m2 = fmaxf(m2, __shfl_xor(m2, 2)); m2 = fmaxf(m2, __shfl_xor(m2, 4));
          const float gs = m1 + m2; const int gid = lane >> 3;
          int grank = 0;
#pragma unroll
          for (int g2 = 0; g2 < 8; ++g2) { const float og = __shfl(gs, g2 * 8); grank += (og > gs || (og == gs && g2 < gid)) ? 1 : 0; }
          const bool gok = grank < 4;
          const float mk = gok ? bs : -INFINITY;
          int rank = 0;
          for (int e2 = 0; e2 < 64; ++e2) { const float ov = __shfl(mk, e2); rank += (ov > mk || (ov == mk && e2 < lane)) ? 1 : 0; }
          const bool sel = gok && rank < TOPK;
          const float wsum = wave_sum(sel ? sc : 0.f);
          if (sel) { eidx[t * 8 + rank] = lane; wts[t * 8 + rank] = sc / wsum * 2.5f; atomicAdd(&counts[lane], 1); } }
        __syncthreads();
    }
}

__device__ __forceinline__ void offsets_phase(const Params& p) {
    int* cnt = (int*)(p.ws + OFF_CNT); int* cursor = cnt + 64; int* pstart = cnt + 128; int* nblk = cnt + 256; int* blk_e = (int*)(p.ws + OFF_BLKE);
    if (blockIdx.x != 0) return;
    __shared__ int ps[66];
    if (threadIdx.x == 0) { int a = 0; for (int e = 0; e < 64; ++e) { ps[e] = a; a += (cnt[e] + 255) / 256 * 256; } ps[64] = a; ps[65] = a + NTOK; }
    __syncthreads();
    if (threadIdx.x < 66) pstart[threadIdx.x] = ps[threadIdx.x];
    if (threadIdx.x < 64) cursor[threadIdx.x] = 0;
    if (threadIdx.x == 0) *nblk = ps[65] / 256;
    for (int rb = threadIdx.x; rb < ps[65] / 256; rb += blockDim.x) { int e = 0; while (e < 64 && rb * 256 >= ps[e + 1]) ++e; blk_e[rb] = e; }
}
__device__ __forceinline__ void scatter_phase(const Params& p) {
    int* cnt = (int*)(p.ws + OFF_CNT); int* cursor = cnt + 64; const int* pstart = cnt + 128;
    const int* eidx = (const int*)(p.ws + OFF_EIDX); int* apos = (int*)(p.ws + OFF_APOS); int* row_tok = (int*)(p.ws + OFF_ROWTOK);
    const int gt = blockIdx.x * blockDim.x + threadIdx.x, gs = gridDim.x * blockDim.x;
    for (int i = gt; i < NTOK * TOPK; i += gs) { const int e = eidx[i]; const int pos = pstart[e] + atomicAdd(&cursor[e], 1); row_tok[pos] = i >> 3; apos[i] = pos; }
    for (int i = gt; i < 64 * 256; i += gs) { const int e = i >> 8, j = i & 255; const int pos = pstart[e] + cnt[e] + j; if (pos < pstart[e + 1]) row_tok[pos] = NTOK; }
    for (int i = gt; i < NTOK; i += gs) row_tok[pstart[64] + i] = i;
}

template <int HALFI>
__device__ __forceinline__ void combine_phase(const Params& p) {
    const int wid = threadIdx.x >> 6, lane = threadIdx.x & 63;
    float* X1 = (float*)(p.ws + OFF_X1); const float* mod = (const float*)(p.ws + OFF_MOD); const bf16_t* Y2 = (const bf16_t*)(p.ws + OFF_Y2);
    const int* apos = (const int*)(p.ws + OFF_APOS); const float* wts = (const float*)(p.ws + OFF_WTS); float* out = (float*)p.out;
    for (int t = blockIdx.x * 8 + wid; t < NTOK; t += gridDim.x * 8) {
        float a[8];
#pragma unroll
        for (int q = 0; q < 8; ++q) a[q] = 0.f;
#pragma unroll
        for (int k = 0; k < TOPK; ++k) { const int pos = apos[t * 8 + k]; const float w = wts[t * 8 + k];
            const u32x4 yv = *(const u32x4*)(Y2 + (size_t)pos * 512 + lane * 8);
            a[0] += w * bf_lo(yv.x); a[1] += w * bf_hi(yv.x); a[2] += w * bf_lo(yv.y); a[3] += w * bf_hi(yv.y); a[4] += w * bf_lo(yv.z); a[5] += w * bf_hi(yv.z); a[6] += w * bf_lo(yv.w); a[7] += w * bf_hi(yv.w); }
        const int col = HALFI * 512 + lane * 8;
        const float* g2 = mod + (size_t)(t / SEQ) * NIN + 5120 + col;
        float* xp = X1 + (size_t)t * 1024 + col;
        f32x4 v0 = *(const f32x4*)xp, v1 = *(const f32x4*)(xp + 4);
        const f32x4 ga = *(const f32x4*)g2, gb = *(const f32x4*)(g2 + 4);
#pragma unroll
        for (int q = 0; q < 4; ++q) { v0[q] += ga[q] * a[q]; v1[q] += gb[q] * a[4 + q]; }
        if (HALFI == 0) { *(f32x4*)xp = v0; *(f32x4*)(xp + 4) = v1; }
        else {
            const float* xo = X1 + (size_t)t * 1024 + lane * 8;
            const f32x4 w0 = *(const f32x4*)xo, w1 = *(const f32x4*)(xo + 4);
            float ss = 0.f;
#pragma unroll
            for (int q = 0; q < 4; ++q) ss += v0[q] * v0[q] + v1[q] * v1[q] + w0[q] * w0[q] + w1[q] * w1[q];
            ss = wave_sum(ss); const float rstd = rsqrtf(ss * (1.0f / 1024.0f) + EPSF);
            const float* gf = p.final_g; float* op = out + (size_t)t * 1024;
            const f32x4 f0 = *(const f32x4*)(gf + lane * 8), f1 = *(const f32x4*)(gf + lane * 8 + 4), f2 = *(const f32x4*)(gf + col), f3 = *(const f32x4*)(gf + col + 4);
            *(f32x4*)(op + lane * 8) = w0 * rstd * f0; *(f32x4*)(op + lane * 8 + 4) = w1 * rstd * f1;
            *(f32x4*)(op + col) = v0 * rstd * f2; *(f32x4*)(op + col + 4) = v1 * rstd * f3;
        }
    }
}
#define DYN_LDS extern __shared__ __attribute__((aligned(16))) unsigned char shm[]; LAS unsigned char* lds = (LAS unsigned char*)shm

__global__ __launch_bounds__(512, 2) void k_prep0(Params p) { DYN_LDS;
    if (blockIdx.x == 0 && threadIdx.x < 128) ((int*)(p.ws + OFF_CNT))[threadIdx.x] = 0;
    ada_phase(p, lds); }
__global__ __launch_bounds__(512, 2) void k_prep1(Params p) { DYN_LDS; cvt_dense_phase(p, lds); norm1_phase(p); }
__global__ __launch_bounds__(512, 2) void k_gemm_z(Params p) { DYN_LDS;
    PlainSched S; S.init(p.ws + OFF_H, 1024, p.ws + OFF_WINT, 1024, NROWS / 256, NIN / 256);
    EpiZ E{(bf16_t*)(p.ws + OFF_U), (bf16_t*)(p.ws + OFF_Z)};
    ge::gemm_phase<EpiZ, PlainSched, false>(lds, 1024, 1024, 1024, S, E); }
__global__ __launch_bounds__(512, 2) void k_gla_naive(Params p) { DYN_LDS; gla_naive_phase(p, lds); }
__global__ __launch_bounds__(512, 2) void k_s5_naive(Params p) { DYN_LDS; s5_naive_phase(p, lds); }
__global__ __launch_bounds__(512, 2) void k_s5_fin(Params p) { s5_fin_phase(p); }
__global__ __launch_bounds__(512, 2) void k_post(Params p) { DYN_LDS;
    yb_phase(p);
    PlainSched S; S.init(p.out + DO_Y, 256, p.ws + OFF_GLUT, 256, NTOK / 256, 1);
    EpiYa E{(const bf16_t*)(p.out + DO_Y), (bf16_t*)(p.ws + OFF_YA)};
    ge::gemm_phase<EpiYa, PlainSched, false>(lds, 256, 256, 256, S, E); }
__global__ __launch_bounds__(512, 2) void k_gemm_ta(Params p) { DYN_LDS;
    PlainSched S; S.init(p.ws + OFF_YA, 256, p.ws + OFF_PAT, 256, NTOK / 256, 4);
    EpiMerge<false> E{(const bf16_t*)(p.ws + OFF_Z), ZGA, (bf16_t*)(p.out + DO_MERGED)};
    ge::gemm_phase<EpiMerge<false>, PlainSched, false>(lds, 256, 256, 256, S, E); }
__global__ __launch_bounds__(512, 2) void k_gemm_tb(Params p) { DYN_LDS;
    PlainSched S; S.init(p.ws + OFF_YB, 768, p.ws + OFF_PBT, 768, NTOK / 256, 4);
    EpiMerge<true> E{(const bf16_t*)(p.ws + OFF_Z), ZGB, (bf16_t*)(p.out + DO_MERGED)};
    ge::gemm_phase<EpiMerge<true>, PlainSched, false>(lds, 768, 768, 768, S, E); }
__global__ __launch_bounds__(512, 2) void k_gemm_x1(Params p) { DYN_LDS;
    PlainSched S; S.init(p.out + DO_MERGED, 1024, p.ws + OFF_WOUTT, 1024, NTOK / 256, 4);
    EpiX1 E{p.x, (const float*)(p.ws + OFF_MOD), (float*)(p.ws + OFF_X1)};
    ge::gemm_phase<EpiX1, PlainSched, false>(lds, 1024, 1024, 1024, S, E); }
__global__ __launch_bounds__(512, 2) void k_route(Params p) { DYN_LDS; route_phase(p, lds); }
__global__ __launch_bounds__(512, 2) void k_offsets(Params p) { offsets_phase(p); }
__global__ __launch_bounds__(512, 2) void k_scatter(Params p) { DYN_LDS; scatter_phase(p); cvt_moe_phase(p, lds); }
__global__ __launch_bounds__(512, 2) void k_moe1(Params p) { DYN_LDS;
    const int* cnt = (const int*)(p.ws + OFF_CNT);
    MoeSched1 S{(const int*)(p.ws + OFF_BLKE), cnt + 256, (const int*)(p.ws + OFF_ROWTOK), (const char*)(p.ws + OFF_H2), (const char*)(p.ws + OFF_BT1), (int)gridDim.x, (int)blockIdx.x};
    EpiHid E{p.ws, p.out};
    ge::gemm_phase<EpiHid, MoeSched1, true>(lds, 1024, 1024, 1024, S, E); }
template <int HALFI> __global__ __launch_bounds__(512, 2) void k_moe2(Params p) { DYN_LDS;
    const int* cnt = (const int*)(p.ws + OFF_CNT);
    MoeSched2 S{(const int*)(p.ws + OFF_BLKE), cnt + 256, p.ws, p.out, (const char*)(p.ws + OFF_BT2), HALFI, (int)gridDim.x, (int)blockIdx.x};
    EpiY2 E{(bf16_t*)(p.ws + OFF_Y2), (float*)(p.ws + OFF_X1), (const float*)(p.ws + OFF_MOD), cnt + 128, HALFI};
    ge::gemm_phase<EpiY2, MoeSched2, false>(lds, 256, 256, 256, S, E); }
template <int HALFI> __global__ __launch_bounds__(512, 2) void k_comb(Params p) { combine_phase<HALFI>(p); }

static Params make_params(void* const* d_in, void* d_out, void* d_ws) {
    Params p{};
    const float** f = (const float**)&p;
    for (int i = 0; i < 32; ++i) f[i] = (const float*)d_in[i];
    p.ws = (unsigned char*)d_ws; p.out = (unsigned char*)d_out;
    return p;
}

extern "C" void kernel_launch(void* const* d_in, const int* in_sizes, int n_in, void* d_out, int out_size, void* d_ws, size_t ws_size, hipStream_t stream) {
    (void)in_sizes; (void)n_in; (void)out_size; (void)ws_size;
    constexpr int LDSB = ge::STAGE_BYTES;
    static bool attr = false;
    if (!attr) {
        const void* ks[] = {(const void*)k_prep0, (const void*)k_prep1, (const void*)k_gemm_z, (const void*)k_gla_naive, (const void*)k_s5_naive, (const void*)k_post, (const void*)k_gemm_ta, (const void*)k_gemm_tb,
                            (const void*)k_gemm_x1, (const void*)k_route, (const void*)k_scatter, (const void*)k_moe1, (const void*)k_moe2<0>, (const void*)k_moe2<1>};
        for (const void* k : ks) hipFuncSetAttribute(k, hipFuncAttributeMaxDynamicSharedMemorySize, LDSB);
        attr = true;
    }
    const Params p = make_params(d_in, d_out, d_ws);
    const dim3 G(256), B(512);
    hipLaunchKernelGGL(k_prep0, G, B, LDSB, stream, p);
    hipLaunchKernelGGL(k_prep1, G, B, LDSB, stream, p);
    hipLaunchKernelGGL(k_gemm_z, G, B, LDSB, stream, p);
    hipLaunchKernelGGL(k_gla_naive, G, B, LDSB, stream, p);
    hipLaunchKernelGGL(k_s5_naive, G, B, LDSB, stream, p);
    hipLaunchKernelGGL(k_s5_fin, G, B, 0, stream, p);
    hipLaunchKernelGGL(k_post, G, B, LDSB, stream, p);
    hipLaunchKernelGGL(k_gemm_ta, G, B, LDSB, stream, p);
    hipLaunchKernelGGL(k_gemm_tb, G, B, LDSB, stream, p);
    hipLaunchKernelGGL(k_gemm_x1, G, B, LDSB, stream, p);
    hipLaunchKernelGGL(k_route, G, B, LDSB, stream, p);
    hipLaunchKernelGGL(k_offsets, G, B, 0, stream, p);
    hipLaunchKernelGGL(k_scatter, G, B, LDSB, stream, p);
    hipLaunchKernelGGL(k_moe1, G, B, LDSB, stream, p);
    hipLaunchKernelGGL(k_moe2<0>, G, B, LDSB, stream, p);
    hipLaunchKernelGGL(k_comb<0>, G, B, 0, stream, p);
    hipLaunchKernelGGL(k_moe2<1>, G, B, LDSB, stream, p);
    hipLaunchKernelGGL(k_comb<1>, G, B, 0, stream, p);
}
```

```cpp
#include <hip/hip_runtime.h>
#include <stdint.h>
#include <stdio.h>

#define LAS __attribute__((address_space(3)))
typedef unsigned short bf16_t;
typedef short bf16x8 __attribute__((ext_vector_type(8)));
typedef float f32x4 __attribute__((ext_vector_type(4)));
typedef float f32x2 __attribute__((ext_vector_type(2)));
typedef unsigned u32x4 __attribute__((ext_vector_type(4)));
typedef unsigned u32x2 __attribute__((ext_vector_type(2)));

constexpr int NB = 4, SEQ = 8192, DM = 1024, NTOK = NB * SEQ, CTXL = 256, NCTX = NB * CTXL, NROWS = NTOK + NCTX;
constexpr int NIN = 6144, ZC = 5888;
constexpr int ZQ = 0, ZFF = 768, ZFB = 1536, ZI = 2304, ZGO = 3072, ZGA = 3840, ZGB = 4864;
constexpr int NEXP = 64, TOPK = 8, EH = 256;
constexpr int CAP_ROUTED = NTOK * TOPK + NEXP * 256;
constexpr int CAP_ROWS = CAP_ROUTED + NTOK;
constexpr int HID1_RB = 1024;
constexpr float EPSF = 1e-6f;

__device__ __forceinline__ unsigned cvt_pk_bf16(float lo, float hi) { unsigned r; asm volatile("v_cvt_pk_bf16_f32 %0, %1, %2" : "=v"(r) : "v"(lo), "v"(hi)); return r; }
__device__ __forceinline__ float bf_lo(unsigned w) { return __uint_as_float(w << 16); }
__device__ __forceinline__ float bf_hi(unsigned w) { return __uint_as_float(w & 0xffff0000u); }
__device__ __forceinline__ float bf2f(bf16_t b) { return __uint_as_float(((unsigned)b) << 16); }
__device__ __forceinline__ bf16_t f2bf(float f) { return (bf16_t)(cvt_pk_bf16(f, 0.f) & 0xffffu); }
__device__ __forceinline__ float sigmoidf_(float x) { return 1.0f / (1.0f + __expf(-x)); }
__device__ __forceinline__ float siluf_(float x) { return x / (1.0f + __expf(-x)); }
__device__ __forceinline__ float wave_sum(float v) {
#pragma unroll
    for (int o = 32; o >= 1; o >>= 1) v += __shfl_xor(v, o);
    return v;
}
__device__ __forceinline__ float gelu_tanh(float y) {
    const float u = 0.7978845608028654f * (y + 0.044715f * y * y * y);
    const float e = __expf(2.0f * u);
    const float t = 1.0f - 2.0f / (e + 1.0f);
    return 0.5f * y * (1.0f + t);
}
#define XB_TMO      128
#define XB_XCNT(j)  (256  + 64 * (j))
#define XB_XSUB(j)  (1280 + 64 * (j))
#define XB_XGEN(j)  (2304 + 64 * (j))
#define XB_TOP      3328
#define XB_TOPGEN   3392
#define XCD_BAR_WORDS 3456
#define XB_SPIN_CAP (1u << 18)

__device__ __forceinline__ unsigned xb_ld(unsigned* p)              { return __hip_atomic_load(p, __ATOMIC_RELAXED, __HIP_MEMORY_SCOPE_AGENT); }
__device__ __forceinline__ unsigned xb_add(unsigned* p, unsigned v) { return __hip_atomic_fetch_add(p, v, __ATOMIC_RELAXED, __HIP_MEMORY_SCOPE_AGENT); }
__device__ __forceinline__ unsigned xb_xcc_id() { return (unsigned)__builtin_amdgcn_s_getreg((3 << 11) | 20) & 0xFu; }
#define XB_SPIN(cond, bar) do { unsigned _sp = 0; while (cond) { __builtin_amdgcn_s_sleep(1); \
    if ((++_sp & 255u) == 0u) { if (xb_ld(&(bar)[XB_TMO])) break; if (_sp > XB_SPIN_CAP) { atomicAdd(&(bar)[XB_TMO], 1u); break; } } } } while (0)

struct XcdBarrier {
    unsigned* bar; unsigned x;
    volatile LAS unsigned* st;
};

__device__ __forceinline__ XcdBarrier xcd_barrier_post(unsigned* bar, volatile LAS unsigned* st) {
    XcdBarrier b; b.bar = bar; b.x = xb_xcc_id(); b.st = st;
    if (threadIdx.x == 0) (void)xb_add(&bar[XB_XCNT(b.x)], 1u);
    return b;
}
__device__ __forceinline__ void xcd_barrier_complete(unsigned* bar, unsigned x, unsigned& nloc, unsigned& nx) {
    const unsigned G = gridDim.x * gridDim.y * gridDim.z;
    unsigned sum, cnt, mine, sp = 0u;
    for (;;) {
        sum = 0u; cnt = 0u; mine = 0u;
#pragma unroll
        for (unsigned j = 0; j < 16; ++j) { const unsigned c = xb_ld(&bar[XB_XCNT(j)]); sum += c; cnt += (c > 0u) ? 1u : 0u; mine = (j == x) ? c : mine; }
        if (sum == G) break;
        __builtin_amdgcn_s_sleep(1);
        if ((++sp & 255u) == 0u) { if (xb_ld(&bar[XB_TMO])) break; if (sp > XB_SPIN_CAP) { atomicAdd(&bar[XB_TMO], 1u); break; } }
    }
    nloc = mine > 0u ? mine : 1u; nx = cnt > 0u ? cnt : 1u;
}

__device__ __forceinline__ void xcd_barrier(const XcdBarrier& b) {
    asm volatile("s_waitcnt vmcnt(0)" ::: "memory");
    __syncthreads();
    if (threadIdx.x == 0) {
        unsigned* bar = b.bar;
        __builtin_amdgcn_s_waitcnt(0);
        unsigned nloc = b.st[0], nx = b.st[1];
        if (nloc == 0u) { xcd_barrier_complete(bar, b.x, nloc, nx); b.st[0] = nloc; b.st[1] = nx; }
        const unsigned old = xb_add(&bar[XB_XSUB(b.x)], 1u);
        const unsigned gen = old / nloc;
        if (old + 1u == (gen + 1u) * nloc) {
            __builtin_amdgcn_fence(__ATOMIC_RELEASE, "agent");
            asm volatile("s_waitcnt vmcnt(0)" ::: "memory");
            const unsigned og = xb_add(&bar[XB_TOP], 1u);
            const unsigned tg = og / nx;
            if (og + 1u == (tg + 1u) * nx) xb_add(&bar[XB_TOPGEN], 1u);
            else XB_SPIN(xb_ld(&bar[XB_TOPGEN]) == tg, bar);
            __builtin_amdgcn_fence(__ATOMIC_ACQUIRE, "agent");
            xb_add(&bar[XB_XGEN(b.x)], 1u);
            asm volatile("s_waitcnt vmcnt(0)" ::: "memory");
        } else {
            XB_SPIN(xb_ld(&bar[XB_XGEN(b.x)]) == gen, bar);
            __builtin_amdgcn_fence(__ATOMIC_ACQUIRE, "agent");
            asm volatile("s_waitcnt vmcnt(0)" ::: "memory");
        }
    }
    __syncthreads();
}

namespace ge {
constexpr int BM = 256, BK = 64, HALF = 128, HTB = HALF * BK * 2, STAGE_BYTES = 8 * HTB, NXCD = 8, WGM = 8;
__host__ __device__ __forceinline__ int lds_byte(int r, int c) { const int st = (r >> 4) * 2 + (c >> 5), rr = r & 15, cc = c & 31, ob = rr * 64 + cc * 2; return st * 1024 + (ob ^ (((ob >> 9) & 1) << 5)); }
__host__ __device__ __forceinline__ void stage_rc(int b, int& R, int& C) { const int st = b / 1024, sb = b % 1024, swz = sb ^ (((sb >> 9) & 1) << 5); R = (st >> 1) * 16 + swz / 64; C = (st & 1) * 32 + (swz % 64) / 2; }
__host__ __device__ __forceinline__ int perm32(int rho) { const int n = rho >> 4, i = rho & 15; return 8 * (i >> 2) + 4 * n + (i & 3); }

struct Unit { int pm, pn, e; };

struct GridOrder {
    int nM, nN, nwg, G, c;
    __device__ void init(int nM_, int nN_, int G_, int c_) { nM = nM_; nN = nN_; nwg = nM * nN; G = G_; c = c_; }
    __device__ bool tile(int i, int& pm, int& pn) const {
        const long L = (long)i * G + c; if (L >= nwg) return false;
        int wgid = (int)L; { const int q = nwg / NXCD, r = nwg % NXCD, xcd = wgid % NXCD, off = wgid / NXCD; wgid = (xcd < r ? xcd * (q + 1) : r * (q + 1) + (xcd - r) * q) + off; }
        const int nig = WGM * nN, gid = wgid / nig, fm = gid * WGM, gsz = (nM - fm) < WGM ? (nM - fm) : WGM;
        pm = fm + ((wgid % nig) % gsz); pn = (wgid % nig) / gsz; return true;
    }
};

template <class Epi, class Sched, bool GATHER>
__device__ __forceinline__ void gemm_phase(LAS unsigned char* lds, const int K, const int lda, const int ldb, const Sched& S, const Epi& E) {
    int tid = threadIdx.x; asm volatile("" : "+v"(tid));
    const int wid = __builtin_amdgcn_readfirstlane(tid >> 6), lane = tid & 63, wr = wid >> 2, wc = wid & 3, fr = lane & 15, fq = lane >> 4;
    const int nt = K / BK;
    int Rr[2], Cc[2]; unsigned voffB[2];
#pragma unroll
    for (int i = 0; i < 2; ++i) { int R, C; stage_rc(tid * 16 + i * 8192, R, C); Rr[i] = R; Cc[i] = C; const int Rb = Epi::PERM ? ((R & ~31) + perm32(R & 31)) : R; voffB[i] = (unsigned)(Rb * ldb + C) * 2u; }
    const size_t kstep = (size_t)(BK * 2);
    const size_t hstepB = (size_t)HALF * ldb * 2;
    const unsigned ldsw = (unsigned)wid * 1024u;
    const int aoff = lds_byte(wr * 64 + fr, fq * 8), boff = lds_byte(wc * 32 + fr, fq * 8);
#define GE_SA(b, h) (((b) * 2 + (h)) * HTB)
#define GE_SB(b, h) ((4 + (b) * 2 + (h)) * HTB)
#define GE_STAGE(bufoff, gbase, v0, v1) do { \
        __builtin_amdgcn_global_load_lds((const unsigned*)((const char*)(gbase) + (v0)), (LAS unsigned*)(lds + (bufoff) + ldsw), 16, 0, 0); \
        __builtin_amdgcn_global_load_lds((const unsigned*)((const char*)(gbase) + (v1)), (LAS unsigned*)(lds + (bufoff) + ldsw + 8192), 16, 0, 0); } while (0)
#define GE_STAGE_B(bufoff, gbase) GE_STAGE(bufoff, gbase, voffB[0], voffB[1])
#define GE_LDA(dst, b, h) do { _Pragma("unroll") for (int m = 0; m < 4; ++m) _Pragma("unroll") for (int k = 0; k < 2; ++k) dst[m][k] = *(const LAS bf16x8*)(lds + GE_SA(b, h) + aoff + m * 2048 + k * 1024); } while (0)
#define GE_LDB(dst, b, h) do { _Pragma("unroll") for (int n = 0; n < 2; ++n) _Pragma("unroll") for (int k = 0; k < 2; ++k) dst[n][k] = *(const LAS bf16x8*)(lds + GE_SB(b, h) + boff + n * 2048 + k * 1024); } while (0)
#define GE_MMA(ai, bj, At, Bt) do { __builtin_amdgcn_s_setprio(1); _Pragma("unroll") for (int m = 0; m < 4; ++m) _Pragma("unroll") for (int n = 0; n < 2; ++n) _Pragma("unroll") for (int k = 0; k < 2; ++k) \
        acc[ai][bj][m][n] = __builtin_amdgcn_mfma_f32_16x16x32_bf16(Bt[n][k], At[m][k], acc[ai][bj][m][n], 0, 0, 0); __builtin_amdgcn_s_setprio(0); } while (0)
#define GE_WAIT_V(n) asm volatile("s_waitcnt vmcnt(" #n ")" ::: "memory")
#define GE_WAIT_L(n) asm volatile("s_waitcnt lgkmcnt(" #n ")" ::: "memory")
#define GE_BAR __builtin_amdgcn_s_barrier()
#define GE_SCHED __builtin_amdgcn_sched_barrier(0)
    Unit cur, nxt; int ui = 0;
    if (!S.next(0, cur)) return;
    unsigned c00, c01, c10, c11, n00, n01, n10, n11;
    if constexpr (GATHER) {
        c00 = (unsigned)(S.a_row(cur, Rr[0]) * lda + Cc[0]) * 2u; c01 = (unsigned)(S.a_row(cur, Rr[1]) * lda + Cc[1]) * 2u;
        c10 = (unsigned)(S.a_row(cur, HALF + Rr[0]) * lda + Cc[0]) * 2u; c11 = (unsigned)(S.a_row(cur, HALF + Rr[1]) * lda + Cc[1]) * 2u;
    } else {
        c00 = (unsigned)(Rr[0] * lda + Cc[0]) * 2u; c01 = (unsigned)(Rr[1] * lda + Cc[1]) * 2u;
        c10 = c00 + (unsigned)(HALF * lda * 2); c11 = c01 + (unsigned)(HALF * lda * 2);
    }
    n00 = c00; n01 = c01; n10 = c10; n11 = c11;
    f32x4 acc[2][2][4][2];
#pragma unroll
    for (int a = 0; a < 2; ++a)
#pragma unroll
        for (int b = 0; b < 2; ++b)
#pragma unroll
            for (int m = 0; m < 4; ++m)
#pragma unroll
                for (int n = 0; n < 2; ++n) acc[a][b][m][n] = (f32x4){0.f, 0.f, 0.f, 0.f};
    bf16x8 At[4][2], B0[2][2], B1[2][2];
    const char* cA = S.a_base(cur); const char* cB = S.b_base(cur);
    GE_STAGE_B(GE_SB(0, 0), cB); GE_STAGE(GE_SA(0, 0), cA, c00, c01); GE_STAGE_B(GE_SB(0, 1), cB + hstepB); GE_STAGE(GE_SA(0, 1), cA, c10, c11);
    if (wr == 1) GE_BAR;
    GE_WAIT_V(4); GE_BAR;
    GE_STAGE_B(GE_SB(1, 0), cB + kstep); GE_STAGE(GE_SA(1, 0), cA + kstep, c00, c01); GE_STAGE_B(GE_SB(1, 1), cB + hstepB + kstep);
    GE_WAIT_V(6); GE_BAR;
    for (;;) {
        const bool has_next = S.next(ui + 1, nxt);
        const char* nA = has_next ? S.a_base(nxt) : cA; const char* nB = has_next ? S.b_base(nxt) : cB;
        if constexpr (GATHER) {
            if (has_next) {
                n00 = (unsigned)(S.a_row(nxt, Rr[0]) * lda + Cc[0]) * 2u; n01 = (unsigned)(S.a_row(nxt, Rr[1]) * lda + Cc[1]) * 2u;
                n10 = (unsigned)(S.a_row(nxt, HALF + Rr[0]) * lda + Cc[0]) * 2u; n11 = (unsigned)(S.a_row(nxt, HALF + Rr[1]) * lda + Cc[1]) * 2u;
            } else { n00 = c00; n01 = c01; n10 = c10; n11 = c11; }
        }
#pragma unroll 1
        for (int t = 0; t < nt; t += 2) {
            const bool last = (t == nt - 2);
            const char* a1 = cA + (size_t)(t + 1) * kstep;
            const char* a2 = last ? nA : cA + (size_t)(t + 2) * kstep; const char* b2 = last ? nB : cB + (size_t)(t + 2) * kstep;
            const char* a3 = a2 + kstep; const char* b3 = b2 + kstep;
            unsigned x00 = c00, x01 = c01, x10 = c10, x11 = c11;
            if constexpr (GATHER) { if (last) { x00 = n00; x01 = n01; x10 = n10; x11 = n11; } }
            GE_LDB(B0, 0, 0); GE_SCHED; GE_LDA(At, 0, 0); GE_STAGE(GE_SA(1, 1), a1, c10, c11);
            GE_WAIT_L(8); GE_BAR; GE_WAIT_L(0); GE_MMA(0, 0, At, B0); GE_BAR; GE_SCHED;
            GE_LDB(B1, 0, 1); GE_STAGE_B(GE_SB(0, 0), b2);
            GE_BAR; GE_WAIT_L(0); GE_MMA(0, 1, At, B1); GE_BAR;
            GE_LDA(At, 0, 1); GE_STAGE(GE_SA(0, 0), a2, x00, x01);
            GE_BAR; GE_WAIT_L(0); GE_MMA(1, 0, At, B0); GE_BAR; GE_SCHED;
            GE_STAGE_B(GE_SB(0, 1), b2 + hstepB);
            GE_WAIT_V(6); GE_BAR; GE_MMA(1, 1, At, B1); GE_BAR;
            GE_LDB(B0, 1, 0); GE_SCHED; GE_LDA(At, 1, 0); GE_STAGE(GE_SA(0, 1), a2, x10, x11);
            GE_WAIT_L(8); GE_BAR; GE_WAIT_L(0); GE_MMA(0, 0, At, B0); GE_BAR; GE_SCHED;
            GE_LDB(B1, 1, 1); GE_STAGE_B(GE_SB(1, 0), b3);
            GE_BAR; GE_WAIT_L(0); GE_MMA(0, 1, At, B1); GE_BAR;
            GE_LDA(At, 1, 1); GE_STAGE(GE_SA(1, 0), a3, x00, x01);
            GE_BAR; GE_WAIT_L(0); GE_MMA(1, 0, At, B0); GE_BAR; GE_SCHED;
            GE_STAGE_B(GE_SB(1, 1), b3 + hstepB);
            GE_WAIT_V(6); GE_BAR; GE_MMA(1, 1, At, B1); GE_BAR;
        }
        E(acc, cur, wr, wc, fr, fq);
        if (!has_next) break;
#pragma unroll
        for (int a = 0; a < 2; ++a)
#pragma unroll
            for (int b = 0; b < 2; ++b)
#pragma unroll
                for (int m = 0; m < 4; ++m)
#pragma unroll
                    for (int n = 0; n < 2; ++n) acc[a][b][m][n] = (f32x4){0.f, 0.f, 0.f, 0.f};
        cur = nxt; cA = nA; cB = nB; ++ui;
        if constexpr (GATHER) { c00 = n00; c01 = n01; c10 = n10; c11 = n11; }
    }
    GE_WAIT_V(0);
    if (wr == 0) GE_BAR;
    GE_BAR;
#undef GE_SA
#undef GE_SB
#undef GE_STAGE
#undef GE_STAGE_B
#undef GE_LDA
#undef GE_LDB
#undef GE_MMA
#undef GE_WAIT_V
#undef GE_WAIT_L
#undef GE_BAR
#undef GE_SCHED
}
}
constexpr size_t MiB = (size_t)1 << 20;
constexpr size_t OFF_BAR    = 0;
constexpr size_t OFF_CNT    = 16 * 1024;
constexpr size_t OFF_BLKE   = 32 * 1024;
constexpr size_t OFF_MOD    = 64 * 1024;
constexpr size_t OFF_EIDX   = 1 * MiB;
constexpr size_t OFF_WTS    = 2 * MiB;
constexpr size_t OFF_APOS   = 3 * MiB;
constexpr size_t OFF_ROWTOK = 4 * MiB;
constexpr size_t OFF_WINT   = 8 * MiB;
constexpr size_t OFF_GLUT   = 20 * MiB;
constexpr size_t OFF_PAT    = OFF_GLUT + 128 * 1024;
constexpr size_t OFF_PBT    = OFF_PAT + 512 * 1024;
constexpr size_t OFF_WOUTT  = OFF_PBT + 1536 * 1024;
constexpr size_t OFF_U      = 34 * MiB;
constexpr size_t OFF_H      = 62 * MiB;
constexpr size_t OFF_Z      = 128 * MiB;
constexpr size_t OFF_YPART  = 62 * MiB;
constexpr size_t OFF_YA     = 26 * MiB;
constexpr size_t OFF_YB     = 42 * MiB;
constexpr size_t OFF_BT2    = 40 * MiB;
constexpr size_t OFF_X1     = 80 * MiB;
constexpr size_t OFF_HID2   = 208 * MiB;
constexpr size_t OFF_H2     = 232 * MiB;
constexpr size_t OFF_BT1    = 297 * MiB;
constexpr size_t OFF_Y2     = 232 * MiB;
constexpr size_t DO_OF = 0, DO_OB = 48 * MiB, DO_Y = 96 * MiB, DO_MERGED = 0, DO_HID1 = 0;

struct Params {
    const float *x, *c, *ctx, *c_ctx, *w_ada, *b_ada, *norm1_g, *norm2_g, *w_in, *lam_re, *lam_im, *log_dt, *b_re, *b_im, *c_re, *c_im, *s5_d, *w_glu, *lb_logits, *hg_norm_g,
                *p_a, *p_b, *w_out, *w_router, *b_router, *w1, *w3, *w2, *ws1, *ws3, *ws2, *final_g;
    unsigned char* ws; unsigned char* out;
};
__device__ __forceinline__ void ada_phase(const Params& p, LAS unsigned char* lds) {
    LAS float* sc = (LAS float*)lds;
    LAS float* red = (LAS float*)(lds + 5 * 1024 * 4);
    const int tid = threadIdx.x;
    float* mod = (float*)(p.ws + OFF_MOD);
    bool loaded = false;
    for (int item = blockIdx.x; item < 192; item += gridDim.x) {
        if (!loaded) {
            for (int i = tid; i < 5 * 1024; i += 512) { const int r = i >> 10, k = i & 1023; const float v = (r < 4) ? p.c[r * 1024 + k] : p.c_ctx[k]; sc[i] = siluf_(v); }
            loaded = true; __syncthreads();
        }
        const int n0 = item * 32, ks = tid >> 5, col = tid & 31;
        float a0 = 0.f, a1 = 0.f, a2 = 0.f, a3 = 0.f, a4 = 0.f;
        for (int k = ks * 64; k < ks * 64 + 64; ++k) {
            const float w = p.w_ada[(size_t)k * NIN + n0 + col];
            a0 += sc[k] * w; a1 += sc[1024 + k] * w; a2 += sc[2048 + k] * w; a3 += sc[3072 + k] * w; a4 += sc[4096 + k] * w;
        }
        red[(ks * 5 + 0) * 32 + col] = a0; red[(ks * 5 + 1) * 32 + col] = a1; red[(ks * 5 + 2) * 32 + col] = a2; red[(ks * 5 + 3) * 32 + col] = a3; red[(ks * 5 + 4) * 32 + col] = a4;
        __syncthreads();
        if (tid < 160) { const int r = tid >> 5, cc = tid & 31; float s = 0.f;
            for (int q = 0; q < 16; ++q) s += red[(q * 5 + r) * 32 + cc];
            mod[r * NIN + n0 + cc] = s + p.b_ada[n0 + cc]; }
        __syncthreads();
    }
}

template <class F>
__device__ __forceinline__ void cvt_tile(const float* src, int ld, int k0, int n0, bf16_t* dst, int ldd, int kdst0, F rowmap, LAS unsigned char* lds) {
    LAS float* t = (LAS float*)lds;
    const int tid = threadIdx.x;
#pragma unroll
    for (int j = 0; j < 2; ++j) { const int kr = (tid >> 4) + 32 * j, nc = (tid & 15) * 4;
        const f32x4 v = *(const f32x4*)(src + (size_t)(k0 + kr) * ld + n0 + nc);
        t[kr * 65 + nc] = v[0]; t[kr * 65 + nc + 1] = v[1]; t[kr * 65 + nc + 2] = v[2]; t[kr * 65 + nc + 3] = v[3]; }
    __syncthreads();
    { const int n = tid >> 3, kc = (tid & 7) * 8; float v[8];
#pragma unroll
      for (int j = 0; j < 8; ++j) v[j] = t[(kc + j) * 65 + n];
      u32x4 w; w.x = cvt_pk_bf16(v[0], v[1]); w.y = cvt_pk_bf16(v[2], v[3]); w.z = cvt_pk_bf16(v[4], v[5]); w.w = cvt_pk_bf16(v[6], v[7]);
      *(u32x4*)(dst + (size_t)rowmap(n0 + n) * ldd + kdst0 + k0 + kc) = w; }
    __syncthreads();
}

__device__ __forceinline__ void cvt_dense_phase(const Params& p, LAS unsigned char* lds) {
    bf16_t* WinT = (bf16_t*)(p.ws + OFF_WINT); bf16_t* gluT = (bf16_t*)(p.ws + OFF_GLUT); bf16_t* PaT = (bf16_t*)(p.ws + OFF_PAT); bf16_t* PbT = (bf16_t*)(p.ws + OFF_PBT); bf16_t* WoutT = (bf16_t*)(p.ws + OFF_WOUTT);
    auto id = [](int n) { return n; };
    constexpr int T_WIN = 16 * 96, T_GLU = 4 * 4, T_PA = 4 * 16, T_PB = 12 * 16, T_WO = 16 * 16, T_ALL = T_WIN + T_GLU + T_PA + T_PB + T_WO;
    for (int it = blockIdx.x; it < T_ALL; it += gridDim.x) {
        int i = it;
        if (i < T_WIN) { cvt_tile(p.w_in, NIN, (i / 96) * 64, (i % 96) * 64, WinT, 1024, 0, id, lds); continue; } i -= T_WIN;
        if (i < T_GLU) { cvt_tile(p.w_glu, 256, (i / 4) * 64, (i % 4) * 64, gluT, 256, 0, id, lds); continue; } i -= T_GLU;
        if (i < T_PA) { cvt_tile(p.p_a, 1024, (i / 16) * 64, (i % 16) * 64, PaT, 256, 0, id, lds); continue; } i -= T_PA;
        if (i < T_PB) { cvt_tile(p.p_b, 1024, (i / 16) * 64, (i % 16) * 64, PbT, 768, 0, id, lds); continue; } i -= T_PB;
        cvt_tile(p.w_out, 1024, (i / 16) * 64, (i % 16) * 64, WoutT, 1024, 0, id, lds);
    }
}

__device__ __forceinline__ void cvt_moe_phase(const Params& p, LAS unsigned char* lds) {
    bf16_t* Bt1 = (bf16_t*)(p.ws + OFF_BT1); bf16_t* Bt2 = (bf16_t*)(p.ws + OFF_BT2);
    auto m1 = [](int n) { return (n >> 7) * 256 + (n & 127); };
    auto m3 = [](int n) { return (n >> 7) * 256 + 128 + (n & 127); };
    auto id = [](int n) { return n; };
    constexpr int PER_E = 64 * 3;
    for (int it = blockIdx.x; it < 65 * PER_E; it += gridDim.x) {
        const int e = it / PER_E, j = it % PER_E, which = j / 64, t = j % 64;
        if (which == 0) { const float* s = (e < 64) ? p.w1 + (size_t)e * 1024 * 256 : p.ws1; cvt_tile(s, 256, (t / 4) * 64, (t % 4) * 64, Bt1 + (size_t)e * 512 * 1024, 1024, 0, m1, lds); }
        else if (which == 1) { const float* s = (e < 64) ? p.w3 + (size_t)e * 1024 * 256 : p.ws3; cvt_tile(s, 256, (t / 4) * 64, (t % 4) * 64, Bt1 + (size_t)e * 512 * 1024, 1024, 0, m3, lds); }
        else { const float* s = (e < 64) ? p.w2 + (size_t)e * 256 * 1024 : p.ws2; cvt_tile(s, 1024, (t / 16) * 64, (t % 16) * 64, Bt2 + (size_t)e * 1024 * 256, 256, 0, id, lds); }
    }
}

__device__ __forceinline__ void norm1_phase(const Params& p) {
    const int wid = threadIdx.x >> 6, lane = threadIdx.x & 63;
    const float* mod = (const float*)(p.ws + OFF_MOD); bf16_t* H = (bf16_t*)(p.ws + OFF_H);
    for (int r = blockIdx.x * 8 + wid; r < NROWS; r += gridDim.x * 8) {
        const float* src = (r < NTOK) ? p.x + (size_t)r * 1024 : p.ctx + (size_t)(r - NTOK) * 1024;
        const float* mr = mod + ((r < NTOK) ? (r / SEQ) : 4) * NIN;
        f32x4 v[4]; float ss = 0.f;
#pragma unroll
        for (int j = 0; j < 4; ++j) { v[j] = *(const f32x4*)(src + j * 256 + lane * 4); ss += v[j][0] * v[j][0] + v[j][1] * v[j][1] + v[j][2] * v[j][2] + v[j][3] * v[j][3]; }
        ss = wave_sum(ss);
        const float rstd = rsqrtf(ss * (1.0f / 1024.0f) + EPSF);
#pragma unroll
        for (int j = 0; j < 4; ++j) { const int k = j * 256 + lane * 4;
            const f32x4 g = *(const f32x4*)(p.norm1_g + k), sh = *(const f32x4*)(mr + k), scv = *(const f32x4*)(mr + 1024 + k);
            float o[4];
#pragma unroll
            for (int q = 0; q < 4; ++q) o[q] = v[j][q] * rstd * g[q] * (1.0f + scv[q]) + sh[q];
            u32x2 w; w.x = cvt_pk_bf16(o[0], o[1]); w.y = cvt_pk_bf16(o[2], o[3]);
            *(u32x2*)(H + (size_t)r * 1024 + k) = w; }
    }
}
struct PlainSched {
    ge::GridOrder go; const char* A; const char* B; size_t atile, btile;
    __device__ void init(const void* A_, int lda, const void* B_, int ldb, int nM, int nN) { A = (const char*)A_; B = (const char*)B_; atile = (size_t)256 * lda * 2; btile = (size_t)256 * ldb * 2; go.init(nM, nN, (int)gridDim.x, (int)blockIdx.x); }
    __device__ __forceinline__ bool next(int i, ge::Unit& u) const { u.e = 0; return go.tile(i, u.pm, u.pn); }
    __device__ __forceinline__ const char* a_base(const ge::Unit& u) const { return A + (size_t)u.pm * atile; }
    __device__ __forceinline__ const char* b_base(const ge::Unit& u) const { return B + (size_t)u.pn * btile; }
    __device__ __forceinline__ int a_row(const ge::Unit&, int) const { return 0; }
};

struct EpiZ {
    static constexpr bool PERM = true;
    bf16_t* U; bf16_t* Z;
    __device__ __forceinline__ void operator()(const f32x4 (&acc)[2][2][4][2], const ge::Unit& u, int wr, int wc, int fr, int fq) const {
        const int row0 = u.pm * 256 + wr * 64 + fr, cl = wc * 32 + 8 * fq;
        bf16_t* base; int ld;
        if (u.pn == 0) { base = U + cl; ld = 256; } else { base = Z + (u.pn - 1) * 256 + cl; ld = ZC; }
#pragma unroll
        for (int ai = 0; ai < 2; ++ai)
#pragma unroll
            for (int m = 0; m < 4; ++m) { bf16_t* rowp = base + (size_t)(row0 + ai * 128 + m * 16) * ld;
#pragma unroll
                for (int bj = 0; bj < 2; ++bj) { const f32x4 v0 = acc[ai][bj][m][0], v1 = acc[ai][bj][m][1];
                    u32x4 w; w.x = cvt_pk_bf16(v0[0], v0[1]); w.y = cvt_pk_bf16(v0[2], v0[3]); w.z = cvt_pk_bf16(v1[0], v1[1]); w.w = cvt_pk_bf16(v1[2], v1[3]);
                    *(u32x4*)(rowp + bj * 128) = w; } }
    }
};


struct EpiZ2 {
    static constexpr bool PERM = true;
    bf16_t* Ae; bf16_t* Uc; bf16_t* Z;
    __device__ __forceinline__ void operator()(const f32x4 (&acc)[2][2][4][2], const ge::Unit& u, int wr, int wc, int fr, int fq) const {
        const int row0 = u.pm * 256 + wr * 64 + fr, cl = wc * 32 + 8 * fq;
#pragma unroll
        for (int ai = 0; ai < 2; ++ai)
#pragma unroll
            for (int m = 0; m < 4; ++m) { const int r = row0 + ai * 128 + m * 16;
#pragma unroll
                for (int bj = 0; bj < 2; ++bj) { const f32x4 v0 = acc[ai][bj][m][0], v1 = acc[ai][bj][m][1];
                    u32x4 w; w.x = cvt_pk_bf16(v0[0], v0[1]); w.y = cvt_pk_bf16(v0[2], v0[3]); w.z = cvt_pk_bf16(v1[0], v1[1]); w.w = cvt_pk_bf16(v1[2], v1[3]);
                    bf16_t* dst;
                    if (u.pn == 0) { const int col = bj * 128 + cl, g = col >> 4, c0 = col & 15;
                        if (u.pm < NTOK / 256) { const int b = r >> 13, l = r & (SEQ - 1); dst = Ae + (size_t)(g * 512 + b * 128 + (l >> 6)) * 1280 + (l & 63) * 16 + c0; }
                        else dst = Uc + (size_t)(r - NTOK) * 256 + col; }
                    else dst = Z + (size_t)r * ZC + (u.pn - 1) * 256 + cl + bj * 128;
                    *(u32x4*)dst = w; } }
    }
};

struct EpiYa {
    static constexpr bool PERM = true;
    const bf16_t* Y; bf16_t* Ya;
    __device__ __forceinline__ void operator()(const f32x4 (&acc)[2][2][4][2], const ge::Unit& u, int wr, int wc, int fr, int fq) const {
        const int row0 = u.pm * 256 + wr * 64 + fr, col0 = u.pn * 256 + wc * 32 + 8 * fq;
#pragma unroll
        for (int ai = 0; ai < 2; ++ai)
#pragma unroll
            for (int m = 0; m < 4; ++m) { const size_t ro = (size_t)(row0 + ai * 128 + m * 16) * 256 + col0;
#pragma unroll
                for (int bj = 0; bj < 2; ++bj) { f32x4 v0 = acc[ai][bj][m][0], v1 = acc[ai][bj][m][1];
                    asm volatile("" : "+v"(v0), "+v"(v1));
                    const u32x4 yv = *(const u32x4*)(Y + ro + bj * 128);
                    float o[8];
                    o[0] = bf_lo(yv.x) * sigmoidf_(v0[0]); o[1] = bf_hi(yv.x) * sigmoidf_(v0[1]); o[2] = bf_lo(yv.y) * sigmoidf_(v0[2]); o[3] = bf_hi(yv.y) * sigmoidf_(v0[3]);
                    o[4] = bf_lo(yv.z) * sigmoidf_(v1[0]); o[5] = bf_hi(yv.z) * sigmoidf_(v1[1]); o[6] = bf_lo(yv.w) * sigmoidf_(v1[2]); o[7] = bf_hi(yv.w) * sigmoidf_(v1[3]);
                    u32x4 w; w.x = cvt_pk_bf16(o[0], o[1]); w.y = cvt_pk_bf16(o[2], o[3]); w.z = cvt_pk_bf16(o[4], o[5]); w.w = cvt_pk_bf16(o[6], o[7]);
                    *(u32x4*)(Ya + ro + bj * 128) = w; asm volatile("" ::: "memory"); } }
    }
};

template <bool ADD> struct EpiMerge {
    static constexpr bool PERM = true;
    const bf16_t* Z; int gcol0; bf16_t* Mg;
    __device__ __forceinline__ void operator()(const f32x4 (&acc)[2][2][4][2], const ge::Unit& u, int wr, int wc, int fr, int fq) const {
        const int row0 = u.pm * 256 + wr * 64 + fr, col0 = u.pn * 256 + wc * 32 + 8 * fq;
#pragma unroll
        for (int ai = 0; ai < 2; ++ai)
#pragma unroll
            for (int m = 0; m < 4; ++m) { const size_t row = (size_t)(row0 + ai * 128 + m * 16);
#pragma unroll
                for (int bj = 0; bj < 2; ++bj) { f32x4 v0 = acc[ai][bj][m][0], v1 = acc[ai][bj][m][1];
                    asm volatile("" : "+v"(v0), "+v"(v1));
                    const u32x4 gv = *(const u32x4*)(Z + row * ZC + gcol0 + col0 + bj * 128);
                    float o[8];
                    o[0] = sigmoidf_(bf_lo(gv.x)) * v0[0]; o[1] = sigmoidf_(bf_hi(gv.x)) * v0[1]; o[2] = sigmoidf_(bf_lo(gv.y)) * v0[2]; o[3] = sigmoidf_(bf_hi(gv.y)) * v0[3];
                    o[4] = sigmoidf_(bf_lo(gv.z)) * v1[0]; o[5] = sigmoidf_(bf_hi(gv.z)) * v1[1]; o[6] = sigmoidf_(bf_lo(gv.w)) * v1[2]; o[7] = sigmoidf_(bf_hi(gv.w)) * v1[3];
                    bf16_t* dst = Mg + row * 1024 + col0 + bj * 128;
                    if (ADD) { const u32x4 pv = *(const u32x4*)dst;
                        o[0] += bf_lo(pv.x); o[1] += bf_hi(pv.x); o[2] += bf_lo(pv.y); o[3] += bf_hi(pv.y); o[4] += bf_lo(pv.z); o[5] += bf_hi(pv.z); o[6] += bf_lo(pv.w); o[7] += bf_hi(pv.w); }
                    u32x4 w; w.x = cvt_pk_bf16(o[0], o[1]); w.y = cvt_pk_bf16(o[2], o[3]); w.z = cvt_pk_bf16(o[4], o[5]); w.w = cvt_pk_bf16(o[6], o[7]);
                    *(u32x4*)dst = w; asm volatile("" ::: "memory"); } }
    }
};

struct EpiX1 {
    static constexpr bool PERM = false;
    const float* X; const float* mod; float* X1;
    __device__ __forceinline__ void operator()(const f32x4 (&acc)[2][2][4][2], const ge::Unit& u, int wr, int wc, int fr, int fq) const {
        const int row0 = u.pm * 256 + wr * 64 + fr, col0 = u.pn * 256 + wc * 32 + 4 * fq;
        const float* g1 = mod + (size_t)((u.pm * 256) / SEQ) * NIN + 2048;
        f32x4 gv[2][2];
#pragma unroll
        for (int bj = 0; bj < 2; ++bj)
#pragma unroll
            for (int n = 0; n < 2; ++n) gv[bj][n] = *(const f32x4*)(g1 + col0 + bj * 128 + n * 16);
#pragma unroll
        for (int ai = 0; ai < 2; ++ai)
#pragma unroll
            for (int m = 0; m < 4; ++m) { const size_t off = (size_t)(row0 + ai * 128 + m * 16) * 1024 + col0;
#pragma unroll
                for (int bj = 0; bj < 2; ++bj)
#pragma unroll
                    for (int n = 0; n < 2; ++n) { const f32x4 xv = *(const f32x4*)(X + off + bj * 128 + n * 16);
                        *(f32x4*)(X1 + off + bj * 128 + n * 16) = xv + gv[bj][n] * acc[ai][bj][m][n]; } asm volatile("" ::: "memory"); }
    }
};

__device__ __forceinline__ bf16_t* hid_rows(unsigned char* ws, unsigned char* out, int rb) {
    return (rb < HID1_RB) ? (bf16_t*)(out + DO_HID1) + (size_t)rb * 256 * EH : (bf16_t*)(ws + OFF_HID2) + (size_t)(rb - HID1_RB) * 256 * EH;
}
struct MoeSched1 {
    const int* blk_e; const int* nblk; const int* row_tok; const char* h2; const char* bt1; int G, c;
    __device__ __forceinline__ bool next(int i, ge::Unit& u) const { const int L = i * G + c, nb = *nblk; if (L >= nb * 2) return false; u.pm = L >> 1; u.pn = L & 1; u.e = blk_e[u.pm]; return true; }
    __device__ __forceinline__ const char* a_base(const ge::Unit&) const { return h2; }
    __device__ __forceinline__ const char* b_base(const ge::Unit& u) const { return bt1 + ((size_t)u.e * 512 + (size_t)u.pn * 256) * 1024 * 2; }
    __device__ __forceinline__ int a_row(const ge::Unit& u, int r) const { return row_tok[u.pm * 256 + r]; }
};
struct EpiHid {
    static constexpr bool PERM = true;
    unsigned char* ws; unsigned char* out;
    __device__ __forceinline__ void operator()(const f32x4 (&acc)[2][2][4][2], const ge::Unit& u, int wr, int wc, int fr, int fq) const {
        bf16_t* base = hid_rows(ws, out, u.pm) + (size_t)(wr * 64 + fr) * EH + u.pn * 128 + wc * 32 + 8 * fq;
#pragma unroll
        for (int ai = 0; ai < 2; ++ai)
#pragma unroll
            for (int m = 0; m < 4; ++m) { const f32x4 a0 = acc[ai][0][m][0], a1 = acc[ai][0][m][1], b0 = acc[ai][1][m][0], b1 = acc[ai][1][m][1];
                u32x4 w; w.x = cvt_pk_bf16(siluf_(a0[0]) * b0[0], siluf_(a0[1]) * b0[1]); w.y = cvt_pk_bf16(siluf_(a0[2]) * b0[2], siluf_(a0[3]) * b0[3]);
                w.z = cvt_pk_bf16(siluf_(a1[0]) * b1[0], siluf_(a1[1]) * b1[1]); w.w = cvt_pk_bf16(siluf_(a1[2]) * b1[2], siluf_(a1[3]) * b1[3]);
                *(u32x4*)(base + (size_t)(ai * 128 + m * 16) * EH) = w; }
    }
};
struct MoeSched2 {
    const int* blk_e; const int* nblk; unsigned char* ws; unsigned char* out; const char* bt2; int half, G, c;
    __device__ __forceinline__ bool next(int i, ge::Unit& u) const { const int L = i * G + c, nb = *nblk; if (L >= nb * 2) return false; u.pm = L >> 1; u.pn = half * 2 + (L & 1); u.e = blk_e[u.pm]; return true; }
    __device__ __forceinline__ const char* a_base(const ge::Unit& u) const { return (const char*)hid_rows(ws, out, u.pm); }
    __device__ __forceinline__ const char* b_base(const ge::Unit& u) const { return bt2 + ((size_t)u.e * 1024 + (size_t)u.pn * 256) * EH * 2; }
    __device__ __forceinline__ int a_row(const ge::Unit&, int) const { return 0; }
};
struct EpiY2 {
    static constexpr bool PERM = true;
    bf16_t* Y2; float* X1; const float* mod; const int* pstart; int half;
    __device__ __forceinline__ void operator()(const f32x4 (&acc)[2][2][4][2], const ge::Unit& u, int wr, int wc, int fr, int fq) const {
        const int r0 = u.pm * 256 + wr * 64 + fr, colg = u.pn * 256 + wc * 32 + 8 * fq;
        if (u.e < NEXP) {
            bf16_t* base = Y2 + (size_t)r0 * 512 + (colg - half * 512);
#pragma unroll
            for (int ai = 0; ai < 2; ++ai)
#pragma unroll
                for (int m = 0; m < 4; ++m)
#pragma unroll
                    for (int bj = 0; bj < 2; ++bj) { const f32x4 v0 = acc[ai][bj][m][0], v1 = acc[ai][bj][m][1];
                        u32x4 w; w.x = cvt_pk_bf16(v0[0], v0[1]); w.y = cvt_pk_bf16(v0[2], v0[3]); w.z = cvt_pk_bf16(v1[0], v1[1]); w.w = cvt_pk_bf16(v1[2], v1[3]);
                        *(u32x4*)(base + (size_t)(ai * 128 + m * 16) * 512 + bj * 128) = w; }
        } else {
            const int t0 = r0 - pstart[NEXP];
            const float* g2 = mod + (size_t)((u.pm * 256 - pstart[NEXP]) / SEQ) * NIN + 5120;
#pragma unroll
            for (int ai = 0; ai < 2; ++ai)
#pragma unroll
                for (int m = 0; m < 4; ++m)
#pragma unroll
                    for (int bj = 0; bj < 2; ++bj) { float* dst = X1 + (size_t)(t0 + ai * 128 + m * 16) * 1024 + colg + bj * 128;
                        const f32x4 g0 = *(const f32x4*)(g2 + colg + bj * 128), g1v = *(const f32x4*)(g2 + colg + bj * 128 + 4);
                        *(f32x4*)dst = *(const f32x4*)dst + g0 * acc[ai][bj][m][0]; *(f32x4*)(dst + 4) = *(const f32x4*)(dst + 4) + g1v * acc[ai][bj][m][1]; asm volatile("" ::: "memory"); }
        }
    }
};
__device__ __forceinline__ void s5_naive_phase(const Params& p, LAS unsigned char* lds, int vb, int nvb) {
    const int tid = threadIdx.x, wid = tid >> 6, lane = tid & 63;
    const bf16_t* U = (const bf16_t*)(p.ws + OFF_U); float* ypart = (float*)(p.ws + OFF_YPART);
    LAS f32x2* Cs = (LAS f32x2*)lds;
    LAS f32x2* ring = (LAS f32x2*)(lds + 16 * 64 * 8);
    for (int item = vb; item < NB * 16; item += nvb) {
        const int b = item >> 4, g = item & 15;
        __syncthreads();
        for (int i = tid; i < 16 * 64; i += blockDim.x) { const int cc = i >> 6, pp = i & 63; Cs[i] = (f32x2){p.c_re[(g * 16 + cc) * 64 + pp], p.c_im[(g * 16 + cc) * 64 + pp]}; }
        __syncthreads();
        if (wid < 2) {
            const int dir = wid;
            const int pi = (dir * 16 + g) * 64 + lane;
            const double lre = fmin((double)p.lam_re[pi], -1e-4), lim = (double)p.lam_im[pi], dt = exp((double)p.log_dt[dir * 16 + g]);
            const double er = exp(lre * dt), th = lim * dt, lbr = er * cos(th), lbi = er * sin(th);
            const double den = lre * lre + lim * lim, nr = lbr - 1.0, ni = lbi;
            const double cfr = (nr * lre + ni * lim) / den, cfi = (ni * lre - nr * lim) / den;
            float Br[16], Bi[16];
#pragma unroll
            for (int cc = 0; cc < 16; ++cc) { const double br = p.b_re[(size_t)pi * 16 + cc], bi = p.b_im[(size_t)pi * 16 + cc]; Br[cc] = (float)(cfr * br - cfi * bi); Bi[cc] = (float)(cfr * bi + cfi * br); }
            const float ar = (float)lbr, ai = (float)lbi;
            float xr = 0.f, xi = 0.f;
            LAS f32x2* rg = ring + wid * 16 * 64;
            const int oc = lane & 15, oq = lane >> 4;
            for (int s = 0; s < CTXL + SEQ; ++s) {
                int row, l = 0;
                if (s < CTXL) { const int lc = dir ? (CTXL - 1 - s) : s; row = NTOK + b * CTXL + lc; }
                else { l = dir ? (SEQ - 1 - (s - CTXL)) : (s - CTXL); row = b * SEQ + l; }
                const u32x4 u0 = *(const u32x4*)(U + (size_t)row * 256 + g * 16), u1 = *(const u32x4*)(U + (size_t)row * 256 + g * 16 + 8);
                float uu[16];
                uu[0] = bf_lo(u0.x); uu[1] = bf_hi(u0.x); uu[2] = bf_lo(u0.y); uu[3] = bf_hi(u0.y); uu[4] = bf_lo(u0.z); uu[5] = bf_hi(u0.z); uu[6] = bf_lo(u0.w); uu[7] = bf_hi(u0.w);
                uu[8] = bf_lo(u1.x); uu[9] = bf_hi(u1.x); uu[10] = bf_lo(u1.y); uu[11] = bf_hi(u1.y); uu[12] = bf_lo(u1.z); uu[13] = bf_hi(u1.z); uu[14] = bf_lo(u1.w); uu[15] = bf_hi(u1.w);
                float bur = 0.f, bui = 0.f;
#pragma unroll
                for (int cc = 0; cc < 16; ++cc) { bur += Br[cc] * uu[cc]; bui += Bi[cc] * uu[cc]; }
                const float nxr = ar * xr - ai * xi + bur, nxi = ar * xi + ai * xr + bui;
                xr = nxr; xi = nxi;
                if (s >= CTXL) {
                    const int k = (s - CTXL) & 15;
                    rg[k * 64 + lane] = (f32x2){xr, xi};
                    if (k == 15) {
                        asm volatile("s_waitcnt lgkmcnt(0)" ::: "memory");
#pragma unroll
                        for (int q = 0; q < 4; ++q) { const int kk = oq * 4 + q; float y = 0.f;
                            for (int pp = 0; pp < 64; ++pp) { const f32x2 xv = rg[kk * 64 + pp], cv = Cs[oc * 64 + pp]; y += xv.x * cv.x - xv.y * cv.y; }
                            const int lt = dir ? (l + 15 - kk) : (l - 15 + kk);
                            ypart[((size_t)dir * NTOK + (size_t)b * SEQ + lt) * 256 + g * 16 + oc] = y; }
                        asm volatile("s_waitcnt lgkmcnt(0)" ::: "memory");
                    }
                }
            }
        }
    }
}
__device__ __forceinline__ void s5_fin_phase(const Params& p) {
    const bf16_t* U = (const bf16_t*)(p.ws + OFF_U); const float* ypart = (const float*)(p.ws + OFF_YPART); bf16_t* Y = (bf16_t*)(p.out + DO_Y);
    for (size_t i = (size_t)blockIdx.x * blockDim.x + threadIdx.x; i < (size_t)NTOK * 256; i += (size_t)gridDim.x * blockDim.x) {
        const float v = ypart[i] + ypart[(size_t)NTOK * 256 + i] + p.s5_d[i & 255] * bf2f(U[i]);
        Y[i] = f2bf(gelu_tanh(v));
    }
}

__device__ __forceinline__ void gla_naive_phase(const Params& p, LAS unsigned char* lds, int vb, int nvb) {
    const int tid = threadIdx.x;
    const bf16_t* Z = (const bf16_t*)(p.ws + OFF_Z);
    LAS float* buf = (LAS float*)lds;
    for (int item = vb; item < NB * 6 * 2; item += nvb) {
        const int dir = item & 1, h = (item >> 1) % 6, b = item / 12;
        bf16_t* O = (bf16_t*)(p.out + (dir ? DO_OB : DO_OF));
        const int v = tid >> 2, iq = tid & 3;
        float S[32];
#pragma unroll
        for (int j = 0; j < 32; ++j) S[j] = 0.f;
        const int role = tid >> 7, ii = tid & 127;
        float lbv = 0.f;
        if (role == 0) { const float l0 = p.lb_logits[h * 128 + ii], l1 = p.lb_logits[768 + h * 128 + ii]; lbv = 1.0f / (1.0f + __expf(l1 - l0)); }
        const int colsel = (role == 0) ? ((dir ? ZFB : ZFF) + h * 128 + ii) : (role == 1) ? (ZQ + h * 128 + ii) : (ZI + h * 128 + ii);
        auto rowof = [&](int s, int& l) -> size_t {
            if (s < CTXL) { const int lc = dir ? (CTXL - 1 - s) : s; l = -1; return (size_t)(NTOK + b * CTXL + lc); }
            const int j = dir ? (SEQ - 1 - (s - CTXL)) : (s - CTXL); l = (j & 127) * 64 + (j >> 7); return (size_t)(b * SEQ + l);
        };
        int lcur; float pre = 0.f;
        { const size_t r0 = rowof(0, lcur); if (role < 3) pre = bf2f(Z[r0 * ZC + colsel]); }
        __syncthreads();
        for (int s = 0; s < CTXL + SEQ; ++s) {
            LAS float* bb = buf + (s & 1) * 512;
            int lthis; (void)rowof(s, lthis);
            if (role == 0) { const float sg = sigmoidf_(pre); bb[ii] = lbv + (1.0f - lbv) * sg; bb[128 + ii] = (1.0f - lbv) * (1.0f - sg); }
            else if (role == 1) bb[256 + ii] = pre;
            else if (role == 2) bb[384 + ii] = pre;
            if (s + 1 < CTXL + SEQ) { int ln; const size_t rn = rowof(s + 1, ln); if (role < 3) pre = bf2f(Z[rn * ZC + colsel]); }
            __syncthreads();
            const float vv = bb[384 + v];
            float o = 0.f;
#pragma unroll
            for (int j4 = 0; j4 < 8; ++j4) {
                const f32x4 f4 = *(const LAS f32x4*)(bb + iq * 32 + j4 * 4), k4 = *(const LAS f32x4*)(bb + 128 + iq * 32 + j4 * 4), q4 = *(const LAS f32x4*)(bb + 256 + iq * 32 + j4 * 4);
#pragma unroll
                for (int e = 0; e < 4; ++e) { const float sn = f4[e] * S[j4 * 4 + e] + k4[e] * vv; S[j4 * 4 + e] = sn; o += sn * q4[e]; }
            }
            o += __shfl_xor(o, 1); o += __shfl_xor(o, 2);
            if (lthis >= 0 && iq == 0) O[(size_t)(b * SEQ + lthis) * 768 + h * 128 + v] = f2bf(o);
        }
        __syncthreads();
    }
}
constexpr size_t DO_LP = 120 * MiB, DO_BBAR = DO_LP + 1088 * 1024, DO_KTAB = DO_BBAR + 256 * 1024, DO_UC = 124 * MiB;
constexpr size_t OFF_MG = 26 * MiB, OFF_AEXT = 34 * MiB, OFF_XEND = 54 * MiB, OFF_WEXT = 62 * MiB, OFF_YS5 = 102 * MiB;
constexpr int AEK = 1280;

__device__ __forceinline__ void s5_tab1_phase(const Params& p) {
    f32x2* Lp = (f32x2*)(p.out + DO_LP); f32x2* Bb = (f32x2*)(p.out + DO_BBAR);
    const int gt = blockIdx.x * blockDim.x + threadIdx.x, gs = gridDim.x * blockDim.x;
    for (int i = gt; i < 2048 * 65; i += gs) { const int pi = i / 65, j = i % 65, dg = pi >> 6;
        const double lre = fmin((double)p.lam_re[pi], -1e-4), lim = (double)p.lam_im[pi], dt = exp((double)p.log_dt[dg]);
        const double er = exp(lre * dt * (double)j), th = lim * dt * (double)j;
        Lp[i] = (f32x2){(float)(er * cos(th)), (float)(er * sin(th))}; }
    for (int i = gt; i < 2048 * 16; i += gs) { const int pi = i >> 4, dg = pi >> 6;
        const double lre = fmin((double)p.lam_re[pi], -1e-4), lim = (double)p.lam_im[pi], dt = exp((double)p.log_dt[dg]);
        const double er = exp(lre * dt), th = lim * dt, nr = er * cos(th) - 1.0, ni = er * sin(th), den = lre * lre + lim * lim;
        const double cfr = (nr * lre + ni * lim) / den, cfi = (ni * lre - nr * lim) / den;
        const double br = p.b_re[i], bi = p.b_im[i];
        Bb[i] = (f32x2){(float)(cfr * br - cfi * bi), (float)(cfr * bi + cfi * br)}; }
}
__device__ __forceinline__ void s5_tab2_phase(const Params& p) {
    const f32x2* Lp = (const f32x2*)(p.out + DO_LP); const f32x2* Bb = (const f32x2*)(p.out + DO_BBAR); float* Kt = (float*)(p.out + DO_KTAB); bf16_t* Mg = (bf16_t*)(p.ws + OFF_MG);
    const int gt = blockIdx.x * blockDim.x + threadIdx.x, gs = gridDim.x * blockDim.x;
    for (int i = gt; i < 2 * 16 * 64 * 256; i += gs) { const int cp = i & 15, c = (i >> 4) & 15, j = (i >> 8) & 63, dg = i >> 14, g = dg & 15;
        float s = 0.f;
        for (int pp = 0; pp < 64; ++pp) { const f32x2 l = Lp[(dg * 64 + pp) * 65 + j], b = Bb[(dg * 64 + pp) * 16 + cp];
            const float xr = l.x * b.x - l.y * b.y, xi = l.x * b.y + l.y * b.x;
            s += p.c_re[(g * 16 + c) * 64 + pp] * xr - p.c_im[(g * 16 + c) * 64 + pp] * xi; }
        Kt[i] = s; }
    for (int i = gt; i < 16 * 256 * 128; i += gs) { const int k8 = i & 127, n = (i >> 7) & 255, g = i >> 15;
        const int dir = n >> 7, part = (n >> 6) & 1, pp = n & 63, s = k8 >> 1, c0 = (k8 & 1) * 8, dg = dir * 16 + g;
        const f32x2 l = Lp[(dg * 64 + pp) * 65 + (dir ? s : 63 - s)];
        float v[8];
#pragma unroll
        for (int q = 0; q < 8; ++q) { const f32x2 b = Bb[(dg * 64 + pp) * 16 + c0 + q]; v[q] = part ? (l.x * b.y + l.y * b.x) : (l.x * b.x - l.y * b.y); }
        u32x4 w; w.x = cvt_pk_bf16(v[0], v[1]); w.y = cvt_pk_bf16(v[2], v[3]); w.z = cvt_pk_bf16(v[4], v[5]); w.w = cvt_pk_bf16(v[6], v[7]);
        *(u32x4*)(Mg + ((size_t)(g * 256 + n)) * 1024 + k8 * 8) = w; }
}
__device__ __forceinline__ void s5_wfill_phase(const Params& p, int vb, int nvb) {
    const f32x2* Lp = (const f32x2*)(p.out + DO_LP); const float* Kt = (const float*)(p.out + DO_KTAB); bf16_t* W = (bf16_t*)(p.ws + OFF_WEXT);
    for (int i = vb * 512 + threadIdx.x; i < 16 * 1024 * 160; i += nvb * 512) { const int k8 = i % 160, n = (i / 160) & 1023, g = i / (160 * 1024), t = n >> 4, c = n & 15;
        float v[8];
        if (k8 < 128) { const int s = k8 >> 1, c0 = (k8 & 1) * 8;
            if (s < t) { const float* kp = Kt + ((((0 * 16 + g) * 64 + (t - s)) * 16 + c) * 16 + c0);
#pragma unroll
                for (int q = 0; q < 8; ++q) v[q] = kp[q]; }
            else if (s > t) { const float* kp = Kt + ((((1 * 16 + g) * 64 + (s - t)) * 16 + c) * 16 + c0);
#pragma unroll
                for (int q = 0; q < 8; ++q) v[q] = kp[q]; }
            else { const float* kf = Kt + ((((0 * 16 + g) * 64) * 16 + c) * 16 + c0); const float* kb = Kt + ((((1 * 16 + g) * 64) * 16 + c) * 16 + c0);
#pragma unroll
                for (int q = 0; q < 8; ++q) v[q] = kf[q] + kb[q] + ((c0 + q == c) ? p.s5_d[g * 16 + c] : 0.f); }
        } else { const int kk = (k8 - 128) * 8, dir = kk >> 7, part = (kk >> 6) & 1, p0 = kk & 63, dg = dir * 16 + g, e = dir ? (64 - t) : (t + 1);
#pragma unroll
            for (int q = 0; q < 8; ++q) { const f32x2 l = Lp[(dg * 64 + p0 + q) * 65 + e]; const float cr = p.c_re[(g * 16 + c) * 64 + p0 + q], ci = p.c_im[(g * 16 + c) * 64 + p0 + q];
                v[q] = part ? -(cr * l.y + ci * l.x) : (cr * l.x - ci * l.y); } }
        u32x4 w; w.x = cvt_pk_bf16(v[0], v[1]); w.y = cvt_pk_bf16(v[2], v[3]); w.z = cvt_pk_bf16(v[4], v[5]); w.w = cvt_pk_bf16(v[6], v[7]);
        *(u32x4*)(W + ((size_t)(g * 1024 + n)) * AEK + k8 * 8) = w; }
}

struct S5aSched {
    const char* A; const char* B; int G, c;
    __device__ __forceinline__ bool next(int i, ge::Unit& u) const { const int L = i * G + c; if (L >= 32) return false; u.e = L >> 1; u.pm = L & 1; u.pn = 0; return true; }
    __device__ __forceinline__ const char* a_base(const ge::Unit& u) const { return A + (size_t)(u.e * 512 + u.pm * 256) * AEK * 2; }
    __device__ __forceinline__ const char* b_base(const ge::Unit& u) const { return B + (size_t)u.e * 256 * 1024 * 2; }
    __device__ __forceinline__ int a_row(const ge::Unit&, int) const { return 0; }
};
struct EpiXend {
    static constexpr bool PERM = false;
    float* X;
    __device__ __forceinline__ void operator()(const f32x4 (&acc)[2][2][4][2], const ge::Unit& u, int wr, int wc, int fr, int fq) const {
        float* base = X + (size_t)(u.e * 512 + u.pm * 256 + wr * 64 + fr) * 256 + wc * 32 + 4 * fq;
#pragma unroll
        for (int ai = 0; ai < 2; ++ai)
#pragma unroll
            for (int m = 0; m < 4; ++m)
#pragma unroll
                for (int bj = 0; bj < 2; ++bj)
#pragma unroll
                    for (int n = 0; n < 2; ++n) *(f32x4*)(base + (size_t)(ai * 128 + m * 16) * 256 + bj * 128 + n * 16) = acc[ai][bj][m][n];
    }
};
__device__ __forceinline__ void s5a_phase(const Params& p, LAS unsigned char* lds, int vb, int nvb) {
    S5aSched S{(const char*)(p.ws + OFF_AEXT), (const char*)(p.ws + OFF_MG), nvb, vb};
    EpiXend E{(float*)(p.ws + OFF_XEND)};
    ge::gemm_phase<EpiXend, S5aSched, false>(lds, 1024, AEK, 1024, S, E);
    for (int L = vb; L < 32; L += nvb) {
        const int g = L >> 1, pm = L & 1, tid = threadIdx.x;
        if (tid < 256) {
            const int bb = tid >> 7, dir = (tid >> 6) & 1, pp = tid & 63, b = pm * 2 + bb, dg = dir * 16 + g;
            const f32x2* Lp = (const f32x2*)(p.out + DO_LP); const f32x2* Bb = (const f32x2*)(p.out + DO_BBAR); const bf16_t* uc = (const bf16_t*)(p.out + DO_UC);
            const f32x2 l1 = Lp[(dg * 64 + pp) * 65 + 1], l64 = Lp[(dg * 64 + pp) * 65 + 64];
            float Br[16], Bi[16];
#pragma unroll
            for (int q = 0; q < 16; ++q) { const f32x2 t = Bb[(dg * 64 + pp) * 16 + q]; Br[q] = t.x; Bi[q] = t.y; }
            float xr = 0.f, xi = 0.f;
#pragma unroll 4
            for (int s = 0; s < CTXL; ++s) { const int lc = dir ? (CTXL - 1 - s) : s;
                const bf16_t* up = uc + (size_t)(b * CTXL + lc) * 256 + g * 16;
                const u32x4 u0 = *(const u32x4*)up, u1 = *(const u32x4*)(up + 8);
                float uu[16];
                uu[0] = bf_lo(u0.x); uu[1] = bf_hi(u0.x); uu[2] = bf_lo(u0.y); uu[3] = bf_hi(u0.y); uu[4] = bf_lo(u0.z); uu[5] = bf_hi(u0.z); uu[6] = bf_lo(u0.w); uu[7] = bf_hi(u0.w);
                uu[8] = bf_lo(u1.x); uu[9] = bf_hi(u1.x); uu[10] = bf_lo(u1.y); uu[11] = bf_hi(u1.y); uu[12] = bf_lo(u1.z); uu[13] = bf_hi(u1.z); uu[14] = bf_lo(u1.w); uu[15] = bf_hi(u1.w);
                float bur = 0.f, bui = 0.f;
#pragma unroll
                for (int q = 0; q < 16; ++q) { bur += Br[q] * uu[q]; bui += Bi[q] * uu[q]; }
                const float nr = l1.x * xr - l1.y * xi + bur, ni = l1.x * xi + l1.y * xr + bui; xr = nr; xi = ni; }
            const float* Xe = (const float*)(p.ws + OFF_XEND); bf16_t* Ae = (bf16_t*)(p.ws + OFF_AEXT);
#pragma unroll 8
            for (int s = 0; s < 128; ++s) { const int m = dir ? (127 - s) : s; const size_t row = (size_t)(g * 512 + b * 128 + m);
                Ae[row * AEK + 1024 + dir * 128 + pp] = f2bf(xr); Ae[row * AEK + 1024 + dir * 128 + 64 + pp] = f2bf(xi);
                const float er = Xe[row * 256 + dir * 128 + pp], ei = Xe[row * 256 + dir * 128 + 64 + pp];
                const float nr = l64.x * xr - l64.y * xi + er, ni = l64.x * xi + l64.y * xr + ei; xr = nr; xi = ni; }
        }
    }
}

struct S5bSched {
    const char* A; const char* B; int G, c;
    __device__ __forceinline__ bool next(int i, ge::Unit& u) const { const int L = i * G + c; if (L >= 128) return false; u.e = L >> 3; u.pm = (L >> 2) & 1; u.pn = L & 3; return true; }
    __device__ __forceinline__ const char* a_base(const ge::Unit& u) const { return A + (size_t)(u.e * 512 + u.pm * 256) * AEK * 2; }
    __device__ __forceinline__ const char* b_base(const ge::Unit& u) const { return B + (size_t)(u.e * 1024 + u.pn * 256) * AEK * 2; }
    __device__ __forceinline__ int a_row(const ge::Unit&, int) const { return 0; }
};
struct EpiYs5 {
    static constexpr bool PERM = true;
    bf16_t* Y;
    __device__ __forceinline__ void operator()(const f32x4 (&acc)[2][2][4][2], const ge::Unit& u, int wr, int wc, int fr, int fq) const {
        bf16_t* rp = Y + ((size_t)(u.pm * 256 + wr * 64 + fr) * 64 + u.pn * 16 + wc * 2 + (fq >> 1)) * 256 + u.e * 16 + 8 * (fq & 1);
#pragma unroll
        for (int ai = 0; ai < 2; ++ai)
#pragma unroll
            for (int m = 0; m < 4; ++m) {
#pragma unroll
                for (int bj = 0; bj < 2; ++bj) { f32x4 v0 = acc[ai][bj][m][0], v1 = acc[ai][bj][m][1];
                    asm volatile("" : "+v"(v0), "+v"(v1));
                    u32x4 w; w.x = cvt_pk_bf16(gelu_tanh(v0[0]), gelu_tanh(v0[1])); w.y = cvt_pk_bf16(gelu_tanh(v0[2]), gelu_tanh(v0[3]));
                    w.z = cvt_pk_bf16(gelu_tanh(v1[0]), gelu_tanh(v1[1])); w.w = cvt_pk_bf16(gelu_tanh(v1[2]), gelu_tanh(v1[3]));
                    *(u32x4*)(rp + bj * 8 * 256) = w; asm volatile("" ::: "memory"); }
                rp += (m == 3) ? (size_t)(128 - 48) * 64 * 256 : (size_t)16 * 64 * 256;
                asm volatile("" : "+v"(rp)); }
    }
};
__device__ __forceinline__ void s5b_phase(const Params& p, LAS unsigned char* lds, int vb, int nvb) {
    S5bSched S{(const char*)(p.ws + OFF_AEXT), (const char*)(p.ws + OFF_WEXT), nvb, vb};
    EpiYs5 E{(bf16_t*)(p.ws + OFF_YS5)};
    ge::gemm_phase<EpiYs5, S5bSched, false>(lds, AEK, AEK, AEK, S, E);
}
constexpr size_t DO_KV = 96 * MiB, DO_DEC = 125 * MiB;
constexpr int GL_QI = 0, GL_KI = 17408, GL_KIT = 34816, GL_VT = 53248, GL_P = 71680, GL_TOT = 80896, GL_EREF = 89088, GL_ETOT = 89600;
constexpr int GLA_NSEG = 8, GLA_SEGC = 16;

template <bool PASS1>
__device__ __forceinline__ void gla_unit(const Params& p, LAS unsigned char* lds, const int chain, const int slot) {
    int tid = threadIdx.x; asm volatile("" : "+v"(tid));
    const int w = __builtin_amdgcn_readfirstlane(tid >> 6), lane = tid & 63, vloc = lane & 15, rq = lane >> 4;
    const int dir = chain & 1, h = (chain >> 1) % 6, b = chain / 12;
    const bf16_t* Z = (const bf16_t*)(p.ws + OFF_Z);
    bf16_t* O = (bf16_t*)(p.out + (dir ? DO_OB : DO_OF));
    float* KV = (float*)(p.out + DO_KV); float* DEC = (float*)(p.out + DO_DEC);
    const int nch = PASS1 ? (slot == 0 ? 4 : GLA_SEGC) : GLA_SEGC;
    const int ch0 = PASS1 ? (slot == 0 ? 0 : (slot - 1) * GLA_SEGC) : slot * GLA_SEGC;
    const bool isctx = PASS1 && slot == 0;
    const float l0a = p.lb_logits[h * 128 + 2 * lane], l1a = p.lb_logits[768 + h * 128 + 2 * lane], l0b = p.lb_logits[h * 128 + 2 * lane + 1], l1b = p.lb_logits[768 + h * 128 + 2 * lane + 1];
    const float lb0 = 1.0f / (1.0f + __expf(l1a - l0a)), lb1 = 1.0f / (1.0f + __expf(l1b - l0b));
    const int colf = (dir ? ZFB : ZFF) + h * 128 + 2 * lane, colq = ZQ + h * 128 + 2 * lane, colv = ZI + h * 128 + 2 * lane;
    auto chunk_rows = [&](int ci, int& base, int& stride) {
        if (isctx) { if (dir == 0) { base = NTOK + b * CTXL + 64 * ci; stride = 1; } else { base = NTOK + b * CTXL + 255 - 64 * ci; stride = -1; } }
        else { const int n = ch0 + ci;
            if (dir == 0) { base = b * SEQ + 4096 * (n & 1) + (n >> 1); stride = 64; }
            else { const int n2 = 127 - n; base = b * SEQ + 4096 * (n2 & 1) + (n2 >> 1) + 64 * 63; stride = -64; } }
    };
    f32x4 S[8];
    if (PASS1) {
#pragma unroll
        for (int it = 0; it < 8; ++it) S[it] = (f32x4){0.f, 0.f, 0.f, 0.f};
    } else {
#pragma unroll
        for (int it = 0; it < 8; ++it) S[it] = (f32x4){0.f, 0.f, 0.f, 0.f};
        for (int sl = 0; sl <= slot; ++sl) {
            const float* kv = KV + ((size_t)(chain * 8 + sl) * 8 + w) * 32 * 64 + lane; const float* dc = DEC + (size_t)(chain * 8 + sl) * 128;
#pragma unroll
            for (int it = 0; it < 8; ++it) { const f32x4 d = *(const f32x4*)(dc + 16 * it + 4 * rq);
#pragma unroll
                for (int j = 0; j < 4; ++j) S[it][j] = d[j] * S[it][j] + kv[(it * 4 + j) * 64]; }
        }
    }
    float dsum0 = 0.f, dsum1 = 0.f;
    unsigned nz[8], nv[8], nq[8];
    { int base, stride; chunk_rows(0, base, stride);
#pragma unroll
      for (int r = 0; r < 8; ++r) { const size_t ro = (size_t)(base + stride * (8 * w + r)) * ZC; nz[r] = *(const unsigned*)(Z + ro + colf); nv[r] = *(const unsigned*)(Z + ro + colv); if (!PASS1) nq[r] = *(const unsigned*)(Z + ro + colq); } }
    for (int ci = 0; ci < nch; ++ci) {
        unsigned cz[8], cv[8], cq[8];
#pragma unroll
        for (int r = 0; r < 8; ++r) { cz[r] = nz[r]; cv[r] = nv[r]; if (!PASS1) cq[r] = nq[r]; }
        int base, stride; chunk_rows(ci, base, stride);
        if (ci + 1 < nch) { int nb_, ns_; chunk_rows(ci + 1, nb_, ns_);
#pragma unroll
            for (int r = 0; r < 8; ++r) { const size_t ro = (size_t)(nb_ + ns_ * (8 * w + r)) * ZC; nz[r] = *(const unsigned*)(Z + ro + colf); nv[r] = *(const unsigned*)(Z + ro + colv); if (!PASS1) nq[r] = *(const unsigned*)(Z + ro + colq); } }
        float cl0[8], cl1[8], kk0[8], kk1[8]; float c0 = 0.f, c1 = 0.f;
#pragma unroll
        for (int r = 0; r < 8; ++r) { const float s0 = sigmoidf_(bf_lo(cz[r])), s1 = sigmoidf_(bf_hi(cz[r]));
            const float f0 = lb0 + (1.0f - lb0) * s0, f1 = lb1 + (1.0f - lb1) * s1;
            c0 += __logf(f0); c1 += __logf(f1); cl0[r] = c0; cl1[r] = c1; kk0[r] = (1.0f - lb0) * (1.0f - s0); kk1[r] = (1.0f - lb1) * (1.0f - s1); }
        *(LAS f32x2*)(lds + GL_TOT + (w * 128 + 2 * lane) * 4) = (f32x2){c0, c1};
        __syncthreads();
        float pre0 = 0.f, pre1 = 0.f, ref0 = 0.f, ref1 = 0.f, tot0 = 0.f, tot1 = 0.f;
#pragma unroll
        for (int ww = 0; ww < 8; ++ww) { const f32x2 tv = *(const LAS f32x2*)(lds + GL_TOT + (ww * 128 + 2 * lane) * 4);
            if (ww < w) { pre0 += tv.x; pre1 += tv.y; } if (ww < 4) { ref0 += tv.x; ref1 += tv.y; } tot0 += tv.x; tot1 += tv.y; }
        dsum0 += tot0; dsum1 += tot1;
        { float ki0[8], ki1[8];
#pragma unroll
          for (int r = 0; r < 8; ++r) { const float e0 = __expf(pre0 + cl0[r] - ref0), e1 = __expf(pre1 + cl1[r] - ref1);
              ki0[r] = kk0[r] / e0; ki1[r] = kk1[r] / e1;
              const int t = 8 * w + r;
              if (!PASS1) { *(LAS unsigned*)(lds + GL_QI + t * 272 + lane * 4) = cvt_pk_bf16(bf_lo(cq[r]) * e0, bf_hi(cq[r]) * e1);
                            *(LAS unsigned*)(lds + GL_KI + t * 272 + lane * 4) = cvt_pk_bf16(ki0[r], ki1[r]); } }
          u32x4 a, bq;
          a.x = cvt_pk_bf16(ki0[0], ki0[1]); a.y = cvt_pk_bf16(ki0[2], ki0[3]); a.z = cvt_pk_bf16(ki0[4], ki0[5]); a.w = cvt_pk_bf16(ki0[6], ki0[7]);
          bq.x = cvt_pk_bf16(ki1[0], ki1[1]); bq.y = cvt_pk_bf16(ki1[2], ki1[3]); bq.z = cvt_pk_bf16(ki1[4], ki1[5]); bq.w = cvt_pk_bf16(ki1[6], ki1[7]);
          *(LAS u32x4*)(lds + GL_KIT + (2 * lane) * 144 + 16 * w) = a; *(LAS u32x4*)(lds + GL_KIT + (2 * lane + 1) * 144 + 16 * w) = bq;
          u32x4 va, vb2;
          va.x = (cv[0] & 0xffffu) | (cv[1] << 16); va.y = (cv[2] & 0xffffu) | (cv[3] << 16); va.z = (cv[4] & 0xffffu) | (cv[5] << 16); va.w = (cv[6] & 0xffffu) | (cv[7] << 16);
          vb2.x = (cv[0] >> 16) | (cv[1] & 0xffff0000u); vb2.y = (cv[2] >> 16) | (cv[3] & 0xffff0000u); vb2.z = (cv[4] >> 16) | (cv[5] & 0xffff0000u); vb2.w = (cv[6] >> 16) | (cv[7] & 0xffff0000u);
          *(LAS u32x4*)(lds + GL_VT + (2 * lane) * 144 + 16 * w) = va; *(LAS u32x4*)(lds + GL_VT + (2 * lane + 1) * 144 + 16 * w) = vb2; }
        if (w == 0) { *(LAS f32x2*)(lds + GL_EREF + 2 * lane * 4) = (f32x2){__expf(ref0), __expf(ref1)}; *(LAS f32x2*)(lds + GL_ETOT + 2 * lane * 4) = (f32x2){__expf(tot0 - ref0), __expf(tot1 - ref1)}; }
        __syncthreads();
#pragma unroll
        for (int it = 0; it < 8; ++it) { const f32x4 er = *(const LAS f32x4*)(lds + GL_EREF + (16 * it + 4 * rq) * 4); S[it] = S[it] * er; }
        f32x4 o[4];
        if (!PASS1) {
            bf16x8 Sb[4];
#pragma unroll
            for (int c = 0; c < 4; ++c) { u32x4 t; t.x = cvt_pk_bf16(S[2 * c][0], S[2 * c][1]); t.y = cvt_pk_bf16(S[2 * c][2], S[2 * c][3]); t.z = cvt_pk_bf16(S[2 * c + 1][0], S[2 * c + 1][1]); t.w = cvt_pk_bf16(S[2 * c + 1][2], S[2 * c + 1][3]); Sb[c] = __builtin_bit_cast(bf16x8, t); }
#pragma unroll
            for (int tt = 0; tt < 4; ++tt) { o[tt] = (f32x4){0.f, 0.f, 0.f, 0.f};
#pragma unroll
                for (int c = 0; c < 4; ++c) { const LAS unsigned char* qa = lds + GL_QI + (16 * tt + vloc) * 272 + (32 * c + 4 * rq) * 2;
                    const u32x2 lo = *(const LAS u32x2*)qa, hi = *(const LAS u32x2*)(qa + 32);
                    u32x4 t; t.x = lo.x; t.y = lo.y; t.z = hi.x; t.w = hi.y;
                    o[tt] = __builtin_amdgcn_mfma_f32_16x16x32_bf16(__builtin_bit_cast(bf16x8, t), Sb[c], o[tt], 0, 0, 0); } }
            { const int tt = w >> 1;
#pragma unroll
              for (int sh = 0; sh < 2; ++sh) { const int st = 2 * (w & 1) + sh; f32x4 pacc = (f32x4){0.f, 0.f, 0.f, 0.f};
#pragma unroll
                  for (int c = 0; c < 4; ++c) { const bf16x8 ka = *(const LAS bf16x8*)(lds + GL_KI + (16 * st + vloc) * 272 + (32 * c + 8 * rq) * 2);
                      const bf16x8 qb = *(const LAS bf16x8*)(lds + GL_QI + (16 * tt + vloc) * 272 + (32 * c + 8 * rq) * 2);
                      pacc = __builtin_amdgcn_mfma_f32_16x16x32_bf16(ka, qb, pacc, 0, 0, 0); }
                  const int tg = 16 * tt + vloc, sg = 16 * st + 4 * rq;
                  u32x2 pw; pw.x = cvt_pk_bf16(sg + 0 <= tg ? pacc[0] : 0.f, sg + 1 <= tg ? pacc[1] : 0.f); pw.y = cvt_pk_bf16(sg + 2 <= tg ? pacc[2] : 0.f, sg + 3 <= tg ? pacc[3] : 0.f);
                  *(LAS u32x2*)(lds + GL_P + tg * 144 + sg * 2) = pw; } }
        }
        __syncthreads();
        { bf16x8 vb[2];
#pragma unroll
          for (int c = 0; c < 2; ++c) vb[c] = *(const LAS bf16x8*)(lds + GL_VT + (16 * w + vloc) * 144 + (32 * c + 8 * rq) * 2);
          if (!PASS1) {
#pragma unroll
              for (int tt = 0; tt < 4; ++tt)
#pragma unroll
                  for (int c = 0; c < 2; ++c) { const bf16x8 pa = *(const LAS bf16x8*)(lds + GL_P + (16 * tt + vloc) * 144 + (32 * c + 8 * rq) * 2); o[tt] = __builtin_amdgcn_mfma_f32_16x16x32_bf16(pa, vb[c], o[tt], 0, 0, 0); }
          }
#pragma unroll
          for (int it = 0; it < 8; ++it)
#pragma unroll
              for (int c = 0; c < 2; ++c) { const bf16x8 ka = *(const LAS bf16x8*)(lds + GL_KIT + (16 * it + vloc) * 144 + (32 * c + 8 * rq) * 2); S[it] = __builtin_amdgcn_mfma_f32_16x16x32_bf16(ka, vb[c], S[it], 0, 0, 0); }
#pragma unroll
          for (int it = 0; it < 8; ++it) { const f32x4 et = *(const LAS f32x4*)(lds + GL_ETOT + (16 * it + 4 * rq) * 4); S[it] = S[it] * et; }
          if (!PASS1) {
#pragma unroll
              for (int tt = 0; tt < 4; ++tt)
#pragma unroll
                  for (int j = 0; j < 4; ++j) { const int t = 16 * tt + 4 * rq + j; O[(size_t)(base + stride * t) * 768 + h * 128 + 16 * w + vloc] = f2bf(o[tt][j]); }
          } }
    }
    if (PASS1) {
        float* kv = KV + ((size_t)(chain * 8 + slot) * 8 + w) * 32 * 64 + lane;
#pragma unroll
        for (int it = 0; it < 8; ++it)
#pragma unroll
            for (int j = 0; j < 4; ++j) kv[(it * 4 + j) * 64] = S[it][j];
        if (w == 0) *(f32x2*)(DEC + (size_t)(chain * 8 + slot) * 128 + 2 * lane) = (f32x2){__expf(dsum0), __expf(dsum1)};
    }
    __syncthreads();
}
__device__ __forceinline__ void yb_phase(const Params& p) {
    const int wid = threadIdx.x >> 6, lane = threadIdx.x & 63;
    const bf16_t* Of = (const bf16_t*)(p.out + DO_OF); const bf16_t* Ob = (const bf16_t*)(p.out + DO_OB); const bf16_t* Z = (const bf16_t*)(p.ws + OFF_Z); bf16_t* Yb = (bf16_t*)(p.ws + OFF_YB);
    const float gn0 = p.hg_norm_g[lane * 2], gn1 = p.hg_norm_g[lane * 2 + 1];
    for (int t = blockIdx.x * 8 + wid; t < NTOK; t += gridDim.x * 8) {
#pragma unroll
        for (int h = 0; h < 6; ++h) {
            const int col = h * 128 + lane * 2;
            const unsigned a = *(const unsigned*)(Of + (size_t)t * 768 + col), bb = *(const unsigned*)(Ob + (size_t)t * 768 + col), gw = *(const unsigned*)(Z + (size_t)t * ZC + ZGO + col);
            const float o0 = bf_lo(a) + bf_lo(bb), o1 = bf_hi(a) + bf_hi(bb);
            const float ss = wave_sum(o0 * o0 + o1 * o1);
            const float rstd = rsqrtf(ss * (1.0f / 128.0f) + EPSF);
            *(unsigned*)(Yb + (size_t)t * 768 + col) = cvt_pk_bf16(o0 * rstd * gn0 * siluf_(bf_lo(gw)), o1 * rstd * gn1 * siluf_(bf_hi(gw)));
        }
    }
}

__device__ __forceinline__ void route_phase(const Params& p, LAS unsigned char* lds) {
    const int tid = threadIdx.x, wid = tid >> 6, lane = tid & 63;
    LAS float* hs = (LAS float*)lds;
    LAS float* part = (LAS float*)(lds + 32768);
    const float* X1 = (const float*)(p.ws + OFF_X1); const float* mod = (const float*)(p.ws + OFF_MOD);
    bf16_t* H2 = (bf16_t*)(p.ws + OFF_H2); int* eidx = (int*)(p.ws + OFF_EIDX); float* wts = (float*)(p.ws + OFF_WTS); int* counts = (int*)(p.ws + OFF_CNT);
    if (blockIdx.x == 0) for (int i = tid; i < 512; i += blockDim.x) *(unsigned*)(H2 + (size_t)NTOK * 1024 + i * 2) = 0u;
    for (int grp = blockIdx.x; grp < NTOK / 8; grp += gridDim.x) {
        { const int t = grp * 8 + wid; const float* src = X1 + (size_t)t * 1024; const float* mr = mod + (size_t)(t / SEQ) * NIN;
          f32x4 v[4]; float ss = 0.f;
#pragma unroll
          for (int j = 0; j < 4; ++j) { v[j] = *(const f32x4*)(src + j * 256 + lane * 4); ss += v[j][0] * v[j][0] + v[j][1] * v[j][1] + v[j][2] * v[j][2] + v[j][3] * v[j][3]; }
          ss = wave_sum(ss); const float rstd = rsqrtf(ss * (1.0f / 1024.0f) + EPSF);
#pragma unroll
          for (int j = 0; j < 4; ++j) { const int k = j * 256 + lane * 4;
              const f32x4 g = *(const f32x4*)(p.norm2_g + k), sh = *(const f32x4*)(mr + 3072 + k), scv = *(const f32x4*)(mr + 4096 + k);
              f32x4 o;
#pragma unroll
              for (int q = 0; q < 4; ++q) o[q] = v[j][q] * rstd * g[q] * (1.0f + scv[q]) + sh[q];
              *(LAS f32x4*)(hs + wid * 1024 + k) = o;
              u32x2 w; w.x = cvt_pk_bf16(o[0], o[1]); w.y = cvt_pk_bf16(o[2], o[3]); *(u32x2*)(H2 + (size_t)t * 1024 + k) = w; } }
        __syncthreads();
        { float a[8];
#pragma unroll
          for (int q = 0; q < 8; ++q) a[q] = 0.f;
          for (int k = wid * 128; k < wid * 128 + 128; ++k) { const float w = p.w_router[k * 64 + lane];
#pragma unroll
              for (int q = 0; q < 8; ++q) a[q] += hs[q * 1024 + k] * w; }
#pragma unroll
          for (int q = 0; q < 8; ++q) part[(wid * 8 + q) * 64 + lane] = a[q]; }
        __syncthreads();
        { const int t = grp * 8 + wid; float logit = 0.f;
#pragma unroll
          for (int w = 0; w < 8; ++w) logit += part[(w * 8 + wid) * 64 + lane];
          const float sc = 1.0f / (1.0f + expf(-logit)), bs = sc + p.b_router[lane];
          float m1 = bs;
          m1 = fmaxf(m1, __shfl_xor(m1, 1)); m1 = fmaxf(m1, __shfl_xor(m1, 2)); m1 = fmaxf(m1, __shfl_xor(m1, 4));
          const unsigned long long ism = __ballot(bs == m1);
          const int gbase = lane & ~7; const unsigned gm = (unsigned)((ism >> gbase) & 0xffull);
          const int first = gbase + __builtin_ctz(gm);
          float m2 = (lane == first) ? -INFINITY : bs;
          m2 = fmaxf(m2, __shfl_xor(m2, 1)); m2 = fmaxf(m2, __shfl_xor(m2, 2)); m2 = fmaxf(m2, __shfl_xor(m2, 4));
          const float gs = m1 + m2; const int gid = lane >> 3;
          int grank = 0;
#pragma unroll
          for (int g2 = 0; g2 < 8; ++g2) { const float og = __shfl(gs, g2 * 8); grank += (og > gs || (og == gs && g2 < gid)) ? 1 : 0; }
          const bool gok = grank < 4;
          const float mk = gok ? bs : -INFINITY;
          int rank = 0;
          for (int e2 = 0; e2 < 64; ++e2) { const float ov = __shfl(mk, e2); rank += (ov > mk || (ov == mk && e2 < lane)) ? 1 : 0; }
          const bool sel = gok && rank < TOPK;
          const float wsum = wave_sum(sel ? sc : 0.f);
          if (sel) { eidx[t * 8 + rank] = lane; wts[t * 8 + rank] = sc / wsum * 2.5f; atomicAdd(&counts[lane], 1); } }
        __syncthreads();
    }
}

__device__ __forceinline__ void offsets_phase(const Params& p, LAS unsigned char* lds) {
    int* cnt = (int*)(p.ws + OFF_CNT); int* cursor = cnt + 64; int* pstart = cnt + 128; int* nblk = cnt + 256; int* blk_e = (int*)(p.ws + OFF_BLKE);
    if (blockIdx.x != 0) return;
    LAS int* ps = (LAS int*)lds;
    if (threadIdx.x == 0) { int a = 0; for (int e = 0; e < 64; ++e) { ps[e] = a; a += (cnt[e] + 255) / 256 * 256; } ps[64] = a; ps[65] = a + NTOK; }
    __syncthreads();
    if (threadIdx.x < 66) pstart[threadIdx.x] = ps[threadIdx.x];
    if (threadIdx.x < 64) cursor[threadIdx.x] = 0;
    if (threadIdx.x == 0) *nblk = ps[65] / 256;
    for (int rb = threadIdx.x; rb < ps[65] / 256; rb += blockDim.x) { int e = 0; while (e < 64 && rb * 256 >= ps[e + 1]) ++e; blk_e[rb] = e; }
}
__device__ __forceinline__ void scatter_phase(const Params& p) {
    int* cnt = (int*)(p.ws + OFF_CNT); int* cursor = cnt + 64; const int* pstart = cnt + 128;
    const int* eidx = (const int*)(p.ws + OFF_EIDX); int* apos = (int*)(p.ws + OFF_APOS); int* row_tok = (int*)(p.ws + OFF_ROWTOK);
    const int gt = blockIdx.x * blockDim.x + threadIdx.x, gs = gridDim.x * blockDim.x;
    for (int i = gt; i < NTOK * TOPK; i += gs) { const int e = eidx[i]; const int pos = pstart[e] + atomicAdd(&cursor[e], 1); row_tok[pos] = i >> 3; apos[i] = pos; }
    for (int i = gt; i < 64 * 256; i += gs) { const int e = i >> 8, j = i & 255; const int pos = pstart[e] + cnt[e] + j; if (pos < pstart[e + 1]) row_tok[pos] = NTOK; }
    for (int i = gt; i < NTOK; i += gs) row_tok[pstart[64] + i] = i;
}

template <int HALFI>
__device__ __forceinline__ void combine_phase(const Params& p) {
    const int wid = threadIdx.x >> 6, lane = threadIdx.x & 63;
    float* X1 = (float*)(p.ws + OFF_X1); const float* mod = (const float*)(p.ws + OFF_MOD); const bf16_t* Y2 = (const bf16_t*)(p.ws + OFF_Y2);
    const int* apos = (const int*)(p.ws + OFF_APOS); const float* wts = (const float*)(p.ws + OFF_WTS); float* out = (float*)p.out;
    for (int t = blockIdx.x * 8 + wid; t < NTOK; t += gridDim.x * 8) {
        float a[8];
#pragma unroll
        for (int q = 0; q < 8; ++q) a[q] = 0.f;
#pragma unroll
        for (int k = 0; k < TOPK; ++k) { const int pos = apos[t * 8 + k]; const float w = wts[t * 8 + k];
            const u32x4 yv = *(const u32x4*)(Y2 + (size_t)pos * 512 + lane * 8);
            a[0] += w * bf_lo(yv.x); a[1] += w * bf_hi(yv.x); a[2] += w * bf_lo(yv.y); a[3] += w * bf_hi(yv.y); a[4] += w * bf_lo(yv.z); a[5] += w * bf_hi(yv.z); a[6] += w * bf_lo(yv.w); a[7] += w * bf_hi(yv.w); }
        const int col = HALFI * 512 + lane * 8;
        const float* g2 = mod + (size_t)(t / SEQ) * NIN + 5120 + col;
        float* xp = X1 + (size_t)t * 1024 + col;
        f32x4 v0 = *(const f32x4*)xp, v1 = *(const f32x4*)(xp + 4);
        const f32x4 ga = *(const f32x4*)g2, gb = *(const f32x4*)(g2 + 4);
#pragma unroll
        for (int q = 0; q < 4; ++q) { v0[q] += ga[q] * a[q]; v1[q] += gb[q] * a[4 + q]; }
        if (HALFI == 0) { *(f32x4*)xp = v0; *(f32x4*)(xp + 4) = v1; }
        else {
            const float* xo = X1 + (size_t)t * 1024 + lane * 8;
            const f32x4 w0 = *(const f32x4*)xo, w1 = *(const f32x4*)(xo + 4);
            float ss = 0.f;
#pragma unroll
            for (int q = 0; q < 4; ++q) ss += v0[q] * v0[q] + v1[q] * v1[q] + w0[q] * w0[q] + w1[q] * w1[q];
            ss = wave_sum(ss); const float rstd = rsqrtf(ss * (1.0f / 1024.0f) + EPSF);
            const float* gf = p.final_g; float* op = out + (size_t)t * 1024;
            const f32x4 f0 = *(const f32x4*)(gf + lane * 8), f1 = *(const f32x4*)(gf + lane * 8 + 4), f2 = *(const f32x4*)(gf + col), f3 = *(const f32x4*)(gf + col + 4);
            *(f32x4*)(op + lane * 8) = w0 * rstd * f0; *(f32x4*)(op + lane * 8 + 4) = w1 * rstd * f1;
            *(f32x4*)(op + col) = v0 * rstd * f2; *(f32x4*)(op + col + 4) = v1 * rstd * f3;
        }
    }
}
constexpr int FUSED_LDS = ge::STAGE_BYTES + 64;

template <int PA, int PB> __global__ __launch_bounds__(512, 2) void k_fwd(Params p) {
    extern __shared__ __attribute__((aligned(16))) unsigned char shm[];
    LAS unsigned char* lds = (LAS unsigned char*)shm;
    LAS unsigned* xbw = (LAS unsigned*)(lds + ge::STAGE_BYTES);
    if (threadIdx.x == 0) { xbw[0] = 0u; xbw[1] = 0u; xbw[2] = 0u; xbw[3] = 0u; }
    __syncthreads();
    XcdBarrier bar = xcd_barrier_post((unsigned*)(p.ws + OFF_BAR), (volatile LAS unsigned*)xbw);
    const int nb = (int)gridDim.x, bid = (int)blockIdx.x;
    const int* cnt = (const int*)(p.ws + OFF_CNT);
#define PH(k) if constexpr (PA <= (k) && (k) < PB)
#define BARRIER(k) if constexpr (PA <= (k) && (k) + 1 < PB) xcd_barrier(bar)
    PH(0) { if (bid == 0 && threadIdx.x < 128) ((int*)(p.ws + OFF_CNT))[threadIdx.x] = 0;
            ada_phase(p, lds); s5_tab1_phase(p); }
    BARRIER(0);
    PH(1) { cvt_dense_phase(p, lds); norm1_phase(p); s5_tab2_phase(p); }
    BARRIER(1);
    PH(2) { PlainSched S; S.init(p.ws + OFF_H, 1024, p.ws + OFF_WINT, 1024, NROWS / 256, NIN / 256);
      EpiZ2 E{(bf16_t*)(p.ws + OFF_AEXT), (bf16_t*)(p.out + DO_UC), (bf16_t*)(p.ws + OFF_Z)};
      ge::gemm_phase<EpiZ2, PlainSched, false>(lds, 1024, 1024, 1024, S, E); }
    BARRIER(2);
    PH(3) { if (bid < 32) s5a_phase(p, lds, bid, 32);
            else for (int u = bid - 32; u < 48 * 8; u += nb - 32) gla_unit<true>(p, lds, u >> 3, u & 7);
            s5_wfill_phase(p, bid, nb); }
    BARRIER(3);
    PH(4) { for (int u = bid; u < 48 * 8; u += nb) gla_unit<false>(p, lds, u >> 3, u & 7);
            if (bid >= nb - 128) s5b_phase(p, lds, bid - (nb - 128), 128); }
    BARRIER(4);
    PH(5) { yb_phase(p);
      PlainSched S; S.init(p.ws + OFF_YS5, 256, p.ws + OFF_GLUT, 256, NTOK / 256, 1);
      EpiYa E{(const bf16_t*)(p.ws + OFF_YS5), (bf16_t*)(p.ws + OFF_YA)};
      ge::gemm_phase<EpiYa, PlainSched, false>(lds, 256, 256, 256, S, E); }
    BARRIER(5);
    PH(6) { PlainSched S; S.init(p.ws + OFF_YA, 256, p.ws + OFF_PAT, 256, NTOK / 256, 4);
      EpiMerge<false> E{(const bf16_t*)(p.ws + OFF_Z), ZGA, (bf16_t*)(p.out + DO_MERGED)};
      ge::gemm_phase<EpiMerge<false>, PlainSched, false>(lds, 256, 256, 256, S, E); }
    BARRIER(6);
    PH(7) { PlainSched S; S.init(p.ws + OFF_YB, 768, p.ws + OFF_PBT, 768, NTOK / 256, 4);
      EpiMerge<true> E{(const bf16_t*)(p.ws + OFF_Z), ZGB, (bf16_t*)(p.out + DO_MERGED)};
      ge::gemm_phase<EpiMerge<true>, PlainSched, false>(lds, 768, 768, 768, S, E); }
    BARRIER(7);
    PH(8) { PlainSched S; S.init(p.out + DO_MERGED, 1024, p.ws + OFF_WOUTT, 1024, NTOK / 256, 4);
      EpiX1 E{p.x, (const float*)(p.ws + OFF_MOD), (float*)(p.ws + OFF_X1)};
      ge::gemm_phase<EpiX1, PlainSched, false>(lds, 1024, 1024, 1024, S, E); }
    BARRIER(8);
    PH(9) { route_phase(p, lds); cvt_moe_phase(p, lds); }
    BARRIER(9);
    PH(10) { offsets_phase(p, lds); }
    BARRIER(10);
    PH(11) { scatter_phase(p); }
    BARRIER(11);
    PH(12) { MoeSched1 S{(const int*)(p.ws + OFF_BLKE), cnt + 256, (const int*)(p.ws + OFF_ROWTOK), (const char*)(p.ws + OFF_H2), (const char*)(p.ws + OFF_BT1), nb, bid};
      EpiHid E{p.ws, p.out};
      ge::gemm_phase<EpiHid, MoeSched1, true>(lds, 1024, 1024, 1024, S, E); }
    BARRIER(12);
    PH(13) { MoeSched2 S{(const int*)(p.ws + OFF_BLKE), cnt + 256, p.ws, p.out, (const char*)(p.ws + OFF_BT2), 0, nb, bid};
      EpiY2 E{(bf16_t*)(p.ws + OFF_Y2), (float*)(p.ws + OFF_X1), (const float*)(p.ws + OFF_MOD), cnt + 128, 0};
      ge::gemm_phase<EpiY2, MoeSched2, false>(lds, 256, 256, 256, S, E); }
    BARRIER(13);
    PH(14) { combine_phase<0>(p); }
    BARRIER(14);
    PH(15) { MoeSched2 S{(const int*)(p.ws + OFF_BLKE), cnt + 256, p.ws, p.out, (const char*)(p.ws + OFF_BT2), 1, nb, bid};
      EpiY2 E{(bf16_t*)(p.ws + OFF_Y2), (float*)(p.ws + OFF_X1), (const float*)(p.ws + OFF_MOD), cnt + 128, 1};
      ge::gemm_phase<EpiY2, MoeSched2, false>(lds, 256, 256, 256, S, E); }
    BARRIER(15);
    PH(16) { combine_phase<1>(p); }
#undef PH
#undef BARRIER
}


static Params make_params(void* const* d_in, void* d_out, void* d_ws) {
    Params p{};
    const float** f = (const float**)&p;
    for (int i = 0; i < 32; ++i) f[i] = (const float*)d_in[i];
    p.ws = (unsigned char*)d_ws; p.out = (unsigned char*)d_out;
    return p;
}

extern "C" void kernel_launch(void* const* d_in, const int* in_sizes, int n_in, void* d_out, int out_size, void* d_ws, size_t ws_size, hipStream_t stream) {
    (void)in_sizes; (void)n_in; (void)out_size; (void)ws_size;
    static int grid = 0;
    if (!grid) {
        (void)hipFuncSetAttribute((const void*)k_fwd<0, 17>, hipFuncAttributeMaxDynamicSharedMemorySize, FUSED_LDS);
        int dev = 0, cus = 0, per_cu = 0;
        (void)hipGetDevice(&dev);
        (void)hipDeviceGetAttribute(&cus, hipDeviceAttributeMultiprocessorCount, dev);
        (void)hipOccupancyMaxActiveBlocksPerMultiprocessor(&per_cu, (const void*)k_fwd<0, 17>, 512, FUSED_LDS);
        if (per_cu < 1) { fprintf(stderr, "k_fwd: occupancy query says 0 blocks per CU\n"); per_cu = 1; }
        grid = cus;
    }
    const Params p = make_params(d_in, d_out, d_ws);
    (void)hipMemsetAsync((unsigned char*)d_ws + OFF_BAR, 0, XCD_BAR_WORDS * sizeof(unsigned), stream);
    hipLaunchKernelGGL((k_fwd<0, 17>), dim3(grid), dim3(512), FUSED_LDS, stream, p);
}
```

```cpp
#include <hip/hip_runtime.h>
#include <stdint.h>
#include <stdio.h>

#define LAS __attribute__((address_space(3)))
typedef unsigned short bf16_t;
typedef short bf16x8 __attribute__((ext_vector_type(8)));
typedef float f32x4 __attribute__((ext_vector_type(4)));
typedef float f32x2 __attribute__((ext_vector_type(2)));
typedef unsigned u32x4 __attribute__((ext_vector_type(4)));
typedef unsigned u32x2 __attribute__((ext_vector_type(2)));

constexpr int NB = 4, SEQ = 8192, DM = 1024, NTOK = NB * SEQ, CTXL = 256, NCTX = NB * CTXL, NROWS = NTOK + NCTX;
constexpr int NIN = 6144, ZC = 5888;
constexpr int ZQ = 0, ZFF = 768, ZFB = 1536, ZI = 2304, ZGO = 3072, ZGA = 3840, ZGB = 4864;
constexpr int NEXP = 64, TOPK = 8, EH = 256;
constexpr int CAP_ROUTED = NTOK * TOPK + NEXP * 256;
constexpr int CAP_ROWS = CAP_ROUTED + NTOK;
constexpr int HID1_RB = 1024;
constexpr float EPSF = 1e-6f;

__device__ __forceinline__ unsigned cvt_pk_bf16(float lo, float hi) { unsigned r; asm volatile("v_cvt_pk_bf16_f32 %0, %1, %2" : "=v"(r) : "v"(lo), "v"(hi)); return r; }
__device__ __forceinline__ float bf_lo(unsigned w) { return __uint_as_float(w << 16); }
__device__ __forceinline__ float bf_hi(unsigned w) { return __uint_as_float(w & 0xffff0000u); }
__device__ __forceinline__ float bf2f(bf16_t b) { return __uint_as_float(((unsigned)b) << 16); }
__device__ __forceinline__ bf16_t f2bf(float f) { return (bf16_t)(cvt_pk_bf16(f, 0.f) & 0xffffu); }
__device__ __forceinline__ float frcp_(float x) { return __builtin_amdgcn_rcpf(x); }
__device__ __forceinline__ float sigmoidf_(float x) { return frcp_(1.0f + __expf(-x)); }
__device__ __forceinline__ float siluf_(float x) { return x * frcp_(1.0f + __expf(-x)); }
template <int CTRL> __device__ __forceinline__ float dpp_mov_(float v) { return __int_as_float(__builtin_amdgcn_update_dpp(0, __float_as_int(v), CTRL, 0xf, 0xf, true)); }
__device__ __forceinline__ float wave_sum(float v) {
    v += dpp_mov_<0xB1>(v); v += dpp_mov_<0x4E>(v); v += dpp_mov_<0x141>(v); v += dpp_mov_<0x140>(v);
    const float a = __int_as_float(__builtin_amdgcn_readlane(__float_as_int(v), 0)), b = __int_as_float(__builtin_amdgcn_readlane(__float_as_int(v), 16));
    const float c = __int_as_float(__builtin_amdgcn_readlane(__float_as_int(v), 32)), d = __int_as_float(__builtin_amdgcn_readlane(__float_as_int(v), 48));
    return (a + b) + (c + d);
}
__device__ __forceinline__ float gelu_tanh(float y) {
    const float u = 0.7978845608028654f * (y + 0.044715f * y * y * y);
    const float e = __expf(2.0f * u);
    const float t = 1.0f - 2.0f * frcp_(e + 1.0f);
    return 0.5f * y * (1.0f + t);
}
#define XB_TMO      128
#define XB_XCNT(j)  (256  + 64 * (j))
#define XB_XSUB(j)  (1280 + 64 * (j))
#define XB_XGEN(j)  (2304 + 64 * (j))
#define XB_TOP      3328
#define XB_TOPGEN   3392
#define XCD_BAR_WORDS 3456
#define XB_SPIN_CAP (1u << 18)

__device__ __forceinline__ unsigned xb_ld(unsigned* p)              { return __hip_atomic_load(p, __ATOMIC_RELAXED, __HIP_MEMORY_SCOPE_AGENT); }
__device__ __forceinline__ unsigned xb_add(unsigned* p, unsigned v) { return __hip_atomic_fetch_add(p, v, __ATOMIC_RELAXED, __HIP_MEMORY_SCOPE_AGENT); }
__device__ __forceinline__ unsigned xb_xcc_id() { return (unsigned)__builtin_amdgcn_s_getreg((3 << 11) | 20) & 0xFu; }
#define XB_SPIN(cond, bar) do { unsigned _sp = 0; while (cond) { __builtin_amdgcn_s_sleep(1); \
    if ((++_sp & 255u) == 0u) { if (xb_ld(&(bar)[XB_TMO])) break; if (_sp > XB_SPIN_CAP) { atomicAdd(&(bar)[XB_TMO], 1u); break; } } } } while (0)

struct XcdBarrier {
    unsigned* bar; unsigned x;
    volatile LAS unsigned* st;
};

__device__ __forceinline__ XcdBarrier xcd_barrier_post(unsigned* bar, volatile LAS unsigned* st) {
    XcdBarrier b; b.bar = bar; b.x = xb_xcc_id(); b.st = st;
    if (threadIdx.x == 0) (void)xb_add(&bar[XB_XCNT(b.x)], 1u);
    return b;
}
__device__ __forceinline__ void xcd_barrier_complete(unsigned* bar, unsigned x, unsigned& nloc, unsigned& nx) {
    const unsigned G = gridDim.x * gridDim.y * gridDim.z;
    unsigned sum, cnt, mine, sp = 0u;
    for (;;) {
        sum = 0u; cnt = 0u; mine = 0u;
#pragma unroll
        for (unsigned j = 0; j < 16; ++j) { const unsigned c = xb_ld(&bar[XB_XCNT(j)]); sum += c; cnt += (c > 0u) ? 1u : 0u; mine = (j == x) ? c : mine; }
        if (sum == G) break;
        __builtin_amdgcn_s_sleep(1);
        if ((++sp & 255u) == 0u) { if (xb_ld(&bar[XB_TMO])) break; if (sp > XB_SPIN_CAP) { atomicAdd(&bar[XB_TMO], 1u); break; } }
    }
    nloc = mine > 0u ? mine : 1u; nx = cnt > 0u ? cnt : 1u;
}

__device__ __forceinline__ void xcd_barrier(const XcdBarrier& b) {
    asm volatile("s_waitcnt vmcnt(0)" ::: "memory");
    __syncthreads();
    if (threadIdx.x == 0) {
        unsigned* bar = b.bar;
        __builtin_amdgcn_s_waitcnt(0);
        unsigned nloc = b.st[0], nx = b.st[1];
        if (nloc == 0u) { xcd_barrier_complete(bar, b.x, nloc, nx); b.st[0] = nloc; b.st[1] = nx; }
        const unsigned old = xb_add(&bar[XB_XSUB(b.x)], 1u);
        const unsigned gen = old / nloc;
        if (old + 1u == (gen + 1u) * nloc) {
            __builtin_amdgcn_fence(__ATOMIC_RELEASE, "agent");
            asm volatile("s_waitcnt vmcnt(0)" ::: "memory");
            const unsigned og = xb_add(&bar[XB_TOP], 1u);
            const unsigned tg = og / nx;
            if (og + 1u == (tg + 1u) * nx) xb_add(&bar[XB_TOPGEN], 1u);
            else XB_SPIN(xb_ld(&bar[XB_TOPGEN]) == tg, bar);
            __builtin_amdgcn_fence(__ATOMIC_ACQUIRE, "agent");
            xb_add(&bar[XB_XGEN(b.x)], 1u);
            asm volatile("s_waitcnt vmcnt(0)" ::: "memory");
        } else {
            XB_SPIN(xb_ld(&bar[XB_XGEN(b.x)]) == gen, bar);
            __builtin_amdgcn_fence(__ATOMIC_ACQUIRE, "agent");
            asm volatile("s_waitcnt vmcnt(0)" ::: "memory");
        }
    }
    __syncthreads();
}

namespace ge {
typedef int i32x4 __attribute__((ext_vector_type(4)));
typedef int i32x8 __attribute__((ext_vector_type(8)));
constexpr int BM = 256, BK = 64, HALF = 128, HTB = HALF * BK * 2, STAGE_BYTES = 8 * HTB, NXCD = 8, WGM = 8;
__host__ __device__ __forceinline__ int lds_byte(int r, int c) { const int st = (r >> 4) * 2 + (c >> 5), rr = r & 15, cc = c & 31, ob = rr * 64 + cc * 2; return st * 1024 + (ob ^ (((ob >> 9) & 1) << 5)); }
__host__ __device__ __forceinline__ void stage_rc(int b, int& R, int& C) { const int st = b / 1024, sb = b % 1024, swz = sb ^ (((sb >> 9) & 1) << 5); R = (st >> 1) * 16 + swz / 64; C = (st & 1) * 32 + (swz % 64) / 2; }
__host__ __device__ __forceinline__ int perm32(int rho) { const int n = rho >> 4, i = rho & 15; return 8 * (i >> 2) + 4 * n + (i & 3); }

struct Unit { int pm, pn, e, k; };

struct GridOrder {
    int nM, nN, nwg, G, c;
    __device__ void init(int nM_, int nN_, int G_, int c_) { nM = nM_; nN = nN_; nwg = nM * nN; G = G_; c = c_; }
    __device__ bool tile(int i, int& pm, int& pn) const {
        const long L = (long)i * G + c; if (L >= nwg) return false;
        int wgid = (int)L; { const int q = nwg / NXCD, r = nwg % NXCD, xcd = wgid % NXCD, off = wgid / NXCD; wgid = (xcd < r ? xcd * (q + 1) : r * (q + 1) + (xcd - r) * q) + off; }
        const int nig = WGM * nN, gid = wgid / nig, fm = gid * WGM, gsz = (nM - fm) < WGM ? (nM - fm) : WGM;
        pm = fm + ((wgid % nig) % gsz); pn = (wgid % nig) / gsz; return true;
    }
};

template <class Epi, class Sched, bool GATHER>
__device__ __forceinline__ void gemm_phase(LAS unsigned char* lds, const int K, const int lda, const int ldb, const Sched& S, const Epi& E) {
    int tid = threadIdx.x; asm volatile("" : "+v"(tid));
    const int wid = __builtin_amdgcn_readfirstlane(tid >> 6), lane = tid & 63, wr = wid >> 2, wc = wid & 3, fr = lane & 15, fq = lane >> 4;
    const int nt = K / BK;
    int Rr[2], Cc[2]; unsigned voffB[2];
#pragma unroll
    for (int i = 0; i < 2; ++i) { int R, C; stage_rc(tid * 16 + i * 8192, R, C); Rr[i] = R; Cc[i] = C; const int Rb = Epi::PERM ? ((R & ~31) + perm32(R & 31)) : R; voffB[i] = (unsigned)(Rb * ldb + C) * 2u; }
    const size_t kstep = (size_t)(BK * 2);
    const size_t hstepB = (size_t)HALF * ldb * 2;
    const unsigned ldsw = (unsigned)wid * 1024u;
    const int aoff = lds_byte(wr * 64 + fr, fq * 8), boff = lds_byte(wc * 32 + fr, fq * 8);
#define GE_SA(b, h) (((b) * 2 + (h)) * HTB)
#define GE_SB(b, h) ((4 + (b) * 2 + (h)) * HTB)
#define GE_STAGE(bufoff, gbase, v0, v1) do { \
        __builtin_amdgcn_global_load_lds((const unsigned*)((const char*)(gbase) + (v0)), (LAS unsigned*)(lds + (bufoff) + ldsw), 16, 0, 0); \
        __builtin_amdgcn_global_load_lds((const unsigned*)((const char*)(gbase) + (v1)), (LAS unsigned*)(lds + (bufoff) + ldsw + 8192), 16, 0, 0); } while (0)
#define GE_STAGE_B(bufoff, gbase) GE_STAGE(bufoff, gbase, voffB[0], voffB[1])
#define GE_LDA(dst, b, h) do { _Pragma("unroll") for (int m = 0; m < 4; ++m) _Pragma("unroll") for (int k = 0; k < 2; ++k) dst[m][k] = *(const LAS bf16x8*)(lds + GE_SA(b, h) + aoff + m * 2048 + k * 1024); } while (0)
#define GE_LDB(dst, b, h) do { _Pragma("unroll") for (int n = 0; n < 2; ++n) _Pragma("unroll") for (int k = 0; k < 2; ++k) dst[n][k] = *(const LAS bf16x8*)(lds + GE_SB(b, h) + boff + n * 2048 + k * 1024); } while (0)
#define GE_MMA(ai, bj, At, Bt) do { __builtin_amdgcn_s_setprio(1); _Pragma("unroll") for (int m = 0; m < 4; ++m) _Pragma("unroll") for (int n = 0; n < 2; ++n) _Pragma("unroll") for (int k = 0; k < 2; ++k) \
        acc[ai][bj][m][n] = __builtin_amdgcn_mfma_f32_16x16x32_bf16(Bt[n][k], At[m][k], acc[ai][bj][m][n], 0, 0, 0); __builtin_amdgcn_s_setprio(0); } while (0)
#define GE_WAIT_V(n) asm volatile("s_waitcnt vmcnt(" #n ")" ::: "memory")
#define GE_WAIT_L(n) asm volatile("s_waitcnt lgkmcnt(" #n ")" ::: "memory")
#define GE_BAR __builtin_amdgcn_s_barrier()
#define GE_SCHED __builtin_amdgcn_sched_barrier(0)
    Unit cur, nxt, nn; int ui = 0;
    if (!S.next(0, cur)) return;
    bool has_next = S.next(1, nxt);
    unsigned c00, c01, c10, c11, n00, n01, n10, n11; int rn0 = 0, rn1 = 0, rn2 = 0, rn3 = 0, rq0 = 0, rq1 = 0, rq2 = 0, rq3 = 0;
    if constexpr (GATHER) {
        c00 = (unsigned)(S.a_row(cur, Rr[0]) * lda + Cc[0]) * 2u; c01 = (unsigned)(S.a_row(cur, Rr[1]) * lda + Cc[1]) * 2u;
        c10 = (unsigned)(S.a_row(cur, HALF + Rr[0]) * lda + Cc[0]) * 2u; c11 = (unsigned)(S.a_row(cur, HALF + Rr[1]) * lda + Cc[1]) * 2u;
        if (has_next) { rn0 = S.a_row(nxt, Rr[0]); rn1 = S.a_row(nxt, Rr[1]); rn2 = S.a_row(nxt, HALF + Rr[0]); rn3 = S.a_row(nxt, HALF + Rr[1]); }
    } else {
        c00 = (unsigned)(Rr[0] * lda + Cc[0]) * 2u; c01 = (unsigned)(Rr[1] * lda + Cc[1]) * 2u;
        c10 = c00 + (unsigned)(HALF * lda * 2); c11 = c01 + (unsigned)(HALF * lda * 2);
    }
    n00 = c00; n01 = c01; n10 = c10; n11 = c11;
    f32x4 acc[2][2][4][2];
#pragma unroll
    for (int a = 0; a < 2; ++a)
#pragma unroll
        for (int b = 0; b < 2; ++b)
#pragma unroll
            for (int m = 0; m < 4; ++m)
#pragma unroll
                for (int n = 0; n < 2; ++n) acc[a][b][m][n] = (f32x4){0.f, 0.f, 0.f, 0.f};
    bf16x8 At[4][2], B0[2][2], B1[2][2];
    const char* cA = S.a_base(cur); const char* cB = S.b_base(cur);
    GE_STAGE_B(GE_SB(0, 0), cB); GE_STAGE(GE_SA(0, 0), cA, c00, c01); GE_STAGE_B(GE_SB(0, 1), cB + hstepB); GE_STAGE(GE_SA(0, 1), cA, c10, c11);
    if (wr == 1) GE_BAR;
    GE_WAIT_V(4); GE_BAR;
    GE_STAGE_B(GE_SB(1, 0), cB + kstep); GE_STAGE(GE_SA(1, 0), cA + kstep, c00, c01); GE_STAGE_B(GE_SB(1, 1), cB + hstepB + kstep);
    GE_WAIT_V(6); GE_BAR;
    for (;;) {
        const bool has_nn = has_next ? S.next(ui + 2, nn) : false;
        const char* nA = has_next ? S.a_base(nxt) : cA; const char* nB = has_next ? S.b_base(nxt) : cB;
        if constexpr (GATHER) {
            if (has_next) { n00 = (unsigned)(rn0 * lda + Cc[0]) * 2u; n01 = (unsigned)(rn1 * lda + Cc[1]) * 2u; n10 = (unsigned)(rn2 * lda + Cc[0]) * 2u; n11 = (unsigned)(rn3 * lda + Cc[1]) * 2u; }
            else { n00 = c00; n01 = c01; n10 = c10; n11 = c11; }
            if (has_nn) { rq0 = S.a_row(nn, Rr[0]); rq1 = S.a_row(nn, Rr[1]); rq2 = S.a_row(nn, HALF + Rr[0]); rq3 = S.a_row(nn, HALF + Rr[1]); }
        }
#pragma unroll 1
        for (int t = 0; t < nt; t += 2) {
            const bool last = (t == nt - 2);
            const char* a1 = cA + (size_t)(t + 1) * kstep;
            const char* a2 = last ? nA : cA + (size_t)(t + 2) * kstep; const char* b2 = last ? nB : cB + (size_t)(t + 2) * kstep;
            const char* a3 = a2 + kstep; const char* b3 = b2 + kstep;
            unsigned x00 = c00, x01 = c01, x10 = c10, x11 = c11;
            if constexpr (GATHER) { if (last) { x00 = n00; x01 = n01; x10 = n10; x11 = n11; } }
            GE_LDB(B0, 0, 0); GE_SCHED; GE_LDA(At, 0, 0); GE_STAGE(GE_SA(1, 1), a1, c10, c11);
            GE_WAIT_L(8); GE_BAR; GE_WAIT_L(0); GE_MMA(0, 0, At, B0); GE_BAR; GE_SCHED;
            GE_LDB(B1, 0, 1); GE_STAGE_B(GE_SB(0, 0), b2);
            GE_BAR; GE_WAIT_L(0); GE_MMA(0, 1, At, B1); GE_BAR;
            GE_LDA(At, 0, 1); GE_STAGE(GE_SA(0, 0), a2, x00, x01);
            GE_BAR; GE_WAIT_L(0); GE_MMA(1, 0, At, B0); GE_BAR; GE_SCHED;
            GE_STAGE_B(GE_SB(0, 1), b2 + hstepB);
            GE_WAIT_V(6); GE_BAR; GE_MMA(1, 1, At, B1); GE_BAR;
            GE_LDB(B0, 1, 0); GE_SCHED; GE_LDA(At, 1, 0); GE_STAGE(GE_SA(0, 1), a2, x10, x11);
            GE_WAIT_L(8); GE_BAR; GE_WAIT_L(0); GE_MMA(0, 0, At, B0); GE_BAR; GE_SCHED;
            GE_LDB(B1, 1, 1); GE_STAGE_B(GE_SB(1, 0), b3);
            GE_BAR; GE_WAIT_L(0); GE_MMA(0, 1, At, B1); GE_BAR;
            GE_LDA(At, 1, 1); GE_STAGE(GE_SA(1, 0), a3, x00, x01);
            GE_BAR; GE_WAIT_L(0); GE_MMA(1, 0, At, B0); GE_BAR; GE_SCHED;
            GE_STAGE_B(GE_SB(1, 1), b3 + hstepB);
            GE_WAIT_V(6); GE_BAR; GE_MMA(1, 1, At, B1); GE_BAR;
        }
        E(acc, cur, wr, wc, fr, fq);
        if (!has_next) break;
#pragma unroll
        for (int a = 0; a < 2; ++a)
#pragma unroll
            for (int b = 0; b < 2; ++b)
#pragma unroll
                for (int m = 0; m < 4; ++m)
#pragma unroll
                    for (int n = 0; n < 2; ++n) acc[a][b][m][n] = (f32x4){0.f, 0.f, 0.f, 0.f};
        cur = nxt; nxt = nn; has_next = has_nn; cA = nA; cB = nB; ++ui;
        if constexpr (GATHER) { c00 = n00; c01 = n01; c10 = n10; c11 = n11; rn0 = rq0; rn1 = rq1; rn2 = rq2; rn3 = rq3; }
    }
    GE_WAIT_V(0);
    if (wr == 0) GE_BAR;
    GE_BAR;
#undef GE_SA
#undef GE_SB
#undef GE_STAGE
#undef GE_STAGE_B
#undef GE_LDA
#undef GE_LDB
#undef GE_MMA
#undef GE_WAIT_V
#undef GE_WAIT_L
#undef GE_BAR
#undef GE_SCHED
}

template <class Epi, class Sched, bool GATHER>
__device__ __forceinline__ void gemm_phase_f8(LAS unsigned char* lds, const int K, const int lda, const int ldb, const Sched& S, const Epi& E) {
    int tid = threadIdx.x; asm volatile("" : "+v"(tid));
    const int wid = __builtin_amdgcn_readfirstlane(tid >> 6), lane = tid & 63, wr = wid >> 2, wc = wid & 3, fr = lane & 15, fq = lane >> 4;
    const int nt = K / BK;
    const size_t kstep = (size_t)(BK * 2);
    const size_t hstepB = (size_t)HALF * ldb * 2;
    const unsigned ldsw = (unsigned)wid * 1024u;
    const int aoff = lds_byte(wr * 64 + fr, fq * 8), boff = lds_byte(wc * 32 + fr, fq * 8);
#define GE_SA(b, h) (((b) * 2 + (h)) * HTB)
#define GE_SB(b, h) ((4 + (b) * 2 + (h)) * HTB)
#define GE_STAGE(bufoff, gbase, v0, v1) do { \
        __builtin_amdgcn_global_load_lds((const unsigned*)((const char*)(gbase) + (v0)), (LAS unsigned*)(lds + (bufoff) + ldsw), 16, 0, 0); \
        __builtin_amdgcn_global_load_lds((const unsigned*)((const char*)(gbase) + (v1)), (LAS unsigned*)(lds + (bufoff) + ldsw + 8192), 16, 0, 0); } while (0)
#define GE_RC() int t2_ = tid; asm volatile("" : "+v"(t2_)); int R0_, C0_, R1_, C1_; stage_rc(t2_ * 16, R0_, C0_); stage_rc(t2_ * 16 + 8192, R1_, C1_)
#define GE_STAGE_B(bufoff, gbase) do { GE_RC(); const int Rb0_ = Epi::PERM ? ((R0_ & ~31) + perm32(R0_ & 31)) : R0_, Rb1_ = Epi::PERM ? ((R1_ & ~31) + perm32(R1_ & 31)) : R1_; \
        GE_STAGE(bufoff, gbase, (unsigned)(Rb0_ * ldb + C0_) * 2u, (unsigned)(Rb1_ * ldb + C1_) * 2u); } while (0)
#define GE_LDA(dst, b, h) do { _Pragma("unroll") for (int m = 0; m < 4; ++m) { const i32x4 lo_ = *(const LAS i32x4*)(lds + GE_SA(b, h) + aoff + m * 2048), hi_ = *(const LAS i32x4*)(lds + GE_SA(b, h) + aoff + m * 2048 + 1024); dst[m] = __builtin_shufflevector(lo_, hi_, 0, 1, 2, 3, 4, 5, 6, 7); } } while (0)
#define GE_LDB(dst, b, h) do { _Pragma("unroll") for (int n = 0; n < 2; ++n) { const i32x4 lo_ = *(const LAS i32x4*)(lds + GE_SB(b, h) + boff + n * 2048), hi_ = *(const LAS i32x4*)(lds + GE_SB(b, h) + boff + n * 2048 + 1024); dst[n] = __builtin_shufflevector(lo_, hi_, 0, 1, 2, 3, 4, 5, 6, 7); } } while (0)
#define GE_MMA(ai, bj, At, Bt) do { __builtin_amdgcn_s_setprio(1); _Pragma("unroll") for (int m = 0; m < 4; ++m) _Pragma("unroll") for (int n = 0; n < 2; ++n) \
        acc[ai][bj][m][n] = __builtin_amdgcn_mfma_scale_f32_16x16x128_f8f6f4(Bt[n], At[m], acc[ai][bj][m][n], 0, 0, 0, 0x7a7a7a7a, 0, 0x7f7f7f7f); __builtin_amdgcn_s_setprio(0); } while (0)
#define GE_WAIT_V(n) asm volatile("s_waitcnt vmcnt(" #n ")" ::: "memory")
#define GE_WAIT_L(n) asm volatile("s_waitcnt lgkmcnt(" #n ")" ::: "memory")
#define GE_BAR __builtin_amdgcn_s_barrier()
#define GE_SCHED __builtin_amdgcn_sched_barrier(0)
    Unit cur, nxt, nn; int ui = 0;
    if (!S.next(0, cur)) return;
    bool has_next = S.next(1, nxt);
#define GE_STG(bufoff, gbase, u_, h) do { GE_RC(); GE_STAGE(bufoff, gbase, (unsigned)(S.a_row(u_, (h) * HALF + R0_) * lda + C0_) * 2u, (unsigned)(S.a_row(u_, (h) * HALF + R1_) * lda + C1_) * 2u); } while (0)
    f32x4 acc[2][2][4][2];
#pragma unroll
    for (int a = 0; a < 2; ++a)
#pragma unroll
        for (int b = 0; b < 2; ++b)
#pragma unroll
            for (int m = 0; m < 4; ++m)
#pragma unroll
                for (int n = 0; n < 2; ++n) acc[a][b][m][n] = (f32x4){0.f, 0.f, 0.f, 0.f};
    i32x8 At[4], B0[2], B1[2];
    const char* cA = S.a_base(cur); const char* cB = S.b_base(cur);
    GE_STAGE_B(GE_SB(0, 0), cB); GE_STG(GE_SA(0, 0), cA, cur, 0); GE_STAGE_B(GE_SB(0, 1), cB + hstepB); GE_STG(GE_SA(0, 1), cA, cur, 1);
    if (wr == 1) GE_BAR;
    GE_WAIT_V(4); GE_BAR;
    GE_STAGE_B(GE_SB(1, 0), cB + kstep); GE_STG(GE_SA(1, 0), cA + kstep, cur, 0); GE_STAGE_B(GE_SB(1, 1), cB + hstepB + kstep);
    GE_WAIT_V(6); GE_BAR;
    for (;;) {
        const bool has_nn = has_next ? S.next(ui + 2, nn) : false;
        const char* nA = has_next ? S.a_base(nxt) : cA; const char* nB = has_next ? S.b_base(nxt) : cB;
#pragma unroll 1
        for (int t = 0; t < nt; t += 2) {
            const bool last = (t == nt - 2);
            const char* a1 = cA + (size_t)(t + 1) * kstep;
            const char* a2 = last ? nA : cA + (size_t)(t + 2) * kstep; const char* b2 = last ? nB : cB + (size_t)(t + 2) * kstep;
            const char* a3 = a2 + kstep; const char* b3 = b2 + kstep;
            Unit xu = cur; if (last && has_next) xu = nxt;
            GE_LDB(B0, 0, 0); GE_SCHED; GE_LDA(At, 0, 0); GE_STG(GE_SA(1, 1), a1, cur, 1);
            GE_WAIT_L(8); GE_BAR; GE_WAIT_L(0); GE_MMA(0, 0, At, B0); GE_BAR; GE_SCHED;
            GE_LDB(B1, 0, 1); GE_STAGE_B(GE_SB(0, 0), b2);
            GE_BAR; GE_WAIT_L(0); GE_MMA(0, 1, At, B1); GE_BAR;
            GE_LDA(At, 0, 1); GE_STG(GE_SA(0, 0), a2, xu, 0);
            GE_BAR; GE_WAIT_L(0); GE_MMA(1, 0, At, B0); GE_BAR; GE_SCHED;
            GE_STAGE_B(GE_SB(0, 1), b2 + hstepB);
            GE_WAIT_V(6); GE_BAR; GE_MMA(1, 1, At, B1); GE_BAR;
            GE_LDB(B0, 1, 0); GE_SCHED; GE_LDA(At, 1, 0); GE_STG(GE_SA(0, 1), a2, xu, 1);
            GE_WAIT_L(8); GE_BAR; GE_WAIT_L(0); GE_MMA(0, 0, At, B0); GE_BAR; GE_SCHED;
            GE_LDB(B1, 1, 1); GE_STAGE_B(GE_SB(1, 0), b3);
            GE_BAR; GE_WAIT_L(0); GE_MMA(0, 1, At, B1); GE_BAR;
            GE_LDA(At, 1, 1); GE_STG(GE_SA(1, 0), a3, xu, 0);
            GE_BAR; GE_WAIT_L(0); GE_MMA(1, 0, At, B0); GE_BAR; GE_SCHED;
            GE_STAGE_B(GE_SB(1, 1), b3 + hstepB);
            GE_WAIT_V(6); GE_BAR; GE_MMA(1, 1, At, B1); GE_BAR;
        }
        E(acc, cur, wr, wc, fr, fq);
        if (!has_next) break;
#pragma unroll
        for (int a = 0; a < 2; ++a)
#pragma unroll
            for (int b = 0; b < 2; ++b)
#pragma unroll
                for (int m = 0; m < 4; ++m)
#pragma unroll
                    for (int n = 0; n < 2; ++n) acc[a][b][m][n] = (f32x4){0.f, 0.f, 0.f, 0.f};
        cur = nxt; nxt = nn; has_next = has_nn; cA = nA; cB = nB; ++ui;
    }
    GE_WAIT_V(0);
    if (wr == 0) GE_BAR;
    GE_BAR;
#undef GE_SA
#undef GE_SB
#undef GE_STAGE
#undef GE_STAGE_B
#undef GE_STG
#undef GE_RC
#undef GE_LDA
#undef GE_LDB
#undef GE_MMA
#undef GE_WAIT_V
#undef GE_WAIT_L
#undef GE_BAR
#undef GE_SCHED
}

template <class Epi, class Sched>
__device__ __forceinline__ void gemm_phase_v(LAS unsigned char* lds, const Sched& S, const Epi& E) {
    int tid = threadIdx.x; asm volatile("" : "+v"(tid));
    const int wid = __builtin_amdgcn_readfirstlane(tid >> 6), lane = tid & 63, wr = wid >> 2, wc = wid & 3, fr = lane & 15, fq = lane >> 4;
    int Rr[2], Rbb[2]; unsigned C2[2];
#pragma unroll
    for (int i = 0; i < 2; ++i) { int R, C; stage_rc(tid * 16 + i * 8192, R, C); Rr[i] = R; C2[i] = (unsigned)C * 2u; Rbb[i] = Epi::PERM ? ((R & ~31) + perm32(R & 31)) : R; }
    const size_t kstep = (size_t)(BK * 2);
    const unsigned ldsw = (unsigned)wid * 1024u;
    const int aoff = lds_byte(wr * 64 + fr, fq * 8), boff = lds_byte(wc * 32 + fr, fq * 8);
#define GE_SA(b, h) (((b) * 2 + (h)) * HTB)
#define GE_SB(b, h) ((4 + (b) * 2 + (h)) * HTB)
#define GE_STAGE(bufoff, gbase, v0, v1) do { \
        __builtin_amdgcn_global_load_lds((const unsigned*)((const char*)(gbase) + (v0)), (LAS unsigned*)(lds + (bufoff) + ldsw), 16, 0, 0); \
        __builtin_amdgcn_global_load_lds((const unsigned*)((const char*)(gbase) + (v1)), (LAS unsigned*)(lds + (bufoff) + ldsw + 8192), 16, 0, 0); } while (0)
#define GE_LDA(dst, b, h) do { _Pragma("unroll") for (int m = 0; m < 4; ++m) _Pragma("unroll") for (int k = 0; k < 2; ++k) dst[m][k] = *(const LAS bf16x8*)(lds + GE_SA(b, h) + aoff + m * 2048 + k * 1024); } while (0)
#define GE_LDB(dst, b, h) do { _Pragma("unroll") for (int n = 0; n < 2; ++n) _Pragma("unroll") for (int k = 0; k < 2; ++k) dst[n][k] = *(const LAS bf16x8*)(lds + GE_SB(b, h) + boff + n * 2048 + k * 1024); } while (0)
#define GE_MMA(ai, bj, At, Bt) do { __builtin_amdgcn_s_setprio(1); _Pragma("unroll") for (int m = 0; m < 4; ++m) _Pragma("unroll") for (int n = 0; n < 2; ++n) _Pragma("unroll") for (int k = 0; k < 2; ++k) \
        acc[ai][bj][m][n] = __builtin_amdgcn_mfma_f32_16x16x32_bf16(Bt[n][k], At[m][k], acc[ai][bj][m][n], 0, 0, 0); __builtin_amdgcn_s_setprio(0); } while (0)
#define GE_WAIT_V(n) asm volatile("s_waitcnt vmcnt(" #n ")" ::: "memory")
#define GE_WAIT_L(n) asm volatile("s_waitcnt lgkmcnt(" #n ")" ::: "memory")
#define GE_BAR __builtin_amdgcn_s_barrier()
#define GE_SCHED __builtin_amdgcn_sched_barrier(0)
#define GE_STA(bufoff, gbase, pitch, h) GE_STAGE(bufoff, gbase, __umul24((unsigned)(Rr[0] + (h) * HALF), (unsigned)(pitch)) + C2[0], __umul24((unsigned)(Rr[1] + (h) * HALF), (unsigned)(pitch)) + C2[1])
#define GE_STB(bufoff, gbase, pitch, h) GE_STAGE(bufoff, gbase, __umul24((unsigned)(Rbb[0] + (h) * HALF), (unsigned)(pitch)) + C2[0], __umul24((unsigned)(Rbb[1] + (h) * HALF), (unsigned)(pitch)) + C2[1])
    Unit cur, nxt; int ui = 0;
    if (!S.next(0, cur)) return;
    int cpa = S.lda(cur) * 2, cpb = S.ldb(cur) * 2, npa = cpa, npb = cpb;
    f32x4 acc[2][2][4][2];
#pragma unroll
    for (int a = 0; a < 2; ++a)
#pragma unroll
        for (int b = 0; b < 2; ++b)
#pragma unroll
            for (int m = 0; m < 4; ++m)
#pragma unroll
                for (int n = 0; n < 2; ++n) acc[a][b][m][n] = (f32x4){0.f, 0.f, 0.f, 0.f};
    bf16x8 At[4][2], B0[2][2], B1[2][2];
    const char* cA = S.a_base(cur); const char* cB = S.b_base(cur);
    GE_STB(GE_SB(0, 0), cB, cpb, 0); GE_STA(GE_SA(0, 0), cA, cpa, 0); GE_STB(GE_SB(0, 1), cB, cpb, 1); GE_STA(GE_SA(0, 1), cA, cpa, 1);
    if (wr == 1) GE_BAR;
    GE_WAIT_V(4); GE_BAR;
    GE_STB(GE_SB(1, 0), cB + kstep, cpb, 0); GE_STA(GE_SA(1, 0), cA + kstep, cpa, 0); GE_STB(GE_SB(1, 1), cB + kstep, cpb, 1);
    GE_WAIT_V(6); GE_BAR;
    for (;;) {
        const bool has_next = S.next(ui + 1, nxt);
        const char* nA = has_next ? S.a_base(nxt) : cA; const char* nB = has_next ? S.b_base(nxt) : cB;
        if (has_next) { npa = S.lda(nxt) * 2; npb = S.ldb(nxt) * 2; } else { npa = cpa; npb = cpb; }
        const int nt = S.nt(cur);
#pragma unroll 1
        for (int t = 0; t < nt; t += 2) {
            const bool last = (t == nt - 2);
            const char* a1 = cA + (size_t)(t + 1) * kstep;
            const char* a2 = last ? nA : cA + (size_t)(t + 2) * kstep; const char* b2 = last ? nB : cB + (size_t)(t + 2) * kstep;
            const char* a3 = a2 + kstep; const char* b3 = b2 + kstep;
            const int xpa = last ? npa : cpa, xpb = last ? npb : cpb;
            GE_LDB(B0, 0, 0); GE_SCHED; GE_LDA(At, 0, 0); GE_STA(GE_SA(1, 1), a1, cpa, 1);
            GE_WAIT_L(8); GE_BAR; GE_WAIT_L(0); GE_MMA(0, 0, At, B0); GE_BAR; GE_SCHED;
            GE_LDB(B1, 0, 1); GE_STB(GE_SB(0, 0), b2, xpb, 0);
            GE_BAR; GE_WAIT_L(0); GE_MMA(0, 1, At, B1); GE_BAR;
            GE_LDA(At, 0, 1); GE_STA(GE_SA(0, 0), a2, xpa, 0);
            GE_BAR; GE_WAIT_L(0); GE_MMA(1, 0, At, B0); GE_BAR; GE_SCHED;
            GE_STB(GE_SB(0, 1), b2, xpb, 1);
            GE_WAIT_V(6); GE_BAR; GE_MMA(1, 1, At, B1); GE_BAR;
            GE_LDB(B0, 1, 0); GE_SCHED; GE_LDA(At, 1, 0); GE_STA(GE_SA(0, 1), a2, xpa, 1);
            GE_WAIT_L(8); GE_BAR; GE_WAIT_L(0); GE_MMA(0, 0, At, B0); GE_BAR; GE_SCHED;
            GE_LDB(B1, 1, 1); GE_STB(GE_SB(1, 0), b3, xpb, 0);
            GE_BAR; GE_WAIT_L(0); GE_MMA(0, 1, At, B1); GE_BAR;
            GE_LDA(At, 1, 1); GE_STA(GE_SA(1, 0), a3, xpa, 0);
            GE_BAR; GE_WAIT_L(0); GE_MMA(1, 0, At, B0); GE_BAR; GE_SCHED;
            GE_STB(GE_SB(1, 1), b3, xpb, 1);
            GE_WAIT_V(6); GE_BAR; GE_MMA(1, 1, At, B1); GE_BAR;
        }
        const bool keep = E(acc, cur, wr, wc, fr, fq);
        if (!has_next) break;
        if (!keep) {
#pragma unroll
            for (int a = 0; a < 2; ++a)
#pragma unroll
                for (int b = 0; b < 2; ++b)
#pragma unroll
                    for (int m = 0; m < 4; ++m)
#pragma unroll
                        for (int n = 0; n < 2; ++n) acc[a][b][m][n] = (f32x4){0.f, 0.f, 0.f, 0.f};
        }
        cur = nxt; cA = nA; cB = nB; ++ui;
        cpa = npa; cpb = npb;
    }
    GE_WAIT_V(0);
    if (wr == 0) GE_BAR;
    GE_BAR;
#undef GE_SA
#undef GE_SB
#undef GE_STAGE
#undef GE_LDA
#undef GE_LDB
#undef GE_MMA
#undef GE_WAIT_V
#undef GE_WAIT_L
#undef GE_BAR
#undef GE_SCHED
#undef GE_STA
#undef GE_STB
}
}
constexpr size_t MiB = (size_t)1 << 20;
constexpr size_t OFF_BAR    = 0;
constexpr size_t OFF_CNT    = 16 * 1024;
constexpr size_t OFF_BLKE   = 32 * 1024;
constexpr size_t OFF_MOD    = 64 * 1024;
constexpr size_t OFF_PAIR   = 192 * 1024;
constexpr size_t OFF_EIDX   = 1 * MiB;
constexpr size_t OFF_WTS    = 2 * MiB;
constexpr size_t OFF_APOS   = 3 * MiB;
constexpr size_t OFF_ROWTOK = 4 * MiB;
constexpr size_t OFF_WINT   = 8 * MiB;
constexpr size_t OFF_GLUT   = 20 * MiB;
constexpr size_t OFF_PAT    = OFF_GLUT + 128 * 1024;
constexpr size_t OFF_PBT    = OFF_PAT + 512 * 1024;
constexpr size_t OFF_WOUTT  = OFF_PBT + 1536 * 1024;
constexpr size_t OFF_U      = 34 * MiB;
constexpr size_t OFF_H      = 62 * MiB;
constexpr size_t OFF_Z      = 128 * MiB;
constexpr size_t OFF_YPART  = 62 * MiB;
constexpr size_t OFF_YA     = 26 * MiB;
constexpr size_t OFF_YB     = 42 * MiB;
constexpr size_t OFF_BT2    = 40 * MiB;
constexpr size_t OFF_HID1   = 92 * MiB;
constexpr size_t OFF_HID2   = 208 * MiB;
constexpr size_t OFF_H2     = 232 * MiB;
constexpr size_t OFF_BT1    = 57 * MiB;
constexpr size_t OFF_Y2     = 232 * MiB;
constexpr size_t DO_OF = 0, DO_OB = 48 * MiB, DO_X1 = 0;

constexpr size_t OFF_BCNT = 6 * MiB;
constexpr size_t OFF_LIST = 504 * MiB;
constexpr size_t OFF_ROWDST = 90 * MiB;
constexpr size_t OFF_Y2S = 8 * MiB;
constexpr size_t OFF_WRT = 6 * MiB + 512 * 1024;

struct Params {
    const float *x, *c, *ctx, *c_ctx, *w_ada, *b_ada, *norm1_g, *norm2_g, *w_in, *lam_re, *lam_im, *log_dt, *b_re, *b_im, *c_re, *c_im, *s5_d, *w_glu, *lb_logits, *hg_norm_g,
                *p_a, *p_b, *w_out, *w_router, *b_router, *w1, *w3, *w2, *ws1, *ws3, *ws2, *final_g;
    unsigned char* ws; unsigned char* out;
};
__device__ __forceinline__ void ada_phase(const Params& p, LAS unsigned char* lds) {
    LAS float* sc = (LAS float*)lds;
    LAS float* red = (LAS float*)(lds + 5 * 1024 * 4);
    const int tid = threadIdx.x;
    float* mod = (float*)(p.ws + OFF_MOD);
    bool loaded = false;
    for (int item = blockIdx.x; item < 192; item += gridDim.x) {
        if (!loaded) {
            for (int i = tid; i < 5 * 1024; i += 512) { const int r = i >> 10, k = i & 1023; const float v = (r < 4) ? p.c[r * 1024 + k] : p.c_ctx[k]; sc[i] = siluf_(v); }
            loaded = true; __syncthreads();
        }
        const int n0 = item * 32, ks = tid >> 5, col = tid & 31;
        float a0 = 0.f, a1 = 0.f, a2 = 0.f, a3 = 0.f, a4 = 0.f;
#pragma unroll 16
        for (int k = ks * 64; k < ks * 64 + 64; ++k) {
            const float w = p.w_ada[(size_t)k * NIN + n0 + col];
            a0 += sc[k] * w; a1 += sc[1024 + k] * w; a2 += sc[2048 + k] * w; a3 += sc[3072 + k] * w; a4 += sc[4096 + k] * w;
        }
        red[(ks * 5 + 0) * 32 + col] = a0; red[(ks * 5 + 1) * 32 + col] = a1; red[(ks * 5 + 2) * 32 + col] = a2; red[(ks * 5 + 3) * 32 + col] = a3; red[(ks * 5 + 4) * 32 + col] = a4;
        __syncthreads();
        if (tid < 160) { const int r = tid >> 5, cc = tid & 31; float s = 0.f;
            for (int q = 0; q < 16; ++q) s += red[(q * 5 + r) * 32 + cc];
            mod[r * NIN + n0 + cc] = s + p.b_ada[n0 + cc]; }
        __syncthreads();
    }
}

template <class F>
__device__ __forceinline__ void cvt_tile(const float* src, int ld, int k0, int n0, bf16_t* dst, int ldd, int kdst0, F rowmap, LAS unsigned char* lds) {
    LAS float* t = (LAS float*)lds;
    const int tid = threadIdx.x;
#pragma unroll
    for (int j = 0; j < 2; ++j) { const int kr = (tid >> 4) + 32 * j, nc = (tid & 15) * 4;
        const f32x4 v = *(const f32x4*)(src + (size_t)(k0 + kr) * ld + n0 + nc);
        t[kr * 65 + nc] = v[0]; t[kr * 65 + nc + 1] = v[1]; t[kr * 65 + nc + 2] = v[2]; t[kr * 65 + nc + 3] = v[3]; }
    __syncthreads();
    { const int n = tid >> 3, kc = (tid & 7) * 8; float v[8];
#pragma unroll
      for (int j = 0; j < 8; ++j) v[j] = t[(kc + j) * 65 + n];
      u32x4 w; w.x = cvt_pk_bf16(v[0], v[1]); w.y = cvt_pk_bf16(v[2], v[3]); w.z = cvt_pk_bf16(v[4], v[5]); w.w = cvt_pk_bf16(v[6], v[7]);
      *(u32x4*)(dst + (size_t)rowmap(n0 + n) * ldd + kdst0 + k0 + kc) = w; }
    __syncthreads();
}

__device__ __forceinline__ void cvt_dense_phase(const Params& p, LAS unsigned char* lds) {
    bf16_t* WinT = (bf16_t*)(p.ws + OFF_WINT); bf16_t* gluT = (bf16_t*)(p.ws + OFF_GLUT); bf16_t* PaT = (bf16_t*)(p.ws + OFF_PAT); bf16_t* PbT = (bf16_t*)(p.ws + OFF_PBT); bf16_t* WoutT = (bf16_t*)(p.ws + OFF_WOUTT);
    auto id = [](int n) { return n; };
    constexpr int T_WIN = 16 * 96, T_GLU = 4 * 4, T_PA = 4 * 16, T_PB = 12 * 16, T_WO = 16 * 16, T_ALL = T_WIN + T_GLU + T_PA + T_PB + T_WO;
    for (int it = blockIdx.x; it < T_ALL; it += gridDim.x) {
        int i = it;
        if (i < T_WIN) { cvt_tile(p.w_in, NIN, (i / 96) * 64, (i % 96) * 64, WinT, 1024, 0, id, lds); continue; } i -= T_WIN;
        if (i < T_GLU) { cvt_tile(p.w_glu, 256, (i / 4) * 64, (i % 4) * 64, gluT, 256, 0, id, lds); continue; } i -= T_GLU;
        if (i < T_PA) { cvt_tile(p.p_a, 1024, (i / 16) * 64, (i % 16) * 64, PaT, 256, 0, id, lds); continue; } i -= T_PA;
        if (i < T_PB) { cvt_tile(p.p_b, 1024, (i / 16) * 64, (i % 16) * 64, PbT, 768, 0, id, lds); continue; } i -= T_PB;
        cvt_tile(p.w_out, 1024, (i / 16) * 64, (i % 16) * 64, WoutT, 1024, 0, id, lds);
    }
}

__device__ __forceinline__ unsigned moe_pack_fp8x4(float a, float b, float c, float d) {
    a = __builtin_amdgcn_fmed3f(a, -448.f, 448.f); b = __builtin_amdgcn_fmed3f(b, -448.f, 448.f); c = __builtin_amdgcn_fmed3f(c, -448.f, 448.f); d = __builtin_amdgcn_fmed3f(d, -448.f, 448.f);
    int w = 0; w = __builtin_amdgcn_cvt_pk_fp8_f32(a, b, w, false); w = __builtin_amdgcn_cvt_pk_fp8_f32(c, d, w, true); return (unsigned)w; }
struct MoeStrip { const float* src; int ld; unsigned char* dst; int ldd; int mode; };
__device__ __forceinline__ MoeStrip moe_strip(const Params& p, int it) {
    const int e = it / 48, j = it % 48, which = j >> 4, t = j & 15; MoeStrip s;
    unsigned char* Bt1 = p.ws + OFF_BT1 + (size_t)e * 512 * 1024; unsigned char* Bt2 = p.ws + OFF_BT2 + (size_t)e * 1024 * 256;
    if (which == 0) { s.src = ((e < 64) ? p.w1 + (size_t)e * 1024 * 256 : p.ws1) + (size_t)(t * 64) * 256; s.ld = 256; s.dst = Bt1 + t * 64; s.ldd = 1024; s.mode = 0; }
    else if (which == 1) { s.src = ((e < 64) ? p.w3 + (size_t)e * 1024 * 256 : p.ws3) + (size_t)(t * 64) * 256; s.ld = 256; s.dst = Bt1 + t * 64; s.ldd = 1024; s.mode = 1; }
    else { const int kt = t >> 2, nt = t & 3; s.src = ((e < 64) ? p.w2 + (size_t)e * 256 * 1024 : p.ws2) + (size_t)(kt * 64) * 1024 + nt * 256; s.ld = 1024; s.dst = Bt2 + (size_t)(nt * 256) * 256 + kt * 64; s.ldd = 256; s.mode = 2; }
    return s;
}
__device__ __forceinline__ void cvt_moe_phase(const Params& p, LAS unsigned char* lds) {
    int tid = threadIdx.x; asm volatile("" : "+v"(tid));
    LAS float* tl = (LAS float*)lds;
    const int NIT = 65 * 48;
    f32x4 r[8];
    int it = blockIdx.x;
    if (it < NIT) { const MoeStrip s = moe_strip(p, it);
#pragma unroll
        for (int j = 0; j < 8; ++j) r[j] = *(const f32x4*)(s.src + (size_t)((tid >> 6) + 8 * j) * s.ld + (tid & 63) * 4); }
    for (; it < NIT; it += gridDim.x) {
        const MoeStrip s = moe_strip(p, it);
#pragma unroll
        for (int j = 0; j < 8; ++j) { const int kr = (tid >> 6) + 8 * j, nc = (tid & 63) * 4; tl[kr * 257 + nc] = r[j][0]; tl[kr * 257 + nc + 1] = r[j][1]; tl[kr * 257 + nc + 2] = r[j][2]; tl[kr * 257 + nc + 3] = r[j][3]; }
        __syncthreads();
        if (it + (int)gridDim.x < NIT) { const MoeStrip s2 = moe_strip(p, it + gridDim.x);
#pragma unroll
            for (int j = 0; j < 8; ++j) r[j] = *(const f32x4*)(s2.src + (size_t)((tid >> 6) + 8 * j) * s2.ld + (tid & 63) * 4); }
        { const int k8 = (tid & 7) * 8;
#pragma unroll
          for (int c = 0; c < 4; ++c) { const int n = (tid >> 3) + 64 * c;
              const int row = (s.mode == 2) ? n : ((n >> 7) * 256 + (s.mode == 1 ? 128 : 0) + (n & 127));
              float v[8];
#pragma unroll
              for (int q = 0; q < 8; ++q) v[q] = tl[(k8 + q) * 257 + n];
              { u32x2 w; w.x = moe_pack_fp8x4(v[0] * 32.f, v[1] * 32.f, v[2] * 32.f, v[3] * 32.f); w.y = moe_pack_fp8x4(v[4] * 32.f, v[5] * 32.f, v[6] * 32.f, v[7] * 32.f);
                  *(u32x2*)(s.dst + (size_t)row * s.ldd + k8) = w; } } }
        __syncthreads();
    }
}

__device__ __forceinline__ void norm1_phase(const Params& p) {
    const int wid = threadIdx.x >> 6, lane = threadIdx.x & 63;
    const float* mod = (const float*)(p.ws + OFF_MOD); bf16_t* H = (bf16_t*)(p.ws + OFF_H);
    for (int r = blockIdx.x * 8 + wid; r < NROWS; r += gridDim.x * 8) {
        const float* src = (r < NTOK) ? p.x + (size_t)r * 1024 : p.ctx + (size_t)(r - NTOK) * 1024;
        const float* mr = mod + ((r < NTOK) ? (r / SEQ) : 4) * NIN;
        f32x4 v[4]; float ss = 0.f;
#pragma unroll
        for (int j = 0; j < 4; ++j) { v[j] = *(const f32x4*)(src + j * 256 + lane * 4); ss += v[j][0] * v[j][0] + v[j][1] * v[j][1] + v[j][2] * v[j][2] + v[j][3] * v[j][3]; }
        ss = wave_sum(ss);
        const float rstd = rsqrtf(ss * (1.0f / 1024.0f) + EPSF);
#pragma unroll
        for (int j = 0; j < 4; ++j) { const int k = j * 256 + lane * 4;
            const f32x4 g = *(const f32x4*)(p.norm1_g + k), sh = *(const f32x4*)(mr + k), scv = *(const f32x4*)(mr + 1024 + k);
            float o[4];
#pragma unroll
            for (int q = 0; q < 4; ++q) o[q] = v[j][q] * rstd * g[q] * (1.0f + scv[q]) + sh[q];
            u32x2 w; w.x = cvt_pk_bf16(o[0], o[1]); w.y = cvt_pk_bf16(o[2], o[3]);
            *(u32x2*)(H + (size_t)r * 1024 + k) = w; }
    }
}
struct PlainSched {
    ge::GridOrder go; const char* A; const char* B; size_t atile, btile;
    __device__ void init(const void* A_, int lda, const void* B_, int ldb, int nM, int nN) { A = (const char*)A_; B = (const char*)B_; atile = (size_t)256 * lda * 2; btile = (size_t)256 * ldb * 2; go.init(nM, nN, (int)gridDim.x, (int)blockIdx.x); }
    __device__ __forceinline__ bool next(int i, ge::Unit& u) const { u.e = 0; return go.tile(i, u.pm, u.pn); }
    __device__ __forceinline__ const char* a_base(const ge::Unit& u) const { return A + (size_t)u.pm * atile; }
    __device__ __forceinline__ const char* b_base(const ge::Unit& u) const { return B + (size_t)u.pn * btile; }
    __device__ __forceinline__ int a_row(const ge::Unit&, int) const { return 0; }
};

struct EpiZ {
    static constexpr bool PERM = true;
    bf16_t* U; bf16_t* Z;
    __device__ __forceinline__ void operator()(const f32x4 (&acc)[2][2][4][2], const ge::Unit& u, int wr, int wc, int fr, int fq) const {
        const int row0 = u.pm * 256 + wr * 64 + fr, cl = wc * 32 + 8 * fq;
        bf16_t* base; int ld;
        if (u.pn == 0) { base = U + cl; ld = 256; } else { base = Z + (u.pn - 1) * 256 + cl; ld = ZC; }
#pragma unroll
        for (int ai = 0; ai < 2; ++ai)
#pragma unroll
            for (int m = 0; m < 4; ++m) { bf16_t* rowp = base + (size_t)(row0 + ai * 128 + m * 16) * ld;
#pragma unroll
                for (int bj = 0; bj < 2; ++bj) { const f32x4 v0 = acc[ai][bj][m][0], v1 = acc[ai][bj][m][1];
                    u32x4 w; w.x = cvt_pk_bf16(v0[0], v0[1]); w.y = cvt_pk_bf16(v0[2], v0[3]); w.z = cvt_pk_bf16(v1[0], v1[1]); w.w = cvt_pk_bf16(v1[2], v1[3]);
                    *(u32x4*)(rowp + bj * 128) = w; } }
    }
};


struct EpiZ2 {
    static constexpr bool PERM = true;
    bf16_t* Ae; bf16_t* Uc; bf16_t* Z;
    __device__ __forceinline__ void operator()(const f32x4 (&acc)[2][2][4][2], const ge::Unit& u, int wr, int wc, int fr, int fq) const {
        const int row0 = u.pm * 256 + wr * 64 + fr, cl = wc * 32 + 8 * fq;
#pragma unroll
        for (int ai = 0; ai < 2; ++ai)
#pragma unroll
            for (int m = 0; m < 4; ++m) { const int r = row0 + ai * 128 + m * 16;
#pragma unroll
                for (int bj = 0; bj < 2; ++bj) { const f32x4 v0 = acc[ai][bj][m][0], v1 = acc[ai][bj][m][1];
                    u32x4 w; w.x = cvt_pk_bf16(v0[0], v0[1]); w.y = cvt_pk_bf16(v0[2], v0[3]); w.z = cvt_pk_bf16(v1[0], v1[1]); w.w = cvt_pk_bf16(v1[2], v1[3]);
                    bf16_t* dst;
                    if (u.pn == 0) { const int col = bj * 128 + cl, g = col >> 4, c0 = col & 15;
                        if (u.pm < NTOK / 256) { const int b = r >> 13, l = r & (SEQ - 1); dst = Ae + (size_t)(g * 512 + b * 128 + (l >> 6)) * 1280 + (l & 63) * 16 + c0; }
                        else dst = Uc + (size_t)(r - NTOK) * 256 + col; }
                    else dst = Z + (size_t)r * ZC + (u.pn - 1) * 256 + cl + bj * 128;
                    *(u32x4*)dst = w; } }
    }
};

struct EpiYa {
    static constexpr bool PERM = true;
    const bf16_t* Y; bf16_t* Ya;
    __device__ __forceinline__ void operator()(const f32x4 (&acc)[2][2][4][2], const ge::Unit& u, int wr, int wc, int fr, int fq) const {
        const int row0 = u.pm * 256 + wr * 64 + fr, col0 = u.pn * 256 + wc * 32 + 8 * fq;
        u32x4 cur[2][2], nxt[2][2];
#pragma unroll
        for (int mm = 0; mm < 2; ++mm)
#pragma unroll
            for (int bj = 0; bj < 2; ++bj) cur[mm][bj] = *(const u32x4*)(Y + (size_t)(row0 + mm * 16) * 256 + col0 + bj * 128);
#pragma unroll
        for (int gi = 0; gi < 4; ++gi) { const int ai = gi >> 1, mh = gi & 1;
            if (gi < 3) { const int ai2 = (gi + 1) >> 1, mh2 = (gi + 1) & 1;
#pragma unroll
                for (int mm = 0; mm < 2; ++mm)
#pragma unroll
                    for (int bj = 0; bj < 2; ++bj) nxt[mm][bj] = *(const u32x4*)(Y + (size_t)(row0 + ai2 * 128 + (2 * mh2 + mm) * 16) * 256 + col0 + bj * 128); }
#pragma unroll
            for (int mm = 0; mm < 2; ++mm)
#pragma unroll
                for (int bj = 0; bj < 2; ++bj) { const int m = 2 * mh + mm; const f32x4 v0 = acc[ai][bj][m][0], v1 = acc[ai][bj][m][1]; const u32x4 y4 = cur[mm][bj];
                    float o[8];
                    o[0] = bf_lo(y4.x) * sigmoidf_(v0[0]); o[1] = bf_hi(y4.x) * sigmoidf_(v0[1]); o[2] = bf_lo(y4.y) * sigmoidf_(v0[2]); o[3] = bf_hi(y4.y) * sigmoidf_(v0[3]);
                    o[4] = bf_lo(y4.z) * sigmoidf_(v1[0]); o[5] = bf_hi(y4.z) * sigmoidf_(v1[1]); o[6] = bf_lo(y4.w) * sigmoidf_(v1[2]); o[7] = bf_hi(y4.w) * sigmoidf_(v1[3]);
                    u32x4 w; w.x = cvt_pk_bf16(o[0], o[1]); w.y = cvt_pk_bf16(o[2], o[3]); w.z = cvt_pk_bf16(o[4], o[5]); w.w = cvt_pk_bf16(o[6], o[7]);
                    *(u32x4*)(Ya + (size_t)(row0 + ai * 128 + m * 16) * 256 + col0 + bj * 128) = w; }
#pragma unroll
            for (int mm = 0; mm < 2; ++mm)
#pragma unroll
                for (int bj = 0; bj < 2; ++bj) cur[mm][bj] = nxt[mm][bj];
            asm volatile("" ::: "memory"); }
    }
};

template <bool ADD> struct EpiMerge {
    static constexpr bool PERM = true;
    const bf16_t* Z; int gcol0; bf16_t* Mg;
    __device__ __forceinline__ void operator()(const f32x4 (&acc)[2][2][4][2], const ge::Unit& u, int wr, int wc, int fr, int fq) const {
        const int row0 = u.pm * 256 + wr * 64 + fr, col0 = u.pn * 256 + wc * 32 + 8 * fq;
        u32x4 gc[2][2], gn[2][2], pc[2][2], pn_[2][2];
#pragma unroll
        for (int mm = 0; mm < 2; ++mm)
#pragma unroll
            for (int bj = 0; bj < 2; ++bj) { const size_t row = (size_t)(row0 + mm * 16); gc[mm][bj] = *(const u32x4*)(Z + row * ZC + gcol0 + col0 + bj * 128); if (ADD) pc[mm][bj] = *(const u32x4*)(Mg + row * 1024 + col0 + bj * 128); }
#pragma unroll
        for (int gi = 0; gi < 4; ++gi) { const int ai = gi >> 1, mh = gi & 1;
            if (gi < 3) { const int ai2 = (gi + 1) >> 1, mh2 = (gi + 1) & 1;
#pragma unroll
                for (int mm = 0; mm < 2; ++mm)
#pragma unroll
                    for (int bj = 0; bj < 2; ++bj) { const size_t row = (size_t)(row0 + ai2 * 128 + (2 * mh2 + mm) * 16); gn[mm][bj] = *(const u32x4*)(Z + row * ZC + gcol0 + col0 + bj * 128); if (ADD) pn_[mm][bj] = *(const u32x4*)(Mg + row * 1024 + col0 + bj * 128); } }
#pragma unroll
            for (int mm = 0; mm < 2; ++mm)
#pragma unroll
                for (int bj = 0; bj < 2; ++bj) { const int m = 2 * mh + mm; const size_t row = (size_t)(row0 + ai * 128 + m * 16);
                    const f32x4 v0 = acc[ai][bj][m][0], v1 = acc[ai][bj][m][1]; const u32x4 g4 = gc[mm][bj];
                    float o[8];
                    o[0] = sigmoidf_(bf_lo(g4.x)) * v0[0]; o[1] = sigmoidf_(bf_hi(g4.x)) * v0[1]; o[2] = sigmoidf_(bf_lo(g4.y)) * v0[2]; o[3] = sigmoidf_(bf_hi(g4.y)) * v0[3];
                    o[4] = sigmoidf_(bf_lo(g4.z)) * v1[0]; o[5] = sigmoidf_(bf_hi(g4.z)) * v1[1]; o[6] = sigmoidf_(bf_lo(g4.w)) * v1[2]; o[7] = sigmoidf_(bf_hi(g4.w)) * v1[3];
                    if (ADD) { const u32x4 p4 = pc[mm][bj];
                        o[0] += bf_lo(p4.x); o[1] += bf_hi(p4.x); o[2] += bf_lo(p4.y); o[3] += bf_hi(p4.y); o[4] += bf_lo(p4.z); o[5] += bf_hi(p4.z); o[6] += bf_lo(p4.w); o[7] += bf_hi(p4.w); }
                    u32x4 w; w.x = cvt_pk_bf16(o[0], o[1]); w.y = cvt_pk_bf16(o[2], o[3]); w.z = cvt_pk_bf16(o[4], o[5]); w.w = cvt_pk_bf16(o[6], o[7]);
                    *(u32x4*)(Mg + row * 1024 + col0 + bj * 128) = w; }
#pragma unroll
            for (int mm = 0; mm < 2; ++mm)
#pragma unroll
                for (int bj = 0; bj < 2; ++bj) { gc[mm][bj] = gn[mm][bj]; if (ADD) pc[mm][bj] = pn_[mm][bj]; }
            asm volatile("" ::: "memory"); }
    }
};


struct MergeSched {
    ge::GridOrder go; const char* Ya; const char* Yb; const char* Pa; const char* Pb;
    __device__ void init(const void* ya, const void* yb, const void* pa, const void* pb) { Ya = (const char*)ya; Yb = (const char*)yb; Pa = (const char*)pa; Pb = (const char*)pb; go.init(NTOK / 256, 4, (int)gridDim.x, (int)blockIdx.x); }
    __device__ __forceinline__ bool next(int i, ge::Unit& u) const { u.e = i & 1; return go.tile(i >> 1, u.pm, u.pn); }
    __device__ __forceinline__ const char* a_base(const ge::Unit& u) const { return u.e ? Yb + (size_t)u.pm * 256 * 768 * 2 : Ya + (size_t)u.pm * 256 * 256 * 2; }
    __device__ __forceinline__ const char* b_base(const ge::Unit& u) const { return u.e ? Pb + (size_t)u.pn * 256 * 768 * 2 : Pa + (size_t)u.pn * 256 * 256 * 2; }
    __device__ __forceinline__ int nt(const ge::Unit& u) const { return u.e ? 12 : 4; }
    __device__ __forceinline__ int lda(const ge::Unit& u) const { return u.e ? 768 : 256; }
    __device__ __forceinline__ int ldb(const ge::Unit& u) const { return u.e ? 768 : 256; }
};
template <bool WT = false> struct EpiMergeF {
    static constexpr bool PERM = true;
    const bf16_t* Z; bf16_t* Mg; int ldm;
    __device__ __forceinline__ bool operator()(f32x4 (&acc)[2][2][4][2], const ge::Unit& u, int wr, int wc, int fr, int fq) const {
        const int row0 = u.pm * 256 + wr * 64 + fr, col0 = u.pn * 256 + wc * 32 + 8 * fq;
        __amdgpu_buffer_rsrc_t rs = __builtin_amdgcn_make_buffer_rsrc((void*)Mg, 0, 0x7ffffff0, 0x00020000);
        if (u.e == 0) {
#pragma unroll
            for (int gi = 0; gi < 4; ++gi) { const int ai = gi >> 1, mh = gi & 1;
                u32x4 ga[2][2], gb[2][2];
#pragma unroll
                for (int mm = 0; mm < 2; ++mm)
#pragma unroll
                    for (int bj = 0; bj < 2; ++bj) { const bf16_t* zr = Z + (size_t)(row0 + ai * 128 + (2 * mh + mm) * 16) * ZC + col0 + bj * 128; ga[mm][bj] = *(const u32x4*)(zr + ZGA); gb[mm][bj] = *(const u32x4*)(zr + ZGB); }
#pragma unroll
                for (int mm = 0; mm < 2; ++mm)
#pragma unroll
                    for (int bj = 0; bj < 2; ++bj) { const int m = 2 * mh + mm; const u32x4 a4 = ga[mm][bj], b4 = gb[mm][bj];
#define MF_R(aw, bw, lo) ((1.0f + __expf(-(lo ? bf_lo(bw) : bf_hi(bw)))) * frcp_(1.0f + __expf(-(lo ? bf_lo(aw) : bf_hi(aw)))))
                        acc[ai][bj][m][0][0] *= MF_R(a4.x, b4.x, true); acc[ai][bj][m][0][1] *= MF_R(a4.x, b4.x, false); acc[ai][bj][m][0][2] *= MF_R(a4.y, b4.y, true); acc[ai][bj][m][0][3] *= MF_R(a4.y, b4.y, false);
                        acc[ai][bj][m][1][0] *= MF_R(a4.z, b4.z, true); acc[ai][bj][m][1][1] *= MF_R(a4.z, b4.z, false); acc[ai][bj][m][1][2] *= MF_R(a4.w, b4.w, true); acc[ai][bj][m][1][3] *= MF_R(a4.w, b4.w, false);
#undef MF_R
                    }
                asm volatile("" ::: "memory"); }
            return true;
        }
#pragma unroll
        for (int gi = 0; gi < 4; ++gi) { const int ai = gi >> 1, mh = gi & 1;
            u32x4 gb[2][2];
#pragma unroll
            for (int mm = 0; mm < 2; ++mm)
#pragma unroll
                for (int bj = 0; bj < 2; ++bj) gb[mm][bj] = *(const u32x4*)(Z + (size_t)(row0 + ai * 128 + (2 * mh + mm) * 16) * ZC + ZGB + col0 + bj * 128);
#pragma unroll
            for (int mm = 0; mm < 2; ++mm)
#pragma unroll
                for (int bj = 0; bj < 2; ++bj) { const int m = 2 * mh + mm; const f32x4 v0 = acc[ai][bj][m][0], v1 = acc[ai][bj][m][1]; const u32x4 g4 = gb[mm][bj];
                    float o[8];
                    o[0] = sigmoidf_(bf_lo(g4.x)) * v0[0]; o[1] = sigmoidf_(bf_hi(g4.x)) * v0[1]; o[2] = sigmoidf_(bf_lo(g4.y)) * v0[2]; o[3] = sigmoidf_(bf_hi(g4.y)) * v0[3];
                    o[4] = sigmoidf_(bf_lo(g4.z)) * v1[0]; o[5] = sigmoidf_(bf_hi(g4.z)) * v1[1]; o[6] = sigmoidf_(bf_lo(g4.w)) * v1[2]; o[7] = sigmoidf_(bf_hi(g4.w)) * v1[3];
                    u32x4 w; w.x = cvt_pk_bf16(o[0], o[1]); w.y = cvt_pk_bf16(o[2], o[3]); w.z = cvt_pk_bf16(o[4], o[5]); w.w = cvt_pk_bf16(o[6], o[7]);
                    if constexpr (WT) __builtin_amdgcn_raw_buffer_store_b128(w, rs, (int)(((unsigned)(row0 + ai * 128 + m * 16) * (unsigned)ldm + (unsigned)(col0 + bj * 128)) * 2u), 0, 16);
                    else *(u32x4*)(Mg + (size_t)(row0 + ai * 128 + m * 16) * ldm + col0 + bj * 128) = w; }
            asm volatile("" ::: "memory"); }
        return false;
    }
};


struct OneUnitSched {
    const char* A; const char* B; int pm;
    __device__ __forceinline__ bool next(int i, ge::Unit& u) const { if (i) return false; u.pm = pm; u.pn = 0; u.e = 0; return true; }
    __device__ __forceinline__ const char* a_base(const ge::Unit& u) const { return A + (size_t)u.pm * 256 * 256 * 2; }
    __device__ __forceinline__ const char* b_base(const ge::Unit&) const { return B; }
    __device__ __forceinline__ int a_row(const ge::Unit&, int) const { return 0; }
};
struct PanelMergeSched {
    const char* Ya; const char* Yb; const char* Pa; const char* Pb; int pm, pn0;
    __device__ __forceinline__ bool next(int i, ge::Unit& u) const { if (i >= 4) return false; u.pm = pm; u.pn = pn0 + (i >> 1); u.e = i & 1; return true; }
    __device__ __forceinline__ const char* a_base(const ge::Unit& u) const { return u.e ? Yb + (size_t)u.pm * 256 * 768 * 2 : Ya + (size_t)u.pm * 256 * 256 * 2; }
    __device__ __forceinline__ const char* b_base(const ge::Unit& u) const { return u.e ? Pb + (size_t)u.pn * 256 * 768 * 2 : Pa + (size_t)u.pn * 256 * 256 * 2; }
    __device__ __forceinline__ int nt(const ge::Unit& u) const { return u.e ? 12 : 4; }
    __device__ __forceinline__ int lda(const ge::Unit& u) const { return u.e ? 768 : 256; }
    __device__ __forceinline__ int ldb(const ge::Unit& u) const { return u.e ? 768 : 256; }
};

template <bool WT = false> struct EpiX1 {
    static constexpr bool PERM = false;
    const float* X; const float* mod; float* X1;
    __device__ __forceinline__ void operator()(const f32x4 (&acc)[2][2][4][2], const ge::Unit& u, int wr, int wc, int fr, int fq) const {
        const int row0 = u.pm * 256 + wr * 64 + fr, col0 = u.pn * 256 + wc * 32 + 4 * fq;
        const float* g1 = mod + (size_t)((u.pm * 256) / SEQ) * NIN + 2048;
        f32x4 gv[2][2];
#pragma unroll
        for (int bj = 0; bj < 2; ++bj)
#pragma unroll
            for (int n = 0; n < 2; ++n) gv[bj][n] = *(const f32x4*)(g1 + col0 + bj * 128 + n * 16);
        __amdgpu_buffer_rsrc_t rs = __builtin_amdgcn_make_buffer_rsrc((void*)X1, 0, 0x7ffffff0, 0x00020000);
        f32x4 cur[2][2], nxt[2][2];
#pragma unroll
        for (int bj = 0; bj < 2; ++bj)
#pragma unroll
            for (int n = 0; n < 2; ++n) cur[bj][n] = *(const f32x4*)(X + (size_t)row0 * 1024 + col0 + bj * 128 + n * 16);
#pragma unroll
        for (int gi = 0; gi < 8; ++gi) { const int ai = gi >> 2, m = gi & 3;
            if (gi < 7) { const int ai2 = (gi + 1) >> 2, m2 = (gi + 1) & 3;
#pragma unroll
                for (int bj = 0; bj < 2; ++bj)
#pragma unroll
                    for (int n = 0; n < 2; ++n) nxt[bj][n] = *(const f32x4*)(X + (size_t)(row0 + ai2 * 128 + m2 * 16) * 1024 + col0 + bj * 128 + n * 16); }
#pragma unroll
            for (int bj = 0; bj < 2; ++bj)
#pragma unroll
                for (int n = 0; n < 2; ++n) { const f32x4 r = cur[bj][n] + gv[bj][n] * acc[ai][bj][m][n];
                    if constexpr (WT) __builtin_amdgcn_raw_buffer_store_b128(__builtin_bit_cast(u32x4, r), rs, (int)(((unsigned)(row0 + ai * 128 + m * 16) * 1024u + (unsigned)(col0 + bj * 128 + n * 16)) * 4u), 0, 16);
                    else *(f32x4*)(X1 + (size_t)(row0 + ai * 128 + m * 16) * 1024 + col0 + bj * 128 + n * 16) = r; }
#pragma unroll
            for (int bj = 0; bj < 2; ++bj)
#pragma unroll
                for (int n = 0; n < 2; ++n) cur[bj][n] = nxt[bj][n];
            asm volatile("" ::: "memory"); }
    }
};


__device__ __forceinline__ void pair_sync(unsigned* cnt, unsigned target, unsigned* tmo) {
    asm volatile("s_waitcnt vmcnt(0)" ::: "memory");
    __syncthreads();
    if (threadIdx.x == 0) {
        (void)__hip_atomic_fetch_add(cnt, 1u, __ATOMIC_RELAXED, __HIP_MEMORY_SCOPE_AGENT);
        unsigned sp = 0;
        while (__hip_atomic_load(cnt, __ATOMIC_RELAXED, __HIP_MEMORY_SCOPE_AGENT) < target) { __builtin_amdgcn_s_sleep(1);
            if ((++sp & 255u) == 0u) { if (__hip_atomic_load(tmo, __ATOMIC_RELAXED, __HIP_MEMORY_SCOPE_AGENT)) break; if (sp > (1u << 20)) { atomicAdd(tmo, 1u); break; } } }
        __builtin_amdgcn_fence(__ATOMIC_ACQUIRE, "agent");
        asm volatile("s_waitcnt vmcnt(0)" ::: "memory");
    }
    __syncthreads();
}
struct PanelX1Sched {
    const char* A; const char* B; int pm, pn0, nu;
    __device__ __forceinline__ bool next(int i, ge::Unit& u) const { if (i >= nu) return false; u.pm = pm; u.pn = pn0 + i; u.e = 0; return true; }
    __device__ __forceinline__ const char* a_base(const ge::Unit& u) const { return A + (size_t)u.pm * 256 * ZC * 2; }
    __device__ __forceinline__ const char* b_base(const ge::Unit& u) const { return B + (size_t)u.pn * 256 * 1024 * 2; }
    __device__ __forceinline__ int a_row(const ge::Unit&, int) const { return 0; }
};

__device__ __forceinline__ unsigned pack_fp8x4(float a, float b, float c, float d) {
    a = __builtin_amdgcn_fmed3f(a, -448.f, 448.f); b = __builtin_amdgcn_fmed3f(b, -448.f, 448.f); c = __builtin_amdgcn_fmed3f(c, -448.f, 448.f); d = __builtin_amdgcn_fmed3f(d, -448.f, 448.f);
    int w = 0; w = __builtin_amdgcn_cvt_pk_fp8_f32(a, b, w, false); w = __builtin_amdgcn_cvt_pk_fp8_f32(c, d, w, true); return (unsigned)w;
}

__device__ __forceinline__ bf16_t* hid_rows(unsigned char* ws, unsigned char* out, int rb) {
    (void)out; return (bf16_t*)(ws + OFF_HID1 + (size_t)rb * 256 * EH);
}
__device__ __forceinline__ int xcd_perm(int c, int G) { return (G & 7) ? c : (c & 7) * (G >> 3) + (c >> 3); }
struct MoeSched1 {
    const int* blk_e; const int* nblk; const int* row_tok; const char* h2; const char* bt1; int G, c;
    __device__ __forceinline__ bool next(int i, ge::Unit& u) const { const int rb = (i >> 1) * G + xcd_perm(c, G); if (rb >= *nblk) return false; u.pm = rb; u.pn = i & 1; u.e = blk_e[rb]; return true; }
    __device__ __forceinline__ const char* a_base(const ge::Unit&) const { return h2; }
    __device__ __forceinline__ const char* b_base(const ge::Unit& u) const { return bt1 + ((size_t)u.e * 512 + (size_t)u.pn * 256) * 1024 * 2; }
    __device__ __forceinline__ int a_row(const ge::Unit& u, int r) const { return row_tok[u.pm * 256 + r]; }
};

constexpr int MP_BASE = 131072, MP_TOT = MP_BASE, MP_PS = MP_BASE + 256, MP_PART = MP_BASE + 1024, MP_MINE = MP_BASE + 3072, MP_PREF = MP_BASE + 4096, MP_RT = MP_BASE + 9216;
constexpr int MP_MAXRB = 5;
__device__ __forceinline__ void moe_pull_prep(const Params& p, LAS unsigned char* lds) {
    int tid = threadIdx.x; asm volatile("" : "+v"(tid));
    const int nb = (int)gridDim.x, bid = (int)blockIdx.x, lane = tid & 63, wid = tid >> 6;
    const int* bc = (const int*)(p.ws + OFF_BCNT); const int* lst = (const int*)(p.ws + OFF_LIST);
    int* cnt = (int*)(p.ws + OFF_CNT); int* pstart = cnt + 128; int* nblk_g = cnt + 256; int* blk_e = (int*)(p.ws + OFF_BLKE); int* row_dst = (int*)(p.ws + OFF_ROWDST);
    LAS int* tot = (LAS int*)(lds + MP_TOT); LAS int* ps = (LAS int*)(lds + MP_PS); LAS int* part = (LAS int*)(lds + MP_PART); LAS int* mine = (LAS int*)(lds + MP_MINE);
    LAS int* pref = (LAS int*)(lds + MP_PREF); LAS int* rt = (LAS int*)(lds + MP_RT);
    { const int e = tid & 63, pg = tid >> 6, per = (nb + 7) / 8; int t = 0;
#pragma unroll 8
      for (int wg = pg * per; wg < (pg + 1) * per; ++wg) if (wg < nb) t += bc[wg * 64 + e];
      part[pg * 64 + e] = t; }
    __syncthreads();
    if (tid < 64) { int t = 0;
#pragma unroll
        for (int pg = 0; pg < 8; ++pg) t += part[pg * 64 + tid];
        tot[tid] = t; }
    __syncthreads();
    if (tid == 0) { int a = 0; for (int e = 0; e < 64; ++e) { ps[e] = a; a += (tot[e] + 255) / 256 * 256; } ps[64] = a; ps[65] = a + NTOK;
        const int nblk = ps[65] / 256; int n = 0;
        for (int i = 0; i < MP_MAXRB; ++i) { const int rb = i * nb + xcd_perm(bid, nb); if (rb < nblk) { int e = 0; while (e < 64 && rb * 256 >= ps[e + 1]) ++e; mine[1 + 3 * n] = rb; mine[2 + 3 * n] = e; mine[3 + 3 * n] = rb * 256 - ps[e]; ++n; } }
        mine[0] = n; }
    __syncthreads();
    const int nmine = mine[0];
    for (int j = 0; j < (MP_MAXRB + 1) / 2; ++j) { const int sl = 2 * j + (wid >> 2), b = (wid & 3) * 64 + lane; const bool act = sl < nmine && mine[2 + 3 * sl] < 64;
        int v = (act && b < nb) ? bc[b * 64 + mine[2 + 3 * (act ? sl : 0)]] : 0; const int own = v;
#pragma unroll
        for (int o = 1; o < 64; o <<= 1) { const int u = __shfl_up(v, o); if (lane >= o) v += u; }
        if (lane == 63) part[wid] = v;
        __syncthreads();
        int base = 0;
#pragma unroll
        for (int q = 0; q < 4; ++q) if (q < (wid & 3)) base += part[(wid & ~3) + q];
        if (act) pref[sl * 256 + b] = base + v - own;
        __syncthreads(); }
    for (int j = 0; j < (MP_MAXRB + 1) / 2; ++j) { const int sl = 2 * j + (tid >> 8), r = tid & 255;
        if (sl < nmine) { const int rb = mine[1 + 3 * sl], e = mine[2 + 3 * sl], jrow = mine[3 + 3 * sl] + r; int tokv, dst;
            if (e >= 64) { tokv = jrow; dst = -1; }
            else if (jrow >= tot[e]) { tokv = NTOK; dst = -1; }
            else { int lo = 0, hi = (nb < 256 ? nb : 256) - 1;
                while (lo < hi) { const int mid = (lo + hi + 1) >> 1; if (pref[sl * 256 + mid] <= jrow) lo = mid; else hi = mid - 1; }
                dst = lst[((size_t)lo * 64 + e) * 128 + (jrow - pref[sl * 256 + lo])]; tokv = dst >> 3; }
            rt[sl * 256 + r] = tokv; if (e < 64) row_dst[rb * 256 + r] = dst; } }
    if (bid == 0) {
        if (tid < 66) pstart[tid] = ps[tid];
        if (tid == 0) *nblk_g = ps[65] / 256;
        for (int rb = tid; rb < ps[65] / 256; rb += 512) { int e = 0; while (e < 64 && rb * 256 >= ps[e + 1]) ++e; blk_e[rb] = e; }
    }
    __syncthreads();
}
struct MoeSched1P {
    LAS unsigned char* lds; const char* h2; const char* bt1;
    __device__ __forceinline__ bool next(int i, ge::Unit& u) const { const LAS int* mine = (const LAS int*)(lds + MP_MINE); const int k = i >> 1; if (k >= mine[0]) return false; u.k = k; u.pm = mine[1 + 3 * k]; u.e = mine[2 + 3 * k]; u.pn = i & 1; return true; }
    __device__ __forceinline__ const char* a_base(const ge::Unit&) const { return h2; }
    __device__ __forceinline__ const char* b_base(const ge::Unit& u) const { return bt1 + ((size_t)u.e * 512 + (size_t)u.pn * 256) * 1024; }
    __device__ __forceinline__ int a_row(const ge::Unit& u, int r) const { return ((const LAS int*)(lds + MP_RT))[u.k * 256 + r]; }
};
struct EpiHid {
    static constexpr bool PERM = true;
    unsigned char* ws; unsigned char* out;
    __device__ __forceinline__ void operator()(const f32x4 (&acc)[2][2][4][2], const ge::Unit& u, int wr, int wc, int fr, int fq) const {
        unsigned char* base = (unsigned char*)hid_rows(ws, out, u.pm) + (size_t)(wr * 64 + fr) * EH + u.pn * 128 + wc * 32 + 8 * fq;
#pragma unroll
        for (int ai = 0; ai < 2; ++ai)
#pragma unroll
            for (int m = 0; m < 4; ++m) { const f32x4 a0 = acc[ai][0][m][0], a1 = acc[ai][0][m][1], b0 = acc[ai][1][m][0], b1 = acc[ai][1][m][1];
                u32x2 w; w.x = pack_fp8x4(siluf_(a0[0]) * b0[0], siluf_(a0[1]) * b0[1], siluf_(a0[2]) * b0[2], siluf_(a0[3]) * b0[3]);
                w.y = pack_fp8x4(siluf_(a1[0]) * b1[0], siluf_(a1[1]) * b1[1], siluf_(a1[2]) * b1[2], siluf_(a1[3]) * b1[3]);
                *(u32x2*)(base + (size_t)(ai * 128 + m * 16) * EH) = w; }
    }
};
struct MoeSched2 {
    const int* blk_e; const int* nblk; unsigned char* ws; unsigned char* out; const char* bt2; int G, c;
    __device__ __forceinline__ bool next(int i, ge::Unit& u) const { const int rb = (i >> 2) * G + xcd_perm(c, G); if (rb >= *nblk) return false; u.pm = rb; u.pn = i & 3; u.e = blk_e[rb]; return true; }
    __device__ __forceinline__ const char* a_base(const ge::Unit& u) const { return (const char*)hid_rows(ws, out, u.pm); }
    __device__ __forceinline__ const char* b_base(const ge::Unit& u) const { return bt2 + ((size_t)u.e * 1024 + (size_t)u.pn * 256) * EH; }
    __device__ __forceinline__ int a_row(const ge::Unit&, int r) const { return r; }
};
struct EpiY2 {
    static constexpr bool PERM = true;
    unsigned char* Y2; unsigned char* Y2s; const int* pstart; const int* row_dst;
    __device__ __forceinline__ void operator()(const f32x4 (&acc)[2][2][4][2], const ge::Unit& u, int wr, int wc, int fr, int fq) const {
        const int r0 = u.pm * 256 + wr * 64 + fr, colg = u.pn * 256 + wc * 32 + 8 * fq;
        if (u.e < NEXP) {
            const int rl = r0 + (fq & 1) * 16, cl2 = colg - (fq & 1) * 8;
            int rd[2][2];
#pragma unroll
            for (int ai = 0; ai < 2; ++ai)
#pragma unroll
                for (int mp = 0; mp < 2; ++mp) rd[ai][mp] = row_dst[rl + ai * 128 + mp * 32];
#pragma unroll
            for (int ai = 0; ai < 2; ++ai)
#pragma unroll
                for (int mp = 0; mp < 2; ++mp)
#pragma unroll
                    for (int bj = 0; bj < 2; ++bj) { const f32x4 v0 = acc[ai][bj][2 * mp][0], v1 = acc[ai][bj][2 * mp][1], v2 = acc[ai][bj][2 * mp + 1][0], v3 = acc[ai][bj][2 * mp + 1][1];
                        unsigned ax = pack_fp8x4(v0[0], v0[1], v0[2], v0[3]), ay = pack_fp8x4(v1[0], v1[1], v1[2], v1[3]), bx = pack_fp8x4(v2[0], v2[1], v2[2], v2[3]), by = pack_fp8x4(v3[0], v3[1], v3[2], v3[3]);
                        { auto r = __builtin_amdgcn_permlane16_swap(ax, bx, false, false); ax = r[0]; bx = r[1]; }
                        { auto r = __builtin_amdgcn_permlane16_swap(ay, by, false, false); ay = r[0]; by = r[1]; }
                        u32x4 w; w.x = ax; w.y = ay; w.z = bx; w.w = by;
                        if (rd[ai][mp] >= 0) *(u32x4*)(Y2 + (size_t)rd[ai][mp] * 1024 + cl2 + bj * 128) = w; }
        } else {
            const int t0 = r0 - pstart[NEXP] + (fq & 1) * 16, cl2 = colg - (fq & 1) * 8;
#pragma unroll
            for (int ai = 0; ai < 2; ++ai)
#pragma unroll
                for (int mp = 0; mp < 2; ++mp)
#pragma unroll
                    for (int bj = 0; bj < 2; ++bj) { const f32x4 v0 = acc[ai][bj][2 * mp][0], v1 = acc[ai][bj][2 * mp][1], v2 = acc[ai][bj][2 * mp + 1][0], v3 = acc[ai][bj][2 * mp + 1][1];
                        unsigned ax = pack_fp8x4(v0[0], v0[1], v0[2], v0[3]), ay = pack_fp8x4(v1[0], v1[1], v1[2], v1[3]), bx = pack_fp8x4(v2[0], v2[1], v2[2], v2[3]), by = pack_fp8x4(v3[0], v3[1], v3[2], v3[3]);
                        { auto r = __builtin_amdgcn_permlane16_swap(ax, bx, false, false); ax = r[0]; bx = r[1]; }
                        { auto r = __builtin_amdgcn_permlane16_swap(ay, by, false, false); ay = r[0]; by = r[1]; }
                        u32x4 w; w.x = ax; w.y = ay; w.z = bx; w.w = by;
                        *(u32x4*)(Y2s + (size_t)(t0 + ai * 128 + mp * 32) * 1024 + cl2 + bj * 128) = w; }
        }
    }
};

struct EpiNull { static constexpr bool PERM = true; float* sink;
    __device__ __forceinline__ void operator()(const f32x4 (&acc)[2][2][4][2], const ge::Unit& u, int wr, int wc, int fr, int fq) const {
        float s = 0.f;
#pragma unroll
        for (int ai = 0; ai < 2; ++ai)
#pragma unroll
            for (int bj = 0; bj < 2; ++bj)
#pragma unroll
                for (int m = 0; m < 4; ++m)
#pragma unroll
                    for (int n = 0; n < 2; ++n) s += acc[ai][bj][m][n][0] + acc[ai][bj][m][n][1] + acc[ai][bj][m][n][2] + acc[ai][bj][m][n][3];
        if (s == 12345.678f) sink[0] = s; } };
struct MoeSched2R {
    const int* blk_e; const int* pstart; unsigned char* ws; unsigned char* out; const char* bt2; int G, c;
    __device__ __forceinline__ bool next(int i, ge::Unit& u) const { const int rb = (i >> 2) * G + c; if (rb >= pstart[NEXP] / 256) return false; u.pm = rb; u.pn = i & 3; u.e = blk_e[rb]; return true; }
    __device__ __forceinline__ const char* a_base(const ge::Unit& u) const { return (const char*)hid_rows(ws, out, u.pm); }
    __device__ __forceinline__ const char* b_base(const ge::Unit& u) const { return bt2 + ((size_t)u.e * 1024 + (size_t)u.pn * 256) * EH * 2; }
    __device__ __forceinline__ int a_row(const ge::Unit&, int) const { return 0; }
};
constexpr size_t DO_LP = 120 * MiB, DO_BBAR = DO_LP + 1088 * 1024, DO_KTAB = DO_BBAR + 256 * 1024, DO_UC = 124 * MiB;
constexpr size_t OFF_MG = 26 * MiB, OFF_AEXT = 34 * MiB, OFF_XEND = 54 * MiB, OFF_WEXT = 62 * MiB, OFF_YS5 = 102 * MiB;
constexpr int AEK = 1280;

__device__ __forceinline__ void s5_tab1_phase(const Params& p) {
    f32x2* Lp = (f32x2*)(p.out + DO_LP); f32x2* Bb = (f32x2*)(p.out + DO_BBAR);
    const int gt = blockIdx.x * blockDim.x + threadIdx.x, gs = gridDim.x * blockDim.x;
    for (int i = gt; i < 2048 * 65; i += gs) { const int pi = i / 65, j = i % 65, dg = pi >> 6;
        const double lre = fmin((double)p.lam_re[pi], -1e-4), lim = (double)p.lam_im[pi], dt = exp((double)p.log_dt[dg]);
        const double er = exp(lre * dt * (double)j), th = lim * dt * (double)j;
        Lp[i] = (f32x2){(float)(er * cos(th)), (float)(er * sin(th))}; }
    for (int i = gt; i < 2048 * 16; i += gs) { const int pi = i >> 4, dg = pi >> 6;
        const double lre = fmin((double)p.lam_re[pi], -1e-4), lim = (double)p.lam_im[pi], dt = exp((double)p.log_dt[dg]);
        const double er = exp(lre * dt), th = lim * dt, nr = er * cos(th) - 1.0, ni = er * sin(th), den = lre * lre + lim * lim;
        const double cfr = (nr * lre + ni * lim) / den, cfi = (ni * lre - nr * lim) / den;
        const double br = p.b_re[i], bi = p.b_im[i];
        Bb[i] = (f32x2){(float)(cfr * br - cfi * bi), (float)(cfr * bi + cfi * br)}; }
}
__device__ __forceinline__ void s5_tab2_phase(const Params& p, int vb, int nvb) {
    const f32x2* Lp = (const f32x2*)(p.out + DO_LP); const f32x2* Bb = (const f32x2*)(p.out + DO_BBAR); float* Kt = (float*)(p.out + DO_KTAB); bf16_t* Mg = (bf16_t*)(p.ws + OFF_MG);
    const int gt = vb * 512 + threadIdx.x, gs = nvb * 512;
    for (int i = gt; i < 2 * 16 * 64 * 256; i += gs) { const int cp = i & 15, c = (i >> 4) & 15, j = (i >> 8) & 63, dg = i >> 14, g = dg & 15;
        float s = 0.f;
#pragma unroll 16
        for (int pp = 0; pp < 64; ++pp) { const f32x2 l = Lp[(dg * 64 + pp) * 65 + j], b = Bb[(dg * 64 + pp) * 16 + cp];
            const float xr = l.x * b.x - l.y * b.y, xi = l.x * b.y + l.y * b.x;
            s += p.c_re[(g * 16 + c) * 64 + pp] * xr - p.c_im[(g * 16 + c) * 64 + pp] * xi; }
        Kt[i] = s; }
    for (int i = gt; i < 16 * 256 * 128; i += gs) { const int k8 = i & 127, n = (i >> 7) & 255, g = i >> 15;
        const int dir = n >> 7, part = (n >> 6) & 1, pp = n & 63, s = k8 >> 1, c0 = (k8 & 1) * 8, dg = dir * 16 + g;
        const f32x2 l = Lp[(dg * 64 + pp) * 65 + (dir ? s : 63 - s)];
        float v[8];
#pragma unroll
        for (int q = 0; q < 8; ++q) { const f32x2 b = Bb[(dg * 64 + pp) * 16 + c0 + q]; v[q] = part ? (l.x * b.y + l.y * b.x) : (l.x * b.x - l.y * b.y); }
        u32x4 w; w.x = cvt_pk_bf16(v[0], v[1]); w.y = cvt_pk_bf16(v[2], v[3]); w.z = cvt_pk_bf16(v[4], v[5]); w.w = cvt_pk_bf16(v[6], v[7]);
        *(u32x4*)(Mg + ((size_t)(g * 256 + n)) * 1024 + k8 * 8) = w; }
}
__device__ __forceinline__ void s5_wfill_phase(const Params& p, int vb, int nvb) {
    const f32x2* Lp = (const f32x2*)(p.out + DO_LP); const float* Kt = (const float*)(p.out + DO_KTAB); bf16_t* W = (bf16_t*)(p.ws + OFF_WEXT);
    for (int i = vb * 512 + threadIdx.x; i < 16 * 1024 * 160; i += nvb * 512) { const int k8 = i % 160, n = (i / 160) & 1023, g = i / (160 * 1024), t = n >> 4, c = n & 15;
        float v[8];
        if (k8 < 128) { const int s = k8 >> 1, c0 = (k8 & 1) * 8;
            if (s < t) { const float* kp = Kt + ((((0 * 16 + g) * 64 + (t - s)) * 16 + c) * 16 + c0);
#pragma unroll
                for (int q = 0; q < 8; ++q) v[q] = kp[q]; }
            else if (s > t) { const float* kp = Kt + ((((1 * 16 + g) * 64 + (s - t)) * 16 + c) * 16 + c0);
#pragma unroll
                for (int q = 0; q < 8; ++q) v[q] = kp[q]; }
            else { const float* kf = Kt + ((((0 * 16 + g) * 64) * 16 + c) * 16 + c0); const float* kb = Kt + ((((1 * 16 + g) * 64) * 16 + c) * 16 + c0);
#pragma unroll
                for (int q = 0; q < 8; ++q) v[q] = kf[q] + kb[q] + ((c0 + q == c) ? p.s5_d[g * 16 + c] : 0.f); }
        } else { const int kk = (k8 - 128) * 8, dir = kk >> 7, part = (kk >> 6) & 1, p0 = kk & 63, dg = dir * 16 + g, e = dir ? (64 - t) : (t + 1);
#pragma unroll
            for (int q = 0; q < 8; ++q) { const f32x2 l = Lp[(dg * 64 + p0 + q) * 65 + e]; const float cr = p.c_re[(g * 16 + c) * 64 + p0 + q], ci = p.c_im[(g * 16 + c) * 64 + p0 + q];
                v[q] = part ? -(cr * l.y + ci * l.x) : (cr * l.x - ci * l.y); } }
        u32x4 w; w.x = cvt_pk_bf16(v[0], v[1]); w.y = cvt_pk_bf16(v[2], v[3]); w.z = cvt_pk_bf16(v[4], v[5]); w.w = cvt_pk_bf16(v[6], v[7]);
        *(u32x4*)(W + ((size_t)(g * 1024 + n)) * AEK + k8 * 8) = w; }
}

struct S5aSched {
    const char* A; const char* B; int G, c;
    __device__ __forceinline__ bool next(int i, ge::Unit& u) const { const int L = i * G + c; if (L >= 32) return false; u.e = L >> 1; u.pm = L & 1; u.pn = 0; return true; }
    __device__ __forceinline__ const char* a_base(const ge::Unit& u) const { return A + (size_t)(u.e * 512 + u.pm * 256) * AEK * 2; }
    __device__ __forceinline__ const char* b_base(const ge::Unit& u) const { return B + (size_t)u.e * 256 * 1024 * 2; }
    __device__ __forceinline__ int a_row(const ge::Unit&, int) const { return 0; }
};
struct EpiXend {
    static constexpr bool PERM = false;
    float* X;
    __device__ __forceinline__ void operator()(const f32x4 (&acc)[2][2][4][2], const ge::Unit& u, int wr, int wc, int fr, int fq) const {
        float* base = X + (size_t)(u.e * 512 + u.pm * 256 + wr * 64 + fr) * 256 + wc * 32 + 4 * fq;
#pragma unroll
        for (int ai = 0; ai < 2; ++ai)
#pragma unroll
            for (int m = 0; m < 4; ++m)
#pragma unroll
                for (int bj = 0; bj < 2; ++bj)
#pragma unroll
                    for (int n = 0; n < 2; ++n) *(f32x4*)(base + (size_t)(ai * 128 + m * 16) * 256 + bj * 128 + n * 16) = acc[ai][bj][m][n];
    }
};
__device__ __forceinline__ void s5a_phase(const Params& p, LAS unsigned char* lds, int vb, int nvb) {
    S5aSched S{(const char*)(p.ws + OFF_AEXT), (const char*)(p.ws + OFF_MG), nvb, vb};
    EpiXend E{(float*)(p.ws + OFF_XEND)};
    ge::gemm_phase<EpiXend, S5aSched, false>(lds, 1024, AEK, 1024, S, E);
    for (int L = vb; L < 32; L += nvb) {
        const int g = L >> 1, pm = L & 1; int tid = threadIdx.x; asm volatile("" : "+v"(tid));
        const f32x2* Lp = (const f32x2*)(p.out + DO_LP); const f32x2* Bb = (const f32x2*)(p.out + DO_BBAR); const bf16_t* uc = (const bf16_t*)(p.out + DO_UC);
        LAS float* us = (LAS float*)lds; LAS f32x2* xh = (LAS f32x2*)(lds + 32768);
        for (int i = tid; i < 2 * CTXL * 2; i += 512) { const int half = i & 1, row = i >> 1;
            const u32x4 u0 = *(const u32x4*)(uc + (size_t)((pm * 2 + (row >> 8)) * CTXL + (row & 255)) * 256 + g * 16 + half * 8);
            LAS float* d = us + row * 16 + half * 8;
            d[0] = bf_lo(u0.x); d[1] = bf_hi(u0.x); d[2] = bf_lo(u0.y); d[3] = bf_hi(u0.y); d[4] = bf_lo(u0.z); d[5] = bf_hi(u0.z); d[6] = bf_lo(u0.w); d[7] = bf_hi(u0.w); }
        __syncthreads();
        const int hq = tid >> 8, t2 = tid & 255, bb = t2 >> 7, dir = (t2 >> 6) & 1, pp = t2 & 63, b = pm * 2 + bb, dg = dir * 16 + g;
        const f32x2 l1 = Lp[(dg * 64 + pp) * 65 + 1], l64 = Lp[(dg * 64 + pp) * 65 + 64];
        float xr = 0.f, xi = 0.f;
        { float Br[16], Bi[16];
#pragma unroll
          for (int q = 0; q < 16; ++q) { const f32x2 tq = Bb[(dg * 64 + pp) * 16 + q]; Br[q] = tq.x; Bi[q] = tq.y; }
#pragma unroll 4
          for (int s = hq * 128; s < hq * 128 + 128; ++s) { const int lc = dir ? (CTXL - 1 - s) : s;
              const LAS float* up = us + (bb * CTXL + lc) * 16;
              const f32x4 ua = *(const LAS f32x4*)up, ub = *(const LAS f32x4*)(up + 4), uc4 = *(const LAS f32x4*)(up + 8), ud = *(const LAS f32x4*)(up + 12);
              float bur = 0.f, bui = 0.f;
#pragma unroll
              for (int q = 0; q < 4; ++q) { bur += Br[q] * ua[q] + Br[4 + q] * ub[q] + Br[8 + q] * uc4[q] + Br[12 + q] * ud[q]; bui += Bi[q] * ua[q] + Bi[4 + q] * ub[q] + Bi[8 + q] * uc4[q] + Bi[12 + q] * ud[q]; }
              const float nr = l1.x * xr - l1.y * xi + bur, ni = l1.x * xi + l1.y * xr + bui; xr = nr; xi = ni; } }
        if (hq == 1) xh[t2] = (f32x2){xr, xi};
        __syncthreads();
        if (hq == 0) {
            const float l128r = l64.x * l64.x - l64.y * l64.y, l128i = 2.0f * l64.x * l64.y; const f32x2 x2 = xh[t2];
            { const float nr = l128r * xr - l128i * xi + x2.x, ni = l128r * xi + l128i * xr + x2.y; xr = nr; xi = ni; }
            const float* Xe = (const float*)(p.ws + OFF_XEND); bf16_t* Ae = (bf16_t*)(p.ws + OFF_AEXT);
#pragma unroll 8
            for (int s = 0; s < 128; ++s) { const int m = dir ? (127 - s) : s; const size_t row = (size_t)(g * 512 + b * 128 + m);
                Ae[row * AEK + 1024 + dir * 128 + pp] = f2bf(xr); Ae[row * AEK + 1024 + dir * 128 + 64 + pp] = f2bf(xi);
                const float er = Xe[row * 256 + dir * 128 + pp], ei = Xe[row * 256 + dir * 128 + 64 + pp];
                const float nr = l64.x * xr - l64.y * xi + er, ni = l64.x * xi + l64.y * xr + ei; xr = nr; xi = ni; }
        }
        __syncthreads();
    }
}

struct S5bSched {
    const char* A; const char* B; int G, c;
    __device__ __forceinline__ bool next(int i, ge::Unit& u) const { const int L = i * G + c; if (L >= 128) return false; u.e = L >> 3; u.pm = (L >> 2) & 1; u.pn = L & 3; return true; }
    __device__ __forceinline__ const char* a_base(const ge::Unit& u) const { return A + (size_t)(u.e * 512 + u.pm * 256) * AEK * 2; }
    __device__ __forceinline__ const char* b_base(const ge::Unit& u) const { return B + (size_t)(u.e * 1024 + u.pn * 256) * AEK * 2; }
    __device__ __forceinline__ int a_row(const ge::Unit&, int) const { return 0; }
};
struct EpiYs5 {
    static constexpr bool PERM = true;
    bf16_t* Y;
    __device__ __forceinline__ void operator()(const f32x4 (&acc)[2][2][4][2], const ge::Unit& u, int wr, int wc, int fr, int fq) const {
        bf16_t* rp = Y + ((size_t)(u.pm * 256 + wr * 64 + fr) * 64 + u.pn * 16 + wc * 2 + (fq >> 1)) * 256 + u.e * 16 + 8 * (fq & 1);
#pragma unroll
        for (int ai = 0; ai < 2; ++ai)
#pragma unroll
            for (int m = 0; m < 4; ++m) {
#pragma unroll
                for (int bj = 0; bj < 2; ++bj) { f32x4 v0 = acc[ai][bj][m][0], v1 = acc[ai][bj][m][1];
                    asm volatile("" : "+v"(v0), "+v"(v1));
                    u32x4 w; w.x = cvt_pk_bf16(gelu_tanh(v0[0]), gelu_tanh(v0[1])); w.y = cvt_pk_bf16(gelu_tanh(v0[2]), gelu_tanh(v0[3]));
                    w.z = cvt_pk_bf16(gelu_tanh(v1[0]), gelu_tanh(v1[1])); w.w = cvt_pk_bf16(gelu_tanh(v1[2]), gelu_tanh(v1[3]));
                    *(u32x4*)(rp + bj * 8 * 256) = w; asm volatile("" ::: "memory"); }
                rp += (m == 3) ? (size_t)(128 - 48) * 64 * 256 : (size_t)16 * 64 * 256;
                asm volatile("" : "+v"(rp)); }
    }
};
__device__ __forceinline__ void s5b_phase(const Params& p, LAS unsigned char* lds, int vb, int nvb) {
    S5bSched S{(const char*)(p.ws + OFF_AEXT), (const char*)(p.ws + OFF_WEXT), nvb, vb};
    EpiYs5 E{(bf16_t*)(p.ws + OFF_YS5)};
    ge::gemm_phase<EpiYs5, S5bSched, false>(lds, AEK, AEK, AEK, S, E);
}
constexpr size_t DO_KV = 96 * MiB, DO_DEC = 125 * MiB;
constexpr int GLA_SLOTS = 16;
constexpr int GL_QI = 0, GL_KI = 17408, GL_KIT = 34816, GL_VT = 53248, GL_P = 71680, GL_TOT = 80896, GL_EREF = 89088, GL_ETOT = 89600;
constexpr int GLA_NSEG = 8, GLA_SEGC = 16;

template <bool PASS1, int VAR = 0>
__device__ __forceinline__ void gla_unit(const Params& p, LAS unsigned char* lds, const int chain, const int ch0, const int nch, const int nfold) {
    int tid = threadIdx.x; asm volatile("" : "+v"(tid));
    const int w = __builtin_amdgcn_readfirstlane(tid >> 6), lane = tid & 63, vloc = lane & 15, rq = lane >> 4;
    const int dir = chain & 1, h = (chain >> 1) % 6, b = chain / 12;
    const bf16_t* Z = (const bf16_t*)(p.ws + OFF_Z);
    bf16_t* O = (bf16_t*)(p.out + (dir ? DO_OB : DO_OF));
    float* KV = (float*)(p.out + DO_KV); float* DEC = (float*)(p.out + DO_DEC);
    const bool isctx = false; const int slot = 0; (void)slot;
    static_assert(!PASS1, "pass 1 uses gla_pass1_unit");
    const float l0a = p.lb_logits[h * 128 + 2 * lane], l1a = p.lb_logits[768 + h * 128 + 2 * lane], l0b = p.lb_logits[h * 128 + 2 * lane + 1], l1b = p.lb_logits[768 + h * 128 + 2 * lane + 1];
    const float lb0 = frcp_(1.0f + __expf(l1a - l0a)), lb1 = frcp_(1.0f + __expf(l1b - l0b));
    const int colf = (dir ? ZFB : ZFF) + h * 128 + 2 * lane, colq = ZQ + h * 128 + 2 * lane, colv = ZI + h * 128 + 2 * lane;
    auto chunk_rows = [&](int ci, int& base, int& stride) {
        if (isctx) { if (dir == 0) { base = NTOK + b * CTXL + 64 * ci; stride = 1; } else { base = NTOK + b * CTXL + 255 - 64 * ci; stride = -1; } }
        else { const int n = ch0 + ci;
            if (dir == 0) { base = b * SEQ + 4096 * (n & 1) + (n >> 1); stride = 64; }
            else { const int n2 = 127 - n; base = b * SEQ + 4096 * (n2 & 1) + (n2 >> 1) + 64 * 63; stride = -64; } }
    };
    f32x4 S[8];
    if (PASS1) {
#pragma unroll
        for (int it = 0; it < 8; ++it) S[it] = (f32x4){0.f, 0.f, 0.f, 0.f};
    } else {
#pragma unroll
        for (int it = 0; it < 8; ++it) S[it] = (f32x4){0.f, 0.f, 0.f, 0.f};
        for (int sl = 0; sl < nfold; ++sl) {
            const unsigned* kv = (const unsigned*)KV + ((size_t)(chain * GLA_SLOTS + sl) * 8 + w) * 16 * 64 + lane; const float* dc = DEC + (size_t)(chain * GLA_SLOTS + sl) * 128;
#pragma unroll
            for (int it = 0; it < 8; ++it) { const f32x4 d = *(const f32x4*)(dc + 16 * it + 4 * rq); const unsigned w0 = kv[(it * 2) * 64], w1 = kv[(it * 2 + 1) * 64];
                S[it][0] = d[0] * S[it][0] + bf_lo(w0); S[it][1] = d[1] * S[it][1] + bf_hi(w0); S[it][2] = d[2] * S[it][2] + bf_lo(w1); S[it][3] = d[3] * S[it][3] + bf_hi(w1); }
        }
    }
    float dsum0 = 1.f, dsum1 = 1.f;
    unsigned nz[8], nv[8], nq[8];
    { int base, stride; chunk_rows(0, base, stride);
#pragma unroll
      for (int r = 0; r < 8; ++r) { const size_t ro = (size_t)(base + stride * (8 * w + r)) * ZC; nz[r] = *(const unsigned*)(Z + ro + colf); nv[r] = *(const unsigned*)(Z + ro + colv); if (!PASS1) nq[r] = *(const unsigned*)(Z + ro + colq); } }
    for (int ci = 0; ci < nch; ++ci) {
        unsigned cz[8], cv[8], cq[8];
#pragma unroll
        for (int r = 0; r < 8; ++r) { cz[r] = nz[r]; cv[r] = nv[r]; if (!PASS1) cq[r] = nq[r]; }
        int base, stride; chunk_rows(ci, base, stride);
        if (ci + 1 < nch) { int nb_, ns_; chunk_rows(ci + 1, nb_, ns_);
#pragma unroll
            for (int r = 0; r < 8; ++r) { const size_t ro = (size_t)(nb_ + ns_ * (8 * w + r)) * ZC; nz[r] = *(const unsigned*)(Z + ro + colf); nv[r] = *(const unsigned*)(Z + ro + colv); if (!PASS1) nq[r] = *(const unsigned*)(Z + ro + colq); } }
        f32x2 cp[8], kk[8]; f32x2 run = (f32x2){1.0f, 1.0f};
        const f32x2 lbv = (f32x2){lb0, lb1}, one = (f32x2){1.0f, 1.0f}, omlb = one - lbv;
#pragma unroll
        for (int r = 0; r < 8; ++r) { const f32x2 z = (f32x2){bf_lo(cz[r]), bf_hi(cz[r])}; const f32x2 zz = z * (-1.4426950408889634f);
            f32x2 E; E.x = __builtin_amdgcn_exp2f(zz.x); E.y = __builtin_amdgcn_exp2f(zz.y);
            const f32x2 d = one + E; f32x2 D; D.x = frcp_(d.x); D.y = frcp_(d.y);
            const f32x2 f = (one + lbv * E) * D;
            kk[r] = omlb * E * D;
            run = run * f; cp[r] = run; }
        *(LAS f32x2*)(lds + GL_TOT + (w * 128 + 2 * lane) * 4) = run;
        __syncthreads();
        f32x2 pre = one, refp = one, totp = one;
#pragma unroll
        for (int ww = 0; ww < 8; ++ww) { const f32x2 tv = *(const LAS f32x2*)(lds + GL_TOT + (ww * 128 + 2 * lane) * 4);
            if (ww < w) pre = pre * tv; if (ww < 4) refp = refp * tv; totp = totp * tv; }
        dsum0 *= totp.x; dsum1 *= totp.y;
        f32x2 invR; invR.x = frcp_(refp.x); invR.y = frcp_(refp.y);
        { const f32x2 s_q = pre * invR; f32x2 ki[8];
#pragma unroll
          for (int r = 0; r < 8; ++r) { const f32x2 e = s_q * cp[r]; f32x2 ie; ie.x = frcp_(e.x); ie.y = frcp_(e.y);
              ki[r] = kk[r] * ie;
              const int t = 8 * w + r;
              if (!PASS1) { const f32x2 qv = (f32x2){bf_lo(cq[r]), bf_hi(cq[r])} * e;
                            *(LAS unsigned*)(lds + GL_QI + t * 272 + lane * 4) = cvt_pk_bf16(qv.x, qv.y);
                            *(LAS unsigned*)(lds + GL_KI + t * 272 + lane * 4) = cvt_pk_bf16(ki[r].x, ki[r].y); } }
          u32x4 a, bq;
          a.x = cvt_pk_bf16(ki[0].x, ki[1].x); a.y = cvt_pk_bf16(ki[2].x, ki[3].x); a.z = cvt_pk_bf16(ki[4].x, ki[5].x); a.w = cvt_pk_bf16(ki[6].x, ki[7].x);
          bq.x = cvt_pk_bf16(ki[0].y, ki[1].y); bq.y = cvt_pk_bf16(ki[2].y, ki[3].y); bq.z = cvt_pk_bf16(ki[4].y, ki[5].y); bq.w = cvt_pk_bf16(ki[6].y, ki[7].y);
          *(LAS u32x4*)(lds + GL_KIT + (2 * lane) * 144 + 16 * w) = a; *(LAS u32x4*)(lds + GL_KIT + (2 * lane + 1) * 144 + 16 * w) = bq;
          u32x4 va, vb2;
          va.x = (cv[0] & 0xffffu) | (cv[1] << 16); va.y = (cv[2] & 0xffffu) | (cv[3] << 16); va.z = (cv[4] & 0xffffu) | (cv[5] << 16); va.w = (cv[6] & 0xffffu) | (cv[7] << 16);
          vb2.x = (cv[0] >> 16) | (cv[1] & 0xffff0000u); vb2.y = (cv[2] >> 16) | (cv[3] & 0xffff0000u); vb2.z = (cv[4] >> 16) | (cv[5] & 0xffff0000u); vb2.w = (cv[6] >> 16) | (cv[7] & 0xffff0000u);
          *(LAS u32x4*)(lds + GL_VT + (2 * lane) * 144 + 16 * w) = va; *(LAS u32x4*)(lds + GL_VT + (2 * lane + 1) * 144 + 16 * w) = vb2; }
        if (w == 0) { *(LAS f32x2*)(lds + GL_EREF + 2 * lane * 4) = refp; *(LAS f32x2*)(lds + GL_ETOT + 2 * lane * 4) = totp * invR; }
        __syncthreads();
#pragma unroll
        for (int it = 0; it < 8; ++it) { const f32x4 er = *(const LAS f32x4*)(lds + GL_EREF + (16 * it + 4 * rq) * 4); S[it] = S[it] * er; }
        f32x4 o[4];
        if (!PASS1 && VAR != 2) {
            bf16x8 Sb[4];
#pragma unroll
            for (int c = 0; c < 4; ++c) { u32x4 t; t.x = cvt_pk_bf16(S[2 * c][0], S[2 * c][1]); t.y = cvt_pk_bf16(S[2 * c][2], S[2 * c][3]); t.z = cvt_pk_bf16(S[2 * c + 1][0], S[2 * c + 1][1]); t.w = cvt_pk_bf16(S[2 * c + 1][2], S[2 * c + 1][3]); Sb[c] = __builtin_bit_cast(bf16x8, t); }
#pragma unroll
            for (int tt = 0; tt < 4; ++tt) { o[tt] = (f32x4){0.f, 0.f, 0.f, 0.f};
#pragma unroll
                for (int c = 0; c < (VAR == 4 ? 0 : 4); ++c) { const LAS unsigned char* qa = lds + GL_QI + (16 * tt + vloc) * 272 + (32 * c + 4 * rq) * 2;
                    const u32x2 lo = *(const LAS u32x2*)qa, hi = *(const LAS u32x2*)(qa + 32);
                    u32x4 t; t.x = lo.x; t.y = lo.y; t.z = hi.x; t.w = hi.y;
                    o[tt] = __builtin_amdgcn_mfma_f32_16x16x32_bf16(__builtin_bit_cast(bf16x8, t), Sb[c], o[tt], 0, 0, 0); } }
            { const int tt = w >> 1;
#pragma unroll
              for (int sh = 0; sh < (VAR == 5 ? 0 : 2); ++sh) { const int st = 2 * (w & 1) + sh; f32x4 pacc = (f32x4){0.f, 0.f, 0.f, 0.f};
#pragma unroll
                  for (int c = 0; c < 4; ++c) { const bf16x8 ka = *(const LAS bf16x8*)(lds + GL_KI + (16 * st + vloc) * 272 + (32 * c + 8 * rq) * 2);
                      const bf16x8 qb = *(const LAS bf16x8*)(lds + GL_QI + (16 * tt + vloc) * 272 + (32 * c + 8 * rq) * 2);
                      pacc = __builtin_amdgcn_mfma_f32_16x16x32_bf16(ka, qb, pacc, 0, 0, 0); }
                  const int tg = 16 * tt + vloc, sg = 16 * st + 4 * rq;
                  u32x2 pw; pw.x = cvt_pk_bf16(sg + 0 <= tg ? pacc[0] : 0.f, sg + 1 <= tg ? pacc[1] : 0.f); pw.y = cvt_pk_bf16(sg + 2 <= tg ? pacc[2] : 0.f, sg + 3 <= tg ? pacc[3] : 0.f);
                  *(LAS u32x2*)(lds + GL_P + tg * 144 + sg * 2) = pw; } }
        }
        __syncthreads();
        if (VAR != 2) { bf16x8 vb[2];
#pragma unroll
          for (int c = 0; c < 2; ++c) vb[c] = *(const LAS bf16x8*)(lds + GL_VT + (16 * w + vloc) * 144 + (32 * c + 8 * rq) * 2);
          if (!PASS1) {
#pragma unroll
              for (int tt = 0; tt < (VAR == 5 ? 0 : 4); ++tt)
#pragma unroll
                  for (int c = 0; c < 2; ++c) { const bf16x8 pa = *(const LAS bf16x8*)(lds + GL_P + (16 * tt + vloc) * 144 + (32 * c + 8 * rq) * 2); o[tt] = __builtin_amdgcn_mfma_f32_16x16x32_bf16(pa, vb[c], o[tt], 0, 0, 0); }
          }
#pragma unroll
          for (int it = 0; it < 8; ++it)
#pragma unroll
              for (int c = 0; c < 2; ++c) { const bf16x8 ka = *(const LAS bf16x8*)(lds + GL_KIT + (16 * it + vloc) * 144 + (32 * c + 8 * rq) * 2); S[it] = __builtin_amdgcn_mfma_f32_16x16x32_bf16(ka, vb[c], S[it], 0, 0, 0); }
#pragma unroll
          for (int it = 0; it < 8; ++it) { const f32x4 et = *(const LAS f32x4*)(lds + GL_ETOT + (16 * it + 4 * rq) * 4); S[it] = S[it] * et; }
          if (!PASS1) {
#pragma unroll
              for (int tt = 0; tt < 4; ++tt)
#pragma unroll
                  for (int j = 0; j < 4; ++j) { const int t = 16 * tt + 4 * rq + j; if (VAR == 0 || o[tt][j] == 1.2345e-30f) O[(size_t)(base + stride * t) * 768 + h * 128 + 16 * w + vloc] = f2bf(o[tt][j]); }
          } }
    }
    __syncthreads();
}

constexpr int G1_KIT = 0, G1_VT = 34816, G1_TOT = 69632, G1_EREF = 77824, G1_ETOT = 78336;
__device__ __forceinline__ void gla_pass1_unit(const Params& p, LAS unsigned char* lds, const int chain, const int slot) {
    int tid = threadIdx.x; asm volatile("" : "+v"(tid));
    const int w = __builtin_amdgcn_readfirstlane(tid >> 6), lane = tid & 63, vloc = lane & 15, rq = lane >> 4;
    const int dir = chain & 1, h = (chain >> 1) % 6, b = chain / 12;
    const bf16_t* Z = (const bf16_t*)(p.ws + OFF_Z);
    float* KV = (float*)(p.out + DO_KV); float* DEC = (float*)(p.out + DO_DEC);
    const bool isctx = slot == 0;
    const int nst = isctx ? 2 : 4, col0 = isctx ? 0 : (slot - 1) * 4;
    const float l0a = p.lb_logits[h * 128 + 2 * lane], l1a = p.lb_logits[768 + h * 128 + 2 * lane], l0b = p.lb_logits[h * 128 + 2 * lane + 1], l1b = p.lb_logits[768 + h * 128 + 2 * lane + 1];
    const float lb0 = frcp_(1.0f + __expf(l1a - l0a)), lb1 = frcp_(1.0f + __expf(l1b - l0b));
    const int colf = (dir ? ZFB : ZFF) + h * 128 + 2 * lane, colv = ZI + h * 128 + 2 * lane;
    auto step_rows = [&](int j, int& base, int& stride) {
        if (isctx) { if (dir == 0) { base = NTOK + b * CTXL + 128 * j; stride = 1; } else { base = NTOK + b * CTXL + 255 - 128 * j; stride = -1; } }
        else { const int c = col0 + j;
            if (dir == 0) { base = b * SEQ + c; stride = 64; } else { base = b * SEQ + (63 - c) + 64 * 127; stride = -64; } }
    };
    f32x4 S[8];
#pragma unroll
    for (int it = 0; it < 8; ++it) S[it] = (f32x4){0.f, 0.f, 0.f, 0.f};
    float dsum0 = 1.f, dsum1 = 1.f;
    unsigned nz[16], nv[16];
    { int base, stride; step_rows(0, base, stride);
#pragma unroll
      for (int r = 0; r < 16; ++r) { const size_t ro = (size_t)(base + stride * (16 * w + r)) * ZC; nz[r] = *(const unsigned*)(Z + ro + colf); nv[r] = *(const unsigned*)(Z + ro + colv); } }
    for (int j = 0; j < nst; ++j) {
        unsigned cz[16], cv[16];
#pragma unroll
        for (int r = 0; r < 16; ++r) { cz[r] = nz[r]; cv[r] = nv[r]; }
        if (j + 1 < nst) { int nb_, ns_; step_rows(j + 1, nb_, ns_);
#pragma unroll
            for (int r = 0; r < 16; ++r) { const size_t ro = (size_t)(nb_ + ns_ * (16 * w + r)) * ZC; nz[r] = *(const unsigned*)(Z + ro + colf); nv[r] = *(const unsigned*)(Z + ro + colv); } }
        f32x2 cp[16], kk[16]; f32x2 run = (f32x2){1.0f, 1.0f};
        const f32x2 lbv = (f32x2){lb0, lb1}, one = (f32x2){1.0f, 1.0f}, omlb = one - lbv;
#pragma unroll
        for (int r = 0; r < 16; ++r) { const f32x2 z = (f32x2){bf_lo(cz[r]), bf_hi(cz[r])}; const f32x2 zz = z * (-1.4426950408889634f);
            f32x2 E; E.x = __builtin_amdgcn_exp2f(zz.x); E.y = __builtin_amdgcn_exp2f(zz.y);
            const f32x2 d = one + E; f32x2 D; D.x = frcp_(d.x); D.y = frcp_(d.y);
            const f32x2 f = (one + lbv * E) * D; kk[r] = omlb * E * D; run = run * f; cp[r] = run; }
        *(LAS f32x2*)(lds + G1_TOT + (w * 128 + 2 * lane) * 4) = run;
        __syncthreads();
        f32x2 pre = one, refp = one, totp = one;
#pragma unroll
        for (int ww = 0; ww < 8; ++ww) { const f32x2 tv = *(const LAS f32x2*)(lds + G1_TOT + (ww * 128 + 2 * lane) * 4);
            if (ww < w) pre = pre * tv; if (ww < 4) refp = refp * tv; totp = totp * tv; }
        dsum0 *= totp.x; dsum1 *= totp.y;
        f32x2 invR; invR.x = frcp_(refp.x); invR.y = frcp_(refp.y);
        { unsigned k0p[8], k1p[8], v0p[8], v1p[8]; const f32x2 s_q = pre * invR;
#pragma unroll
          for (int r = 0; r < 16; r += 2) { const f32x2 ea = s_q * cp[r], eb = s_q * cp[r + 1]; f32x2 ia, ib; ia.x = frcp_(ea.x); ia.y = frcp_(ea.y); ib.x = frcp_(eb.x); ib.y = frcp_(eb.y);
              const f32x2 ka_ = kk[r] * ia, kb_ = kk[r + 1] * ib;
              k0p[r >> 1] = cvt_pk_bf16(ka_.x, kb_.x); k1p[r >> 1] = cvt_pk_bf16(ka_.y, kb_.y);
              v0p[r >> 1] = (cv[r] & 0xffffu) | (cv[r + 1] << 16); v1p[r >> 1] = (cv[r] >> 16) | (cv[r + 1] & 0xffff0000u); }
          LAS unsigned char* ka = lds + G1_KIT + (2 * lane) * 272 + 32 * w; LAS unsigned char* va = lds + G1_VT + (2 * lane) * 272 + 32 * w;
          *(LAS u32x4*)ka = (u32x4){k0p[0], k0p[1], k0p[2], k0p[3]}; *(LAS u32x4*)(ka + 16) = (u32x4){k0p[4], k0p[5], k0p[6], k0p[7]};
          *(LAS u32x4*)(ka + 272) = (u32x4){k1p[0], k1p[1], k1p[2], k1p[3]}; *(LAS u32x4*)(ka + 272 + 16) = (u32x4){k1p[4], k1p[5], k1p[6], k1p[7]};
          *(LAS u32x4*)va = (u32x4){v0p[0], v0p[1], v0p[2], v0p[3]}; *(LAS u32x4*)(va + 16) = (u32x4){v0p[4], v0p[5], v0p[6], v0p[7]};
          *(LAS u32x4*)(va + 272) = (u32x4){v1p[0], v1p[1], v1p[2], v1p[3]}; *(LAS u32x4*)(va + 272 + 16) = (u32x4){v1p[4], v1p[5], v1p[6], v1p[7]}; }
        if (w == 0) { *(LAS f32x2*)(lds + G1_EREF + 2 * lane * 4) = refp; *(LAS f32x2*)(lds + G1_ETOT + 2 * lane * 4) = totp * invR; }
        __syncthreads();
#pragma unroll
        for (int it = 0; it < 8; ++it) { const f32x4 er = *(const LAS f32x4*)(lds + G1_EREF + (16 * it + 4 * rq) * 4); S[it] = S[it] * er; }
        { bf16x8 vb[4];
#pragma unroll
          for (int c = 0; c < 4; ++c) vb[c] = *(const LAS bf16x8*)(lds + G1_VT + (16 * w + vloc) * 272 + (32 * c + 8 * rq) * 2);
#pragma unroll
          for (int it = 0; it < 8; ++it)
#pragma unroll
              for (int c = 0; c < 4; ++c) { const bf16x8 ka = *(const LAS bf16x8*)(lds + G1_KIT + (16 * it + vloc) * 272 + (32 * c + 8 * rq) * 2); S[it] = __builtin_amdgcn_mfma_f32_16x16x32_bf16(ka, vb[c], S[it], 0, 0, 0); } }
#pragma unroll
        for (int it = 0; it < 8; ++it) { const f32x4 et = *(const LAS f32x4*)(lds + G1_ETOT + (16 * it + 4 * rq) * 4); S[it] = S[it] * et; }
    }
    unsigned* kv = (unsigned*)KV + ((size_t)(chain * GLA_SLOTS + slot) * 8 + w) * 16 * 64 + lane;
#pragma unroll
    for (int it = 0; it < 8; ++it) { kv[(it * 2) * 64] = cvt_pk_bf16(S[it][0], S[it][1]); kv[(it * 2 + 1) * 64] = cvt_pk_bf16(S[it][2], S[it][3]); }
    if (w == 0) *(f32x2*)(DEC + (size_t)(chain * GLA_SLOTS + slot) * 128 + 2 * lane) = (f32x2){dsum0, dsum1};
    __syncthreads();
}

constexpr int G3_IMG = 73728, G3_QI = 0, G3_KI = 17408, G3_KIT = 34816, G3_VT = 53248, G3_EREF = 71680, G3_ETOT = 72192, G3_P = 147456, G3_TOT = 156672;
__device__ __forceinline__ void gla_unit_p3(const Params& p, LAS unsigned char* lds, const int chain, const int ch0, const int nch, const int nfold) {
    int tid = threadIdx.x; asm volatile("" : "+v"(tid));
    const int w = __builtin_amdgcn_readfirstlane(tid >> 6), lane = tid & 63, vloc = lane & 15, rq = lane >> 4;
    const int dir = chain & 1, h = (chain >> 1) % 6, b = chain / 12;
    const bf16_t* Z = (const bf16_t*)(p.ws + OFF_Z);
    bf16_t* O = (bf16_t*)(p.out + (dir ? DO_OB : DO_OF));
    const float* KV = (const float*)(p.out + DO_KV); const float* DEC = (const float*)(p.out + DO_DEC);
    const float l0a = p.lb_logits[h * 128 + 2 * lane], l1a = p.lb_logits[768 + h * 128 + 2 * lane], l0b = p.lb_logits[h * 128 + 2 * lane + 1], l1b = p.lb_logits[768 + h * 128 + 2 * lane + 1];
    const float lb0 = frcp_(1.0f + __expf(l1a - l0a)), lb1 = frcp_(1.0f + __expf(l1b - l0b));
    const int colf = (dir ? ZFB : ZFF) + h * 128 + 2 * lane, colq = ZQ + h * 128 + 2 * lane, colv = ZI + h * 128 + 2 * lane;
    auto chunk_rows = [&](int ci, int& base, int& stride) { const int n = ch0 + ci;
        if (dir == 0) { base = b * SEQ + 4096 * (n & 1) + (n >> 1); stride = 64; }
        else { const int n2 = 127 - n; base = b * SEQ + 4096 * (n2 & 1) + (n2 >> 1) + 64 * 63; stride = -64; } };
    unsigned zA[8], qB[8], vB[8];
    float cl0[8], cl1[8], kk0[8], kk1[8];
    f32x4 S[8], o[4];
#define G3_LOADZ(ci) do { int b_, s_; chunk_rows(ci, b_, s_); _Pragma("unroll") for (int r = 0; r < 8; ++r) zA[r] = *(const unsigned*)(Z + (size_t)(b_ + s_ * (8 * w + r)) * ZC + colf); } while (0)
#define G3_LOADQV(ci) do { int b_, s_; chunk_rows(ci, b_, s_); _Pragma("unroll") for (int r = 0; r < 8; ++r) { const size_t ro = (size_t)(b_ + s_ * (8 * w + r)) * ZC; qB[r] = *(const unsigned*)(Z + ro + colq); vB[r] = *(const unsigned*)(Z + ro + colv); } } while (0)
#define G3_STAGE_A() do { float c0 = 0.f, c1 = 0.f; \
        _Pragma("unroll") for (int r = 0; r < 8; ++r) { const float s0 = sigmoidf_(bf_lo(zA[r])), s1 = sigmoidf_(bf_hi(zA[r])); \
            const float f0 = lb0 + (1.0f - lb0) * s0, f1 = lb1 + (1.0f - lb1) * s1; \
            c0 += __logf(f0); c1 += __logf(f1); cl0[r] = c0; cl1[r] = c1; kk0[r] = (1.0f - lb0) * (1.0f - s0); kk1[r] = (1.0f - lb1) * (1.0f - s1); } \
        *(LAS f32x2*)(lds + G3_TOT + (w * 128 + 2 * lane) * 4) = (f32x2){c0, c1}; } while (0)
#define G3_STAGE_B(IB) do { float pre0 = 0.f, pre1 = 0.f, ref0 = 0.f, ref1 = 0.f, tot0 = 0.f, tot1 = 0.f; \
        _Pragma("unroll") for (int ww = 0; ww < 8; ++ww) { const f32x2 tv = *(const LAS f32x2*)(lds + G3_TOT + (ww * 128 + 2 * lane) * 4); \
            if (ww < w) { pre0 += tv.x; pre1 += tv.y; } if (ww < 4) { ref0 += tv.x; ref1 += tv.y; } tot0 += tv.x; tot1 += tv.y; } \
        float ki0[8], ki1[8]; \
        _Pragma("unroll") for (int r = 0; r < 8; ++r) { const float e0 = __expf(pre0 + cl0[r] - ref0), e1 = __expf(pre1 + cl1[r] - ref1); \
            ki0[r] = kk0[r] * frcp_(e0); ki1[r] = kk1[r] * frcp_(e1); const int t = 8 * w + r; \
            *(LAS unsigned*)(lds + (IB) + G3_QI + t * 272 + lane * 4) = cvt_pk_bf16(bf_lo(qB[r]) * e0, bf_hi(qB[r]) * e1); \
            *(LAS unsigned*)(lds + (IB) + G3_KI + t * 272 + lane * 4) = cvt_pk_bf16(ki0[r], ki1[r]); } \
        u32x4 a_, b_; \
        a_.x = cvt_pk_bf16(ki0[0], ki0[1]); a_.y = cvt_pk_bf16(ki0[2], ki0[3]); a_.z = cvt_pk_bf16(ki0[4], ki0[5]); a_.w = cvt_pk_bf16(ki0[6], ki0[7]); \
        b_.x = cvt_pk_bf16(ki1[0], ki1[1]); b_.y = cvt_pk_bf16(ki1[2], ki1[3]); b_.z = cvt_pk_bf16(ki1[4], ki1[5]); b_.w = cvt_pk_bf16(ki1[6], ki1[7]); \
        *(LAS u32x4*)(lds + (IB) + G3_KIT + (2 * lane) * 144 + 16 * w) = a_; *(LAS u32x4*)(lds + (IB) + G3_KIT + (2 * lane + 1) * 144 + 16 * w) = b_; \
        u32x4 va, vb2; \
        va.x = (vB[0] & 0xffffu) | (vB[1] << 16); va.y = (vB[2] & 0xffffu) | (vB[3] << 16); va.z = (vB[4] & 0xffffu) | (vB[5] << 16); va.w = (vB[6] & 0xffffu) | (vB[7] << 16); \
        vb2.x = (vB[0] >> 16) | (vB[1] & 0xffff0000u); vb2.y = (vB[2] >> 16) | (vB[3] & 0xffff0000u); vb2.z = (vB[4] >> 16) | (vB[5] & 0xffff0000u); vb2.w = (vB[6] >> 16) | (vB[7] & 0xffff0000u); \
        *(LAS u32x4*)(lds + (IB) + G3_VT + (2 * lane) * 144 + 16 * w) = va; *(LAS u32x4*)(lds + (IB) + G3_VT + (2 * lane + 1) * 144 + 16 * w) = vb2; \
        if (w == 0) { *(LAS f32x2*)(lds + (IB) + G3_EREF + 2 * lane * 4) = (f32x2){__expf(ref0), __expf(ref1)}; *(LAS f32x2*)(lds + (IB) + G3_ETOT + 2 * lane * 4) = (f32x2){__expf(tot0 - ref0), __expf(tot1 - ref1)}; } } while (0)
#define G3_STAGE_C(IB) do { \
        _Pragma("unroll") for (int it = 0; it < 8; ++it) { const f32x4 er = *(const LAS f32x4*)(lds + (IB) + G3_EREF + (16 * it + 4 * rq) * 4); S[it] = S[it] * er; } \
        bf16x8 Sb[4]; \
        _Pragma("unroll") for (int c = 0; c < 4; ++c) { u32x4 t; t.x = cvt_pk_bf16(S[2 * c][0], S[2 * c][1]); t.y = cvt_pk_bf16(S[2 * c][2], S[2 * c][3]); t.z = cvt_pk_bf16(S[2 * c + 1][0], S[2 * c + 1][1]); t.w = cvt_pk_bf16(S[2 * c + 1][2], S[2 * c + 1][3]); Sb[c] = __builtin_bit_cast(bf16x8, t); } \
        _Pragma("unroll") for (int tt = 0; tt < 4; ++tt) { o[tt] = (f32x4){0.f, 0.f, 0.f, 0.f}; \
            _Pragma("unroll") for (int c = 0; c < 4; ++c) { const LAS unsigned char* qa = lds + (IB) + G3_QI + (16 * tt + vloc) * 272 + (32 * c + 4 * rq) * 2; \
                const u32x2 lo = *(const LAS u32x2*)qa, hi = *(const LAS u32x2*)(qa + 32); u32x4 t; t.x = lo.x; t.y = lo.y; t.z = hi.x; t.w = hi.y; \
                o[tt] = __builtin_amdgcn_mfma_f32_16x16x32_bf16(__builtin_bit_cast(bf16x8, t), Sb[c], o[tt], 0, 0, 0); } } \
        { const int tt = w >> 1; \
          _Pragma("unroll") for (int sh = 0; sh < 2; ++sh) { const int st = 2 * (w & 1) + sh; f32x4 pacc = (f32x4){0.f, 0.f, 0.f, 0.f}; \
              _Pragma("unroll") for (int c = 0; c < 4; ++c) { const bf16x8 ka = *(const LAS bf16x8*)(lds + (IB) + G3_KI + (16 * st + vloc) * 272 + (32 * c + 8 * rq) * 2); \
                  const bf16x8 qb = *(const LAS bf16x8*)(lds + (IB) + G3_QI + (16 * tt + vloc) * 272 + (32 * c + 8 * rq) * 2); \
                  pacc = __builtin_amdgcn_mfma_f32_16x16x32_bf16(ka, qb, pacc, 0, 0, 0); } \
              const int tg = 16 * tt + vloc, sg = 16 * st + 4 * rq; \
              u32x2 pw; pw.x = cvt_pk_bf16(sg + 0 <= tg ? pacc[0] : 0.f, sg + 1 <= tg ? pacc[1] : 0.f); pw.y = cvt_pk_bf16(sg + 2 <= tg ? pacc[2] : 0.f, sg + 3 <= tg ? pacc[3] : 0.f); \
              *(LAS u32x2*)(lds + G3_P + tg * 144 + sg * 2) = pw; } } } while (0)
#define G3_STAGE_D(IB, CI) do { bf16x8 vb[2]; \
        _Pragma("unroll") for (int c = 0; c < 2; ++c) vb[c] = *(const LAS bf16x8*)(lds + (IB) + G3_VT + (16 * w + vloc) * 144 + (32 * c + 8 * rq) * 2); \
        _Pragma("unroll") for (int tt = 0; tt < 4; ++tt) _Pragma("unroll") for (int c = 0; c < 2; ++c) { const bf16x8 pa = *(const LAS bf16x8*)(lds + G3_P + (16 * tt + vloc) * 144 + (32 * c + 8 * rq) * 2); o[tt] = __builtin_amdgcn_mfma_f32_16x16x32_bf16(pa, vb[c], o[tt], 0, 0, 0); } \
        _Pragma("unroll") for (int it = 0; it < 8; ++it) _Pragma("unroll") for (int c = 0; c < 2; ++c) { const bf16x8 ka = *(const LAS bf16x8*)(lds + (IB) + G3_KIT + (16 * it + vloc) * 144 + (32 * c + 8 * rq) * 2); S[it] = __builtin_amdgcn_mfma_f32_16x16x32_bf16(ka, vb[c], S[it], 0, 0, 0); } \
        _Pragma("unroll") for (int it = 0; it < 8; ++it) { const f32x4 et = *(const LAS f32x4*)(lds + (IB) + G3_ETOT + (16 * it + 4 * rq) * 4); S[it] = S[it] * et; } \
        { int b_, s_; chunk_rows(CI, b_, s_); \
          _Pragma("unroll") for (int tt = 0; tt < 4; ++tt) _Pragma("unroll") for (int j = 0; j < 4; ++j) { const int t = 16 * tt + 4 * rq + j; O[(size_t)(b_ + s_ * t) * 768 + h * 128 + 16 * w + vloc] = f2bf(o[tt][j]); } } } while (0)
    G3_LOADZ(0); G3_LOADQV(0);
#pragma unroll
    for (int it = 0; it < 8; ++it) S[it] = (f32x4){0.f, 0.f, 0.f, 0.f};
    for (int sl = 0; sl < nfold; ++sl) {
        const unsigned* kv = (const unsigned*)KV + ((size_t)(chain * GLA_SLOTS + sl) * 8 + w) * 16 * 64 + lane; const float* dc = DEC + (size_t)(chain * GLA_SLOTS + sl) * 128;
#pragma unroll
        for (int it = 0; it < 8; ++it) { const f32x4 d = *(const f32x4*)(dc + 16 * it + 4 * rq); const unsigned w0 = kv[(it * 2) * 64], w1 = kv[(it * 2 + 1) * 64];
            S[it][0] = d[0] * S[it][0] + bf_lo(w0); S[it][1] = d[1] * S[it][1] + bf_hi(w0); S[it][2] = d[2] * S[it][2] + bf_lo(w1); S[it][3] = d[3] * S[it][3] + bf_hi(w1); }
    }
    G3_STAGE_A();
    if (1 < nch) G3_LOADZ(1);
    __syncthreads();
    G3_STAGE_B(0);
    if (1 < nch) G3_LOADQV(1);
    __syncthreads();
    if (1 < nch) { G3_STAGE_A(); if (2 < nch) G3_LOADZ(2); }
    __syncthreads();
    for (int n = 0; n < nch; ++n) {
        const int ib = (n & 1) * G3_IMG, ib1 = ((n + 1) & 1) * G3_IMG;
        if (w < 4) { G3_STAGE_C(ib); G3_STAGE_B(ib1); } else { G3_STAGE_B(ib1); G3_STAGE_C(ib); }
        G3_LOADQV(n + 2 < nch ? n + 2 : nch - 1);
        __syncthreads();
        if (w < 4) { G3_STAGE_D(ib, n); G3_STAGE_A(); } else { G3_STAGE_A(); G3_STAGE_D(ib, n); }
        G3_LOADZ(n + 3 < nch ? n + 3 : nch - 1);
        __syncthreads();
    }
#undef G3_LOADZ
#undef G3_LOADQV
#undef G3_STAGE_A
#undef G3_STAGE_B
#undef G3_STAGE_C
#undef G3_STAGE_D
}
__device__ __forceinline__ void yb_rows(const Params& p, const int r0, const int nrows) {
    int tid = threadIdx.x; asm volatile("" : "+v"(tid));
    const int wid = tid >> 6, lane = tid & 63;
    const bf16_t* Of = (const bf16_t*)(p.out + DO_OF); const bf16_t* Ob = (const bf16_t*)(p.out + DO_OB); const bf16_t* Z = (const bf16_t*)(p.ws + OFF_Z); bf16_t* Yb = (bf16_t*)(p.ws + OFF_YB);
    const float gn0 = p.hg_norm_g[lane * 2], gn1 = p.hg_norm_g[lane * 2 + 1];
    for (int t = r0 + wid; t < r0 + nrows; t += 8) {
        unsigned a[6], bb[6], gw[6];
#pragma unroll
        for (int h = 0; h < 6; ++h) { const int col = h * 128 + lane * 2; a[h] = *(const unsigned*)(Of + (size_t)t * 768 + col); bb[h] = *(const unsigned*)(Ob + (size_t)t * 768 + col); gw[h] = *(const unsigned*)(Z + (size_t)t * ZC + ZGO + col); }
#pragma unroll
        for (int h = 0; h < 6; ++h) {
            const int col = h * 128 + lane * 2;
            const float o0 = bf_lo(a[h]) + bf_lo(bb[h]), o1 = bf_hi(a[h]) + bf_hi(bb[h]);
            const float ss = wave_sum(o0 * o0 + o1 * o1);
            const float rstd = rsqrtf(ss * (1.0f / 128.0f) + EPSF);
            *(unsigned*)(Yb + (size_t)t * 768 + col) = cvt_pk_bf16(o0 * rstd * gn0 * siluf_(bf_lo(gw[h])), o1 * rstd * gn1 * siluf_(bf_hi(gw[h])));
        }
    }
}

constexpr int RT_AHI = 0, RT_ALO = 66048, RT_LG = 132096, RT_ROW = 2064, RT_HIST = 144 * 1024 - 1024 + 256;
__device__ __forceinline__ void router_w_phase(const Params& p) {
    bf16_t* hi = (bf16_t*)(p.ws + OFF_WRT); bf16_t* lo = hi + 64 * 1024;
    for (int i = blockIdx.x * blockDim.x + threadIdx.x; i < 64 * 1024; i += gridDim.x * blockDim.x) { const int k = i >> 6, e = i & 63;
        const float w = p.w_router[i]; const bf16_t h = f2bf(w); hi[e * 1024 + k] = h; lo[e * 1024 + k] = f2bf(w - bf2f(h)); }
}
__device__ __forceinline__ void route_phase(const Params& p, LAS unsigned char* lds) {
    int tid = threadIdx.x; asm volatile("" : "+v"(tid));
    const int wid = __builtin_amdgcn_readfirstlane(tid >> 6), lane = tid & 63, vloc = lane & 15, rq = lane >> 4;
    LAS int* hist = (LAS int*)(lds + RT_HIST);
    const float* X1 = (const float*)(p.out + DO_X1); const float* mod = (const float*)(p.ws + OFF_MOD);
    const bf16_t* Whi = (const bf16_t*)(p.ws + OFF_WRT); const bf16_t* Wlo = Whi + 64 * 1024;
    unsigned char* H2 = p.ws + OFF_H2;
    int* eidx = (int*)(p.ws + OFF_EIDX); float* wts = (float*)(p.ws + OFF_WTS); int* lrank = (int*)(p.ws + OFF_APOS); int* lst = (int*)(p.ws + OFF_LIST);
    const int nb = (int)gridDim.x, TPB = (NTOK + nb - 1) / nb, tb0 = (int)blockIdx.x * TPB;
    if (blockIdx.x == 0) for (int i = tid; i < 256; i += 512) *(unsigned*)(H2 + (size_t)NTOK * 1024 + i * 4) = 0u;
    if (tid < 64) hist[tid] = 0;
    const float brl = p.b_router[lane];
    const int tm = wid >> 2, tn = wid & 3;
    const bool onebatch = (tb0 / SEQ) == ((tb0 + TPB - 1) / SEQ);
    f32x4 gq[4], shq[4], scq[4];
    { const float* mr = mod + (size_t)(tb0 / SEQ) * NIN;
#pragma unroll
      for (int j = 0; j < 4; ++j) { const int k = j * 256 + lane * 4; gq[j] = *(const f32x4*)(p.norm2_g + k); shq[j] = *(const f32x4*)(mr + 3072 + k); scq[j] = *(const f32x4*)(mr + 4096 + k); } }
    f32x4 vq[4][4];
    { const int t0 = tb0 + wid * 4;
#pragma unroll
      for (int q = 0; q < 4; ++q) { const int t = (t0 + q < NTOK) ? t0 + q : NTOK - 1;
#pragma unroll
          for (int j = 0; j < 4; ++j) vq[q][j] = *(const f32x4*)(X1 + (size_t)t * 1024 + j * 256 + lane * 4); } }
    for (int it = 0; it * 32 < TPB; ++it) {
        const int t0 = tb0 + it * 32 + wid * 4;
#pragma unroll
        for (int q = 0; q < 4; ++q) { const int t = t0 + q, row = wid * 4 + q;
            if (t < NTOK && t < tb0 + TPB) { const float* mr = mod + (size_t)(t / SEQ) * NIN;
                f32x4 v[4]; float ss = 0.f;
#pragma unroll
                for (int j = 0; j < 4; ++j) { v[j] = vq[q][j]; ss += v[j][0] * v[j][0] + v[j][1] * v[j][1] + v[j][2] * v[j][2] + v[j][3] * v[j][3]; }
                ss = wave_sum(ss); const float rstd = rsqrtf(ss * (1.0f / 1024.0f) + EPSF);
#pragma unroll
                for (int j = 0; j < 4; ++j) { const int k = j * 256 + lane * 4;
                    f32x4 g = gq[j], sh = shq[j], scv = scq[j];
                    if (!onebatch) { sh = *(const f32x4*)(mr + 3072 + k); scv = *(const f32x4*)(mr + 4096 + k); }
                    f32x4 o;
#pragma unroll
                    for (int e = 0; e < 4; ++e) o[e] = v[j][e] * rstd * g[e] * (1.0f + scv[e]) + sh[e];
                    u32x2 wh; wh.x = cvt_pk_bf16(o[0], o[1]); wh.y = cvt_pk_bf16(o[2], o[3]);
                    u32x2 wl; wl.x = cvt_pk_bf16(o[0] - bf_lo(wh.x), o[1] - bf_hi(wh.x)); wl.y = cvt_pk_bf16(o[2] - bf_lo(wh.y), o[3] - bf_hi(wh.y));
                    *(LAS u32x2*)(lds + RT_AHI + row * RT_ROW + k * 2) = wh; *(LAS u32x2*)(lds + RT_ALO + row * RT_ROW + k * 2) = wl;
                    *(unsigned*)(H2 + (size_t)t * 1024 + k) = pack_fp8x4(o[0], o[1], o[2], o[3]); } }
            else {
#pragma unroll
                for (int j = 0; j < 4; ++j) { const int k = j * 256 + lane * 4; *(LAS u32x2*)(lds + RT_AHI + row * RT_ROW + k * 2) = (u32x2){0u, 0u}; *(LAS u32x2*)(lds + RT_ALO + row * RT_ROW + k * 2) = (u32x2){0u, 0u}; } } }
        if ((it + 1) * 32 < TPB) { const int t1 = t0 + 32;
#pragma unroll
            for (int q = 0; q < 4; ++q) { const int t = (t1 + q < NTOK) ? t1 + q : NTOK - 1;
#pragma unroll
                for (int j = 0; j < 4; ++j) vq[q][j] = *(const f32x4*)(X1 + (size_t)t * 1024 + j * 256 + lane * 4); } }
        __syncthreads();
        { f32x4 acc = (f32x4){0.f, 0.f, 0.f, 0.f};
          const LAS unsigned char* ah_p = lds + RT_AHI + (16 * tm + vloc) * RT_ROW + rq * 16; const LAS unsigned char* al_p = lds + RT_ALO + (16 * tm + vloc) * RT_ROW + rq * 16;
          const bf16_t* bh_p = Whi + (size_t)(16 * tn + vloc) * 1024 + rq * 8; const bf16_t* bl_p = Wlo + (size_t)(16 * tn + vloc) * 1024 + rq * 8;
#pragma unroll 8
          for (int c = 0; c < 32; ++c) { const bf16x8 ah = *(const LAS bf16x8*)(ah_p + c * 64), al = *(const LAS bf16x8*)(al_p + c * 64);
              const bf16x8 bh = *(const bf16x8*)(bh_p + c * 32), bl = *(const bf16x8*)(bl_p + c * 32);
              acc = __builtin_amdgcn_mfma_f32_16x16x32_bf16(ah, bh, acc, 0, 0, 0); acc = __builtin_amdgcn_mfma_f32_16x16x32_bf16(al, bh, acc, 0, 0, 0); acc = __builtin_amdgcn_mfma_f32_16x16x32_bf16(ah, bl, acc, 0, 0, 0); }
          LAS float* lg = (LAS float*)(lds + RT_LG);
#pragma unroll
          for (int j = 0; j < 4; ++j) lg[(16 * tm + 4 * rq + j) * 64 + 16 * tn + vloc] = acc[j]; }
        __syncthreads();
#pragma unroll
        for (int q = 0; q < 4; ++q) { const int t = t0 + q; const float logit = ((const LAS float*)(lds + RT_LG))[(wid * 4 + q) * 64 + lane];
            if (t < NTOK && t < tb0 + TPB) {
                const float sc = 1.0f / (1.0f + __expf(-logit)), bs = sc + brl;
                float m1 = bs;
                m1 = fmaxf(m1, dpp_mov_<0xB1>(m1)); m1 = fmaxf(m1, dpp_mov_<0x4E>(m1)); m1 = fmaxf(m1, dpp_mov_<0x141>(m1));
                const unsigned long long ism = __ballot(bs == m1);
                const int gbase = lane & ~7; const unsigned gm = (unsigned)((ism >> gbase) & 0xffull);
                const int first = gbase + __builtin_ctz(gm);
                float m2 = (lane == first) ? -INFINITY : bs;
                m2 = fmaxf(m2, dpp_mov_<0xB1>(m2)); m2 = fmaxf(m2, dpp_mov_<0x4E>(m2)); m2 = fmaxf(m2, dpp_mov_<0x141>(m2));
                const float gs = m1 + m2; const int gid = lane >> 3;
                int grank = 0;
#pragma unroll
                for (int g2 = 0; g2 < 8; ++g2) { const float og = __int_as_float(__builtin_amdgcn_readlane(__float_as_int(gs), g2 * 8)); grank += (og > gs || (og == gs && g2 < gid)) ? 1 : 0; }
                const bool gok = grank < 4;
                const float mk = gok ? bs : -INFINITY;
                int rank = 0;
#pragma unroll
                for (int e2 = 0; e2 < 64; ++e2) { const float ov = __int_as_float(__builtin_amdgcn_readlane(__float_as_int(mk), e2)); rank += (ov > mk || (ov == mk && e2 < lane)) ? 1 : 0; }
                const bool sel = gok && rank < TOPK;
                const float wsum = wave_sum(sel ? sc : 0.f);
                if (sel) { const int lr = __hip_atomic_fetch_add(hist + lane, 1, __ATOMIC_RELAXED, __HIP_MEMORY_SCOPE_WORKGROUP);
                    eidx[t * 8 + rank] = lane; wts[t * 8 + rank] = sc / wsum * 2.5f; lrank[t * 8 + rank] = lr; lst[((size_t)blockIdx.x * 64 + lane) * 128 + lr] = t * 8 + rank; } } }
    }
    __syncthreads();
    if (tid < 64) ((int*)(p.ws + OFF_BCNT))[blockIdx.x * 64 + tid] = hist[tid];
    __syncthreads();
}

__device__ __forceinline__ void scatter_phase(const Params& p, LAS unsigned char* lds) {
    int tid = threadIdx.x; asm volatile("" : "+v"(tid));
    int* cnt = (int*)(p.ws + OFF_CNT); int* pstart = cnt + 128; int* nblk = cnt + 256; int* blk_e = (int*)(p.ws + OFF_BLKE);
    const int* bc = (const int*)(p.ws + OFF_BCNT);
    const int* eidx = (const int*)(p.ws + OFF_EIDX); int* apos = (int*)(p.ws + OFF_APOS); int* row_tok = (int*)(p.ws + OFF_ROWTOK);
    LAS int* tot = (LAS int*)lds; LAS int* ps = tot + 64; LAS int* ms = ps + 72;
    const int nb = (int)gridDim.x, bid = (int)blockIdx.x, TPB = (NTOK + nb - 1) / nb, tb0 = bid * TPB;
    LAS int* part = ms + 64;
    { const int e = tid & 63, pg = tid >> 6, per = (nb + 7) / 8; int t = 0, bl = 0;
#pragma unroll 8
      for (int wg = pg * per; wg < (pg + 1) * per; ++wg) if (wg < nb) { const int c = bc[wg * 64 + e]; if (wg < bid) bl += c; t += c; }
      part[(pg * 2 + 0) * 64 + e] = t; part[(pg * 2 + 1) * 64 + e] = bl; }
    __syncthreads();
    int below = 0;
    if (tid < 64) { int t = 0;
#pragma unroll
        for (int pg = 0; pg < 8; ++pg) { t += part[(pg * 2 + 0) * 64 + tid]; below += part[(pg * 2 + 1) * 64 + tid]; }
        tot[tid] = t; }
    __syncthreads();
    if (tid == 0) { int a = 0; for (int e = 0; e < 64; ++e) { ps[e] = a; a += (tot[e] + 255) / 256 * 256; } ps[64] = a; ps[65] = a + NTOK; }
    __syncthreads();
    if (tid < 64) ms[tid] = ps[tid] + below;
    __syncthreads();
    int* row_dst = (int*)(p.ws + OFF_ROWDST);
    for (int i = tid; i < TPB * 8; i += 512) { const int t = tb0 + (i >> 3); if (t < NTOK) { const int idx = t * 8 + (i & 7); const int e = eidx[idx]; const int pos = ms[e] + apos[idx]; row_tok[pos] = t; row_dst[pos] = idx; } }
    for (int e = bid; e < 64; e += nb) for (int j = tid; j < 256; j += 512) { const int pos = ps[e] + tot[e] + j; if (pos < ps[e + 1]) { row_tok[pos] = NTOK; row_dst[pos] = -1; } }
    for (int i = tid; i < TPB; i += 512) { const int t = tb0 + i; if (t < NTOK) row_tok[ps[64] + t] = t; }
    if (bid == 0) {
        if (tid < 66) pstart[tid] = ps[tid];
        if (tid == 0) *nblk = ps[65] / 256;
        for (int rb = tid; rb < ps[65] / 256; rb += 512) { int e = 0; while (e < 64 && rb * 256 >= ps[e + 1]) ++e; blk_e[rb] = e; }
    }
    __syncthreads();
}

__device__ __forceinline__ void combine_phase(const Params& p) {
    int tid = threadIdx.x; asm volatile("" : "+v"(tid));
    const int wid = tid >> 6, lane = tid & 63;
    const float* X1 = (const float*)(p.out + DO_X1); const float* mod = (const float*)(p.ws + OFF_MOD); const unsigned char* Y2 = (const unsigned char*)(p.ws + OFF_Y2);
    const unsigned char* Y2s = (const unsigned char*)(p.ws + OFF_Y2S);
    const float* wts = (const float*)(p.ws + OFF_WTS); float* out = (float*)p.out;
    f32x4 gf[4];
#pragma unroll
    for (int j = 0; j < 4; ++j) gf[j] = *(const f32x4*)(p.final_g + lane * 16 + 4 * j);
    const int stride = gridDim.x * 8;
    int t = blockIdx.x * 8 + wid;
    u32x4 yv[8]; float wk[8]; f32x4 xv[4]; u32x4 sv;
    if (t < NTOK) {
#pragma unroll
        for (int k = 0; k < TOPK; ++k) { wk[k] = wts[t * 8 + k]; yv[k] = *(const u32x4*)(Y2 + (size_t)(t * 8 + k) * 1024 + lane * 16); }
#pragma unroll
        for (int j = 0; j < 4; ++j) xv[j] = *(const f32x4*)(X1 + (size_t)t * 1024 + lane * 16 + 4 * j);
        sv = *(const u32x4*)(Y2s + (size_t)t * 1024 + lane * 16); }
    for (; t < NTOK; t += stride) {
        const float* g2 = mod + (size_t)(t / SEQ) * NIN + 5120 + lane * 16;
        f32x4 a[4];
#pragma unroll
        for (int j = 0; j < 4; ++j) { const int wd = (int)sv[j]; const f32x2 lo = __builtin_amdgcn_cvt_pk_f32_fp8(wd, false), hi = __builtin_amdgcn_cvt_pk_f32_fp8(wd, true); a[j] = (f32x4){lo.x, lo.y, hi.x, hi.y}; }
#pragma unroll
        for (int k = 0; k < TOPK; ++k) {
#pragma unroll
            for (int j = 0; j < 4; ++j) { const int wd = (int)yv[k][j]; const f32x2 lo = __builtin_amdgcn_cvt_pk_f32_fp8(wd, false), hi = __builtin_amdgcn_cvt_pk_f32_fp8(wd, true);
                a[j][0] += wk[k] * lo.x; a[j][1] += wk[k] * lo.y; a[j][2] += wk[k] * hi.x; a[j][3] += wk[k] * hi.y; } }
        f32x4 xo[4]; float ss = 0.f;
#pragma unroll
        for (int j = 0; j < 4; ++j) { const f32x4 gv = *(const f32x4*)(g2 + 4 * j); xo[j] = xv[j] + gv * a[j]; ss += xo[j][0] * xo[j][0] + xo[j][1] * xo[j][1] + xo[j][2] * xo[j][2] + xo[j][3] * xo[j][3]; }
        asm volatile("" : "+v"(xo[0]), "+v"(xo[1]), "+v"(xo[2]), "+v"(xo[3]));
        const int t2 = t + stride;
        if (t2 < NTOK) {
#pragma unroll
            for (int k = 0; k < TOPK; ++k) { wk[k] = wts[t2 * 8 + k]; yv[k] = *(const u32x4*)(Y2 + (size_t)(t2 * 8 + k) * 1024 + lane * 16); }
#pragma unroll
            for (int j = 0; j < 4; ++j) xv[j] = *(const f32x4*)(X1 + (size_t)t2 * 1024 + lane * 16 + 4 * j);
            sv = *(const u32x4*)(Y2s + (size_t)t2 * 1024 + lane * 16); }
        ss = wave_sum(ss); const float rstd = rsqrtf(ss * (1.0f / 1024.0f) + EPSF);
        float* op = out + (size_t)t * 1024 + lane * 16;
#pragma unroll
        for (int j = 0; j < 4; ++j) *(f32x4*)(op + 4 * j) = xo[j] * rstd * gf[j];
    }
}
constexpr int FUSED_LDS = 144 * 1024;
constexpr int PROBE_DUP = 0;
constexpr int PROBE_PHASE = -1;

template <int PA, int PB> __global__ __launch_bounds__(512, 2) void k_fwd(Params p) {
    extern __shared__ __attribute__((aligned(16))) unsigned char shm[];
    LAS unsigned char* lds = (LAS unsigned char*)shm;
    LAS unsigned* xbw = (LAS unsigned*)(lds + FUSED_LDS - 1024);
    if (threadIdx.x == 0) { xbw[0] = 0u; xbw[1] = 0u; xbw[2] = 0u; xbw[3] = 0u; }
    __syncthreads();
    XcdBarrier bar = xcd_barrier_post((unsigned*)(p.ws + OFF_BAR), (volatile LAS unsigned*)xbw);
    const int nb = (int)gridDim.x, bid = (int)blockIdx.x;
    unsigned long long t_start = 0, t_mark = 0, w_acc = 0; if constexpr (PROBE_PHASE >= 0) t_start = __builtin_amdgcn_s_memrealtime();
    const int* cnt = (const int*)(p.ws + OFF_CNT);
#define PH(k) if constexpr (PA <= (k) && (k) < PB)
#define BARRIER(k) if constexpr (PROBE_PHASE == 100) { if ((k) == 13 && threadIdx.x == 0) atomicAdd((unsigned long long*)(p.ws + OFF_PAIR), w_acc); const unsigned long long t_a = __builtin_amdgcn_s_memrealtime(); xcd_barrier(bar); w_acc += __builtin_amdgcn_s_memrealtime() - t_a; if ((k) == 13) t_mark = *(volatile unsigned long long*)(p.ws + OFF_PAIR) / gridDim.x; } else { if constexpr (PA <= (k) && (k) + 1 < PB) xcd_barrier(bar); if constexpr ((k) == PROBE_PHASE) t_mark = __builtin_amdgcn_s_memrealtime() - t_start; }
    PH(0) { if (bid == 0 && threadIdx.x < 128) ((int*)(p.ws + OFF_CNT))[threadIdx.x] = 0;
            ada_phase(p, lds); s5_tab1_phase(p); }
    BARRIER(0);
    PH(1) { cvt_dense_phase(p, lds); if constexpr (PROBE_DUP == 15) cvt_dense_phase(p, lds); norm1_phase(p); if constexpr (PROBE_DUP == 1) norm1_phase(p); s5_tab2_phase(p, bid, nb); router_w_phase(p); }
    BARRIER(1);
    PH(2) { PlainSched S; S.init(p.ws + OFF_H, 1024, p.ws + OFF_WINT, 1024, NROWS / 256, NIN / 256);
      EpiZ2 E{(bf16_t*)(p.ws + OFF_AEXT), (bf16_t*)(p.out + DO_UC), (bf16_t*)(p.ws + OFF_Z)};
      ge::gemm_phase<EpiZ2, PlainSched, false>(lds, 1024, 1024, 1024, S, E); }
    BARRIER(2);
    PH(3) { if (bid < 32) s5a_phase(p, lds, bid, 32);
            else for (int u = bid - 32; u < 48 * GLA_SLOTS; u += nb - 32) gla_pass1_unit(p, lds, u >> 4, u & 15);
            s5_wfill_phase(p, bid, nb); if constexpr (PROBE_DUP == 12) s5_wfill_phase(p, bid, nb); }
    BARRIER(3);
    PH(4) { if (nb == 256) {
                if (bid < 240) { const int chain = bid / 5, q = bid % 5; gla_unit<false>(p, lds, chain, 24 * q, 24, 3 * q + 1);
                    const int r = q * 48 + chain; if (r < 128) s5b_phase(p, lds, r, 128); }
                else for (int k = 0; k < 3; ++k) gla_unit<false>(p, lds, (bid - 240) * 3 + k, 120, 8, 16);
            } else {
                for (int u = bid; u < 48 * 6; u += nb) { const int chain = u / 6, q = u % 6; gla_unit<false>(p, lds, chain, 24 * q, q < 5 ? 24 : 8, 3 * q + 1); }
                s5b_phase(p, lds, bid, nb);
            } }
    BARRIER(4);
    PH(5) { for (int item = bid; item < (NTOK / 256) * 2; item += nb) { const int pm = item >> 1, half = item & 1;
                yb_rows(p, pm * 256, 256);
                { OneUnitSched S{(const char*)(p.ws + OFF_YS5), (const char*)(p.ws + OFF_GLUT), pm};
                  EpiYa E{(const bf16_t*)(p.ws + OFF_YS5), (bf16_t*)(p.ws + OFF_YA)};
                  ge::gemm_phase<EpiYa, OneUnitSched, false>(lds, 256, 256, 256, S, E); }
                { PanelMergeSched S{(const char*)(p.ws + OFF_YA), (const char*)(p.ws + OFF_YB), (const char*)(p.ws + OFF_PAT), (const char*)(p.ws + OFF_PBT), pm, 2 * half};
                  EpiMergeF<false> E{(const bf16_t*)(p.ws + OFF_Z), (bf16_t*)(p.ws + OFF_Z), ZC};
                  ge::gemm_phase_v<EpiMergeF<false>, PanelMergeSched>(lds, S, E); } } }
    BARRIER(5);
    PH(6) { }
    PH(7) { }
    PH(8) { if (bid & 1) cvt_moe_phase(p, lds);
      { PlainSched S; S.init(p.ws + OFF_Z, ZC, p.ws + OFF_WOUTT, 1024, NTOK / 256, 4);
        EpiX1<false> E{p.x, (const float*)(p.ws + OFF_MOD), (float*)(p.out + DO_X1)};
        ge::gemm_phase<EpiX1<false>, PlainSched, false>(lds, 1024, ZC, 1024, S, E); }
      if (!(bid & 1)) cvt_moe_phase(p, lds); }
    BARRIER(8);
    PH(9) { route_phase(p, lds); if constexpr (PROBE_DUP == 5) route_phase(p, lds); }
    BARRIER(9);
    PH(10) { }
    PH(11) { }
    PH(12) { moe_pull_prep(p, lds);
      MoeSched1P S{lds, (const char*)(p.ws + OFF_H2), (const char*)(p.ws + OFF_BT1)};
      EpiHid E{p.ws, p.out};
      ge::gemm_phase_f8<EpiHid, MoeSched1P, true>(lds, 512, 512, 512, S, E); }
    BARRIER(12);
    PH(13) { MoeSched2 S{(const int*)(p.ws + OFF_BLKE), cnt + 256, p.ws, p.out, (const char*)(p.ws + OFF_BT2), nb, bid};
      EpiY2 E{(unsigned char*)(p.ws + OFF_Y2), (unsigned char*)(p.ws + OFF_Y2S), cnt + 128, (const int*)(p.ws + OFF_ROWDST)};
      ge::gemm_phase_f8<EpiY2, MoeSched2, true>(lds, 128, 128, 128, S, E); }
    if constexpr (PROBE_DUP == 6) { MoeSched2R S{(const int*)(p.ws + OFF_BLKE), cnt + 128, p.ws, p.out, (const char*)(p.ws + OFF_BT2), nb, bid};
      EpiY2 E{(unsigned char*)(p.ws + OFF_Y2), (unsigned char*)(p.ws + OFF_Y2S), cnt + 128, (const int*)(p.ws + OFF_ROWDST)};
      ge::gemm_phase<EpiY2, MoeSched2R, false>(lds, 256, 256, 256, S, E); }
    if constexpr (PROBE_DUP == 7) { MoeSched2R S{(const int*)(p.ws + OFF_BLKE), cnt + 128, p.ws, p.out, (const char*)(p.ws + OFF_BT2), nb, bid};
      EpiNull E{(float*)(p.ws + OFF_BCNT)};
      ge::gemm_phase<EpiNull, MoeSched2R, false>(lds, 256, 256, 256, S, E); }
    BARRIER(13);
    PH(14) { combine_phase(p); if constexpr (PROBE_DUP == 3) combine_phase(p); if constexpr (PROBE_DUP == 4) { for (int r = 0; r < 10; ++r) xcd_barrier(bar); } }
#undef PH
#undef BARRIER
    if constexpr (PROBE_PHASE >= 0) { if (bid == 0 && threadIdx.x == 0) { const unsigned long long t0 = __builtin_amdgcn_s_memrealtime(); while (__builtin_amdgcn_s_memrealtime() - t0 < t_mark) __builtin_amdgcn_s_sleep(8); } }
}


static Params make_params(void* const* d_in, void* d_out, void* d_ws) {
    Params p{};
    const float** f = (const float**)&p;
    for (int i = 0; i < 32; ++i) f[i] = (const float*)d_in[i];
    p.ws = (unsigned char*)d_ws; p.out = (unsigned char*)d_out;
    return p;
}

extern "C" void kernel_launch(void* const* d_in, const int* in_sizes, int n_in, void* d_out, int out_size, void* d_ws, size_t ws_size, hipStream_t stream) {
    (void)in_sizes; (void)n_in; (void)out_size; (void)ws_size;
    static int grid = 0;
    if (!grid) {
        (void)hipFuncSetAttribute((const void*)k_fwd<0, 17>, hipFuncAttributeMaxDynamicSharedMemorySize, FUSED_LDS);
        int dev = 0, cus = 0, per_cu = 0;
        (void)hipGetDevice(&dev);
        (void)hipDeviceGetAttribute(&cus, hipDeviceAttributeMultiprocessorCount, dev);
        (void)hipOccupancyMaxActiveBlocksPerMultiprocessor(&per_cu, (const void*)k_fwd<0, 17>, 512, FUSED_LDS);
        if (per_cu < 1) { fprintf(stderr, "k_fwd: occupancy query says 0 blocks per CU\n"); per_cu = 1; }
        grid = cus;
    }
    const Params p = make_params(d_in, d_out, d_ws);
    (void)hipMemsetAsync((unsigned char*)d_ws + OFF_BAR, 0, XCD_BAR_WORDS * sizeof(unsigned), stream);
    if (PROBE_PHASE == 100) (void)hipMemsetAsync((unsigned char*)d_ws + OFF_PAIR, 0, 256, stream);
    hipLaunchKernelGGL((k_fwd<0, 17>), dim3(grid), dim3(512), FUSED_LDS, stream, p);
}
```

```cpp
#include <hip/hip_runtime.h>
#include <stdint.h>
#include <stdio.h>

#define LAS __attribute__((address_space(3)))
typedef unsigned short bf16_t;
typedef short bf16x8 __attribute__((ext_vector_type(8)));
typedef float f32x4 __attribute__((ext_vector_type(4)));
typedef float f32x2 __attribute__((ext_vector_type(2)));
typedef unsigned u32x4 __attribute__((ext_vector_type(4)));
typedef unsigned u32x2 __attribute__((ext_vector_type(2)));

constexpr int NB = 4, SEQ = 8192, DM = 1024, NTOK = NB * SEQ, CTXL = 256, NCTX = NB * CTXL, NROWS = NTOK + NCTX;
constexpr int NIN = 6144, ZC = 5888;
constexpr int ZQ = 0, ZFF = 768, ZFB = 1536, ZI = 2304, ZGO = 3072, ZGA = 3840, ZGB = 4864;
constexpr int NEXP = 64, TOPK = 8, EH = 256;
constexpr int CAP_ROUTED = NTOK * TOPK + NEXP * 256;
constexpr int CAP_ROWS = CAP_ROUTED + NTOK;
constexpr int HID1_RB = 1024;
constexpr float EPSF = 1e-6f;

__device__ __forceinline__ unsigned cvt_pk_bf16(float lo, float hi) { unsigned r; asm volatile("v_cvt_pk_bf16_f32 %0, %1, %2" : "=v"(r) : "v"(lo), "v"(hi)); return r; }
__device__ __forceinline__ float bf_lo(unsigned w) { return __uint_as_float(w << 16); }
__device__ __forceinline__ float bf_hi(unsigned w) { return __uint_as_float(w & 0xffff0000u); }
__device__ __forceinline__ float bf2f(bf16_t b) { return __uint_as_float(((unsigned)b) << 16); }
__device__ __forceinline__ bf16_t f2bf(float f) { return (bf16_t)(cvt_pk_bf16(f, 0.f) & 0xffffu); }
__device__ __forceinline__ float frcp_(float x) { return __builtin_amdgcn_rcpf(x); }
__device__ __forceinline__ float sigmoidf_(float x) { return frcp_(1.0f + __expf(-x)); }
__device__ __forceinline__ float siluf_(float x) { return x * frcp_(1.0f + __expf(-x)); }
template <int CTRL> __device__ __forceinline__ float dpp_mov_(float v) { return __int_as_float(__builtin_amdgcn_update_dpp(0, __float_as_int(v), CTRL, 0xf, 0xf, true)); }
__device__ __forceinline__ float wave_sum(float v) {
    v += dpp_mov_<0xB1>(v); v += dpp_mov_<0x4E>(v); v += dpp_mov_<0x141>(v); v += dpp_mov_<0x140>(v);
    const float a = __int_as_float(__builtin_amdgcn_readlane(__float_as_int(v), 0)), b = __int_as_float(__builtin_amdgcn_readlane(__float_as_int(v), 16));
    const float c = __int_as_float(__builtin_amdgcn_readlane(__float_as_int(v), 32)), d = __int_as_float(__builtin_amdgcn_readlane(__float_as_int(v), 48));
    return (a + b) + (c + d);
}
__device__ __forceinline__ float gelu_tanh(float y) {
    const float u = 0.7978845608028654f * (y + 0.044715f * y * y * y);
    const float e = __expf(2.0f * u);
    const float t = 1.0f - 2.0f * frcp_(e + 1.0f);
    return 0.5f * y * (1.0f + t);
}
#define XB_TMO      128
#define XB_XCNT(j)  (256  + 64 * (j))
#define XB_XSUB(j)  (1280 + 64 * (j))
#define XB_XGEN(j)  (2304 + 64 * (j))
#define XB_TOP      3328
#define XB_TOPGEN   3392
#define XCD_BAR_WORDS 3456
#define XB_SPIN_CAP (1u << 18)

__device__ __forceinline__ unsigned xb_ld(unsigned* p)              { return __hip_atomic_load(p, __ATOMIC_RELAXED, __HIP_MEMORY_SCOPE_AGENT); }
__device__ __forceinline__ unsigned xb_add(unsigned* p, unsigned v) { return __hip_atomic_fetch_add(p, v, __ATOMIC_RELAXED, __HIP_MEMORY_SCOPE_AGENT); }
__device__ __forceinline__ unsigned xb_xcc_id() { return (unsigned)__builtin_amdgcn_s_getreg((3 << 11) | 20) & 0xFu; }
#define XB_SPIN(cond, bar) do { unsigned _sp = 0; while (cond) { __builtin_amdgcn_s_sleep(1); \
    if ((++_sp & 255u) == 0u) { if (xb_ld(&(bar)[XB_TMO])) break; if (_sp > XB_SPIN_CAP) { atomicAdd(&(bar)[XB_TMO], 1u); break; } } } } while (0)

struct XcdBarrier {
    unsigned* bar; unsigned x;
    volatile LAS unsigned* st;
};

__device__ __forceinline__ XcdBarrier xcd_barrier_post(unsigned* bar, volatile LAS unsigned* st) {
    XcdBarrier b; b.bar = bar; b.x = xb_xcc_id(); b.st = st;
    if (threadIdx.x == 0) (void)xb_add(&bar[XB_XCNT(b.x)], 1u);
    return b;
}
__device__ __forceinline__ void xcd_barrier_complete(unsigned* bar, unsigned x, unsigned& nloc, unsigned& nx) {
    const unsigned G = gridDim.x * gridDim.y * gridDim.z;
    unsigned sum, cnt, mine, sp = 0u;
    for (;;) {
        sum = 0u; cnt = 0u; mine = 0u;
#pragma unroll
        for (unsigned j = 0; j < 16; ++j) { const unsigned c = xb_ld(&bar[XB_XCNT(j)]); sum += c; cnt += (c > 0u) ? 1u : 0u; mine = (j == x) ? c : mine; }
        if (sum == G) break;
        __builtin_amdgcn_s_sleep(1);
        if ((++sp & 255u) == 0u) { if (xb_ld(&bar[XB_TMO])) break; if (sp > XB_SPIN_CAP) { atomicAdd(&bar[XB_TMO], 1u); break; } }
    }
    nloc = mine > 0u ? mine : 1u; nx = cnt > 0u ? cnt : 1u;
}

__device__ __forceinline__ void xcd_barrier(const XcdBarrier& b) {
    asm volatile("s_waitcnt vmcnt(0)" ::: "memory");
    __syncthreads();
    if (threadIdx.x == 0) {
        unsigned* bar = b.bar;
        __builtin_amdgcn_s_waitcnt(0);
        unsigned nloc = b.st[0], nx = b.st[1];
        if (nloc == 0u) { xcd_barrier_complete(bar, b.x, nloc, nx); b.st[0] = nloc; b.st[1] = nx; }
        const unsigned old = xb_add(&bar[XB_XSUB(b.x)], 1u);
        const unsigned gen = old / nloc;
        if (old + 1u == (gen + 1u) * nloc) {
            __builtin_amdgcn_fence(__ATOMIC_RELEASE, "agent");
            asm volatile("s_waitcnt vmcnt(0)" ::: "memory");
            const unsigned og = xb_add(&bar[XB_TOP], 1u);
            const unsigned tg = og / nx;
            if (og + 1u == (tg + 1u) * nx) xb_add(&bar[XB_TOPGEN], 1u);
            else XB_SPIN(xb_ld(&bar[XB_TOPGEN]) == tg, bar);
            __builtin_amdgcn_fence(__ATOMIC_ACQUIRE, "agent");
            xb_add(&bar[XB_XGEN(b.x)], 1u);
            asm volatile("s_waitcnt vmcnt(0)" ::: "memory");
        } else {
            XB_SPIN(xb_ld(&bar[XB_XGEN(b.x)]) == gen, bar);
            __builtin_amdgcn_fence(__ATOMIC_ACQUIRE, "agent");
            asm volatile("s_waitcnt vmcnt(0)" ::: "memory");
        }
    }
    __syncthreads();
}

namespace ge {
typedef int i32x4 __attribute__((ext_vector_type(4)));
typedef int i32x8 __attribute__((ext_vector_type(8)));
constexpr int BM = 256, BK = 64, HALF = 128, HTB = HALF * BK * 2, STAGE_BYTES = 8 * HTB, NXCD = 8, WGM = 8;
__host__ __device__ __forceinline__ int lds_byte(int r, int c) { const int st = (r >> 4) * 2 + (c >> 5), rr = r & 15, cc = c & 31, ob = rr * 64 + cc * 2; return st * 1024 + (ob ^ (((ob >> 9) & 1) << 5)); }
__host__ __device__ __forceinline__ void stage_rc(int b, int& R, int& C) { const int st = b / 1024, sb = b % 1024, swz = sb ^ (((sb >> 9) & 1) << 5); R = (st >> 1) * 16 + swz / 64; C = (st & 1) * 32 + (swz % 64) / 2; }
__host__ __device__ __forceinline__ int perm32(int rho) { const int n = rho >> 4, i = rho & 15; return 8 * (i >> 2) + 4 * n + (i & 3); }

struct Unit { int pm, pn, e, k; };

struct GridOrder {
    int nM, nN, nwg, G, c;
    __device__ void init(int nM_, int nN_, int G_, int c_) { nM = nM_; nN = nN_; nwg = nM * nN; G = G_; c = c_; }
    __device__ bool tile(int i, int& pm, int& pn) const {
        const long L = (long)i * G + c; if (L >= nwg) return false;
        int wgid = (int)L; { const int q = nwg / NXCD, r = nwg % NXCD, xcd = wgid % NXCD, off = wgid / NXCD; wgid = (xcd < r ? xcd * (q + 1) : r * (q + 1) + (xcd - r) * q) + off; }
        const int nig = WGM * nN, gid = wgid / nig, fm = gid * WGM, gsz = (nM - fm) < WGM ? (nM - fm) : WGM;
        pm = fm + ((wgid % nig) % gsz); pn = (wgid % nig) / gsz; return true;
    }
};

template <class Epi, class Sched, bool GATHER>
__device__ __forceinline__ void gemm_phase(LAS unsigned char* lds, const int K, const int lda, const int ldb, const Sched& S, const Epi& E) {
    int tid = threadIdx.x; asm volatile("" : "+v"(tid));
    const int wid = __builtin_amdgcn_readfirstlane(tid >> 6), lane = tid & 63, wr = wid >> 2, wc = wid & 3, fr = lane & 15, fq = lane >> 4;
    const int nt = K / BK;
    int Rr[2], Cc[2]; unsigned voffB[2];
#pragma unroll
    for (int i = 0; i < 2; ++i) { int R, C; stage_rc(tid * 16 + i * 8192, R, C); Rr[i] = R; Cc[i] = C; const int Rb = Epi::PERM ? ((R & ~31) + perm32(R & 31)) : R; voffB[i] = (unsigned)(Rb * ldb + C) * 2u; }
    const size_t kstep = (size_t)(BK * 2);
    const size_t hstepB = (size_t)HALF * ldb * 2;
    const unsigned ldsw = (unsigned)wid * 1024u;
    const int aoff = lds_byte(wr * 64 + fr, fq * 8), boff = lds_byte(wc * 32 + fr, fq * 8);
#define GE_SA(b, h) (((b) * 2 + (h)) * HTB)
#define GE_SB(b, h) ((4 + (b) * 2 + (h)) * HTB)
#define GE_STAGE(bufoff, gbase, v0, v1) do { \
        __builtin_amdgcn_global_load_lds((const unsigned*)((const char*)(gbase) + (v0)), (LAS unsigned*)(lds + (bufoff) + ldsw), 16, 0, 0); \
        __builtin_amdgcn_global_load_lds((const unsigned*)((const char*)(gbase) + (v1)), (LAS unsigned*)(lds + (bufoff) + ldsw + 8192), 16, 0, 0); } while (0)
#define GE_STAGE_B(bufoff, gbase) GE_STAGE(bufoff, gbase, voffB[0], voffB[1])
#define GE_LDA(dst, b, h) do { _Pragma("unroll") for (int m = 0; m < 4; ++m) _Pragma("unroll") for (int k = 0; k < 2; ++k) dst[m][k] = *(const LAS bf16x8*)(lds + GE_SA(b, h) + aoff + m * 2048 + k * 1024); } while (0)
#define GE_LDB(dst, b, h) do { _Pragma("unroll") for (int n = 0; n < 2; ++n) _Pragma("unroll") for (int k = 0; k < 2; ++k) dst[n][k] = *(const LAS bf16x8*)(lds + GE_SB(b, h) + boff + n * 2048 + k * 1024); } while (0)
#define GE_MMA(ai, bj, At, Bt) do { __builtin_amdgcn_s_setprio(1); _Pragma("unroll") for (int m = 0; m < 4; ++m) _Pragma("unroll") for (int n = 0; n < 2; ++n) _Pragma("unroll") for (int k = 0; k < 2; ++k) \
        acc[ai][bj][m][n] = __builtin_amdgcn_mfma_f32_16x16x32_bf16(Bt[n][k], At[m][k], acc[ai][bj][m][n], 0, 0, 0); __builtin_amdgcn_s_setprio(0); } while (0)
#define GE_WAIT_V(n) asm volatile("s_waitcnt vmcnt(" #n ")" ::: "memory")
#define GE_WAIT_L(n) asm volatile("s_waitcnt lgkmcnt(" #n ")" ::: "memory")
#define GE_BAR __builtin_amdgcn_s_barrier()
#define GE_SCHED __builtin_amdgcn_sched_barrier(0)
    Unit cur, nxt, nn; int ui = 0;
    if (!S.next(0, cur)) return;
    bool has_next = S.next(1, nxt);
    unsigned c00, c01, c10, c11, n00, n01, n10, n11; int rn0 = 0, rn1 = 0, rn2 = 0, rn3 = 0, rq0 = 0, rq1 = 0, rq2 = 0, rq3 = 0;
    if constexpr (GATHER) {
        c00 = (unsigned)(S.a_row(cur, Rr[0]) * lda + Cc[0]) * 2u; c01 = (unsigned)(S.a_row(cur, Rr[1]) * lda + Cc[1]) * 2u;
        c10 = (unsigned)(S.a_row(cur, HALF + Rr[0]) * lda + Cc[0]) * 2u; c11 = (unsigned)(S.a_row(cur, HALF + Rr[1]) * lda + Cc[1]) * 2u;
        if (has_next) { rn0 = S.a_row(nxt, Rr[0]); rn1 = S.a_row(nxt, Rr[1]); rn2 = S.a_row(nxt, HALF + Rr[0]); rn3 = S.a_row(nxt, HALF + Rr[1]); }
    } else {
        c00 = (unsigned)(Rr[0] * lda + Cc[0]) * 2u; c01 = (unsigned)(Rr[1] * lda + Cc[1]) * 2u;
        c10 = c00 + (unsigned)(HALF * lda * 2); c11 = c01 + (unsigned)(HALF * lda * 2);
    }
    n00 = c00; n01 = c01; n10 = c10; n11 = c11;
    f32x4 acc[2][2][4][2];
#pragma unroll
    for (int a = 0; a < 2; ++a)
#pragma unroll
        for (int b = 0; b < 2; ++b)
#pragma unroll
            for (int m = 0; m < 4; ++m)
#pragma unroll
                for (int n = 0; n < 2; ++n) acc[a][b][m][n] = (f32x4){0.f, 0.f, 0.f, 0.f};
    bf16x8 At[4][2], B0[2][2], B1[2][2];
    const char* cA = S.a_base(cur); const char* cB = S.b_base(cur);
    GE_STAGE_B(GE_SB(0, 0), cB); GE_STAGE(GE_SA(0, 0), cA, c00, c01); GE_STAGE_B(GE_SB(0, 1), cB + hstepB); GE_STAGE(GE_SA(0, 1), cA, c10, c11);
    if (wr == 1) GE_BAR;
    GE_WAIT_V(4); GE_BAR;
    GE_STAGE_B(GE_SB(1, 0), cB + kstep); GE_STAGE(GE_SA(1, 0), cA + kstep, c00, c01); GE_STAGE_B(GE_SB(1, 1), cB + hstepB + kstep);
    GE_WAIT_V(6); GE_BAR;
    for (;;) {
        const bool has_nn = has_next ? S.next(ui + 2, nn) : false;
        const char* nA = has_next ? S.a_base(nxt) : cA; const char* nB = has_next ? S.b_base(nxt) : cB;
        if constexpr (GATHER) {
            if (has_next) { n00 = (unsigned)(rn0 * lda + Cc[0]) * 2u; n01 = (unsigned)(rn1 * lda + Cc[1]) * 2u; n10 = (unsigned)(rn2 * lda + Cc[0]) * 2u; n11 = (unsigned)(rn3 * lda + Cc[1]) * 2u; }
            else { n00 = c00; n01 = c01; n10 = c10; n11 = c11; }
            if (has_nn) { rq0 = S.a_row(nn, Rr[0]); rq1 = S.a_row(nn, Rr[1]); rq2 = S.a_row(nn, HALF + Rr[0]); rq3 = S.a_row(nn, HALF + Rr[1]); }
        }
#pragma unroll 1
        for (int t = 0; t < nt; t += 2) {
            const bool last = (t == nt - 2);
            const char* a1 = cA + (size_t)(t + 1) * kstep;
            const char* a2 = last ? nA : cA + (size_t)(t + 2) * kstep; const char* b2 = last ? nB : cB + (size_t)(t + 2) * kstep;
            const char* a3 = a2 + kstep; const char* b3 = b2 + kstep;
            unsigned x00 = c00, x01 = c01, x10 = c10, x11 = c11;
            if constexpr (GATHER) { if (last) { x00 = n00; x01 = n01; x10 = n10; x11 = n11; } }
            GE_LDB(B0, 0, 0); GE_SCHED; GE_LDA(At, 0, 0); GE_STAGE(GE_SA(1, 1), a1, c10, c11);
            GE_WAIT_L(8); GE_BAR; GE_WAIT_L(0); GE_MMA(0, 0, At, B0); GE_BAR; GE_SCHED;
            GE_LDB(B1, 0, 1); GE_STAGE_B(GE_SB(0, 0), b2);
            GE_BAR; GE_WAIT_L(0); GE_MMA(0, 1, At, B1); GE_BAR;
            GE_LDA(At, 0, 1); GE_STAGE(GE_SA(0, 0), a2, x00, x01);
            GE_BAR; GE_WAIT_L(0); GE_MMA(1, 0, At, B0); GE_BAR; GE_SCHED;
            GE_STAGE_B(GE_SB(0, 1), b2 + hstepB);
            GE_WAIT_V(6); GE_BAR; GE_MMA(1, 1, At, B1); GE_BAR;
            GE_LDB(B0, 1, 0); GE_SCHED; GE_LDA(At, 1, 0); GE_STAGE(GE_SA(0, 1), a2, x10, x11);
            GE_WAIT_L(8); GE_BAR; GE_WAIT_L(0); GE_MMA(0, 0, At, B0); GE_BAR; GE_SCHED;
            GE_LDB(B1, 1, 1); GE_STAGE_B(GE_SB(1, 0), b3);
            GE_BAR; GE_WAIT_L(0); GE_MMA(0, 1, At, B1); GE_BAR;
            GE_LDA(At, 1, 1); GE_STAGE(GE_SA(1, 0), a3, x00, x01);
            GE_BAR; GE_WAIT_L(0); GE_MMA(1, 0, At, B0); GE_BAR; GE_SCHED;
            GE_STAGE_B(GE_SB(1, 1), b3 + hstepB);
            GE_WAIT_V(6); GE_BAR; GE_MMA(1, 1, At, B1); GE_BAR;
        }
        E(acc, cur, wr, wc, fr, fq);
        if (!has_next) break;
#pragma unroll
        for (int a = 0; a < 2; ++a)
#pragma unroll
            for (int b = 0; b < 2; ++b)
#pragma unroll
                for (int m = 0; m < 4; ++m)
#pragma unroll
                    for (int n = 0; n < 2; ++n) acc[a][b][m][n] = (f32x4){0.f, 0.f, 0.f, 0.f};
        cur = nxt; nxt = nn; has_next = has_nn; cA = nA; cB = nB; ++ui;
        if constexpr (GATHER) { c00 = n00; c01 = n01; c10 = n10; c11 = n11; rn0 = rq0; rn1 = rq1; rn2 = rq2; rn3 = rq3; }
    }
    GE_WAIT_V(0);
    if (wr == 0) GE_BAR;
    GE_BAR;
#undef GE_SA
#undef GE_SB
#undef GE_STAGE
#undef GE_STAGE_B
#undef GE_LDA
#undef GE_LDB
#undef GE_MMA
#undef GE_WAIT_V
#undef GE_WAIT_L
#undef GE_BAR
#undef GE_SCHED
}

template <class Epi, class Sched, bool GATHER>
__device__ __forceinline__ void gemm_phase_f8(LAS unsigned char* lds, const int K, const int lda, const int ldb, const Sched& S, const Epi& E) {
    int tid = threadIdx.x; asm volatile("" : "+v"(tid));
    const int wid = __builtin_amdgcn_readfirstlane(tid >> 6), lane = tid & 63, wr = wid >> 2, wc = wid & 3, fr = lane & 15, fq = lane >> 4;
    const int nt = K / BK;
    const size_t kstep = (size_t)(BK * 2);
    const size_t hstepB = (size_t)HALF * ldb * 2;
    const unsigned ldsw = (unsigned)wid * 1024u;
    const int aoff = lds_byte(wr * 64 + fr, fq * 8), boff = lds_byte(wc * 32 + fr, fq * 8);
#define GE_SA(b, h) (((b) * 2 + (h)) * HTB)
#define GE_SB(b, h) ((4 + (b) * 2 + (h)) * HTB)
#define GE_STAGE(bufoff, gbase, v0, v1) do { \
        __builtin_amdgcn_global_load_lds((const unsigned*)((const char*)(gbase) + (v0)), (LAS unsigned*)(lds + (bufoff) + ldsw), 16, 0, 0); \
        __builtin_amdgcn_global_load_lds((const unsigned*)((const char*)(gbase) + (v1)), (LAS unsigned*)(lds + (bufoff) + ldsw + 8192), 16, 0, 0); } while (0)
#define GE_RC() int t2_ = tid; asm volatile("" : "+v"(t2_)); int R0_, C0_, R1_, C1_; stage_rc(t2_ * 16, R0_, C0_); stage_rc(t2_ * 16 + 8192, R1_, C1_)
#define GE_STAGE_B(bufoff, gbase) do { GE_RC(); const int Rb0_ = Epi::PERM ? ((R0_ & ~31) + perm32(R0_ & 31)) : R0_, Rb1_ = Epi::PERM ? ((R1_ & ~31) + perm32(R1_ & 31)) : R1_; \
        GE_STAGE(bufoff, gbase, (unsigned)(Rb0_ * ldb + C0_) * 2u, (unsigned)(Rb1_ * ldb + C1_) * 2u); } while (0)
#define GE_LDA(dst, b, h) do { _Pragma("unroll") for (int m = 0; m < 4; ++m) { const i32x4 lo_ = *(const LAS i32x4*)(lds + GE_SA(b, h) + aoff + m * 2048), hi_ = *(const LAS i32x4*)(lds + GE_SA(b, h) + aoff + m * 2048 + 1024); dst[m] = __builtin_shufflevector(lo_, hi_, 0, 1, 2, 3, 4, 5, 6, 7); } } while (0)
#define GE_LDB(dst, b, h) do { _Pragma("unroll") for (int n = 0; n < 2; ++n) { const i32x4 lo_ = *(const LAS i32x4*)(lds + GE_SB(b, h) + boff + n * 2048), hi_ = *(const LAS i32x4*)(lds + GE_SB(b, h) + boff + n * 2048 + 1024); dst[n] = __builtin_shufflevector(lo_, hi_, 0, 1, 2, 3, 4, 5, 6, 7); } } while (0)
#define GE_MMA(ai, bj, At, Bt) do { __builtin_amdgcn_s_setprio(1); _Pragma("unroll") for (int m = 0; m < 4; ++m) _Pragma("unroll") for (int n = 0; n < 2; ++n) \
        acc[ai][bj][m][n] = __builtin_amdgcn_mfma_scale_f32_16x16x128_f8f6f4(Bt[n], At[m], acc[ai][bj][m][n], 0, 0, 0, 0x7a7a7a7a, 0, 0x7f7f7f7f); __builtin_amdgcn_s_setprio(0); } while (0)
#define GE_WAIT_V(n) asm volatile("s_waitcnt vmcnt(" #n ")" ::: "memory")
#define GE_WAIT_L(n) asm volatile("s_waitcnt lgkmcnt(" #n ")" ::: "memory")
#define GE_BAR __builtin_amdgcn_s_barrier()
#define GE_SCHED __builtin_amdgcn_sched_barrier(0)
    Unit cur, nxt, nn; int ui = 0;
    if (!S.next(0, cur)) return;
    bool has_next = S.next(1, nxt);
#define GE_STG(bufoff, gbase, u_, h) do { GE_RC(); GE_STAGE(bufoff, gbase, (unsigned)(S.a_row(u_, (h) * HALF + R0_) * lda + C0_) * 2u, (unsigned)(S.a_row(u_, (h) * HALF + R1_) * lda + C1_) * 2u); } while (0)
    f32x4 acc[2][2][4][2];
#pragma unroll
    for (int a = 0; a < 2; ++a)
#pragma unroll
        for (int b = 0; b < 2; ++b)
#pragma unroll
            for (int m = 0; m < 4; ++m)
#pragma unroll
                for (int n = 0; n < 2; ++n) acc[a][b][m][n] = (f32x4){0.f, 0.f, 0.f, 0.f};
    i32x8 At[4], B0[2], B1[2];
    const char* cA = S.a_base(cur); const char* cB = S.b_base(cur);
    GE_STAGE_B(GE_SB(0, 0), cB); GE_STG(GE_SA(0, 0), cA, cur, 0); GE_STAGE_B(GE_SB(0, 1), cB + hstepB); GE_STG(GE_SA(0, 1), cA, cur, 1);
    if (wr == 1) GE_BAR;
    GE_WAIT_V(4); GE_BAR;
    GE_STAGE_B(GE_SB(1, 0), cB + kstep); GE_STG(GE_SA(1, 0), cA + kstep, cur, 0); GE_STAGE_B(GE_SB(1, 1), cB + hstepB + kstep);
    GE_WAIT_V(6); GE_BAR;
    for (;;) {
        const bool has_nn = has_next ? S.next(ui + 2, nn) : false;
        const char* nA = has_next ? S.a_base(nxt) : cA; const char* nB = has_next ? S.b_base(nxt) : cB;
#pragma unroll 1
        for (int t = 0; t < nt; t += 2) {
            const bool last = (t == nt - 2);
            const char* a1 = cA + (size_t)(t + 1) * kstep;
            const char* a2 = last ? nA : cA + (size_t)(t + 2) * kstep; const char* b2 = last ? nB : cB + (size_t)(t + 2) * kstep;
            const char* a3 = a2 + kstep; const char* b3 = b2 + kstep;
            Unit xu = cur; if (last && has_next) xu = nxt;
            GE_LDB(B0, 0, 0); GE_SCHED; GE_LDA(At, 0, 0); GE_STG(GE_SA(1, 1), a1, cur, 1);
            GE_WAIT_L(8); GE_BAR; GE_WAIT_L(0); GE_MMA(0, 0, At, B0); GE_BAR; GE_SCHED;
            GE_LDB(B1, 0, 1); GE_STAGE_B(GE_SB(0, 0), b2);
            GE_BAR; GE_WAIT_L(0); GE_MMA(0, 1, At, B1); GE_BAR;
            GE_LDA(At, 0, 1); GE_STG(GE_SA(0, 0), a2, xu, 0);
            GE_BAR; GE_WAIT_L(0); GE_MMA(1, 0, At, B0); GE_BAR; GE_SCHED;
            GE_STAGE_B(GE_SB(0, 1), b2 + hstepB);
            GE_WAIT_V(6); GE_BAR; GE_MMA(1, 1, At, B1); GE_BAR;
            GE_LDB(B0, 1, 0); GE_SCHED; GE_LDA(At, 1, 0); GE_STG(GE_SA(0, 1), a2, xu, 1);
            GE_WAIT_L(8); GE_BAR; GE_WAIT_L(0); GE_MMA(0, 0, At, B0); GE_BAR; GE_SCHED;
            GE_LDB(B1, 1, 1); GE_STAGE_B(GE_SB(1, 0), b3);
            GE_BAR; GE_WAIT_L(0); GE_MMA(0, 1, At, B1); GE_BAR;
            GE_LDA(At, 1, 1); GE_STG(GE_SA(1, 0), a3, xu, 0);
            GE_BAR; GE_WAIT_L(0); GE_MMA(1, 0, At, B0); GE_BAR; GE_SCHED;
            GE_STAGE_B(GE_SB(1, 1), b3 + hstepB);
            GE_WAIT_V(6); GE_BAR; GE_MMA(1, 1, At, B1); GE_BAR;
        }
        E(acc, cur, wr, wc, fr, fq);
        if (!has_next) break;
#pragma unroll
        for (int a = 0; a < 2; ++a)
#pragma unroll
            for (int b = 0; b < 2; ++b)
#pragma unroll
                for (int m = 0; m < 4; ++m)
#pragma unroll
                    for (int n = 0; n < 2; ++n) acc[a][b][m][n] = (f32x4){0.f, 0.f, 0.f, 0.f};
        cur = nxt; nxt = nn; has_next = has_nn; cA = nA; cB = nB; ++ui;
    }
    GE_WAIT_V(0);
    if (wr == 0) GE_BAR;
    GE_BAR;
#undef GE_SA
#undef GE_SB
#undef GE_STAGE
#undef GE_STAGE_B
#undef GE_STG
#undef GE_RC
#undef GE_LDA
#undef GE_LDB
#undef GE_MMA
#undef GE_WAIT_V
#undef GE_WAIT_L
#undef GE_BAR
#undef GE_SCHED
}

template <class Epi, class Sched>
__device__ __forceinline__ void gemm_phase_v(LAS unsigned char* lds, const Sched& S, const Epi& E) {
    int tid = threadIdx.x; asm volatile("" : "+v"(tid));
    const int wid = __builtin_amdgcn_readfirstlane(tid >> 6), lane = tid & 63, wr = wid >> 2, wc = wid & 3, fr = lane & 15, fq = lane >> 4;
    int Rr[2], Rbb[2]; unsigned C2[2];
#pragma unroll
    for (int i = 0; i < 2; ++i) { int R, C; stage_rc(tid * 16 + i * 8192, R, C); Rr[i] = R; C2[i] = (unsigned)C * 2u; Rbb[i] = Epi::PERM ? ((R & ~31) + perm32(R & 31)) : R; }
    const size_t kstep = (size_t)(BK * 2);
    const unsigned ldsw = (unsigned)wid * 1024u;
    const int aoff = lds_byte(wr * 64 + fr, fq * 8), boff = lds_byte(wc * 32 + fr, fq * 8);
#define GE_SA(b, h) (((b) * 2 + (h)) * HTB)
#define GE_SB(b, h) ((4 + (b) * 2 + (h)) * HTB)
#define GE_STAGE(bufoff, gbase, v0, v1) do { \
        __builtin_amdgcn_global_load_lds((const unsigned*)((const char*)(gbase) + (v0)), (LAS unsigned*)(lds + (bufoff) + ldsw), 16, 0, 0); \
        __builtin_amdgcn_global_load_lds((const unsigned*)((const char*)(gbase) + (v1)), (LAS unsigned*)(lds + (bufoff) + ldsw + 8192), 16, 0, 0); } while (0)
#define GE_LDA(dst, b, h) do { _Pragma("unroll") for (int m = 0; m < 4; ++m) _Pragma("unroll") for (int k = 0; k < 2; ++k) dst[m][k] = *(const LAS bf16x8*)(lds + GE_SA(b, h) + aoff + m * 2048 + k * 1024); } while (0)
#define GE_LDB(dst, b, h) do { _Pragma("unroll") for (int n = 0; n < 2; ++n) _Pragma("unroll") for (int k = 0; k < 2; ++k) dst[n][k] = *(const LAS bf16x8*)(lds + GE_SB(b, h) + boff + n * 2048 + k * 1024); } while (0)
#define GE_MMA(ai, bj, At, Bt) do { __builtin_amdgcn_s_setprio(1); _Pragma("unroll") for (int m = 0; m < 4; ++m) _Pragma("unroll") for (int n = 0; n < 2; ++n) _Pragma("unroll") for (int k = 0; k < 2; ++k) \
        acc[ai][bj][m][n] = __builtin_amdgcn_mfma_f32_16x16x32_bf16(Bt[n][k], At[m][k], acc[ai][bj][m][n], 0, 0, 0); __builtin_amdgcn_s_setprio(0); } while (0)
#define GE_WAIT_V(n) asm volatile("s_waitcnt vmcnt(" #n ")" ::: "memory")
#define GE_WAIT_L(n) asm volatile("s_waitcnt lgkmcnt(" #n ")" ::: "memory")
#define GE_BAR __builtin_amdgcn_s_barrier()
#define GE_SCHED __builtin_amdgcn_sched_barrier(0)
#define GE_STA(bufoff, gbase, pitch, h) GE_STAGE(bufoff, gbase, __umul24((unsigned)(Rr[0] + (h) * HALF), (unsigned)(pitch)) + C2[0], __umul24((unsigned)(Rr[1] + (h) * HALF), (unsigned)(pitch)) + C2[1])
#define GE_STB(bufoff, gbase, pitch, h) GE_STAGE(bufoff, gbase, __umul24((unsigned)(Rbb[0] + (h) * HALF), (unsigned)(pitch)) + C2[0], __umul24((unsigned)(Rbb[1] + (h) * HALF), (unsigned)(pitch)) + C2[1])
    Unit cur, nxt; int ui = 0;
    if (!S.next(0, cur)) return;
    int cpa = S.lda(cur) * 2, cpb = S.ldb(cur) * 2, npa = cpa, npb = cpb;
    f32x4 acc[2][2][4][2];
#pragma unroll
    for (int a = 0; a < 2; ++a)
#pragma unroll
        for (int b = 0; b < 2; ++b)
#pragma unroll
            for (int m = 0; m < 4; ++m)
#pragma unroll
                for (int n = 0; n < 2; ++n) acc[a][b][m][n] = (f32x4){0.f, 0.f, 0.f, 0.f};
    bf16x8 At[4][2], B0[2][2], B1[2][2];
    const char* cA = S.a_base(cur); const char* cB = S.b_base(cur);
    GE_STB(GE_SB(0, 0), cB, cpb, 0); GE_STA(GE_SA(0, 0), cA, cpa, 0); GE_STB(GE_SB(0, 1), cB, cpb, 1); GE_STA(GE_SA(0, 1), cA, cpa, 1);
    if (wr == 1) GE_BAR;
    GE_WAIT_V(4); GE_BAR;
    GE_STB(GE_SB(1, 0), cB + kstep, cpb, 0); GE_STA(GE_SA(1, 0), cA + kstep, cpa, 0); GE_STB(GE_SB(1, 1), cB + kstep, cpb, 1);
    GE_WAIT_V(6); GE_BAR;
    for (;;) {
        const bool has_next = S.next(ui + 1, nxt);
        const char* nA = has_next ? S.a_base(nxt) : cA; const char* nB = has_next ? S.b_base(nxt) : cB;
        if (has_next) { npa = S.lda(nxt) * 2; npb = S.ldb(nxt) * 2; } else { npa = cpa; npb = cpb; }
        const int nt = S.nt(cur);
#pragma unroll 1
        for (int t = 0; t < nt; t += 2) {
            const bool last = (t == nt - 2);
            const char* a1 = cA + (size_t)(t + 1) * kstep;
            const char* a2 = last ? nA : cA + (size_t)(t + 2) * kstep; const char* b2 = last ? nB : cB + (size_t)(t + 2) * kstep;
            const char* a3 = a2 + kstep; const char* b3 = b2 + kstep;
            const int xpa = last ? npa : cpa, xpb = last ? npb : cpb;
            GE_LDB(B0, 0, 0); GE_SCHED; GE_LDA(At, 0, 0); GE_STA(GE_SA(1, 1), a1, cpa, 1);
            GE_WAIT_L(8); GE_BAR; GE_WAIT_L(0); GE_MMA(0, 0, At, B0); GE_BAR; GE_SCHED;
            GE_LDB(B1, 0, 1); GE_STB(GE_SB(0, 0), b2, xpb, 0);
            GE_BAR; GE_WAIT_L(0); GE_MMA(0, 1, At, B1); GE_BAR;
            GE_LDA(At, 0, 1); GE_STA(GE_SA(0, 0), a2, xpa, 0);
            GE_BAR; GE_WAIT_L(0); GE_MMA(1, 0, At, B0); GE_BAR; GE_SCHED;
            GE_STB(GE_SB(0, 1), b2, xpb, 1);
            GE_WAIT_V(6); GE_BAR; GE_MMA(1, 1, At, B1); GE_BAR;
            GE_LDB(B0, 1, 0); GE_SCHED; GE_LDA(At, 1, 0); GE_STA(GE_SA(0, 1), a2, xpa, 1);
            GE_WAIT_L(8); GE_BAR; GE_WAIT_L(0); GE_MMA(0, 0, At, B0); GE_BAR; GE_SCHED;
            GE_LDB(B1, 1, 1); GE_STB(GE_SB(1, 0), b3, xpb, 0);
            GE_BAR; GE_WAIT_L(0); GE_MMA(0, 1, At, B1); GE_BAR;
            GE_LDA(At, 1, 1); GE_STA(GE_SA(1, 0), a3, xpa, 0);
            GE_BAR; GE_WAIT_L(0); GE_MMA(1, 0, At, B0); GE_BAR; GE_SCHED;
            GE_STB(GE_SB(1, 1), b3, xpb, 1);
            GE_WAIT_V(6); GE_BAR; GE_MMA(1, 1, At, B1); GE_BAR;
        }
        const bool keep = E(acc, cur, wr, wc, fr, fq);
        if (!has_next) break;
        if (!keep) {
#pragma unroll
            for (int a = 0; a < 2; ++a)
#pragma unroll
                for (int b = 0; b < 2; ++b)
#pragma unroll
                    for (int m = 0; m < 4; ++m)
#pragma unroll
                        for (int n = 0; n < 2; ++n) acc[a][b][m][n] = (f32x4){0.f, 0.f, 0.f, 0.f};
        }
        cur = nxt; cA = nA; cB = nB; ++ui;
        cpa = npa; cpb = npb;
    }
    GE_WAIT_V(0);
    if (wr == 0) GE_BAR;
    GE_BAR;
#undef GE_SA
#undef GE_SB
#undef GE_STAGE
#undef GE_LDA
#undef GE_LDB
#undef GE_MMA
#undef GE_WAIT_V
#undef GE_WAIT_L
#undef GE_BAR
#undef GE_SCHED
#undef GE_STA
#undef GE_STB
}
}
constexpr size_t MiB = (size_t)1 << 20;
constexpr size_t OFF_BAR    = 0;
constexpr size_t OFF_CNT    = 16 * 1024;
constexpr size_t OFF_BLKE   = 32 * 1024;
constexpr size_t OFF_MOD    = 64 * 1024;
constexpr size_t OFF_PAIR   = 192 * 1024;
constexpr size_t OFF_EIDX   = 1 * MiB;
constexpr size_t OFF_WTS    = 2 * MiB;
constexpr size_t OFF_APOS   = 3 * MiB;
constexpr size_t OFF_ROWTOK = 4 * MiB;
constexpr size_t OFF_WINT   = 8 * MiB;
constexpr size_t OFF_GLUT   = 20 * MiB;
constexpr size_t OFF_PAT    = OFF_GLUT + 128 * 1024;
constexpr size_t OFF_PBT    = OFF_PAT + 512 * 1024;
constexpr size_t OFF_WOUTT  = OFF_PBT + 1536 * 1024;
constexpr size_t OFF_U      = 34 * MiB;
constexpr size_t OFF_H      = 62 * MiB;
constexpr size_t OFF_Z      = 128 * MiB;
constexpr size_t OFF_YPART  = 62 * MiB;
constexpr size_t OFF_YA     = 26 * MiB;
constexpr size_t OFF_YB     = 42 * MiB;
constexpr size_t OFF_BT2    = 40 * MiB;
constexpr size_t OFF_HID1   = 92 * MiB;
constexpr size_t OFF_HID2   = 208 * MiB;
constexpr size_t OFF_H2     = 232 * MiB;
constexpr size_t OFF_BT1    = 57 * MiB;
constexpr size_t OFF_Y2     = 232 * MiB;
constexpr size_t DO_OF = 0, DO_OB = 48 * MiB, DO_X1 = 0;

constexpr size_t OFF_BCNT = 6 * MiB;
constexpr size_t OFF_LIST = 504 * MiB;
constexpr size_t OFF_ROWDST = 90 * MiB;
constexpr size_t OFF_Y2S = 8 * MiB;
constexpr size_t OFF_WRT = 6 * MiB + 512 * 1024;

struct Params {
    const float *x, *c, *ctx, *c_ctx, *w_ada, *b_ada, *norm1_g, *norm2_g, *w_in, *lam_re, *lam_im, *log_dt, *b_re, *b_im, *c_re, *c_im, *s5_d, *w_glu, *lb_logits, *hg_norm_g,
                *p_a, *p_b, *w_out, *w_router, *b_router, *w1, *w3, *w2, *ws1, *ws3, *ws2, *final_g;
    unsigned char* ws; unsigned char* out;
};
constexpr bool Z_FP8 = true;
constexpr size_t DO_H8 = 0, DO_W8 = 40 * MiB;
__device__ __forceinline__ void ada_phase(const Params& p, LAS unsigned char* lds) {
    LAS float* sc = (LAS float*)lds;
    LAS float* red = (LAS float*)(lds + 5 * 1024 * 4);
    const int tid = threadIdx.x;
    float* mod = (float*)(p.ws + OFF_MOD);
    bool loaded = false;
    for (int item = blockIdx.x; item < 192; item += gridDim.x) {
        if (!loaded) {
            for (int i = tid; i < 5 * 1024; i += 512) { const int r = i >> 10, k = i & 1023; const float v = (r < 4) ? p.c[r * 1024 + k] : p.c_ctx[k]; sc[i] = siluf_(v); }
            loaded = true; __syncthreads();
        }
        const int n0 = item * 32, ks = tid >> 5, col = tid & 31;
        float a0 = 0.f, a1 = 0.f, a2 = 0.f, a3 = 0.f, a4 = 0.f;
#pragma unroll 16
        for (int k = ks * 64; k < ks * 64 + 64; ++k) {
            const float w = p.w_ada[(size_t)k * NIN + n0 + col];
            a0 += sc[k] * w; a1 += sc[1024 + k] * w; a2 += sc[2048 + k] * w; a3 += sc[3072 + k] * w; a4 += sc[4096 + k] * w;
        }
        red[(ks * 5 + 0) * 32 + col] = a0; red[(ks * 5 + 1) * 32 + col] = a1; red[(ks * 5 + 2) * 32 + col] = a2; red[(ks * 5 + 3) * 32 + col] = a3; red[(ks * 5 + 4) * 32 + col] = a4;
        __syncthreads();
        if (tid < 160) { const int r = tid >> 5, cc = tid & 31; float s = 0.f;
            for (int q = 0; q < 16; ++q) s += red[(q * 5 + r) * 32 + cc];
            mod[r * NIN + n0 + cc] = s + p.b_ada[n0 + cc]; }
        __syncthreads();
    }
}

__device__ __forceinline__ unsigned cvt_pack_fp8x4(float a, float b, float c, float d) {
    a = __builtin_amdgcn_fmed3f(a, -448.f, 448.f); b = __builtin_amdgcn_fmed3f(b, -448.f, 448.f); c = __builtin_amdgcn_fmed3f(c, -448.f, 448.f); d = __builtin_amdgcn_fmed3f(d, -448.f, 448.f);
    int w = 0; w = __builtin_amdgcn_cvt_pk_fp8_f32(a, b, w, false); w = __builtin_amdgcn_cvt_pk_fp8_f32(c, d, w, true); return (unsigned)w; }
template <bool F8 = false, class F>
__device__ __forceinline__ void cvt_tile(const float* src, int ld, int k0, int n0, bf16_t* dst, int ldd, int kdst0, F rowmap, LAS unsigned char* lds) {
    LAS float* t = (LAS float*)lds;
    const int tid = threadIdx.x;
#pragma unroll
    for (int j = 0; j < 2; ++j) { const int kr = (tid >> 4) + 32 * j, nc = (tid & 15) * 4;
        const f32x4 v = *(const f32x4*)(src + (size_t)(k0 + kr) * ld + n0 + nc);
        t[kr * 65 + nc] = v[0]; t[kr * 65 + nc + 1] = v[1]; t[kr * 65 + nc + 2] = v[2]; t[kr * 65 + nc + 3] = v[3]; }
    __syncthreads();
    { const int n = tid >> 3, kc = (tid & 7) * 8; float v[8];
#pragma unroll
      for (int j = 0; j < 8; ++j) v[j] = t[(kc + j) * 65 + n];
      if constexpr (F8) { u32x2 w; w.x = cvt_pack_fp8x4(v[0] * 32.f, v[1] * 32.f, v[2] * 32.f, v[3] * 32.f); w.y = cvt_pack_fp8x4(v[4] * 32.f, v[5] * 32.f, v[6] * 32.f, v[7] * 32.f);
          *(u32x2*)((unsigned char*)dst + (size_t)rowmap(n0 + n) * ldd + kdst0 + k0 + kc) = w; }
      else { u32x4 w; w.x = cvt_pk_bf16(v[0], v[1]); w.y = cvt_pk_bf16(v[2], v[3]); w.z = cvt_pk_bf16(v[4], v[5]); w.w = cvt_pk_bf16(v[6], v[7]);
          *(u32x4*)(dst + (size_t)rowmap(n0 + n) * ldd + kdst0 + k0 + kc) = w; } }
    __syncthreads();
}

__device__ __forceinline__ void cvt_dense_phase(const Params& p, LAS unsigned char* lds) {
    bf16_t* WinT = (bf16_t*)(p.ws + OFF_WINT); bf16_t* gluT = (bf16_t*)(p.ws + OFF_GLUT); bf16_t* PaT = (bf16_t*)(p.ws + OFF_PAT); bf16_t* PbT = (bf16_t*)(p.ws + OFF_PBT); bf16_t* WoutT = (bf16_t*)(p.ws + OFF_WOUTT);
    auto id = [](int n) { return n; };
    constexpr int T_WIN = 16 * 96, T_GLU = 4 * 4, T_PA = 4 * 16, T_PB = 12 * 16, T_WO = 16 * 16, T_ALL = T_WIN + T_GLU + T_PA + T_PB + T_WO;
    for (int it = blockIdx.x; it < T_ALL; it += gridDim.x) {
        int i = it;
        if (i < T_WIN) { if constexpr (Z_FP8) cvt_tile<true>(p.w_in, NIN, (i / 96) * 64, (i % 96) * 64, (bf16_t*)(p.out + DO_W8), 1024, 0, id, lds);
                         else cvt_tile<false>(p.w_in, NIN, (i / 96) * 64, (i % 96) * 64, WinT, 1024, 0, id, lds); continue; } i -= T_WIN;
        if (i < T_GLU) { cvt_tile(p.w_glu, 256, (i / 4) * 64, (i % 4) * 64, gluT, 256, 0, id, lds); continue; } i -= T_GLU;
        if (i < T_PA) { cvt_tile(p.p_a, 1024, (i / 16) * 64, (i % 16) * 64, PaT, 256, 0, id, lds); continue; } i -= T_PA;
        if (i < T_PB) { cvt_tile(p.p_b, 1024, (i / 16) * 64, (i % 16) * 64, PbT, 768, 0, id, lds); continue; } i -= T_PB;
        cvt_tile(p.w_out, 1024, (i / 16) * 64, (i % 16) * 64, WoutT, 1024, 0, id, lds);
    }
}

__device__ __forceinline__ unsigned moe_pack_fp8x4(float a, float b, float c, float d) {
    a = __builtin_amdgcn_fmed3f(a, -448.f, 448.f); b = __builtin_amdgcn_fmed3f(b, -448.f, 448.f); c = __builtin_amdgcn_fmed3f(c, -448.f, 448.f); d = __builtin_amdgcn_fmed3f(d, -448.f, 448.f);
    int w = 0; w = __builtin_amdgcn_cvt_pk_fp8_f32(a, b, w, false); w = __builtin_amdgcn_cvt_pk_fp8_f32(c, d, w, true); return (unsigned)w; }
struct MoeStrip { const float* src; int ld; unsigned char* dst; int ldd; int mode; };
__device__ __forceinline__ MoeStrip moe_strip(const Params& p, int it) {
    const int e = it / 48, j = it % 48, which = j >> 4, t = j & 15; MoeStrip s;
    unsigned char* Bt1 = p.ws + OFF_BT1 + (size_t)e * 512 * 1024; unsigned char* Bt2 = p.ws + OFF_BT2 + (size_t)e * 1024 * 256;
    if (which == 0) { s.src = ((e < 64) ? p.w1 + (size_t)e * 1024 * 256 : p.ws1) + (size_t)(t * 64) * 256; s.ld = 256; s.dst = Bt1 + t * 64; s.ldd = 1024; s.mode = 0; }
    else if (which == 1) { s.src = ((e < 64) ? p.w3 + (size_t)e * 1024 * 256 : p.ws3) + (size_t)(t * 64) * 256; s.ld = 256; s.dst = Bt1 + t * 64; s.ldd = 1024; s.mode = 1; }
    else { const int kt = t >> 2, nt = t & 3; s.src = ((e < 64) ? p.w2 + (size_t)e * 256 * 1024 : p.ws2) + (size_t)(kt * 64) * 1024 + nt * 256; s.ld = 1024; s.dst = Bt2 + (size_t)(nt * 256) * 256 + kt * 64; s.ldd = 256; s.mode = 2; }
    return s;
}
__device__ __forceinline__ void cvt_moe_phase(const Params& p, LAS unsigned char* lds) {
    int tid = threadIdx.x; asm volatile("" : "+v"(tid));
    LAS float* tl = (LAS float*)lds;
    const int NIT = 65 * 48;
    f32x4 r[8];
    int it = blockIdx.x;
    if (it < NIT) { const MoeStrip s = moe_strip(p, it);
#pragma unroll
        for (int j = 0; j < 8; ++j) r[j] = *(const f32x4*)(s.src + (size_t)((tid >> 6) + 8 * j) * s.ld + (tid & 63) * 4); }
    for (; it < NIT; it += gridDim.x) {
        const MoeStrip s = moe_strip(p, it);
#pragma unroll
        for (int j = 0; j < 8; ++j) { const int kr = (tid >> 6) + 8 * j, nc = (tid & 63) * 4; tl[kr * 257 + nc] = r[j][0]; tl[kr * 257 + nc + 1] = r[j][1]; tl[kr * 257 + nc + 2] = r[j][2]; tl[kr * 257 + nc + 3] = r[j][3]; }
        __syncthreads();
        if (it + (int)gridDim.x < NIT) { const MoeStrip s2 = moe_strip(p, it + gridDim.x);
#pragma unroll
            for (int j = 0; j < 8; ++j) r[j] = *(const f32x4*)(s2.src + (size_t)((tid >> 6) + 8 * j) * s2.ld + (tid & 63) * 4); }
        { const int k8 = (tid & 7) * 8;
#pragma unroll
          for (int c = 0; c < 4; ++c) { const int n = (tid >> 3) + 64 * c;
              const int row = (s.mode == 2) ? n : ((n >> 7) * 256 + (s.mode == 1 ? 128 : 0) + (n & 127));
              float v[8];
#pragma unroll
              for (int q = 0; q < 8; ++q) v[q] = tl[(k8 + q) * 257 + n];
              { u32x2 w; w.x = moe_pack_fp8x4(v[0] * 32.f, v[1] * 32.f, v[2] * 32.f, v[3] * 32.f); w.y = moe_pack_fp8x4(v[4] * 32.f, v[5] * 32.f, v[6] * 32.f, v[7] * 32.f);
                  *(u32x2*)(s.dst + (size_t)row * s.ldd + k8) = w; } } }
        __syncthreads();
    }
}

__device__ __forceinline__ void norm1_phase(const Params& p) {
    const int wid = threadIdx.x >> 6, lane = threadIdx.x & 63;
    const float* mod = (const float*)(p.ws + OFF_MOD); bf16_t* H = (bf16_t*)(p.ws + OFF_H);
    for (int r = blockIdx.x * 8 + wid; r < NROWS; r += gridDim.x * 8) {
        const float* src = (r < NTOK) ? p.x + (size_t)r * 1024 : p.ctx + (size_t)(r - NTOK) * 1024;
        const float* mr = mod + ((r < NTOK) ? (r / SEQ) : 4) * NIN;
        f32x4 v[4]; float ss = 0.f;
#pragma unroll
        for (int j = 0; j < 4; ++j) { v[j] = *(const f32x4*)(src + j * 256 + lane * 4); ss += v[j][0] * v[j][0] + v[j][1] * v[j][1] + v[j][2] * v[j][2] + v[j][3] * v[j][3]; }
        ss = wave_sum(ss);
        const float rstd = rsqrtf(ss * (1.0f / 1024.0f) + EPSF);
#pragma unroll
        for (int j = 0; j < 4; ++j) { const int k = j * 256 + lane * 4;
            const f32x4 g = *(const f32x4*)(p.norm1_g + k), sh = *(const f32x4*)(mr + k), scv = *(const f32x4*)(mr + 1024 + k);
            float o[4];
#pragma unroll
            for (int q = 0; q < 4; ++q) o[q] = v[j][q] * rstd * g[q] * (1.0f + scv[q]) + sh[q];
            if constexpr (Z_FP8) *(unsigned*)(p.out + DO_H8 + (size_t)r * 1024 + k) = cvt_pack_fp8x4(o[0], o[1], o[2], o[3]);
            else { u32x2 w; w.x = cvt_pk_bf16(o[0], o[1]); w.y = cvt_pk_bf16(o[2], o[3]); *(u32x2*)(H + (size_t)r * 1024 + k) = w; } }
    }
}
struct PlainSched {
    ge::GridOrder go; const char* A; const char* B; size_t atile, btile;
    __device__ void init(const void* A_, int lda, const void* B_, int ldb, int nM, int nN) { A = (const char*)A_; B = (const char*)B_; atile = (size_t)256 * lda * 2; btile = (size_t)256 * ldb * 2; go.init(nM, nN, (int)gridDim.x, (int)blockIdx.x); }
    __device__ __forceinline__ bool next(int i, ge::Unit& u) const { u.e = 0; return go.tile(i, u.pm, u.pn); }
    __device__ __forceinline__ const char* a_base(const ge::Unit& u) const { return A + (size_t)u.pm * atile; }
    __device__ __forceinline__ const char* b_base(const ge::Unit& u) const { return B + (size_t)u.pn * btile; }
    __device__ __forceinline__ int a_row(const ge::Unit&, int) const { return 0; }
};

struct ZSchedF8 {
    ge::GridOrder go; const char* A; const char* B;
    __device__ void init(const void* A_, const void* B_) { A = (const char*)A_; B = (const char*)B_; go.init(NROWS / 256, NIN / 256, (int)gridDim.x, (int)blockIdx.x); }
    __device__ __forceinline__ bool next(int i, ge::Unit& u) const { u.e = 0; return go.tile(i, u.pm, u.pn); }
    __device__ __forceinline__ const char* a_base(const ge::Unit& u) const { return A + (size_t)u.pm * 256 * 1024; }
    __device__ __forceinline__ const char* b_base(const ge::Unit& u) const { return B + (size_t)u.pn * 256 * 1024; }
    __device__ __forceinline__ int a_row(const ge::Unit&, int r) const { return r; }
};
struct ZSchedBf {
    ge::GridOrder go; const char* A; const char* B;
    __device__ void init(const void* A_, const void* B_) { A = (const char*)A_; B = (const char*)B_; go.init(NROWS / 256, 1, (int)gridDim.x, (int)blockIdx.x); }
    __device__ __forceinline__ bool next(int i, ge::Unit& u) const { u.e = 0; int j; if (!go.tile(i, u.pm, j)) return false; u.pn = j; return true; }
    __device__ __forceinline__ const char* a_base(const ge::Unit& u) const { return A + (size_t)u.pm * 256 * 1024 * 2; }
    __device__ __forceinline__ const char* b_base(const ge::Unit& u) const { return B + (size_t)u.pn * 256 * 1024 * 2; }
    __device__ __forceinline__ int a_row(const ge::Unit&, int) const { return 0; }
};
struct EpiZ {
    static constexpr bool PERM = true;
    bf16_t* U; bf16_t* Z;
    __device__ __forceinline__ void operator()(const f32x4 (&acc)[2][2][4][2], const ge::Unit& u, int wr, int wc, int fr, int fq) const {
        const int row0 = u.pm * 256 + wr * 64 + fr, cl = wc * 32 + 8 * fq;
        bf16_t* base; int ld;
        if (u.pn == 0) { base = U + cl; ld = 256; } else { base = Z + (u.pn - 1) * 256 + cl; ld = ZC; }
#pragma unroll
        for (int ai = 0; ai < 2; ++ai)
#pragma unroll
            for (int m = 0; m < 4; ++m) { bf16_t* rowp = base + (size_t)(row0 + ai * 128 + m * 16) * ld;
#pragma unroll
                for (int bj = 0; bj < 2; ++bj) { const f32x4 v0 = acc[ai][bj][m][0], v1 = acc[ai][bj][m][1];
                    u32x4 w; w.x = cvt_pk_bf16(v0[0], v0[1]); w.y = cvt_pk_bf16(v0[2], v0[3]); w.z = cvt_pk_bf16(v1[0], v1[1]); w.w = cvt_pk_bf16(v1[2], v1[3]);
                    *(u32x4*)(rowp + bj * 128) = w; } }
    }
};


struct EpiZ2 {
    static constexpr bool PERM = true;
    bf16_t* Ae; bf16_t* Uc; bf16_t* Z;
    __device__ __forceinline__ void operator()(const f32x4 (&acc)[2][2][4][2], const ge::Unit& u, int wr, int wc, int fr, int fq) const {
        const int row0 = u.pm * 256 + wr * 64 + fr, cl = wc * 32 + 8 * fq;
#pragma unroll
        for (int ai = 0; ai < 2; ++ai)
#pragma unroll
            for (int m = 0; m < 4; ++m) { const int r = row0 + ai * 128 + m * 16;
#pragma unroll
                for (int bj = 0; bj < 2; ++bj) { const f32x4 v0 = acc[ai][bj][m][0], v1 = acc[ai][bj][m][1];
                    u32x4 w; w.x = cvt_pk_bf16(v0[0], v0[1]); w.y = cvt_pk_bf16(v0[2], v0[3]); w.z = cvt_pk_bf16(v1[0], v1[1]); w.w = cvt_pk_bf16(v1[2], v1[3]);
                    bf16_t* dst;
                    if (u.pn == 0) { const int col = bj * 128 + cl, g = col >> 4, c0 = col & 15;
                        if (u.pm < NTOK / 256) { const int b = r >> 13, l = r & (SEQ - 1); dst = Ae + (size_t)(g * 512 + b * 128 + (l >> 6)) * 1280 + (l & 63) * 16 + c0; }
                        else dst = Uc + (size_t)(r - NTOK) * 256 + col; }
                    else dst = Z + (size_t)r * ZC + (u.pn - 1) * 256 + cl + bj * 128;
                    *(u32x4*)dst = w; } }
    }
};

struct EpiYa {
    static constexpr bool PERM = true;
    const bf16_t* Y; bf16_t* Ya;
    __device__ __forceinline__ void operator()(const f32x4 (&acc)[2][2][4][2], const ge::Unit& u, int wr, int wc, int fr, int fq) const {
        const int row0 = u.pm * 256 + wr * 64 + fr, col0 = u.pn * 256 + wc * 32 + 8 * fq;
        u32x4 cur[2][2], nxt[2][2];
#pragma unroll
        for (int mm = 0; mm < 2; ++mm)
#pragma unroll
            for (int bj = 0; bj < 2; ++bj) cur[mm][bj] = *(const u32x4*)(Y + (size_t)(row0 + mm * 16) * 256 + col0 + bj * 128);
#pragma unroll
        for (int gi = 0; gi < 4; ++gi) { const int ai = gi >> 1, mh = gi & 1;
            if (gi < 3) { const int ai2 = (gi + 1) >> 1, mh2 = (gi + 1) & 1;
#pragma unroll
                for (int mm = 0; mm < 2; ++mm)
#pragma unroll
                    for (int bj = 0; bj < 2; ++bj) nxt[mm][bj] = *(const u32x4*)(Y + (size_t)(row0 + ai2 * 128 + (2 * mh2 + mm) * 16) * 256 + col0 + bj * 128); }
#pragma unroll
            for (int mm = 0; mm < 2; ++mm)
#pragma unroll
                for (int bj = 0; bj < 2; ++bj) { const int m = 2 * mh + mm; const f32x4 v0 = acc[ai][bj][m][0], v1 = acc[ai][bj][m][1]; const u32x4 y4 = cur[mm][bj];
                    float o[8];
                    o[0] = bf_lo(y4.x) * sigmoidf_(v0[0]); o[1] = bf_hi(y4.x) * sigmoidf_(v0[1]); o[2] = bf_lo(y4.y) * sigmoidf_(v0[2]); o[3] = bf_hi(y4.y) * sigmoidf_(v0[3]);
                    o[4] = bf_lo(y4.z) * sigmoidf_(v1[0]); o[5] = bf_hi(y4.z) * sigmoidf_(v1[1]); o[6] = bf_lo(y4.w) * sigmoidf_(v1[2]); o[7] = bf_hi(y4.w) * sigmoidf_(v1[3]);
                    u32x4 w; w.x = cvt_pk_bf16(o[0], o[1]); w.y = cvt_pk_bf16(o[2], o[3]); w.z = cvt_pk_bf16(o[4], o[5]); w.w = cvt_pk_bf16(o[6], o[7]);
                    *(u32x4*)(Ya + (size_t)(row0 + ai * 128 + m * 16) * 256 + col0 + bj * 128) = w; }
#pragma unroll
            for (int mm = 0; mm < 2; ++mm)
#pragma unroll
                for (int bj = 0; bj < 2; ++bj) cur[mm][bj] = nxt[mm][bj];
            asm volatile("" ::: "memory"); }
    }
};

template <bool ADD> struct EpiMerge {
    static constexpr bool PERM = true;
    const bf16_t* Z; int gcol0; bf16_t* Mg;
    __device__ __forceinline__ void operator()(const f32x4 (&acc)[2][2][4][2], const ge::Unit& u, int wr, int wc, int fr, int fq) const {
        const int row0 = u.pm * 256 + wr * 64 + fr, col0 = u.pn * 256 + wc * 32 + 8 * fq;
        u32x4 gc[2][2], gn[2][2], pc[2][2], pn_[2][2];
#pragma unroll
        for (int mm = 0; mm < 2; ++mm)
#pragma unroll
            for (int bj = 0; bj < 2; ++bj) { const size_t row = (size_t)(row0 + mm * 16); gc[mm][bj] = *(const u32x4*)(Z + row * ZC + gcol0 + col0 + bj * 128); if (ADD) pc[mm][bj] = *(const u32x4*)(Mg + row * 1024 + col0 + bj * 128); }
#pragma unroll
        for (int gi = 0; gi < 4; ++gi) { const int ai = gi >> 1, mh = gi & 1;
            if (gi < 3) { const int ai2 = (gi + 1) >> 1, mh2 = (gi + 1) & 1;
#pragma unroll
                for (int mm = 0; mm < 2; ++mm)
#pragma unroll
                    for (int bj = 0; bj < 2; ++bj) { const size_t row = (size_t)(row0 + ai2 * 128 + (2 * mh2 + mm) * 16); gn[mm][bj] = *(const u32x4*)(Z + row * ZC + gcol0 + col0 + bj * 128); if (ADD) pn_[mm][bj] = *(const u32x4*)(Mg + row * 1024 + col0 + bj * 128); } }
#pragma unroll
            for (int mm = 0; mm < 2; ++mm)
#pragma unroll
                for (int bj = 0; bj < 2; ++bj) { const int m = 2 * mh + mm; const size_t row = (size_t)(row0 + ai * 128 + m * 16);
                    const f32x4 v0 = acc[ai][bj][m][0], v1 = acc[ai][bj][m][1]; const u32x4 g4 = gc[mm][bj];
                    float o[8];
                    o[0] = sigmoidf_(bf_lo(g4.x)) * v0[0]; o[1] = sigmoidf_(bf_hi(g4.x)) * v0[1]; o[2] = sigmoidf_(bf_lo(g4.y)) * v0[2]; o[3] = sigmoidf_(bf_hi(g4.y)) * v0[3];
                    o[4] = sigmoidf_(bf_lo(g4.z)) * v1[0]; o[5] = sigmoidf_(bf_hi(g4.z)) * v1[1]; o[6] = sigmoidf_(bf_lo(g4.w)) * v1[2]; o[7] = sigmoidf_(bf_hi(g4.w)) * v1[3];
                    if (ADD) { const u32x4 p4 = pc[mm][bj];
                        o[0] += bf_lo(p4.x); o[1] += bf_hi(p4.x); o[2] += bf_lo(p4.y); o[3] += bf_hi(p4.y); o[4] += bf_lo(p4.z); o[5] += bf_hi(p4.z); o[6] += bf_lo(p4.w); o[7] += bf_hi(p4.w); }
                    u32x4 w; w.x = cvt_pk_bf16(o[0], o[1]); w.y = cvt_pk_bf16(o[2], o[3]); w.z = cvt_pk_bf16(o[4], o[5]); w.w = cvt_pk_bf16(o[6], o[7]);
                    *(u32x4*)(Mg + row * 1024 + col0 + bj * 128) = w; }
#pragma unroll
            for (int mm = 0; mm < 2; ++mm)
#pragma unroll
                for (int bj = 0; bj < 2; ++bj) { gc[mm][bj] = gn[mm][bj]; if (ADD) pc[mm][bj] = pn_[mm][bj]; }
            asm volatile("" ::: "memory"); }
    }
};


struct MergeSched {
    ge::GridOrder go; const char* Ya; const char* Yb; const char* Pa; const char* Pb;
    __device__ void init(const void* ya, const void* yb, const void* pa, const void* pb) { Ya = (const char*)ya; Yb = (const char*)yb; Pa = (const char*)pa; Pb = (const char*)pb; go.init(NTOK / 256, 4, (int)gridDim.x, (int)blockIdx.x); }
    __device__ __forceinline__ bool next(int i, ge::Unit& u) const { u.e = i & 1; return go.tile(i >> 1, u.pm, u.pn); }
    __device__ __forceinline__ const char* a_base(const ge::Unit& u) const { return u.e ? Yb + (size_t)u.pm * 256 * 768 * 2 : Ya + (size_t)u.pm * 256 * 256 * 2; }
    __device__ __forceinline__ const char* b_base(const ge::Unit& u) const { return u.e ? Pb + (size_t)u.pn * 256 * 768 * 2 : Pa + (size_t)u.pn * 256 * 256 * 2; }
    __device__ __forceinline__ int nt(const ge::Unit& u) const { return u.e ? 12 : 4; }
    __device__ __forceinline__ int lda(const ge::Unit& u) const { return u.e ? 768 : 256; }
    __device__ __forceinline__ int ldb(const ge::Unit& u) const { return u.e ? 768 : 256; }
};
template <bool WT = false> struct EpiMergeF {
    static constexpr bool PERM = true;
    const bf16_t* Z; bf16_t* Mg; int ldm;
    __device__ __forceinline__ bool operator()(f32x4 (&acc)[2][2][4][2], const ge::Unit& u, int wr, int wc, int fr, int fq) const {
        const int row0 = u.pm * 256 + wr * 64 + fr, col0 = u.pn * 256 + wc * 32 + 8 * fq;
        __amdgpu_buffer_rsrc_t rs = __builtin_amdgcn_make_buffer_rsrc((void*)Mg, 0, 0x7ffffff0, 0x00020000);
        if (u.e == 0) {
#pragma unroll
            for (int gi = 0; gi < 4; ++gi) { const int ai = gi >> 1, mh = gi & 1;
                u32x4 ga[2][2], gb[2][2];
#pragma unroll
                for (int mm = 0; mm < 2; ++mm)
#pragma unroll
                    for (int bj = 0; bj < 2; ++bj) { const bf16_t* zr = Z + (size_t)(row0 + ai * 128 + (2 * mh + mm) * 16) * ZC + col0 + bj * 128; ga[mm][bj] = *(const u32x4*)(zr + ZGA); gb[mm][bj] = *(const u32x4*)(zr + ZGB); }
#pragma unroll
                for (int mm = 0; mm < 2; ++mm)
#pragma unroll
                    for (int bj = 0; bj < 2; ++bj) { const int m = 2 * mh + mm; const u32x4 a4 = ga[mm][bj], b4 = gb[mm][bj];
#define MF_R(aw, bw, lo) ((1.0f + __expf(-(lo ? bf_lo(bw) : bf_hi(bw)))) * frcp_(1.0f + __expf(-(lo ? bf_lo(aw) : bf_hi(aw)))))
                        acc[ai][bj][m][0][0] *= MF_R(a4.x, b4.x, true); acc[ai][bj][m][0][1] *= MF_R(a4.x, b4.x, false); acc[ai][bj][m][0][2] *= MF_R(a4.y, b4.y, true); acc[ai][bj][m][0][3] *= MF_R(a4.y, b4.y, false);
                        acc[ai][bj][m][1][0] *= MF_R(a4.z, b4.z, true); acc[ai][bj][m][1][1] *= MF_R(a4.z, b4.z, false); acc[ai][bj][m][1][2] *= MF_R(a4.w, b4.w, true); acc[ai][bj][m][1][3] *= MF_R(a4.w, b4.w, false);
#undef MF_R
                    }
                asm volatile("" ::: "memory"); }
            return true;
        }
#pragma unroll
        for (int gi = 0; gi < 4; ++gi) { const int ai = gi >> 1, mh = gi & 1;
            u32x4 gb[2][2];
#pragma unroll
            for (int mm = 0; mm < 2; ++mm)
#pragma unroll
                for (int bj = 0; bj < 2; ++bj) gb[mm][bj] = *(const u32x4*)(Z + (size_t)(row0 + ai * 128 + (2 * mh + mm) * 16) * ZC + ZGB + col0 + bj * 128);
#pragma unroll
            for (int mm = 0; mm < 2; ++mm)
#pragma unroll
                for (int bj = 0; bj < 2; ++bj) { const int m = 2 * mh + mm; const f32x4 v0 = acc[ai][bj][m][0], v1 = acc[ai][bj][m][1]; const u32x4 g4 = gb[mm][bj];
                    float o[8];
                    o[0] = sigmoidf_(bf_lo(g4.x)) * v0[0]; o[1] = sigmoidf_(bf_hi(g4.x)) * v0[1]; o[2] = sigmoidf_(bf_lo(g4.y)) * v0[2]; o[3] = sigmoidf_(bf_hi(g4.y)) * v0[3];
                    o[4] = sigmoidf_(bf_lo(g4.z)) * v1[0]; o[5] = sigmoidf_(bf_hi(g4.z)) * v1[1]; o[6] = sigmoidf_(bf_lo(g4.w)) * v1[2]; o[7] = sigmoidf_(bf_hi(g4.w)) * v1[3];
                    u32x4 w; w.x = cvt_pk_bf16(o[0], o[1]); w.y = cvt_pk_bf16(o[2], o[3]); w.z = cvt_pk_bf16(o[4], o[5]); w.w = cvt_pk_bf16(o[6], o[7]);
                    if constexpr (WT) __builtin_amdgcn_raw_buffer_store_b128(w, rs, (int)(((unsigned)(row0 + ai * 128 + m * 16) * (unsigned)ldm + (unsigned)(col0 + bj * 128)) * 2u), 0, 16);
                    else *(u32x4*)(Mg + (size_t)(row0 + ai * 128 + m * 16) * ldm + col0 + bj * 128) = w; }
            asm volatile("" ::: "memory"); }
        return false;
    }
};


struct OneUnitSched {
    const char* A; const char* B; int pm;
    __device__ __forceinline__ bool next(int i, ge::Unit& u) const { if (i) return false; u.pm = pm; u.pn = 0; u.e = 0; return true; }
    __device__ __forceinline__ const char* a_base(const ge::Unit& u) const { return A + (size_t)u.pm * 256 * 256 * 2; }
    __device__ __forceinline__ const char* b_base(const ge::Unit&) const { return B; }
    __device__ __forceinline__ int a_row(const ge::Unit&, int) const { return 0; }
};
struct PanelMergeSched {
    const char* Ya; const char* Yb; const char* Pa; const char* Pb; int pm, pn0;
    __device__ __forceinline__ bool next(int i, ge::Unit& u) const { if (i >= 4) return false; u.pm = pm; u.pn = pn0 + (i >> 1); u.e = i & 1; return true; }
    __device__ __forceinline__ const char* a_base(const ge::Unit& u) const { return u.e ? Yb + (size_t)u.pm * 256 * 768 * 2 : Ya + (size_t)u.pm * 256 * 256 * 2; }
    __device__ __forceinline__ const char* b_base(const ge::Unit& u) const { return u.e ? Pb + (size_t)u.pn * 256 * 768 * 2 : Pa + (size_t)u.pn * 256 * 256 * 2; }
    __device__ __forceinline__ int nt(const ge::Unit& u) const { return u.e ? 12 : 4; }
    __device__ __forceinline__ int lda(const ge::Unit& u) const { return u.e ? 768 : 256; }
    __device__ __forceinline__ int ldb(const ge::Unit& u) const { return u.e ? 768 : 256; }
};

template <bool WT = false> struct EpiX1 {
    static constexpr bool PERM = false;
    const float* X; const float* mod; float* X1;
    __device__ __forceinline__ void operator()(const f32x4 (&acc)[2][2][4][2], const ge::Unit& u, int wr, int wc, int fr, int fq) const {
        const int row0 = u.pm * 256 + wr * 64 + fr, col0 = u.pn * 256 + wc * 32 + 4 * fq;
        const float* g1 = mod + (size_t)((u.pm * 256) / SEQ) * NIN + 2048;
        f32x4 gv[2][2];
#pragma unroll
        for (int bj = 0; bj < 2; ++bj)
#pragma unroll
            for (int n = 0; n < 2; ++n) gv[bj][n] = *(const f32x4*)(g1 + col0 + bj * 128 + n * 16);
        __amdgpu_buffer_rsrc_t rs = __builtin_amdgcn_make_buffer_rsrc((void*)X1, 0, 0x7ffffff0, 0x00020000);
        f32x4 cur[2][2], nxt[2][2];
#pragma unroll
        for (int bj = 0; bj < 2; ++bj)
#pragma unroll
            for (int n = 0; n < 2; ++n) cur[bj][n] = *(const f32x4*)(X + (size_t)row0 * 1024 + col0 + bj * 128 + n * 16);
#pragma unroll
        for (int gi = 0; gi < 8; ++gi) { const int ai = gi >> 2, m = gi & 3;
            if (gi < 7) { const int ai2 = (gi + 1) >> 2, m2 = (gi + 1) & 3;
#pragma unroll
                for (int bj = 0; bj < 2; ++bj)
#pragma unroll
                    for (int n = 0; n < 2; ++n) nxt[bj][n] = *(const f32x4*)(X + (size_t)(row0 + ai2 * 128 + m2 * 16) * 1024 + col0 + bj * 128 + n * 16); }
#pragma unroll
            for (int bj = 0; bj < 2; ++bj)
#pragma unroll
                for (int n = 0; n < 2; ++n) { const f32x4 r = cur[bj][n] + gv[bj][n] * acc[ai][bj][m][n];
                    if constexpr (WT) __builtin_amdgcn_raw_buffer_store_b128(__builtin_bit_cast(u32x4, r), rs, (int)(((unsigned)(row0 + ai * 128 + m * 16) * 1024u + (unsigned)(col0 + bj * 128 + n * 16)) * 4u), 0, 16);
                    else *(f32x4*)(X1 + (size_t)(row0 + ai * 128 + m * 16) * 1024 + col0 + bj * 128 + n * 16) = r; }
#pragma unroll
            for (int bj = 0; bj < 2; ++bj)
#pragma unroll
                for (int n = 0; n < 2; ++n) cur[bj][n] = nxt[bj][n];
            asm volatile("" ::: "memory"); }
    }
};


__device__ __forceinline__ void pair_sync(unsigned* cnt, unsigned target, unsigned* tmo) {
    asm volatile("s_waitcnt vmcnt(0)" ::: "memory");
    __syncthreads();
    if (threadIdx.x == 0) {
        (void)__hip_atomic_fetch_add(cnt, 1u, __ATOMIC_RELAXED, __HIP_MEMORY_SCOPE_AGENT);
        unsigned sp = 0;
        while (__hip_atomic_load(cnt, __ATOMIC_RELAXED, __HIP_MEMORY_SCOPE_AGENT) < target) { __builtin_amdgcn_s_sleep(1);
            if ((++sp & 255u) == 0u) { if (__hip_atomic_load(tmo, __ATOMIC_RELAXED, __HIP_MEMORY_SCOPE_AGENT)) break; if (sp > (1u << 20)) { atomicAdd(tmo, 1u); break; } } }
        __builtin_amdgcn_fence(__ATOMIC_ACQUIRE, "agent");
        asm volatile("s_waitcnt vmcnt(0)" ::: "memory");
    }
    __syncthreads();
}
struct PanelX1Sched {
    const char* A; const char* B; int pm, pn0, nu;
    __device__ __forceinline__ bool next(int i, ge::Unit& u) const { if (i >= nu) return false; u.pm = pm; u.pn = pn0 + i; u.e = 0; return true; }
    __device__ __forceinline__ const char* a_base(const ge::Unit& u) const { return A + (size_t)u.pm * 256 * ZC * 2; }
    __device__ __forceinline__ const char* b_base(const ge::Unit& u) const { return B + (size_t)u.pn * 256 * 1024 * 2; }
    __device__ __forceinline__ int a_row(const ge::Unit&, int) const { return 0; }
};

__device__ __forceinline__ unsigned pack_fp8x4(float a, float b, float c, float d) {
    a = __builtin_amdgcn_fmed3f(a, -448.f, 448.f); b = __builtin_amdgcn_fmed3f(b, -448.f, 448.f); c = __builtin_amdgcn_fmed3f(c, -448.f, 448.f); d = __builtin_amdgcn_fmed3f(d, -448.f, 448.f);
    int w = 0; w = __builtin_amdgcn_cvt_pk_fp8_f32(a, b, w, false); w = __builtin_amdgcn_cvt_pk_fp8_f32(c, d, w, true); return (unsigned)w;
}

__device__ __forceinline__ bf16_t* hid_rows(unsigned char* ws, unsigned char* out, int rb) {
    (void)out; return (bf16_t*)(ws + OFF_HID1 + (size_t)rb * 256 * EH);
}
__device__ __forceinline__ int xcd_perm(int c, int G) { return (G & 7) ? c : (c & 7) * (G >> 3) + (c >> 3); }
struct MoeSched1 {
    const int* blk_e; const int* nblk; const int* row_tok; const char* h2; const char* bt1; int G, c;
    __device__ __forceinline__ bool next(int i, ge::Unit& u) const { const int rb = (i >> 1) * G + xcd_perm(c, G); if (rb >= *nblk) return false; u.pm = rb; u.pn = i & 1; u.e = blk_e[rb]; return true; }
    __device__ __forceinline__ const char* a_base(const ge::Unit&) const { return h2; }
    __device__ __forceinline__ const char* b_base(const ge::Unit& u) const { return bt1 + ((size_t)u.e * 512 + (size_t)u.pn * 256) * 1024 * 2; }
    __device__ __forceinline__ int a_row(const ge::Unit& u, int r) const { return row_tok[u.pm * 256 + r]; }
};

constexpr int MP_BASE = 131072, MP_TOT = MP_BASE, MP_PS = MP_BASE + 256, MP_PART = MP_BASE + 1024, MP_MINE = MP_BASE + 3072, MP_PREF = MP_BASE + 4096, MP_RT = MP_BASE + 9216;
constexpr int MP_MAXRB = 5;
__device__ __forceinline__ void moe_pull_prep(const Params& p, LAS unsigned char* lds) {
    int tid = threadIdx.x; asm volatile("" : "+v"(tid));
    const int nb = (int)gridDim.x, bid = (int)blockIdx.x, lane = tid & 63, wid = tid >> 6;
    const int* bc = (const int*)(p.ws + OFF_BCNT); const int* lst = (const int*)(p.ws + OFF_LIST);
    int* cnt = (int*)(p.ws + OFF_CNT); int* pstart = cnt + 128; int* nblk_g = cnt + 256; int* blk_e = (int*)(p.ws + OFF_BLKE); int* row_dst = (int*)(p.ws + OFF_ROWDST);
    LAS int* tot = (LAS int*)(lds + MP_TOT); LAS int* ps = (LAS int*)(lds + MP_PS); LAS int* part = (LAS int*)(lds + MP_PART); LAS int* mine = (LAS int*)(lds + MP_MINE);
    LAS int* pref = (LAS int*)(lds + MP_PREF); LAS int* rt = (LAS int*)(lds + MP_RT);
    { const int e = tid & 63, pg = tid >> 6, per = (nb + 7) / 8; int t = 0;
#pragma unroll 8
      for (int wg = pg * per; wg < (pg + 1) * per; ++wg) if (wg < nb) t += bc[wg * 64 + e];
      part[pg * 64 + e] = t; }
    __syncthreads();
    if (tid < 64) { int t = 0;
#pragma unroll
        for (int pg = 0; pg < 8; ++pg) t += part[pg * 64 + tid];
        tot[tid] = t; }
    __syncthreads();
    if (tid == 0) { int a = 0; for (int e = 0; e < 64; ++e) { ps[e] = a; a += (tot[e] + 255) / 256 * 256; } ps[64] = a; ps[65] = a + NTOK;
        const int nblk = ps[65] / 256; int n = 0;
        for (int i = 0; i < MP_MAXRB; ++i) { const int rb = i * nb + xcd_perm(bid, nb); if (rb < nblk) { int e = 0; while (e < 64 && rb * 256 >= ps[e + 1]) ++e; mine[1 + 3 * n] = rb; mine[2 + 3 * n] = e; mine[3 + 3 * n] = rb * 256 - ps[e]; ++n; } }
        mine[0] = n; }
    __syncthreads();
    const int nmine = mine[0];
    for (int j = 0; j < (MP_MAXRB + 1) / 2; ++j) { const int sl = 2 * j + (wid >> 2), b = (wid & 3) * 64 + lane; const bool act = sl < nmine && mine[2 + 3 * sl] < 64;
        int v = (act && b < nb) ? bc[b * 64 + mine[2 + 3 * (act ? sl : 0)]] : 0; const int own = v;
#pragma unroll
        for (int o = 1; o < 64; o <<= 1) { const int u = __shfl_up(v, o); if (lane >= o) v += u; }
        if (lane == 63) part[wid] = v;
        __syncthreads();
        int base = 0;
#pragma unroll
        for (int q = 0; q < 4; ++q) if (q < (wid & 3)) base += part[(wid & ~3) + q];
        if (act) pref[sl * 256 + b] = base + v - own;
        __syncthreads(); }
    for (int j = 0; j < (MP_MAXRB + 1) / 2; ++j) { const int sl = 2 * j + (tid >> 8), r = tid & 255;
        if (sl < nmine) { const int rb = mine[1 + 3 * sl], e = mine[2 + 3 * sl], jrow = mine[3 + 3 * sl] + r; int tokv, dst;
            if (e >= 64) { tokv = jrow; dst = -1; }
            else if (jrow >= tot[e]) { tokv = NTOK; dst = -1; }
            else { int lo = 0, hi = (nb < 256 ? nb : 256) - 1;
                while (lo < hi) { const int mid = (lo + hi + 1) >> 1; if (pref[sl * 256 + mid] <= jrow) lo = mid; else hi = mid - 1; }
                dst = lst[((size_t)lo * 64 + e) * 128 + (jrow - pref[sl * 256 + lo])]; tokv = dst >> 3; }
            rt[sl * 256 + r] = tokv; if (e < 64) row_dst[rb * 256 + r] = dst; } }
    if (bid == 0) {
        if (tid < 66) pstart[tid] = ps[tid];
        if (tid == 0) *nblk_g = ps[65] / 256;
        for (int rb = tid; rb < ps[65] / 256; rb += 512) { int e = 0; while (e < 64 && rb * 256 >= ps[e + 1]) ++e; blk_e[rb] = e; }
    }
    __syncthreads();
}
struct MoeSched1P {
    LAS unsigned char* lds; const char* h2; const char* bt1;
    __device__ __forceinline__ bool next(int i, ge::Unit& u) const { const LAS int* mine = (const LAS int*)(lds + MP_MINE); const int k = i >> 1; if (k >= mine[0]) return false; u.k = k; u.pm = mine[1 + 3 * k]; u.e = mine[2 + 3 * k]; u.pn = i & 1; return true; }
    __device__ __forceinline__ const char* a_base(const ge::Unit&) const { return h2; }
    __device__ __forceinline__ const char* b_base(const ge::Unit& u) const { return bt1 + ((size_t)u.e * 512 + (size_t)u.pn * 256) * 1024; }
    __device__ __forceinline__ int a_row(const ge::Unit& u, int r) const { return ((const LAS int*)(lds + MP_RT))[u.k * 256 + r]; }
};
struct EpiHid {
    static constexpr bool PERM = true;
    unsigned char* ws; unsigned char* out;
    __device__ __forceinline__ void operator()(const f32x4 (&acc)[2][2][4][2], const ge::Unit& u, int wr, int wc, int fr, int fq) const {
        unsigned char* base = (unsigned char*)hid_rows(ws, out, u.pm) + (size_t)(wr * 64 + fr) * EH + u.pn * 128 + wc * 32 + 8 * fq;
#pragma unroll
        for (int ai = 0; ai < 2; ++ai)
#pragma unroll
            for (int m = 0; m < 4; ++m) { const f32x4 a0 = acc[ai][0][m][0], a1 = acc[ai][0][m][1], b0 = acc[ai][1][m][0], b1 = acc[ai][1][m][1];
                const f32x4 z0 = a0 * (-1.4426950408889634f), z1 = a1 * (-1.4426950408889634f);
                f32x4 d0, d1;
#pragma unroll
                for (int q = 0; q < 4; ++q) { d0[q] = frcp_(1.0f + __builtin_amdgcn_exp2f(z0[q])); d1[q] = frcp_(1.0f + __builtin_amdgcn_exp2f(z1[q])); }
                const f32x4 h0 = a0 * b0 * d0, h1 = a1 * b1 * d1;
                u32x2 w; w.x = pack_fp8x4(h0[0], h0[1], h0[2], h0[3]); w.y = pack_fp8x4(h1[0], h1[1], h1[2], h1[3]);
                *(u32x2*)(base + (size_t)(ai * 128 + m * 16) * EH) = w; }
    }
};
struct MoeSched2 {
    const int* blk_e; const int* nblk; unsigned char* ws; unsigned char* out; const char* bt2; int G, c;
    __device__ __forceinline__ bool next(int i, ge::Unit& u) const { const int rb = (i >> 2) * G + xcd_perm(c, G); if (rb >= *nblk) return false; u.pm = rb; u.pn = i & 3; u.e = blk_e[rb]; return true; }
    __device__ __forceinline__ const char* a_base(const ge::Unit& u) const { return (const char*)hid_rows(ws, out, u.pm); }
    __device__ __forceinline__ const char* b_base(const ge::Unit& u) const { return bt2 + ((size_t)u.e * 1024 + (size_t)u.pn * 256) * EH; }
    __device__ __forceinline__ int a_row(const ge::Unit&, int r) const { return r; }
};
struct EpiY2 {
    static constexpr bool PERM = true;
    unsigned char* Y2; unsigned char* Y2s; const int* pstart; const int* row_dst;
    __device__ __forceinline__ void operator()(const f32x4 (&acc)[2][2][4][2], const ge::Unit& u, int wr, int wc, int fr, int fq) const {
        const int r0 = u.pm * 256 + wr * 64 + fr, colg = u.pn * 256 + wc * 32 + 8 * fq;
        if (u.e < NEXP) {
            const int rl = r0 + (fq & 1) * 16, cl2 = colg - (fq & 1) * 8;
            int rd[2][2];
#pragma unroll
            for (int ai = 0; ai < 2; ++ai)
#pragma unroll
                for (int mp = 0; mp < 2; ++mp) rd[ai][mp] = row_dst[rl + ai * 128 + mp * 32];
#pragma unroll
            for (int ai = 0; ai < 2; ++ai)
#pragma unroll
                for (int mp = 0; mp < 2; ++mp)
#pragma unroll
                    for (int bj = 0; bj < 2; ++bj) { const f32x4 v0 = acc[ai][bj][2 * mp][0], v1 = acc[ai][bj][2 * mp][1], v2 = acc[ai][bj][2 * mp + 1][0], v3 = acc[ai][bj][2 * mp + 1][1];
                        unsigned ax = pack_fp8x4(v0[0], v0[1], v0[2], v0[3]), ay = pack_fp8x4(v1[0], v1[1], v1[2], v1[3]), bx = pack_fp8x4(v2[0], v2[1], v2[2], v2[3]), by = pack_fp8x4(v3[0], v3[1], v3[2], v3[3]);
                        { auto r = __builtin_amdgcn_permlane16_swap(ax, bx, false, false); ax = r[0]; bx = r[1]; }
                        { auto r = __builtin_amdgcn_permlane16_swap(ay, by, false, false); ay = r[0]; by = r[1]; }
                        u32x4 w; w.x = ax; w.y = ay; w.z = bx; w.w = by;
                        if (rd[ai][mp] >= 0) *(u32x4*)(Y2 + (size_t)rd[ai][mp] * 1024 + cl2 + bj * 128) = w; }
        } else {
            const int t0 = r0 - pstart[NEXP] + (fq & 1) * 16, cl2 = colg - (fq & 1) * 8;
#pragma unroll
            for (int ai = 0; ai < 2; ++ai)
#pragma unroll
                for (int mp = 0; mp < 2; ++mp)
#pragma unroll
                    for (int bj = 0; bj < 2; ++bj) { const f32x4 v0 = acc[ai][bj][2 * mp][0], v1 = acc[ai][bj][2 * mp][1], v2 = acc[ai][bj][2 * mp + 1][0], v3 = acc[ai][bj][2 * mp + 1][1];
                        unsigned ax = pack_fp8x4(v0[0], v0[1], v0[2], v0[3]), ay = pack_fp8x4(v1[0], v1[1], v1[2], v1[3]), bx = pack_fp8x4(v2[0], v2[1], v2[2], v2[3]), by = pack_fp8x4(v3[0], v3[1], v3[2], v3[3]);
                        { auto r = __builtin_amdgcn_permlane16_swap(ax, bx, false, false); ax = r[0]; bx = r[1]; }
                        { auto r = __builtin_amdgcn_permlane16_swap(ay, by, false, false); ay = r[0]; by = r[1]; }
                        u32x4 w; w.x = ax; w.y = ay; w.z = bx; w.w = by;
                        *(u32x4*)(Y2s + (size_t)(t0 + ai * 128 + mp * 32) * 1024 + cl2 + bj * 128) = w; }
        }
    }
};

struct EpiNull { static constexpr bool PERM = true; float* sink;
    __device__ __forceinline__ void operator()(const f32x4 (&acc)[2][2][4][2], const ge::Unit& u, int wr, int wc, int fr, int fq) const {
        float s = 0.f;
#pragma unroll
        for (int ai = 0; ai < 2; ++ai)
#pragma unroll
            for (int bj = 0; bj < 2; ++bj)
#pragma unroll
                for (int m = 0; m < 4; ++m)
#pragma unroll
                    for (int n = 0; n < 2; ++n) s += acc[ai][bj][m][n][0] + acc[ai][bj][m][n][1] + acc[ai][bj][m][n][2] + acc[ai][bj][m][n][3];
        if (s == 12345.678f) sink[0] = s; } };
struct MoeSched2R {
    const int* blk_e; const int* pstart; unsigned char* ws; unsigned char* out; const char* bt2; int G, c;
    __device__ __forceinline__ bool next(int i, ge::Unit& u) const { const int rb = (i >> 2) * G + c; if (rb >= pstart[NEXP] / 256) return false; u.pm = rb; u.pn = i & 3; u.e = blk_e[rb]; return true; }
    __device__ __forceinline__ const char* a_base(const ge::Unit& u) const { return (const char*)hid_rows(ws, out, u.pm); }
    __device__ __forceinline__ const char* b_base(const ge::Unit& u) const { return bt2 + ((size_t)u.e * 1024 + (size_t)u.pn * 256) * EH * 2; }
    __device__ __forceinline__ int a_row(const ge::Unit&, int) const { return 0; }
};
constexpr size_t DO_LP = 120 * MiB, DO_BBAR = DO_LP + 1088 * 1024, DO_KTAB = DO_BBAR + 256 * 1024, DO_UC = 124 * MiB;
constexpr size_t OFF_MG = 26 * MiB, OFF_AEXT = 34 * MiB, OFF_XEND = 54 * MiB, OFF_WEXT = 62 * MiB, OFF_YS5 = 102 * MiB;
constexpr int AEK = 1280;

__device__ __forceinline__ void s5_tab1_phase(const Params& p) {
    f32x2* Lp = (f32x2*)(p.out + DO_LP); f32x2* Bb = (f32x2*)(p.out + DO_BBAR);
    const int gt = blockIdx.x * blockDim.x + threadIdx.x, gs = gridDim.x * blockDim.x;
    for (int i = gt; i < 2048 * 65; i += gs) { const int pi = i / 65, j = i % 65, dg = pi >> 6;
        const double lre = fmin((double)p.lam_re[pi], -1e-4), lim = (double)p.lam_im[pi], dt = exp((double)p.log_dt[dg]);
        const double er = exp(lre * dt * (double)j), th = lim * dt * (double)j;
        Lp[i] = (f32x2){(float)(er * cos(th)), (float)(er * sin(th))}; }
    for (int i = gt; i < 2048 * 16; i += gs) { const int pi = i >> 4, dg = pi >> 6;
        const double lre = fmin((double)p.lam_re[pi], -1e-4), lim = (double)p.lam_im[pi], dt = exp((double)p.log_dt[dg]);
        const double er = exp(lre * dt), th = lim * dt, nr = er * cos(th) - 1.0, ni = er * sin(th), den = lre * lre + lim * lim;
        const double cfr = (nr * lre + ni * lim) / den, cfi = (ni * lre - nr * lim) / den;
        const double br = p.b_re[i], bi = p.b_im[i];
        Bb[i] = (f32x2){(float)(cfr * br - cfi * bi), (float)(cfr * bi + cfi * br)}; }
}
__device__ __forceinline__ void s5_tab2_phase(const Params& p, int vb, int nvb) {
    const f32x2* Lp = (const f32x2*)(p.out + DO_LP); const f32x2* Bb = (const f32x2*)(p.out + DO_BBAR); float* Kt = (float*)(p.out + DO_KTAB); bf16_t* Mg = (bf16_t*)(p.ws + OFF_MG);
    const int gt = vb * 512 + threadIdx.x, gs = nvb * 512;
    for (int i = gt; i < 2 * 16 * 64 * 256; i += gs) { const int cp = i & 15, c = (i >> 4) & 15, j = (i >> 8) & 63, dg = i >> 14, g = dg & 15;
        float s = 0.f;
#pragma unroll 16
        for (int pp = 0; pp < 64; ++pp) { const f32x2 l = Lp[(dg * 64 + pp) * 65 + j], b = Bb[(dg * 64 + pp) * 16 + cp];
            const float xr = l.x * b.x - l.y * b.y, xi = l.x * b.y + l.y * b.x;
            s += p.c_re[(g * 16 + c) * 64 + pp] * xr - p.c_im[(g * 16 + c) * 64 + pp] * xi; }
        Kt[i] = s; }
    for (int i = gt; i < 16 * 256 * 128; i += gs) { const int k8 = i & 127, n = (i >> 7) & 255, g = i >> 15;
        const int dir = n >> 7, part = (n >> 6) & 1, pp = n & 63, s = k8 >> 1, c0 = (k8 & 1) * 8, dg = dir * 16 + g;
        const f32x2 l = Lp[(dg * 64 + pp) * 65 + (dir ? s : 63 - s)];
        float v[8];
#pragma unroll
        for (int q = 0; q < 8; ++q) { const f32x2 b = Bb[(dg * 64 + pp) * 16 + c0 + q]; v[q] = part ? (l.x * b.y + l.y * b.x) : (l.x * b.x - l.y * b.y); }
        u32x4 w; w.x = cvt_pk_bf16(v[0], v[1]); w.y = cvt_pk_bf16(v[2], v[3]); w.z = cvt_pk_bf16(v[4], v[5]); w.w = cvt_pk_bf16(v[6], v[7]);
        *(u32x4*)(Mg + ((size_t)(g * 256 + n)) * 1024 + k8 * 8) = w; }
}
__device__ __forceinline__ void s5_wfill_phase(const Params& p, int vb, int nvb) {
    const f32x2* Lp = (const f32x2*)(p.out + DO_LP); const float* Kt = (const float*)(p.out + DO_KTAB); bf16_t* W = (bf16_t*)(p.ws + OFF_WEXT);
    for (int i = vb * 512 + threadIdx.x; i < 16 * 1024 * 160; i += nvb * 512) { const int k8 = i % 160, n = (i / 160) & 1023, g = i / (160 * 1024), t = n >> 4, c = n & 15;
        float v[8];
        if (k8 < 128) { const int s = k8 >> 1, c0 = (k8 & 1) * 8;
            if (s < t) { const float* kp = Kt + ((((0 * 16 + g) * 64 + (t - s)) * 16 + c) * 16 + c0);
#pragma unroll
                for (int q = 0; q < 8; ++q) v[q] = kp[q]; }
            else if (s > t) { const float* kp = Kt + ((((1 * 16 + g) * 64 + (s - t)) * 16 + c) * 16 + c0);
#pragma unroll
                for (int q = 0; q < 8; ++q) v[q] = kp[q]; }
            else { const float* kf = Kt + ((((0 * 16 + g) * 64) * 16 + c) * 16 + c0); const float* kb = Kt + ((((1 * 16 + g) * 64) * 16 + c) * 16 + c0);
#pragma unroll
                for (int q = 0; q < 8; ++q) v[q] = kf[q] + kb[q] + ((c0 + q == c) ? p.s5_d[g * 16 + c] : 0.f); }
        } else { const int kk = (k8 - 128) * 8, dir = kk >> 7, part = (kk >> 6) & 1, p0 = kk & 63, dg = dir * 16 + g, e = dir ? (64 - t) : (t + 1);
#pragma unroll
            for (int q = 0; q < 8; ++q) { const f32x2 l = Lp[(dg * 64 + p0 + q) * 65 + e]; const float cr = p.c_re[(g * 16 + c) * 64 + p0 + q], ci = p.c_im[(g * 16 + c) * 64 + p0 + q];
                v[q] = part ? -(cr * l.y + ci * l.x) : (cr * l.x - ci * l.y); } }
        u32x4 w; w.x = cvt_pk_bf16(v[0], v[1]); w.y = cvt_pk_bf16(v[2], v[3]); w.z = cvt_pk_bf16(v[4], v[5]); w.w = cvt_pk_bf16(v[6], v[7]);
        *(u32x4*)(W + ((size_t)(g * 1024 + n)) * AEK + k8 * 8) = w; }
}

struct S5aSched {
    const char* A; const char* B; int G, c;
    __device__ __forceinline__ bool next(int i, ge::Unit& u) const { const int L = i * G + c; if (L >= 32) return false; u.e = L >> 1; u.pm = L & 1; u.pn = 0; return true; }
    __device__ __forceinline__ const char* a_base(const ge::Unit& u) const { return A + (size_t)(u.e * 512 + u.pm * 256) * AEK * 2; }
    __device__ __forceinline__ const char* b_base(const ge::Unit& u) const { return B + (size_t)u.e * 256 * 1024 * 2; }
    __device__ __forceinline__ int a_row(const ge::Unit&, int) const { return 0; }
};
struct EpiXend {
    static constexpr bool PERM = false;
    float* X;
    __device__ __forceinline__ void operator()(const f32x4 (&acc)[2][2][4][2], const ge::Unit& u, int wr, int wc, int fr, int fq) const {
        float* base = X + (size_t)(u.e * 512 + u.pm * 256 + wr * 64 + fr) * 256 + wc * 32 + 4 * fq;
#pragma unroll
        for (int ai = 0; ai < 2; ++ai)
#pragma unroll
            for (int m = 0; m < 4; ++m)
#pragma unroll
                for (int bj = 0; bj < 2; ++bj)
#pragma unroll
                    for (int n = 0; n < 2; ++n) *(f32x4*)(base + (size_t)(ai * 128 + m * 16) * 256 + bj * 128 + n * 16) = acc[ai][bj][m][n];
    }
};
__device__ __forceinline__ void s5a_phase(const Params& p, LAS unsigned char* lds, int vb, int nvb) {
    S5aSched S{(const char*)(p.ws + OFF_AEXT), (const char*)(p.ws + OFF_MG), nvb, vb};
    EpiXend E{(float*)(p.ws + OFF_XEND)};
    ge::gemm_phase<EpiXend, S5aSched, false>(lds, 1024, AEK, 1024, S, E);
    for (int L = vb; L < 32; L += nvb) {
        const int g = L >> 1, pm = L & 1; int tid = threadIdx.x; asm volatile("" : "+v"(tid));
        const f32x2* Lp = (const f32x2*)(p.out + DO_LP); const f32x2* Bb = (const f32x2*)(p.out + DO_BBAR); const bf16_t* uc = (const bf16_t*)(p.out + DO_UC);
        LAS float* us = (LAS float*)lds; LAS f32x2* xh = (LAS f32x2*)(lds + 32768);
        for (int i = tid; i < 2 * CTXL * 2; i += 512) { const int half = i & 1, row = i >> 1;
            const u32x4 u0 = *(const u32x4*)(uc + (size_t)((pm * 2 + (row >> 8)) * CTXL + (row & 255)) * 256 + g * 16 + half * 8);
            LAS float* d = us + row * 16 + half * 8;
            d[0] = bf_lo(u0.x); d[1] = bf_hi(u0.x); d[2] = bf_lo(u0.y); d[3] = bf_hi(u0.y); d[4] = bf_lo(u0.z); d[5] = bf_hi(u0.z); d[6] = bf_lo(u0.w); d[7] = bf_hi(u0.w); }
        __syncthreads();
        const int hq = tid >> 8, t2 = tid & 255, bb = t2 >> 7, dir = (t2 >> 6) & 1, pp = t2 & 63, b = pm * 2 + bb, dg = dir * 16 + g;
        const f32x2 l1 = Lp[(dg * 64 + pp) * 65 + 1], l64 = Lp[(dg * 64 + pp) * 65 + 64];
        float xr = 0.f, xi = 0.f;
        { float Br[16], Bi[16];
#pragma unroll
          for (int q = 0; q < 16; ++q) { const f32x2 tq = Bb[(dg * 64 + pp) * 16 + q]; Br[q] = tq.x; Bi[q] = tq.y; }
#pragma unroll 4
          for (int s = hq * 128; s < hq * 128 + 128; ++s) { const int lc = dir ? (CTXL - 1 - s) : s;
              const LAS float* up = us + (bb * CTXL + lc) * 16;
              const f32x4 ua = *(const LAS f32x4*)up, ub = *(const LAS f32x4*)(up + 4), uc4 = *(const LAS f32x4*)(up + 8), ud = *(const LAS f32x4*)(up + 12);
              float bur = 0.f, bui = 0.f;
#pragma unroll
              for (int q = 0; q < 4; ++q) { bur += Br[q] * ua[q] + Br[4 + q] * ub[q] + Br[8 + q] * uc4[q] + Br[12 + q] * ud[q]; bui += Bi[q] * ua[q] + Bi[4 + q] * ub[q] + Bi[8 + q] * uc4[q] + Bi[12 + q] * ud[q]; }
              const float nr = l1.x * xr - l1.y * xi + bur, ni = l1.x * xi + l1.y * xr + bui; xr = nr; xi = ni; } }
        if (hq == 1) xh[t2] = (f32x2){xr, xi};
        __syncthreads();
        if (hq == 0) {
            const float l128r = l64.x * l64.x - l64.y * l64.y, l128i = 2.0f * l64.x * l64.y; const f32x2 x2 = xh[t2];
            { const float nr = l128r * xr - l128i * xi + x2.x, ni = l128r * xi + l128i * xr + x2.y; xr = nr; xi = ni; }
            const float* Xe = (const float*)(p.ws + OFF_XEND); bf16_t* Ae = (bf16_t*)(p.ws + OFF_AEXT);
#pragma unroll 8
            for (int s = 0; s < 128; ++s) { const int m = dir ? (127 - s) : s; const size_t row = (size_t)(g * 512 + b * 128 + m);
                Ae[row * AEK + 1024 + dir * 128 + pp] = f2bf(xr); Ae[row * AEK + 1024 + dir * 128 + 64 + pp] = f2bf(xi);
                const float er = Xe[row * 256 + dir * 128 + pp], ei = Xe[row * 256 + dir * 128 + 64 + pp];
                const float nr = l64.x * xr - l64.y * xi + er, ni = l64.x * xi + l64.y * xr + ei; xr = nr; xi = ni; }
        }
        __syncthreads();
    }
}

struct S5bSched {
    const char* A; const char* B; int G, c;
    __device__ __forceinline__ bool next(int i, ge::Unit& u) const { const int L = i * G + c; if (L >= 128) return false; u.e = L >> 3; u.pm = (L >> 2) & 1; u.pn = L & 3; return true; }
    __device__ __forceinline__ const char* a_base(const ge::Unit& u) const { return A + (size_t)(u.e * 512 + u.pm * 256) * AEK * 2; }
    __device__ __forceinline__ const char* b_base(const ge::Unit& u) const { return B + (size_t)(u.e * 1024 + u.pn * 256) * AEK * 2; }
    __device__ __forceinline__ int a_row(const ge::Unit&, int) const { return 0; }
};
struct EpiYs5 {
    static constexpr bool PERM = true;
    bf16_t* Y;
    __device__ __forceinline__ void operator()(const f32x4 (&acc)[2][2][4][2], const ge::Unit& u, int wr, int wc, int fr, int fq) const {
        bf16_t* rp = Y + ((size_t)(u.pm * 256 + wr * 64 + fr) * 64 + u.pn * 16 + wc * 2 + (fq >> 1)) * 256 + u.e * 16 + 8 * (fq & 1);
#pragma unroll
        for (int ai = 0; ai < 2; ++ai)
#pragma unroll
            for (int m = 0; m < 4; ++m) {
#pragma unroll
                for (int bj = 0; bj < 2; ++bj) { f32x4 v0 = acc[ai][bj][m][0], v1 = acc[ai][bj][m][1];
                    asm volatile("" : "+v"(v0), "+v"(v1));
                    u32x4 w; w.x = cvt_pk_bf16(gelu_tanh(v0[0]), gelu_tanh(v0[1])); w.y = cvt_pk_bf16(gelu_tanh(v0[2]), gelu_tanh(v0[3]));
                    w.z = cvt_pk_bf16(gelu_tanh(v1[0]), gelu_tanh(v1[1])); w.w = cvt_pk_bf16(gelu_tanh(v1[2]), gelu_tanh(v1[3]));
                    *(u32x4*)(rp + bj * 8 * 256) = w; asm volatile("" ::: "memory"); }
                rp += (m == 3) ? (size_t)(128 - 48) * 64 * 256 : (size_t)16 * 64 * 256;
                asm volatile("" : "+v"(rp)); }
    }
};
__device__ __forceinline__ void s5b_phase(const Params& p, LAS unsigned char* lds, int vb, int nvb) {
    S5bSched S{(const char*)(p.ws + OFF_AEXT), (const char*)(p.ws + OFF_WEXT), nvb, vb};
    EpiYs5 E{(bf16_t*)(p.ws + OFF_YS5)};
    ge::gemm_phase<EpiYs5, S5bSched, false>(lds, AEK, AEK, AEK, S, E);
}
constexpr size_t DO_KV = 96 * MiB, DO_DEC = 125 * MiB;
constexpr int GLA_SLOTS = 16;
constexpr int GL_QI = 0, GL_KI = 17408, GL_KIT = 34816, GL_VT = 53248, GL_P = 71680, GL_TOT = 80896, GL_EREF = 89088, GL_ETOT = 89600;
constexpr int GLA_NSEG = 8, GLA_SEGC = 16;

template <bool PASS1, int VAR = 0>
__device__ __forceinline__ void gla_unit(const Params& p, LAS unsigned char* lds, const int chain, const int ch0, const int nch, const int nfold) {
    int tid = threadIdx.x; asm volatile("" : "+v"(tid));
    const int w = __builtin_amdgcn_readfirstlane(tid >> 6), lane = tid & 63, vloc = lane & 15, rq = lane >> 4;
    const int dir = chain & 1, h = (chain >> 1) % 6, b = chain / 12;
    const bf16_t* Z = (const bf16_t*)(p.ws + OFF_Z);
    bf16_t* O = (bf16_t*)(p.out + (dir ? DO_OB : DO_OF));
    float* KV = (float*)(p.out + DO_KV); float* DEC = (float*)(p.out + DO_DEC);
    const bool isctx = false; const int slot = 0; (void)slot;
    static_assert(!PASS1, "pass 1 uses gla_pass1_unit");
    const float l0a = p.lb_logits[h * 128 + 2 * lane], l1a = p.lb_logits[768 + h * 128 + 2 * lane], l0b = p.lb_logits[h * 128 + 2 * lane + 1], l1b = p.lb_logits[768 + h * 128 + 2 * lane + 1];
    const float lb0 = frcp_(1.0f + __expf(l1a - l0a)), lb1 = frcp_(1.0f + __expf(l1b - l0b));
    const int colf = (dir ? ZFB : ZFF) + h * 128 + 2 * lane, colq = ZQ + h * 128 + 2 * lane, colv = ZI + h * 128 + 2 * lane;
    auto chunk_rows = [&](int ci, int& base, int& stride) {
        if (isctx) { if (dir == 0) { base = NTOK + b * CTXL + 64 * ci; stride = 1; } else { base = NTOK + b * CTXL + 255 - 64 * ci; stride = -1; } }
        else { const int n = ch0 + ci;
            if (dir == 0) { base = b * SEQ + 4096 * (n & 1) + (n >> 1); stride = 64; }
            else { const int n2 = 127 - n; base = b * SEQ + 4096 * (n2 & 1) + (n2 >> 1) + 64 * 63; stride = -64; } }
    };
    f32x4 S[8];
    if (PASS1) {
#pragma unroll
        for (int it = 0; it < 8; ++it) S[it] = (f32x4){0.f, 0.f, 0.f, 0.f};
    } else {
#pragma unroll
        for (int it = 0; it < 8; ++it) S[it] = (f32x4){0.f, 0.f, 0.f, 0.f};
        for (int sl = 0; sl < nfold; ++sl) {
            const unsigned* kv = (const unsigned*)KV + ((size_t)(chain * GLA_SLOTS + sl) * 8 + w) * 16 * 64 + lane; const float* dc = DEC + (size_t)(chain * GLA_SLOTS + sl) * 128;
#pragma unroll
            for (int it = 0; it < 8; ++it) { const f32x4 d = *(const f32x4*)(dc + 16 * it + 4 * rq); const unsigned w0 = kv[(it * 2) * 64], w1 = kv[(it * 2 + 1) * 64];
                S[it][0] = d[0] * S[it][0] + bf_lo(w0); S[it][1] = d[1] * S[it][1] + bf_hi(w0); S[it][2] = d[2] * S[it][2] + bf_lo(w1); S[it][3] = d[3] * S[it][3] + bf_hi(w1); }
        }
    }
    float dsum0 = 1.f, dsum1 = 1.f;
    unsigned nz[8], nv[8], nq[8];
    { int base, stride; chunk_rows(0, base, stride);
#pragma unroll
      for (int r = 0; r < 8; ++r) { const size_t ro = (size_t)(base + stride * (8 * w + r)) * ZC; nz[r] = *(const unsigned*)(Z + ro + colf); nv[r] = *(const unsigned*)(Z + ro + colv); if (!PASS1) nq[r] = *(const unsigned*)(Z + ro + colq); } }
    for (int ci = 0; ci < nch; ++ci) {
        unsigned cz[8], cv[8], cq[8];
#pragma unroll
        for (int r = 0; r < 8; ++r) { cz[r] = nz[r]; cv[r] = nv[r]; if (!PASS1) cq[r] = nq[r]; }
        int base, stride; chunk_rows(ci, base, stride);
        if (ci + 1 < nch) { int nb_, ns_; chunk_rows(ci + 1, nb_, ns_);
#pragma unroll
            for (int r = 0; r < 8; ++r) { const size_t ro = (size_t)(nb_ + ns_ * (8 * w + r)) * ZC; nz[r] = *(const unsigned*)(Z + ro + colf); nv[r] = *(const unsigned*)(Z + ro + colv); if (!PASS1) nq[r] = *(const unsigned*)(Z + ro + colq); } }
        f32x2 cp[8], kk[8]; f32x2 run = (f32x2){1.0f, 1.0f};
        const f32x2 lbv = (f32x2){lb0, lb1}, one = (f32x2){1.0f, 1.0f}, omlb = one - lbv;
#pragma unroll
        for (int r = 0; r < 8; ++r) { const f32x2 z = (f32x2){bf_lo(cz[r]), bf_hi(cz[r])}; const f32x2 zz = z * (-1.4426950408889634f);
            f32x2 E; E.x = __builtin_amdgcn_exp2f(zz.x); E.y = __builtin_amdgcn_exp2f(zz.y);
            const f32x2 d = one + E; f32x2 D; D.x = frcp_(d.x); D.y = frcp_(d.y);
            const f32x2 f = (one + lbv * E) * D;
            kk[r] = omlb * E * D;
            run = run * f; cp[r] = run; }
        *(LAS f32x2*)(lds + GL_TOT + (w * 128 + 2 * lane) * 4) = run;
        __syncthreads();
        f32x2 pre = one, refp = one, totp = one;
#pragma unroll
        for (int ww = 0; ww < 8; ++ww) { const f32x2 tv = *(const LAS f32x2*)(lds + GL_TOT + (ww * 128 + 2 * lane) * 4);
            if (ww < w) pre = pre * tv; if (ww < 4) refp = refp * tv; totp = totp * tv; }
        dsum0 *= totp.x; dsum1 *= totp.y;
        f32x2 invR; invR.x = frcp_(refp.x); invR.y = frcp_(refp.y);
        { const f32x2 s_q = pre * invR; f32x2 ki[8];
#pragma unroll
          for (int r = 0; r < 8; ++r) { const f32x2 e = s_q * cp[r]; f32x2 ie; ie.x = frcp_(e.x); ie.y = frcp_(e.y);
              ki[r] = kk[r] * ie;
              const int t = 8 * w + r;
              if (!PASS1) { const f32x2 qv = (f32x2){bf_lo(cq[r]), bf_hi(cq[r])} * e;
                            *(LAS unsigned*)(lds + GL_QI + t * 272 + lane * 4) = cvt_pk_bf16(qv.x, qv.y);
                            *(LAS unsigned*)(lds + GL_KI + t * 272 + lane * 4) = cvt_pk_bf16(ki[r].x, ki[r].y); } }
          u32x4 a, bq;
          a.x = cvt_pk_bf16(ki[0].x, ki[1].x); a.y = cvt_pk_bf16(ki[2].x, ki[3].x); a.z = cvt_pk_bf16(ki[4].x, ki[5].x); a.w = cvt_pk_bf16(ki[6].x, ki[7].x);
          bq.x = cvt_pk_bf16(ki[0].y, ki[1].y); bq.y = cvt_pk_bf16(ki[2].y, ki[3].y); bq.z = cvt_pk_bf16(ki[4].y, ki[5].y); bq.w = cvt_pk_bf16(ki[6].y, ki[7].y);
          *(LAS u32x4*)(lds + GL_KIT + (2 * lane) * 144 + 16 * w) = a; *(LAS u32x4*)(lds + GL_KIT + (2 * lane + 1) * 144 + 16 * w) = bq;
          u32x4 va, vb2;
          va.x = (cv[0] & 0xffffu) | (cv[1] << 16); va.y = (cv[2] & 0xffffu) | (cv[3] << 16); va.z = (cv[4] & 0xffffu) | (cv[5] << 16); va.w = (cv[6] & 0xffffu) | (cv[7] << 16);
          vb2.x = (cv[0] >> 16) | (cv[1] & 0xffff0000u); vb2.y = (cv[2] >> 16) | (cv[3] & 0xffff0000u); vb2.z = (cv[4] >> 16) | (cv[5] & 0xffff0000u); vb2.w = (cv[6] >> 16) | (cv[7] & 0xffff0000u);
          *(LAS u32x4*)(lds + GL_VT + (2 * lane) * 144 + 16 * w) = va; *(LAS u32x4*)(lds + GL_VT + (2 * lane + 1) * 144 + 16 * w) = vb2; }
        if (w == 0) { *(LAS f32x2*)(lds + GL_EREF + 2 * lane * 4) = refp; *(LAS f32x2*)(lds + GL_ETOT + 2 * lane * 4) = totp * invR; }
        __syncthreads();
#pragma unroll
        for (int it = 0; it < 8; ++it) { const f32x4 er = *(const LAS f32x4*)(lds + GL_EREF + (16 * it + 4 * rq) * 4); S[it] = S[it] * er; }
        f32x4 o[4];
        if (!PASS1 && VAR != 2) {
            bf16x8 Sb[4];
#pragma unroll
            for (int c = 0; c < 4; ++c) { u32x4 t; t.x = cvt_pk_bf16(S[2 * c][0], S[2 * c][1]); t.y = cvt_pk_bf16(S[2 * c][2], S[2 * c][3]); t.z = cvt_pk_bf16(S[2 * c + 1][0], S[2 * c + 1][1]); t.w = cvt_pk_bf16(S[2 * c + 1][2], S[2 * c + 1][3]); Sb[c] = __builtin_bit_cast(bf16x8, t); }
#pragma unroll
            for (int tt = 0; tt < 4; ++tt) { o[tt] = (f32x4){0.f, 0.f, 0.f, 0.f};
#pragma unroll
                for (int c = 0; c < (VAR == 4 ? 0 : 4); ++c) { const LAS unsigned char* qa = lds + GL_QI + (16 * tt + vloc) * 272 + (32 * c + 4 * rq) * 2;
                    const u32x2 lo = *(const LAS u32x2*)qa, hi = *(const LAS u32x2*)(qa + 32);
                    u32x4 t; t.x = lo.x; t.y = lo.y; t.z = hi.x; t.w = hi.y;
                    o[tt] = __builtin_amdgcn_mfma_f32_16x16x32_bf16(__builtin_bit_cast(bf16x8, t), Sb[c], o[tt], 0, 0, 0); } }
            { const int tt = w >> 1;
#pragma unroll
              for (int sh = 0; sh < (VAR == 5 ? 0 : 2); ++sh) { const int st = 2 * (w & 1) + sh; f32x4 pacc = (f32x4){0.f, 0.f, 0.f, 0.f};
#pragma unroll
                  for (int c = 0; c < 4; ++c) { const bf16x8 ka = *(const LAS bf16x8*)(lds + GL_KI + (16 * st + vloc) * 272 + (32 * c + 8 * rq) * 2);
                      const bf16x8 qb = *(const LAS bf16x8*)(lds + GL_QI + (16 * tt + vloc) * 272 + (32 * c + 8 * rq) * 2);
                      pacc = __builtin_amdgcn_mfma_f32_16x16x32_bf16(ka, qb, pacc, 0, 0, 0); }
                  const int tg = 16 * tt + vloc, sg = 16 * st + 4 * rq;
                  u32x2 pw; pw.x = cvt_pk_bf16(sg + 0 <= tg ? pacc[0] : 0.f, sg + 1 <= tg ? pacc[1] : 0.f); pw.y = cvt_pk_bf16(sg + 2 <= tg ? pacc[2] : 0.f, sg + 3 <= tg ? pacc[3] : 0.f);
                  *(LAS u32x2*)(lds + GL_P + tg * 144 + sg * 2) = pw; } }
        }
        __syncthreads();
        if (VAR != 2) { bf16x8 vb[2];
#pragma unroll
          for (int c = 0; c < 2; ++c) vb[c] = *(const LAS bf16x8*)(lds + GL_VT + (16 * w + vloc) * 144 + (32 * c + 8 * rq) * 2);
          if (!PASS1) {
#pragma unroll
              for (int tt = 0; tt < (VAR == 5 ? 0 : 4); ++tt)
#pragma unroll
                  for (int c = 0; c < 2; ++c) { const bf16x8 pa = *(const LAS bf16x8*)(lds + GL_P + (16 * tt + vloc) * 144 + (32 * c + 8 * rq) * 2); o[tt] = __builtin_amdgcn_mfma_f32_16x16x32_bf16(pa, vb[c], o[tt], 0, 0, 0); }
          }
#pragma unroll
          for (int it = 0; it < 8; ++it)
#pragma unroll
              for (int c = 0; c < 2; ++c) { const bf16x8 ka = *(const LAS bf16x8*)(lds + GL_KIT + (16 * it + vloc) * 144 + (32 * c + 8 * rq) * 2); S[it] = __builtin_amdgcn_mfma_f32_16x16x32_bf16(ka, vb[c], S[it], 0, 0, 0); }
#pragma unroll
          for (int it = 0; it < 8; ++it) { const f32x4 et = *(const LAS f32x4*)(lds + GL_ETOT + (16 * it + 4 * rq) * 4); S[it] = S[it] * et; }
          if (!PASS1) {
#pragma unroll
              for (int tt = 0; tt < 4; ++tt)
#pragma unroll
                  for (int j = 0; j < 4; ++j) { const int t = 16 * tt + 4 * rq + j; if (VAR == 0 || o[tt][j] == 1.2345e-30f) O[(size_t)(base + stride * t) * 768 + h * 128 + 16 * w + vloc] = f2bf(o[tt][j]); }
          } }
    }
    __syncthreads();
}

constexpr int G1_KIT = 0, G1_VT = 34816, G1_TOT = 69632, G1_EREF = 77824, G1_ETOT = 78336;
__device__ __forceinline__ void gla_pass1_unit(const Params& p, LAS unsigned char* lds, const int chain, const int slot) {
    int tid = threadIdx.x; asm volatile("" : "+v"(tid));
    const int w = __builtin_amdgcn_readfirstlane(tid >> 6), lane = tid & 63, vloc = lane & 15, rq = lane >> 4;
    const int dir = chain & 1, h = (chain >> 1) % 6, b = chain / 12;
    const bf16_t* Z = (const bf16_t*)(p.ws + OFF_Z);
    float* KV = (float*)(p.out + DO_KV); float* DEC = (float*)(p.out + DO_DEC);
    const bool isctx = slot == 0;
    const int nst = isctx ? 2 : 4, col0 = isctx ? 0 : (slot - 1) * 4;
    const float l0a = p.lb_logits[h * 128 + 2 * lane], l1a = p.lb_logits[768 + h * 128 + 2 * lane], l0b = p.lb_logits[h * 128 + 2 * lane + 1], l1b = p.lb_logits[768 + h * 128 + 2 * lane + 1];
    const float lb0 = frcp_(1.0f + __expf(l1a - l0a)), lb1 = frcp_(1.0f + __expf(l1b - l0b));
    const int colf = (dir ? ZFB : ZFF) + h * 128 + 2 * lane, colv = ZI + h * 128 + 2 * lane;
    auto step_rows = [&](int j, int& base, int& stride) {
        if (isctx) { if (dir == 0) { base = NTOK + b * CTXL + 128 * j; stride = 1; } else { base = NTOK + b * CTXL + 255 - 128 * j; stride = -1; } }
        else { const int c = col0 + j;
            if (dir == 0) { base = b * SEQ + c; stride = 64; } else { base = b * SEQ + (63 - c) + 64 * 127; stride = -64; } }
    };
    f32x4 S[8];
#pragma unroll
    for (int it = 0; it < 8; ++it) S[it] = (f32x4){0.f, 0.f, 0.f, 0.f};
    float dsum0 = 1.f, dsum1 = 1.f;
    unsigned nz[16], nv[16];
    { int base, stride; step_rows(0, base, stride);
#pragma unroll
      for (int r = 0; r < 16; ++r) { const size_t ro = (size_t)(base + stride * (16 * w + r)) * ZC; nz[r] = *(const unsigned*)(Z + ro + colf); nv[r] = *(const unsigned*)(Z + ro + colv); } }
    for (int j = 0; j < nst; ++j) {
        unsigned cz[16], cv[16];
#pragma unroll
        for (int r = 0; r < 16; ++r) { cz[r] = nz[r]; cv[r] = nv[r]; }
        if (j + 1 < nst) { int nb_, ns_; step_rows(j + 1, nb_, ns_);
#pragma unroll
            for (int r = 0; r < 16; ++r) { const size_t ro = (size_t)(nb_ + ns_ * (16 * w + r)) * ZC; nz[r] = *(const unsigned*)(Z + ro + colf); nv[r] = *(const unsigned*)(Z + ro + colv); } }
        f32x2 cp[16], kk[16]; f32x2 run = (f32x2){1.0f, 1.0f};
        const f32x2 lbv = (f32x2){lb0, lb1}, one = (f32x2){1.0f, 1.0f}, omlb = one - lbv;
#pragma unroll
        for (int r = 0; r < 16; ++r) { const f32x2 z = (f32x2){bf_lo(cz[r]), bf_hi(cz[r])}; const f32x2 zz = z * (-1.4426950408889634f);
            f32x2 E; E.x = __builtin_amdgcn_exp2f(zz.x); E.y = __builtin_amdgcn_exp2f(zz.y);
            const f32x2 d = one + E; f32x2 D; D.x = frcp_(d.x); D.y = frcp_(d.y);
            const f32x2 f = (one + lbv * E) * D; kk[r] = omlb * E * D; run = run * f; cp[r] = run; }
        *(LAS f32x2*)(lds + G1_TOT + (w * 128 + 2 * lane) * 4) = run;
        __syncthreads();
        f32x2 pre = one, refp = one, totp = one;
#pragma unroll
        for (int ww = 0; ww < 8; ++ww) { const f32x2 tv = *(const LAS f32x2*)(lds + G1_TOT + (ww * 128 + 2 * lane) * 4);
            if (ww < w) pre = pre * tv; if (ww < 4) refp = refp * tv; totp = totp * tv; }
        dsum0 *= totp.x; dsum1 *= totp.y;
        f32x2 invR; invR.x = frcp_(refp.x); invR.y = frcp_(refp.y);
        { unsigned k0p[8], k1p[8], v0p[8], v1p[8]; const f32x2 s_q = pre * invR;
#pragma unroll
          for (int r = 0; r < 16; r += 2) { const f32x2 ea = s_q * cp[r], eb = s_q * cp[r + 1]; f32x2 ia, ib; ia.x = frcp_(ea.x); ia.y = frcp_(ea.y); ib.x = frcp_(eb.x); ib.y = frcp_(eb.y);
              const f32x2 ka_ = kk[r] * ia, kb_ = kk[r + 1] * ib;
              k0p[r >> 1] = cvt_pk_bf16(ka_.x, kb_.x); k1p[r >> 1] = cvt_pk_bf16(ka_.y, kb_.y);
              v0p[r >> 1] = (cv[r] & 0xffffu) | (cv[r + 1] << 16); v1p[r >> 1] = (cv[r] >> 16) | (cv[r + 1] & 0xffff0000u); }
          LAS unsigned char* ka = lds + G1_KIT + (2 * lane) * 272 + 32 * w; LAS unsigned char* va = lds + G1_VT + (2 * lane) * 272 + 32 * w;
          *(LAS u32x4*)ka = (u32x4){k0p[0], k0p[1], k0p[2], k0p[3]}; *(LAS u32x4*)(ka + 16) = (u32x4){k0p[4], k0p[5], k0p[6], k0p[7]};
          *(LAS u32x4*)(ka + 272) = (u32x4){k1p[0], k1p[1], k1p[2], k1p[3]}; *(LAS u32x4*)(ka + 272 + 16) = (u32x4){k1p[4], k1p[5], k1p[6], k1p[7]};
          *(LAS u32x4*)va = (u32x4){v0p[0], v0p[1], v0p[2], v0p[3]}; *(LAS u32x4*)(va + 16) = (u32x4){v0p[4], v0p[5], v0p[6], v0p[7]};
          *(LAS u32x4*)(va + 272) = (u32x4){v1p[0], v1p[1], v1p[2], v1p[3]}; *(LAS u32x4*)(va + 272 + 16) = (u32x4){v1p[4], v1p[5], v1p[6], v1p[7]}; }
        if (w == 0) { *(LAS f32x2*)(lds + G1_EREF + 2 * lane * 4) = refp; *(LAS f32x2*)(lds + G1_ETOT + 2 * lane * 4) = totp * invR; }
        __syncthreads();
#pragma unroll
        for (int it = 0; it < 8; ++it) { const f32x4 er = *(const LAS f32x4*)(lds + G1_EREF + (16 * it + 4 * rq) * 4); S[it] = S[it] * er; }
        { bf16x8 vb[4];
#pragma unroll
          for (int c = 0; c < 4; ++c) vb[c] = *(const LAS bf16x8*)(lds + G1_VT + (16 * w + vloc) * 272 + (32 * c + 8 * rq) * 2);
#pragma unroll
          for (int it = 0; it < 8; ++it)
#pragma unroll
              for (int c = 0; c < 4; ++c) { const bf16x8 ka = *(const LAS bf16x8*)(lds + G1_KIT + (16 * it + vloc) * 272 + (32 * c + 8 * rq) * 2); S[it] = __builtin_amdgcn_mfma_f32_16x16x32_bf16(ka, vb[c], S[it], 0, 0, 0); } }
#pragma unroll
        for (int it = 0; it < 8; ++it) { const f32x4 et = *(const LAS f32x4*)(lds + G1_ETOT + (16 * it + 4 * rq) * 4); S[it] = S[it] * et; }
    }
    unsigned* kv = (unsigned*)KV + ((size_t)(chain * GLA_SLOTS + slot) * 8 + w) * 16 * 64 + lane;
#pragma unroll
    for (int it = 0; it < 8; ++it) { kv[(it * 2) * 64] = cvt_pk_bf16(S[it][0], S[it][1]); kv[(it * 2 + 1) * 64] = cvt_pk_bf16(S[it][2], S[it][3]); }
    if (w == 0) *(f32x2*)(DEC + (size_t)(chain * GLA_SLOTS + slot) * 128 + 2 * lane) = (f32x2){dsum0, dsum1};
    __syncthreads();
}

constexpr int G3_IMG = 73728, G3_QI = 0, G3_KI = 17408, G3_KIT = 34816, G3_VT = 53248, G3_EREF = 71680, G3_ETOT = 72192, G3_P = 147456, G3_TOT = 156672;
__device__ __forceinline__ void gla_unit_p3(const Params& p, LAS unsigned char* lds, const int chain, const int ch0, const int nch, const int nfold) {
    int tid = threadIdx.x; asm volatile("" : "+v"(tid));
    const int w = __builtin_amdgcn_readfirstlane(tid >> 6), lane = tid & 63, vloc = lane & 15, rq = lane >> 4;
    const int dir = chain & 1, h = (chain >> 1) % 6, b = chain / 12;
    const bf16_t* Z = (const bf16_t*)(p.ws + OFF_Z);
    bf16_t* O = (bf16_t*)(p.out + (dir ? DO_OB : DO_OF));
    const float* KV = (const float*)(p.out + DO_KV); const float* DEC = (const float*)(p.out + DO_DEC);
    const float l0a = p.lb_logits[h * 128 + 2 * lane], l1a = p.lb_logits[768 + h * 128 + 2 * lane], l0b = p.lb_logits[h * 128 + 2 * lane + 1], l1b = p.lb_logits[768 + h * 128 + 2 * lane + 1];
    const float lb0 = frcp_(1.0f + __expf(l1a - l0a)), lb1 = frcp_(1.0f + __expf(l1b - l0b));
    const int colf = (dir ? ZFB : ZFF) + h * 128 + 2 * lane, colq = ZQ + h * 128 + 2 * lane, colv = ZI + h * 128 + 2 * lane;
    auto chunk_rows = [&](int ci, int& base, int& stride) { const int n = ch0 + ci;
        if (dir == 0) { base = b * SEQ + 4096 * (n & 1) + (n >> 1); stride = 64; }
        else { const int n2 = 127 - n; base = b * SEQ + 4096 * (n2 & 1) + (n2 >> 1) + 64 * 63; stride = -64; } };
    unsigned zA[8], qB[8], vB[8];
    float cl0[8], cl1[8], kk0[8], kk1[8];
    f32x4 S[8], o[4];
#define G3_LOADZ(ci) do { int b_, s_; chunk_rows(ci, b_, s_); _Pragma("unroll") for (int r = 0; r < 8; ++r) zA[r] = *(const unsigned*)(Z + (size_t)(b_ + s_ * (8 * w + r)) * ZC + colf); } while (0)
#define G3_LOADQV(ci) do { int b_, s_; chunk_rows(ci, b_, s_); _Pragma("unroll") for (int r = 0; r < 8; ++r) { const size_t ro = (size_t)(b_ + s_ * (8 * w + r)) * ZC; qB[r] = *(const unsigned*)(Z + ro + colq); vB[r] = *(const unsigned*)(Z + ro + colv); } } while (0)
#define G3_STAGE_A() do { float c0 = 0.f, c1 = 0.f; \
        _Pragma("unroll") for (int r = 0; r < 8; ++r) { const float s0 = sigmoidf_(bf_lo(zA[r])), s1 = sigmoidf_(bf_hi(zA[r])); \
            const float f0 = lb0 + (1.0f - lb0) * s0, f1 = lb1 + (1.0f - lb1) * s1; \
            c0 += __logf(f0); c1 += __logf(f1); cl0[r] = c0; cl1[r] = c1; kk0[r] = (1.0f - lb0) * (1.0f - s0); kk1[r] = (1.0f - lb1) * (1.0f - s1); } \
        *(LAS f32x2*)(lds + G3_TOT + (w * 128 + 2 * lane) * 4) = (f32x2){c0, c1}; } while (0)
#define G3_STAGE_B(IB) do { float pre0 = 0.f, pre1 = 0.f, ref0 = 0.f, ref1 = 0.f, tot0 = 0.f, tot1 = 0.f; \
        _Pragma("unroll") for (int ww = 0; ww < 8; ++ww) { const f32x2 tv = *(const LAS f32x2*)(lds + G3_TOT + (ww * 128 + 2 * lane) * 4); \
            if (ww < w) { pre0 += tv.x; pre1 += tv.y; } if (ww < 4) { ref0 += tv.x; ref1 += tv.y; } tot0 += tv.x; tot1 += tv.y; } \
        float ki0[8], ki1[8]; \
        _Pragma("unroll") for (int r = 0; r < 8; ++r) { const float e0 = __expf(pre0 + cl0[r] - ref0), e1 = __expf(pre1 + cl1[r] - ref1); \
            ki0[r] = kk0[r] * frcp_(e0); ki1[r] = kk1[r] * frcp_(e1); const int t = 8 * w + r; \
            *(LAS unsigned*)(lds + (IB) + G3_QI + t * 272 + lane * 4) = cvt_pk_bf16(bf_lo(qB[r]) * e0, bf_hi(qB[r]) * e1); \
            *(LAS unsigned*)(lds + (IB) + G3_KI + t * 272 + lane * 4) = cvt_pk_bf16(ki0[r], ki1[r]); } \
        u32x4 a_, b_; \
        a_.x = cvt_pk_bf16(ki0[0], ki0[1]); a_.y = cvt_pk_bf16(ki0[2], ki0[3]); a_.z = cvt_pk_bf16(ki0[4], ki0[5]); a_.w = cvt_pk_bf16(ki0[6], ki0[7]); \
        b_.x = cvt_pk_bf16(ki1[0], ki1[1]); b_.y = cvt_pk_bf16(ki1[2], ki1[3]); b_.z = cvt_pk_bf16(ki1[4], ki1[5]); b_.w = cvt_pk_bf16(ki1[6], ki1[7]); \
        *(LAS u32x4*)(lds + (IB) + G3_KIT + (2 * lane) * 144 + 16 * w) = a_; *(LAS u32x4*)(lds + (IB) + G3_KIT + (2 * lane + 1) * 144 + 16 * w) = b_; \
        u32x4 va, vb2; \
        va.x = (vB[0] & 0xffffu) | (vB[1] << 16); va.y = (vB[2] & 0xffffu) | (vB[3] << 16); va.z = (vB[4] & 0xffffu) | (vB[5] << 16); va.w = (vB[6] & 0xffffu) | (vB[7] << 16); \
        vb2.x = (vB[0] >> 16) | (vB[1] & 0xffff0000u); vb2.y = (vB[2] >> 16) | (vB[3] & 0xffff0000u); vb2.z = (vB[4] >> 16) | (vB[5] & 0xffff0000u); vb2.w = (vB[6] >> 16) | (vB[7] & 0xffff0000u); \
        *(LAS u32x4*)(lds + (IB) + G3_VT + (2 * lane) * 144 + 16 * w) = va; *(LAS u32x4*)(lds + (IB) + G3_VT + (2 * lane + 1) * 144 + 16 * w) = vb2; \
        if (w == 0) { *(LAS f32x2*)(lds + (IB) + G3_EREF + 2 * lane * 4) = (f32x2){__expf(ref0), __expf(ref1)}; *(LAS f32x2*)(lds + (IB) + G3_ETOT + 2 * lane * 4) = (f32x2){__expf(tot0 - ref0), __expf(tot1 - ref1)}; } } while (0)
#define G3_STAGE_C(IB) do { \
        _Pragma("unroll") for (int it = 0; it < 8; ++it) { const f32x4 er = *(const LAS f32x4*)(lds + (IB) + G3_EREF + (16 * it + 4 * rq) * 4); S[it] = S[it] * er; } \
        bf16x8 Sb[4]; \
        _Pragma("unroll") for (int c = 0; c < 4; ++c) { u32x4 t; t.x = cvt_pk_bf16(S[2 * c][0], S[2 * c][1]); t.y = cvt_pk_bf16(S[2 * c][2], S[2 * c][3]); t.z = cvt_pk_bf16(S[2 * c + 1][0], S[2 * c + 1][1]); t.w = cvt_pk_bf16(S[2 * c + 1][2], S[2 * c + 1][3]); Sb[c] = __builtin_bit_cast(bf16x8, t); } \
        _Pragma("unroll") for (int tt = 0; tt < 4; ++tt) { o[tt] = (f32x4){0.f, 0.f, 0.f, 0.f}; \
            _Pragma("unroll") for (int c = 0; c < 4; ++c) { const LAS unsigned char* qa = lds + (IB) + G3_QI + (16 * tt + vloc) * 272 + (32 * c + 4 * rq) * 2; \
                const u32x2 lo = *(const LAS u32x2*)qa, hi = *(const LAS u32x2*)(qa + 32); u32x4 t; t.x = lo.x; t.y = lo.y; t.z = hi.x; t.w = hi.y; \
                o[tt] = __builtin_amdgcn_mfma_f32_16x16x32_bf16(__builtin_bit_cast(bf16x8, t), Sb[c], o[tt], 0, 0, 0); } } \
        { const int tt = w >> 1; \
          _Pragma("unroll") for (int sh = 0; sh < 2; ++sh) { const int st = 2 * (w & 1) + sh; f32x4 pacc = (f32x4){0.f, 0.f, 0.f, 0.f}; \
              _Pragma("unroll") for (int c = 0; c < 4; ++c) { const bf16x8 ka = *(const LAS bf16x8*)(lds + (IB) + G3_KI + (16 * st + vloc) * 272 + (32 * c + 8 * rq) * 2); \
                  const bf16x8 qb = *(const LAS bf16x8*)(lds + (IB) + G3_QI + (16 * tt + vloc) * 272 + (32 * c + 8 * rq) * 2); \
                  pacc = __builtin_amdgcn_mfma_f32_16x16x32_bf16(ka, qb, pacc, 0, 0, 0); } \
              const int tg = 16 * tt + vloc, sg = 16 * st + 4 * rq; \
              u32x2 pw; pw.x = cvt_pk_bf16(sg + 0 <= tg ? pacc[0] : 0.f, sg + 1 <= tg ? pacc[1] : 0.f); pw.y = cvt_pk_bf16(sg + 2 <= tg ? pacc[2] : 0.f, sg + 3 <= tg ? pacc[3] : 0.f); \
              *(LAS u32x2*)(lds + G3_P + tg * 144 + sg * 2) = pw; } } } while (0)
#define G3_STAGE_D(IB, CI) do { bf16x8 vb[2]; \
        _Pragma("unroll") for (int c = 0; c < 2; ++c) vb[c] = *(const LAS bf16x8*)(lds + (IB) + G3_VT + (16 * w + vloc) * 144 + (32 * c + 8 * rq) * 2); \
        _Pragma("unroll") for (int tt = 0; tt < 4; ++tt) _Pragma("unroll") for (int c = 0; c < 2; ++c) { const bf16x8 pa = *(const LAS bf16x8*)(lds + G3_P + (16 * tt + vloc) * 144 + (32 * c + 8 * rq) * 2); o[tt] = __builtin_amdgcn_mfma_f32_16x16x32_bf16(pa, vb[c], o[tt], 0, 0, 0); } \
        _Pragma("unroll") for (int it = 0; it < 8; ++it) _Pragma("unroll") for (int c = 0; c < 2; ++c) { const bf16x8 ka = *(const LAS bf16x8*)(lds + (IB) + G3_KIT + (16 * it + vloc) * 144 + (32 * c + 8 * rq) * 2); S[it] = __builtin_amdgcn_mfma_f32_16x16x32_bf16(ka, vb[c], S[it], 0, 0, 0); } \
        _Pragma("unroll") for (int it = 0; it < 8; ++it) { const f32x4 et = *(const LAS f32x4*)(lds + (IB) + G3_ETOT + (16 * it + 4 * rq) * 4); S[it] = S[it] * et; } \
        { int b_, s_; chunk_rows(CI, b_, s_); \
          _Pragma("unroll") for (int tt = 0; tt < 4; ++tt) _Pragma("unroll") for (int j = 0; j < 4; ++j) { const int t = 16 * tt + 4 * rq + j; O[(size_t)(b_ + s_ * t) * 768 + h * 128 + 16 * w + vloc] = f2bf(o[tt][j]); } } } while (0)
    G3_LOADZ(0); G3_LOADQV(0);
#pragma unroll
    for (int it = 0; it < 8; ++it) S[it] = (f32x4){0.f, 0.f, 0.f, 0.f};
    for (int sl = 0; sl < nfold; ++sl) {
        const unsigned* kv = (const unsigned*)KV + ((size_t)(chain * GLA_SLOTS + sl) * 8 + w) * 16 * 64 + lane; const float* dc = DEC + (size_t)(chain * GLA_SLOTS + sl) * 128;
#pragma unroll
        for (int it = 0; it < 8; ++it) { const f32x4 d = *(const f32x4*)(dc + 16 * it + 4 * rq); const unsigned w0 = kv[(it * 2) * 64], w1 = kv[(it * 2 + 1) * 64];
            S[it][0] = d[0] * S[it][0] + bf_lo(w0); S[it][1] = d[1] * S[it][1] + bf_hi(w0); S[it][2] = d[2] * S[it][2] + bf_lo(w1); S[it][3] = d[3] * S[it][3] + bf_hi(w1); }
    }
    G3_STAGE_A();
    if (1 < nch) G3_LOADZ(1);
    __syncthreads();
    G3_STAGE_B(0);
    if (1 < nch) G3_LOADQV(1);
    __syncthreads();
    if (1 < nch) { G3_STAGE_A(); if (2 < nch) G3_LOADZ(2); }
    __syncthreads();
    for (int n = 0; n < nch; ++n) {
        const int ib = (n & 1) * G3_IMG, ib1 = ((n + 1) & 1) * G3_IMG;
        if (w < 4) { G3_STAGE_C(ib); G3_STAGE_B(ib1); } else { G3_STAGE_B(ib1); G3_STAGE_C(ib); }
        G3_LOADQV(n + 2 < nch ? n + 2 : nch - 1);
        __syncthreads();
        if (w < 4) { G3_STAGE_D(ib, n); G3_STAGE_A(); } else { G3_STAGE_A(); G3_STAGE_D(ib, n); }
        G3_LOADZ(n + 3 < nch ? n + 3 : nch - 1);
        __syncthreads();
    }
#undef G3_LOADZ
#undef G3_LOADQV
#undef G3_STAGE_A
#undef G3_STAGE_B
#undef G3_STAGE_C
#undef G3_STAGE_D
}
__device__ __forceinline__ void yb_rows(const Params& p, const int r0, const int nrows) {
    int tid = threadIdx.x; asm volatile("" : "+v"(tid));
    const int wid = tid >> 6, lane = tid & 63;
    const bf16_t* Of = (const bf16_t*)(p.out + DO_OF); const bf16_t* Ob = (const bf16_t*)(p.out + DO_OB); const bf16_t* Z = (const bf16_t*)(p.ws + OFF_Z); bf16_t* Yb = (bf16_t*)(p.ws + OFF_YB);
    const float gn0 = p.hg_norm_g[lane * 2], gn1 = p.hg_norm_g[lane * 2 + 1];
    for (int t = r0 + wid; t < r0 + nrows; t += 8) {
        unsigned a[6], bb[6], gw[6];
#pragma unroll
        for (int h = 0; h < 6; ++h) { const int col = h * 128 + lane * 2; a[h] = *(const unsigned*)(Of + (size_t)t * 768 + col); bb[h] = *(const unsigned*)(Ob + (size_t)t * 768 + col); gw[h] = *(const unsigned*)(Z + (size_t)t * ZC + ZGO + col); }
#pragma unroll
        for (int h = 0; h < 6; ++h) {
            const int col = h * 128 + lane * 2;
            const float o0 = bf_lo(a[h]) + bf_lo(bb[h]), o1 = bf_hi(a[h]) + bf_hi(bb[h]);
            const float ss = wave_sum(o0 * o0 + o1 * o1);
            const float rstd = rsqrtf(ss * (1.0f / 128.0f) + EPSF);
            *(unsigned*)(Yb + (size_t)t * 768 + col) = cvt_pk_bf16(o0 * rstd * gn0 * siluf_(bf_lo(gw[h])), o1 * rstd * gn1 * siluf_(bf_hi(gw[h])));
        }
    }
}

constexpr int RT_AHI = 0, RT_ALO = 66048, RT_LG = 132096, RT_ROW = 2064, RT_HIST = 144 * 1024 - 1024 + 256;
__device__ __forceinline__ void router_w_phase(const Params& p) {
    bf16_t* hi = (bf16_t*)(p.ws + OFF_WRT); bf16_t* lo = hi + 64 * 1024;
    for (int i = blockIdx.x * blockDim.x + threadIdx.x; i < 64 * 1024; i += gridDim.x * blockDim.x) { const int k = i >> 6, e = i & 63;
        const float w = p.w_router[i]; const bf16_t h = f2bf(w); hi[e * 1024 + k] = h; lo[e * 1024 + k] = f2bf(w - bf2f(h)); }
}
__device__ __forceinline__ void route_phase(const Params& p, LAS unsigned char* lds) {
    int tid = threadIdx.x; asm volatile("" : "+v"(tid));
    const int wid = __builtin_amdgcn_readfirstlane(tid >> 6), lane = tid & 63, vloc = lane & 15, rq = lane >> 4;
    LAS int* hist = (LAS int*)(lds + RT_HIST);
    const float* X1 = (const float*)(p.out + DO_X1); const float* mod = (const float*)(p.ws + OFF_MOD);
    const bf16_t* Whi = (const bf16_t*)(p.ws + OFF_WRT); const bf16_t* Wlo = Whi + 64 * 1024;
    unsigned char* H2 = p.ws + OFF_H2;
    int* eidx = (int*)(p.ws + OFF_EIDX); float* wts = (float*)(p.ws + OFF_WTS); int* lrank = (int*)(p.ws + OFF_APOS); int* lst = (int*)(p.ws + OFF_LIST);
    const int nb = (int)gridDim.x, TPB = (NTOK + nb - 1) / nb, tb0 = (int)blockIdx.x * TPB;
    if (blockIdx.x == 0) for (int i = tid; i < 256; i += 512) *(unsigned*)(H2 + (size_t)NTOK * 1024 + i * 4) = 0u;
    if (tid < 64) hist[tid] = 0;
    const float brl = p.b_router[lane];
    const int tm = wid >> 2, tn = wid & 3;
    const bool onebatch = (tb0 / SEQ) == ((tb0 + TPB - 1) / SEQ);
    f32x4 gq[4], shq[4], scq[4];
    { const float* mr = mod + (size_t)(tb0 / SEQ) * NIN;
#pragma unroll
      for (int j = 0; j < 4; ++j) { const int k = j * 256 + lane * 4; gq[j] = *(const f32x4*)(p.norm2_g + k); shq[j] = *(const f32x4*)(mr + 3072 + k); scq[j] = *(const f32x4*)(mr + 4096 + k); } }
    f32x4 vq[4][4];
    { const int t0 = tb0 + wid * 4;
#pragma unroll
      for (int q = 0; q < 4; ++q) { const int t = (t0 + q < NTOK) ? t0 + q : NTOK - 1;
#pragma unroll
          for (int j = 0; j < 4; ++j) vq[q][j] = *(const f32x4*)(X1 + (size_t)t * 1024 + j * 256 + lane * 4); } }
    for (int it = 0; it * 32 < TPB; ++it) {
        const int t0 = tb0 + it * 32 + wid * 4;
#pragma unroll
        for (int q = 0; q < 4; ++q) { const int t = t0 + q, row = wid * 4 + q;
            if (t < NTOK && t < tb0 + TPB) { const float* mr = mod + (size_t)(t / SEQ) * NIN;
                f32x4 v[4]; float ss = 0.f;
#pragma unroll
                for (int j = 0; j < 4; ++j) { v[j] = vq[q][j]; ss += v[j][0] * v[j][0] + v[j][1] * v[j][1] + v[j][2] * v[j][2] + v[j][3] * v[j][3]; }
                ss = wave_sum(ss); const float rstd = rsqrtf(ss * (1.0f / 1024.0f) + EPSF);
#pragma unroll
                for (int j = 0; j < 4; ++j) { const int k = j * 256 + lane * 4;
                    f32x4 g = gq[j], sh = shq[j], scv = scq[j];
                    if (!onebatch) { sh = *(const f32x4*)(mr + 3072 + k); scv = *(const f32x4*)(mr + 4096 + k); }
                    f32x4 o;
#pragma unroll
                    for (int e = 0; e < 4; ++e) o[e] = v[j][e] * rstd * g[e] * (1.0f + scv[e]) + sh[e];
                    u32x2 wh; wh.x = cvt_pk_bf16(o[0], o[1]); wh.y = cvt_pk_bf16(o[2], o[3]);
                    u32x2 wl; wl.x = cvt_pk_bf16(o[0] - bf_lo(wh.x), o[1] - bf_hi(wh.x)); wl.y = cvt_pk_bf16(o[2] - bf_lo(wh.y), o[3] - bf_hi(wh.y));
                    *(LAS u32x2*)(lds + RT_AHI + row * RT_ROW + k * 2) = wh; *(LAS u32x2*)(lds + RT_ALO + row * RT_ROW + k * 2) = wl;
                    *(unsigned*)(H2 + (size_t)t * 1024 + k) = pack_fp8x4(o[0], o[1], o[2], o[3]); } }
            else {
#pragma unroll
                for (int j = 0; j < 4; ++j) { const int k = j * 256 + lane * 4; *(LAS u32x2*)(lds + RT_AHI + row * RT_ROW + k * 2) = (u32x2){0u, 0u}; *(LAS u32x2*)(lds + RT_ALO + row * RT_ROW + k * 2) = (u32x2){0u, 0u}; } } }
        if ((it + 1) * 32 < TPB) { const int t1 = t0 + 32;
#pragma unroll
            for (int q = 0; q < 4; ++q) { const int t = (t1 + q < NTOK) ? t1 + q : NTOK - 1;
#pragma unroll
                for (int j = 0; j < 4; ++j) vq[q][j] = *(const f32x4*)(X1 + (size_t)t * 1024 + j * 256 + lane * 4); } }
        __syncthreads();
        { f32x4 acc = (f32x4){0.f, 0.f, 0.f, 0.f};
          const LAS unsigned char* ah_p = lds + RT_AHI + (16 * tm + vloc) * RT_ROW + rq * 16; const LAS unsigned char* al_p = lds + RT_ALO + (16 * tm + vloc) * RT_ROW + rq * 16;
          const bf16_t* bh_p = Whi + (size_t)(16 * tn + vloc) * 1024 + rq * 8; const bf16_t* bl_p = Wlo + (size_t)(16 * tn + vloc) * 1024 + rq * 8;
#pragma unroll 8
          for (int c = 0; c < 32; ++c) { const bf16x8 ah = *(const LAS bf16x8*)(ah_p + c * 64), al = *(const LAS bf16x8*)(al_p + c * 64);
              const bf16x8 bh = *(const bf16x8*)(bh_p + c * 32), bl = *(const bf16x8*)(bl_p + c * 32);
              acc = __builtin_amdgcn_mfma_f32_16x16x32_bf16(ah, bh, acc, 0, 0, 0); acc = __builtin_amdgcn_mfma_f32_16x16x32_bf16(al, bh, acc, 0, 0, 0); acc = __builtin_amdgcn_mfma_f32_16x16x32_bf16(ah, bl, acc, 0, 0, 0); }
          LAS float* lg = (LAS float*)(lds + RT_LG);
#pragma unroll
          for (int j = 0; j < 4; ++j) lg[(16 * tm + 4 * rq + j) * 64 + 16 * tn + vloc] = acc[j]; }
        __syncthreads();
#pragma unroll
        for (int q = 0; q < 4; ++q) { const int t = t0 + q; const float logit = ((const LAS float*)(lds + RT_LG))[(wid * 4 + q) * 64 + lane];
            if (t < NTOK && t < tb0 + TPB) {
                const float sc = 1.0f / (1.0f + __expf(-logit)), bs = sc + brl;
                float m1 = bs;
                m1 = fmaxf(m1, dpp_mov_<0xB1>(m1)); m1 = fmaxf(m1, dpp_mov_<0x4E>(m1)); m1 = fmaxf(m1, dpp_mov_<0x141>(m1));
                const unsigned long long ism = __ballot(bs == m1);
                const int gbase = lane & ~7; const unsigned gm = (unsigned)((ism >> gbase) & 0xffull);
                const int first = gbase + __builtin_ctz(gm);
                float m2 = (lane == first) ? -INFINITY : bs;
                m2 = fmaxf(m2, dpp_mov_<0xB1>(m2)); m2 = fmaxf(m2, dpp_mov_<0x4E>(m2)); m2 = fmaxf(m2, dpp_mov_<0x141>(m2));
                const float gs = m1 + m2; const int gid = lane >> 3;
                int grank = 0;
#pragma unroll
                for (int g2 = 0; g2 < 8; ++g2) { const float og = __int_as_float(__builtin_amdgcn_readlane(__float_as_int(gs), g2 * 8)); grank += (og > gs || (og == gs && g2 < gid)) ? 1 : 0; }
                const bool gok = grank < 4;
                const float mk = gok ? bs : -INFINITY;
                int rank = 0;
#pragma unroll
                for (int e2 = 0; e2 < 64; ++e2) { const float ov = __int_as_float(__builtin_amdgcn_readlane(__float_as_int(mk), e2)); rank += (ov > mk || (ov == mk && e2 < lane)) ? 1 : 0; }
                const bool sel = gok && rank < TOPK;
                const float wsum = wave_sum(sel ? sc : 0.f);
                if (sel) { const int lr = __hip_atomic_fetch_add(hist + lane, 1, __ATOMIC_RELAXED, __HIP_MEMORY_SCOPE_WORKGROUP);
                    eidx[t * 8 + rank] = lane; wts[t * 8 + rank] = sc / wsum * 2.5f; lrank[t * 8 + rank] = lr; lst[((size_t)blockIdx.x * 64 + lane) * 128 + lr] = t * 8 + rank; } } }
    }
    __syncthreads();
    if (tid < 64) ((int*)(p.ws + OFF_BCNT))[blockIdx.x * 64 + tid] = hist[tid];
    __syncthreads();
}

__device__ __forceinline__ void scatter_phase(const Params& p, LAS unsigned char* lds) {
    int tid = threadIdx.x; asm volatile("" : "+v"(tid));
    int* cnt = (int*)(p.ws + OFF_CNT); int* pstart = cnt + 128; int* nblk = cnt + 256; int* blk_e = (int*)(p.ws + OFF_BLKE);
    const int* bc = (const int*)(p.ws + OFF_BCNT);
    const int* eidx = (const int*)(p.ws + OFF_EIDX); int* apos = (int*)(p.ws + OFF_APOS); int* row_tok = (int*)(p.ws + OFF_ROWTOK);
    LAS int* tot = (LAS int*)lds; LAS int* ps = tot + 64; LAS int* ms = ps + 72;
    const int nb = (int)gridDim.x, bid = (int)blockIdx.x, TPB = (NTOK + nb - 1) / nb, tb0 = bid * TPB;
    LAS int* part = ms + 64;
    { const int e = tid & 63, pg = tid >> 6, per = (nb + 7) / 8; int t = 0, bl = 0;
#pragma unroll 8
      for (int wg = pg * per; wg < (pg + 1) * per; ++wg) if (wg < nb) { const int c = bc[wg * 64 + e]; if (wg < bid) bl += c; t += c; }
      part[(pg * 2 + 0) * 64 + e] = t; part[(pg * 2 + 1) * 64 + e] = bl; }
    __syncthreads();
    int below = 0;
    if (tid < 64) { int t = 0;
#pragma unroll
        for (int pg = 0; pg < 8; ++pg) { t += part[(pg * 2 + 0) * 64 + tid]; below += part[(pg * 2 + 1) * 64 + tid]; }
        tot[tid] = t; }
    __syncthreads();
    if (tid == 0) { int a = 0; for (int e = 0; e < 64; ++e) { ps[e] = a; a += (tot[e] + 255) / 256 * 256; } ps[64] = a; ps[65] = a + NTOK; }
    __syncthreads();
    if (tid < 64) ms[tid] = ps[tid] + below;
    __syncthreads();
    int* row_dst = (int*)(p.ws + OFF_ROWDST);
    for (int i = tid; i < TPB * 8; i += 512) { const int t = tb0 + (i >> 3); if (t < NTOK) { const int idx = t * 8 + (i & 7); const int e = eidx[idx]; const int pos = ms[e] + apos[idx]; row_tok[pos] = t; row_dst[pos] = idx; } }
    for (int e = bid; e < 64; e += nb) for (int j = tid; j < 256; j += 512) { const int pos = ps[e] + tot[e] + j; if (pos < ps[e + 1]) { row_tok[pos] = NTOK; row_dst[pos] = -1; } }
    for (int i = tid; i < TPB; i += 512) { const int t = tb0 + i; if (t < NTOK) row_tok[ps[64] + t] = t; }
    if (bid == 0) {
        if (tid < 66) pstart[tid] = ps[tid];
        if (tid == 0) *nblk = ps[65] / 256;
        for (int rb = tid; rb < ps[65] / 256; rb += 512) { int e = 0; while (e < 64 && rb * 256 >= ps[e + 1]) ++e; blk_e[rb] = e; }
    }
    __syncthreads();
}

__device__ __forceinline__ void combine_phase(const Params& p) {
    int tid = threadIdx.x; asm volatile("" : "+v"(tid));
    const int wid = tid >> 6, lane = tid & 63;
    const float* X1 = (const float*)(p.out + DO_X1); const float* mod = (const float*)(p.ws + OFF_MOD); const unsigned char* Y2 = (const unsigned char*)(p.ws + OFF_Y2);
    const unsigned char* Y2s = (const unsigned char*)(p.ws + OFF_Y2S);
    const float* wts = (const float*)(p.ws + OFF_WTS); float* out = (float*)p.out;
    f32x4 gf[4];
#pragma unroll
    for (int j = 0; j < 4; ++j) gf[j] = *(const f32x4*)(p.final_g + lane * 16 + 4 * j);
    const int stride = gridDim.x * 8;
    int t = blockIdx.x * 8 + wid;
    u32x4 yv[8]; float wk[8]; f32x4 xv[4]; u32x4 sv;
    if (t < NTOK) {
#pragma unroll
        for (int k = 0; k < TOPK; ++k) { wk[k] = wts[t * 8 + k]; yv[k] = *(const u32x4*)(Y2 + (size_t)(t * 8 + k) * 1024 + lane * 16); }
#pragma unroll
        for (int j = 0; j < 4; ++j) xv[j] = *(const f32x4*)(X1 + (size_t)t * 1024 + lane * 16 + 4 * j);
        sv = *(const u32x4*)(Y2s + (size_t)t * 1024 + lane * 16); }
    for (; t < NTOK; t += stride) {
        const float* g2 = mod + (size_t)(t / SEQ) * NIN + 5120 + lane * 16;
        f32x4 a[4];
#pragma unroll
        for (int j = 0; j < 4; ++j) { const int wd = (int)sv[j]; const f32x2 lo = __builtin_amdgcn_cvt_pk_f32_fp8(wd, false), hi = __builtin_amdgcn_cvt_pk_f32_fp8(wd, true); a[j] = (f32x4){lo.x, lo.y, hi.x, hi.y}; }
#pragma unroll
        for (int k = 0; k < TOPK; ++k) {
#pragma unroll
            for (int j = 0; j < 4; ++j) { const int wd = (int)yv[k][j]; const f32x2 lo = __builtin_amdgcn_cvt_pk_f32_fp8(wd, false), hi = __builtin_amdgcn_cvt_pk_f32_fp8(wd, true);
                a[j][0] += wk[k] * lo.x; a[j][1] += wk[k] * lo.y; a[j][2] += wk[k] * hi.x; a[j][3] += wk[k] * hi.y; } }
        f32x4 xo[4]; float ss = 0.f;
#pragma unroll
        for (int j = 0; j < 4; ++j) { const f32x4 gv = *(const f32x4*)(g2 + 4 * j); xo[j] = xv[j] + gv * a[j]; ss += xo[j][0] * xo[j][0] + xo[j][1] * xo[j][1] + xo[j][2] * xo[j][2] + xo[j][3] * xo[j][3]; }
        asm volatile("" : "+v"(xo[0]), "+v"(xo[1]), "+v"(xo[2]), "+v"(xo[3]));
        const int t2 = t + stride;
        if (t2 < NTOK) {
#pragma unroll
            for (int k = 0; k < TOPK; ++k) { wk[k] = wts[t2 * 8 + k]; yv[k] = *(const u32x4*)(Y2 + (size_t)(t2 * 8 + k) * 1024 + lane * 16); }
#pragma unroll
            for (int j = 0; j < 4; ++j) xv[j] = *(const f32x4*)(X1 + (size_t)t2 * 1024 + lane * 16 + 4 * j);
            sv = *(const u32x4*)(Y2s + (size_t)t2 * 1024 + lane * 16); }
        ss = wave_sum(ss); const float rstd = rsqrtf(ss * (1.0f / 1024.0f) + EPSF);
        float* op = out + (size_t)t * 1024 + lane * 16;
#pragma unroll
        for (int j = 0; j < 4; ++j) *(f32x4*)(op + 4 * j) = xo[j] * rstd * gf[j];
    }
}
constexpr int FUSED_LDS = 144 * 1024;
constexpr int PROBE_DUP = 0;
constexpr int PROBE_PHASE = -1;

template <int PA, int PB> __global__ __launch_bounds__(512, 2) void k_fwd(Params p) {
    extern __shared__ __attribute__((aligned(16))) unsigned char shm[];
    LAS unsigned char* lds = (LAS unsigned char*)shm;
    LAS unsigned* xbw = (LAS unsigned*)(lds + FUSED_LDS - 1024);
    if (threadIdx.x == 0) { xbw[0] = 0u; xbw[1] = 0u; xbw[2] = 0u; xbw[3] = 0u; }
    __syncthreads();
    XcdBarrier bar = xcd_barrier_post((unsigned*)(p.ws + OFF_BAR), (volatile LAS unsigned*)xbw);
    const int nb = (int)gridDim.x, bid = (int)blockIdx.x;
    unsigned long long t_start = 0, t_mark = 0, w_acc = 0; if constexpr (PROBE_PHASE >= 0) t_start = __builtin_amdgcn_s_memrealtime();
    const int* cnt = (const int*)(p.ws + OFF_CNT);
#define PH(k) if constexpr (PA <= (k) && (k) < PB)
#define BARRIER(k) if constexpr (PROBE_PHASE == 100) { if ((k) == 13 && threadIdx.x == 0) atomicAdd((unsigned long long*)(p.ws + OFF_PAIR), w_acc); const unsigned long long t_a = __builtin_amdgcn_s_memrealtime(); xcd_barrier(bar); w_acc += __builtin_amdgcn_s_memrealtime() - t_a; if ((k) == 13) t_mark = *(volatile unsigned long long*)(p.ws + OFF_PAIR) / gridDim.x; } else { if constexpr (PA <= (k) && (k) + 1 < PB) xcd_barrier(bar); if constexpr ((k) == PROBE_PHASE) t_mark = __builtin_amdgcn_s_memrealtime() - t_start; }
    PH(0) { if (bid == 0 && threadIdx.x < 128) ((int*)(p.ws + OFF_CNT))[threadIdx.x] = 0;
            ada_phase(p, lds); s5_tab1_phase(p); }
    BARRIER(0);
    PH(1) { cvt_dense_phase(p, lds); if constexpr (PROBE_DUP == 15) cvt_dense_phase(p, lds); norm1_phase(p); if constexpr (PROBE_DUP == 1) norm1_phase(p); s5_tab2_phase(p, bid, nb); router_w_phase(p); }
    BARRIER(1);
    PH(2) { EpiZ2 E{(bf16_t*)(p.ws + OFF_AEXT), (bf16_t*)(p.out + DO_UC), (bf16_t*)(p.ws + OFF_Z)};
      if constexpr (Z_FP8) { { ZSchedF8 S; S.init(p.out + DO_H8, p.out + DO_W8); ge::gemm_phase_f8<EpiZ2, ZSchedF8, true>(lds, 512, 512, 512, S, E); }
 }
      else { PlainSched S; S.init(p.ws + OFF_H, 1024, p.ws + OFF_WINT, 1024, NROWS / 256, NIN / 256); ge::gemm_phase<EpiZ2, PlainSched, false>(lds, 1024, 1024, 1024, S, E); } }
    BARRIER(2);
    PH(3) { if (bid < 32) s5a_phase(p, lds, bid, 32);
            else for (int u = bid - 32; u < 48 * GLA_SLOTS; u += nb - 32) gla_pass1_unit(p, lds, u >> 4, u & 15);
            s5_wfill_phase(p, bid, nb); if constexpr (PROBE_DUP == 12) s5_wfill_phase(p, bid, nb); }
    BARRIER(3);
    PH(4) { if (nb == 256) {
                if (bid < 240) { const int chain = bid / 5, q = bid % 5; gla_unit<false>(p, lds, chain, 24 * q, 24, 3 * q + 1);
                    const int r = q * 48 + chain; if (r < 128) s5b_phase(p, lds, r, 128); }
                else for (int k = 0; k < 3; ++k) gla_unit<false>(p, lds, (bid - 240) * 3 + k, 120, 8, 16);
            } else {
                for (int u = bid; u < 48 * 6; u += nb) { const int chain = u / 6, q = u % 6; gla_unit<false>(p, lds, chain, 24 * q, q < 5 ? 24 : 8, 3 * q + 1); }
                s5b_phase(p, lds, bid, nb);
            } }
    BARRIER(4);
    PH(5) { for (int item = bid; item < (NTOK / 256) * 2; item += nb) { const int pm = item >> 1, half = item & 1;
                yb_rows(p, pm * 256, 256);
                { OneUnitSched S{(const char*)(p.ws + OFF_YS5), (const char*)(p.ws + OFF_GLUT), pm};
                  EpiYa E{(const bf16_t*)(p.ws + OFF_YS5), (bf16_t*)(p.ws + OFF_YA)};
                  ge::gemm_phase<EpiYa, OneUnitSched, false>(lds, 256, 256, 256, S, E); }
                { PanelMergeSched S{(const char*)(p.ws + OFF_YA), (const char*)(p.ws + OFF_YB), (const char*)(p.ws + OFF_PAT), (const char*)(p.ws + OFF_PBT), pm, 2 * half};
                  EpiMergeF<false> E{(const bf16_t*)(p.ws + OFF_Z), (bf16_t*)(p.ws + OFF_Z), ZC};
                  ge::gemm_phase_v<EpiMergeF<false>, PanelMergeSched>(lds, S, E); } } }
    BARRIER(5);
    PH(6) { }
    PH(7) { }
    PH(8) { if (bid & 1) cvt_moe_phase(p, lds);
      { PlainSched S; S.init(p.ws + OFF_Z, ZC, p.ws + OFF_WOUTT, 1024, NTOK / 256, 4);
        EpiX1<false> E{p.x, (const float*)(p.ws + OFF_MOD), (float*)(p.out + DO_X1)};
        ge::gemm_phase<EpiX1<false>, PlainSched, false>(lds, 1024, ZC, 1024, S, E); }
      if (!(bid & 1)) cvt_moe_phase(p, lds); }
    BARRIER(8);
    PH(9) { route_phase(p, lds); if constexpr (PROBE_DUP == 5) route_phase(p, lds); }
    BARRIER(9);
    PH(10) { }
    PH(11) { }
    PH(12) { moe_pull_prep(p, lds);
      MoeSched1P S{lds, (const char*)(p.ws + OFF_H2), (const char*)(p.ws + OFF_BT1)};
      EpiHid E{p.ws, p.out};
      ge::gemm_phase_f8<EpiHid, MoeSched1P, true>(lds, 512, 512, 512, S, E); }
    BARRIER(12);
    PH(13) { MoeSched2 S{(const int*)(p.ws + OFF_BLKE), cnt + 256, p.ws, p.out, (const char*)(p.ws + OFF_BT2), nb, bid};
      EpiY2 E{(unsigned char*)(p.ws + OFF_Y2), (unsigned char*)(p.ws + OFF_Y2S), cnt + 128, (const int*)(p.ws + OFF_ROWDST)};
      ge::gemm_phase_f8<EpiY2, MoeSched2, true>(lds, 128, 128, 128, S, E); }
    if constexpr (PROBE_DUP == 6) { MoeSched2R S{(const int*)(p.ws + OFF_BLKE), cnt + 128, p.ws, p.out, (const char*)(p.ws + OFF_BT2), nb, bid};
      EpiY2 E{(unsigned char*)(p.ws + OFF_Y2), (unsigned char*)(p.ws + OFF_Y2S), cnt + 128, (const int*)(p.ws + OFF_ROWDST)};
      ge::gemm_phase<EpiY2, MoeSched2R, false>(lds, 256, 256, 256, S, E); }
    if constexpr (PROBE_DUP == 7) { MoeSched2R S{(const int*)(p.ws + OFF_BLKE), cnt + 128, p.ws, p.out, (const char*)(p.ws + OFF_BT2), nb, bid};
      EpiNull E{(float*)(p.ws + OFF_BCNT)};
      ge::gemm_phase<EpiNull, MoeSched2R, false>(lds, 256, 256, 256, S, E); }
    BARRIER(13);
    PH(14) { combine_phase(p); if constexpr (PROBE_DUP == 3) combine_phase(p); if constexpr (PROBE_DUP == 4) { for (int r = 0; r < 10; ++r) xcd_barrier(bar); } }
#undef PH
#undef BARRIER
    if constexpr (PROBE_PHASE >= 0) { if (bid == 0 && threadIdx.x == 0) { const unsigned long long t0 = __builtin_amdgcn_s_memrealtime(); while (__builtin_amdgcn_s_memrealtime() - t0 < t_mark) __builtin_amdgcn_s_sleep(8); } }
}


static Params make_params(void* const* d_in, void* d_out, void* d_ws) {
    Params p{};
    const float** f = (const float**)&p;
    for (int i = 0; i < 32; ++i) f[i] = (const float*)d_in[i];
    p.ws = (unsigned char*)d_ws; p.out = (unsigned char*)d_out;
    return p;
}

extern "C" void kernel_launch(void* const* d_in, const int* in_sizes, int n_in, void* d_out, int out_size, void* d_ws, size_t ws_size, hipStream_t stream) {
    (void)in_sizes; (void)n_in; (void)out_size; (void)ws_size;
    static int grid = 0;
    if (!grid) {
        (void)hipFuncSetAttribute((const void*)k_fwd<0, 17>, hipFuncAttributeMaxDynamicSharedMemorySize, FUSED_LDS);
        int dev = 0, cus = 0, per_cu = 0;
        (void)hipGetDevice(&dev);
        (void)hipDeviceGetAttribute(&cus, hipDeviceAttributeMultiprocessorCount, dev);
        (void)hipOccupancyMaxActiveBlocksPerMultiprocessor(&per_cu, (const void*)k_fwd<0, 17>, 512, FUSED_LDS);
        if (per_cu < 1) { fprintf(stderr, "k_fwd: occupancy query says 0 blocks per CU\n"); per_cu = 1; }
        grid = cus;
    }
    const Params p = make_params(d_in, d_out, d_ws);
    (void)hipMemsetAsync((unsigned char*)d_ws + OFF_BAR, 0, XCD_BAR_WORDS * sizeof(unsigned), stream);
    if (PROBE_PHASE == 100) (void)hipMemsetAsync((unsigned char*)d_ws + OFF_PAIR, 0, 256, stream);
    hipLaunchKernelGGL((k_fwd<0, 17>), dim3(grid), dim3(512), FUSED_LDS, stream, p);
}
```

```cpp
#include <hip/hip_runtime.h>
#include <stdint.h>
#include <stdio.h>

#define LAS __attribute__((address_space(3)))
typedef unsigned short bf16_t;
typedef short bf16x8 __attribute__((ext_vector_type(8)));
typedef float f32x4 __attribute__((ext_vector_type(4)));
typedef float f32x2 __attribute__((ext_vector_type(2)));
typedef unsigned u32x4 __attribute__((ext_vector_type(4)));
typedef unsigned u32x2 __attribute__((ext_vector_type(2)));

constexpr int NB = 4, SEQ = 8192, DM = 1024, NTOK = NB * SEQ, CTXL = 256, NCTX = NB * CTXL, NROWS = NTOK + NCTX;
constexpr int NIN = 6144, ZC = 5888;
constexpr int ZQ = 0, ZFF = 768, ZFB = 1536, ZI = 2304, ZGO = 3072, ZGA = 3840, ZGB = 4864;
constexpr int NEXP = 64, TOPK = 8, EH = 256;
constexpr int CAP_ROUTED = NTOK * TOPK + NEXP * 256;
constexpr int CAP_ROWS = CAP_ROUTED + NTOK;
constexpr int HID1_RB = 1024;
constexpr float EPSF = 1e-6f;

__device__ __forceinline__ unsigned cvt_pk_bf16(float lo, float hi) { unsigned r; asm volatile("v_cvt_pk_bf16_f32 %0, %1, %2" : "=v"(r) : "v"(lo), "v"(hi)); return r; }
__device__ __forceinline__ float bf_lo(unsigned w) { return __uint_as_float(w << 16); }
__device__ __forceinline__ float bf_hi(unsigned w) { return __uint_as_float(w & 0xffff0000u); }
__device__ __forceinline__ float bf2f(bf16_t b) { return __uint_as_float(((unsigned)b) << 16); }
__device__ __forceinline__ bf16_t f2bf(float f) { return (bf16_t)(cvt_pk_bf16(f, 0.f) & 0xffffu); }
__device__ __forceinline__ float frcp_(float x) { return __builtin_amdgcn_rcpf(x); }
__device__ __forceinline__ float sigmoidf_(float x) { return frcp_(1.0f + __expf(-x)); }
__device__ __forceinline__ float siluf_(float x) { return x * frcp_(1.0f + __expf(-x)); }
template <int CTRL> __device__ __forceinline__ float dpp_mov_(float v) { return __int_as_float(__builtin_amdgcn_update_dpp(0, __float_as_int(v), CTRL, 0xf, 0xf, true)); }
__device__ __forceinline__ float wave_sum(float v) {
    v += dpp_mov_<0xB1>(v); v += dpp_mov_<0x4E>(v); v += dpp_mov_<0x141>(v); v += dpp_mov_<0x140>(v);
    const float a = __int_as_float(__builtin_amdgcn_readlane(__float_as_int(v), 0)), b = __int_as_float(__builtin_amdgcn_readlane(__float_as_int(v), 16));
    const float c = __int_as_float(__builtin_amdgcn_readlane(__float_as_int(v), 32)), d = __int_as_float(__builtin_amdgcn_readlane(__float_as_int(v), 48));
    return (a + b) + (c + d);
}
__device__ __forceinline__ float gelu_tanh(float y) {
    const float u = 0.7978845608028654f * (y + 0.044715f * y * y * y);
    const float e = __expf(2.0f * u);
    const float t = 1.0f - 2.0f * frcp_(e + 1.0f);
    return 0.5f * y * (1.0f + t);
}
#define XB_TMO      128
#define XB_XCNT(j)  (256  + 64 * (j))
#define XB_XSUB(j)  (1280 + 64 * (j))
#define XB_XGEN(j)  (2304 + 64 * (j))
#define XB_TOP      3328
#define XB_TOPGEN   3392
#define XCD_BAR_WORDS 3456
#define XB_SPIN_CAP (1u << 18)

__device__ __forceinline__ unsigned xb_ld(unsigned* p)              { return __hip_atomic_load(p, __ATOMIC_RELAXED, __HIP_MEMORY_SCOPE_AGENT); }
__device__ __forceinline__ unsigned xb_add(unsigned* p, unsigned v) { return __hip_atomic_fetch_add(p, v, __ATOMIC_RELAXED, __HIP_MEMORY_SCOPE_AGENT); }
__device__ __forceinline__ unsigned xb_xcc_id() { return (unsigned)__builtin_amdgcn_s_getreg((3 << 11) | 20) & 0xFu; }
#define XB_SPIN(cond, bar) do { unsigned _sp = 0; while (cond) { __builtin_amdgcn_s_sleep(1); \
    if ((++_sp & 255u) == 0u) { if (xb_ld(&(bar)[XB_TMO])) break; if (_sp > XB_SPIN_CAP) { atomicAdd(&(bar)[XB_TMO], 1u); break; } } } } while (0)

struct XcdBarrier {
    unsigned* bar; unsigned x;
    volatile LAS unsigned* st;
};

__device__ __forceinline__ XcdBarrier xcd_barrier_post(unsigned* bar, volatile LAS unsigned* st) {
    XcdBarrier b; b.bar = bar; b.x = xb_xcc_id(); b.st = st;
    if (threadIdx.x == 0) (void)xb_add(&bar[XB_XCNT(b.x)], 1u);
    return b;
}
__device__ __forceinline__ void xcd_barrier_complete(unsigned* bar, unsigned x, unsigned& nloc, unsigned& nx) {
    const unsigned G = gridDim.x * gridDim.y * gridDim.z;
    unsigned sum, cnt, mine, sp = 0u;
    for (;;) {
        sum = 0u; cnt = 0u; mine = 0u;
#pragma unroll
        for (unsigned j = 0; j < 16; ++j) { const unsigned c = xb_ld(&bar[XB_XCNT(j)]); sum += c; cnt += (c > 0u) ? 1u : 0u; mine = (j == x) ? c : mine; }
        if (sum == G) break;
        __builtin_amdgcn_s_sleep(1);
        if ((++sp & 255u) == 0u) { if (xb_ld(&bar[XB_TMO])) break; if (sp > XB_SPIN_CAP) { atomicAdd(&bar[XB_TMO], 1u); break; } }
    }
    nloc = mine > 0u ? mine : 1u; nx = cnt > 0u ? cnt : 1u;
}

__device__ __forceinline__ void xcd_barrier(const XcdBarrier& b) {
    asm volatile("s_waitcnt vmcnt(0)" ::: "memory");
    __syncthreads();
    if (threadIdx.x == 0) {
        unsigned* bar = b.bar;
        __builtin_amdgcn_s_waitcnt(0);
        unsigned nloc = b.st[0], nx = b.st[1];
        if (nloc == 0u) { xcd_barrier_complete(bar, b.x, nloc, nx); b.st[0] = nloc; b.st[1] = nx; }
        const unsigned old = xb_add(&bar[XB_XSUB(b.x)], 1u);
        const unsigned gen = old / nloc;
        if (old + 1u == (gen + 1u) * nloc) {
            __builtin_amdgcn_fence(__ATOMIC_RELEASE, "agent");
            asm volatile("s_waitcnt vmcnt(0)" ::: "memory");
            const unsigned og = xb_add(&bar[XB_TOP], 1u);
            const unsigned tg = og / nx;
            if (og + 1u == (tg + 1u) * nx) xb_add(&bar[XB_TOPGEN], 1u);
            else XB_SPIN(xb_ld(&bar[XB_TOPGEN]) == tg, bar);
            __builtin_amdgcn_fence(__ATOMIC_ACQUIRE, "agent");
            xb_add(&bar[XB_XGEN(b.x)], 1u);
            asm volatile("s_waitcnt vmcnt(0)" ::: "memory");
        } else {
            XB_SPIN(xb_ld(&bar[XB_XGEN(b.x)]) == gen, bar);
            __builtin_amdgcn_fence(__ATOMIC_ACQUIRE, "agent");
            asm volatile("s_waitcnt vmcnt(0)" ::: "memory");
        }
    }
    __syncthreads();
}

namespace ge {
typedef int i32x4 __attribute__((ext_vector_type(4)));
typedef int i32x8 __attribute__((ext_vector_type(8)));
constexpr int BM = 256, BK = 64, HALF = 128, HTB = HALF * BK * 2, STAGE_BYTES = 8 * HTB, NXCD = 8, WGM = 8;
__host__ __device__ __forceinline__ int lds_byte(int r, int c) { const int st = (r >> 4) * 2 + (c >> 5), rr = r & 15, cc = c & 31, ob = rr * 64 + cc * 2; return st * 1024 + (ob ^ (((ob >> 9) & 1) << 5)); }
__host__ __device__ __forceinline__ void stage_rc(int b, int& R, int& C) { const int st = b / 1024, sb = b % 1024, swz = sb ^ (((sb >> 9) & 1) << 5); R = (st >> 1) * 16 + swz / 64; C = (st & 1) * 32 + (swz % 64) / 2; }
__host__ __device__ __forceinline__ int perm32(int rho) { const int n = rho >> 4, i = rho & 15; return 8 * (i >> 2) + 4 * n + (i & 3); }

struct Unit { int pm, pn, e, k; };

struct GridOrder {
    int nM, nN, nwg, G, c;
    __device__ void init(int nM_, int nN_, int G_, int c_) { nM = nM_; nN = nN_; nwg = nM * nN; G = G_; c = c_; }
    __device__ bool tile(int i, int& pm, int& pn) const {
        const long L = (long)i * G + c; if (L >= nwg) return false;
        int wgid = (int)L; { const int q = nwg / NXCD, r = nwg % NXCD, xcd = wgid % NXCD, off = wgid / NXCD; wgid = (xcd < r ? xcd * (q + 1) : r * (q + 1) + (xcd - r) * q) + off; }
        const int nig = WGM * nN, gid = wgid / nig, fm = gid * WGM, gsz = (nM - fm) < WGM ? (nM - fm) : WGM;
        pm = fm + ((wgid % nig) % gsz); pn = (wgid % nig) / gsz; return true;
    }
};

template <class Epi, class Sched, bool GATHER>
__device__ __forceinline__ void gemm_phase(LAS unsigned char* lds, const int K, const int lda, const int ldb, const Sched& S, const Epi& E) {
    int tid = threadIdx.x; asm volatile("" : "+v"(tid));
    const int wid = __builtin_amdgcn_readfirstlane(tid >> 6), lane = tid & 63, wr = wid >> 2, wc = wid & 3, fr = lane & 15, fq = lane >> 4;
    const int nt = K / BK;
    int Rr[2], Cc[2]; unsigned voffB[2];
#pragma unroll
    for (int i = 0; i < 2; ++i) { int R, C; stage_rc(tid * 16 + i * 8192, R, C); Rr[i] = R; Cc[i] = C; const int Rb = Epi::PERM ? ((R & ~31) + perm32(R & 31)) : R; voffB[i] = (unsigned)(Rb * ldb + C) * 2u; }
    const size_t kstep = (size_t)(BK * 2);
    const size_t hstepB = (size_t)HALF * ldb * 2;
    const unsigned ldsw = (unsigned)wid * 1024u;
    const int aoff = lds_byte(wr * 64 + fr, fq * 8), boff = lds_byte(wc * 32 + fr, fq * 8);
#define GE_SA(b, h) (((b) * 2 + (h)) * HTB)
#define GE_SB(b, h) ((4 + (b) * 2 + (h)) * HTB)
#define GE_STAGE(bufoff, gbase, v0, v1) do { \
        __builtin_amdgcn_global_load_lds((const unsigned*)((const char*)(gbase) + (v0)), (LAS unsigned*)(lds + (bufoff) + ldsw), 16, 0, 0); \
        __builtin_amdgcn_global_load_lds((const unsigned*)((const char*)(gbase) + (v1)), (LAS unsigned*)(lds + (bufoff) + ldsw + 8192), 16, 0, 0); } while (0)
#define GE_STAGE_B(bufoff, gbase) GE_STAGE(bufoff, gbase, voffB[0], voffB[1])
#define GE_LDA(dst, b, h) do { _Pragma("unroll") for (int m = 0; m < 4; ++m) _Pragma("unroll") for (int k = 0; k < 2; ++k) dst[m][k] = *(const LAS bf16x8*)(lds + GE_SA(b, h) + aoff + m * 2048 + k * 1024); } while (0)
#define GE_LDB(dst, b, h) do { _Pragma("unroll") for (int n = 0; n < 2; ++n) _Pragma("unroll") for (int k = 0; k < 2; ++k) dst[n][k] = *(const LAS bf16x8*)(lds + GE_SB(b, h) + boff + n * 2048 + k * 1024); } while (0)
#define GE_MMA(ai, bj, At, Bt) do { __builtin_amdgcn_s_setprio(1); _Pragma("unroll") for (int m = 0; m < 4; ++m) _Pragma("unroll") for (int n = 0; n < 2; ++n) _Pragma("unroll") for (int k = 0; k < 2; ++k) \
        acc[ai][bj][m][n] = __builtin_amdgcn_mfma_f32_16x16x32_bf16(Bt[n][k], At[m][k], acc[ai][bj][m][n], 0, 0, 0); __builtin_amdgcn_s_setprio(0); } while (0)
#define GE_WAIT_V(n) asm volatile("s_waitcnt vmcnt(" #n ")" ::: "memory")
#define GE_WAIT_L(n) asm volatile("s_waitcnt lgkmcnt(" #n ")" ::: "memory")
#define GE_BAR __builtin_amdgcn_s_barrier()
#define GE_SCHED __builtin_amdgcn_sched_barrier(0)
    Unit cur, nxt, nn; int ui = 0;
    if (!S.next(0, cur)) return;
    bool has_next = S.next(1, nxt);
    unsigned c00, c01, c10, c11, n00, n01, n10, n11; int rn0 = 0, rn1 = 0, rn2 = 0, rn3 = 0, rq0 = 0, rq1 = 0, rq2 = 0, rq3 = 0;
    if constexpr (GATHER) {
        c00 = (unsigned)(S.a_row(cur, Rr[0]) * lda + Cc[0]) * 2u; c01 = (unsigned)(S.a_row(cur, Rr[1]) * lda + Cc[1]) * 2u;
        c10 = (unsigned)(S.a_row(cur, HALF + Rr[0]) * lda + Cc[0]) * 2u; c11 = (unsigned)(S.a_row(cur, HALF + Rr[1]) * lda + Cc[1]) * 2u;
        if (has_next) { rn0 = S.a_row(nxt, Rr[0]); rn1 = S.a_row(nxt, Rr[1]); rn2 = S.a_row(nxt, HALF + Rr[0]); rn3 = S.a_row(nxt, HALF + Rr[1]); }
    } else {
        c00 = (unsigned)(Rr[0] * lda + Cc[0]) * 2u; c01 = (unsigned)(Rr[1] * lda + Cc[1]) * 2u;
        c10 = c00 + (unsigned)(HALF * lda * 2); c11 = c01 + (unsigned)(HALF * lda * 2);
    }
    n00 = c00; n01 = c01; n10 = c10; n11 = c11;
    f32x4 acc[2][2][4][2];
#pragma unroll
    for (int a = 0; a < 2; ++a)
#pragma unroll
        for (int b = 0; b < 2; ++b)
#pragma unroll
            for (int m = 0; m < 4; ++m)
#pragma unroll
                for (int n = 0; n < 2; ++n) acc[a][b][m][n] = (f32x4){0.f, 0.f, 0.f, 0.f};
    bf16x8 At[4][2], B0[2][2], B1[2][2];
    const char* cA = S.a_base(cur); const char* cB = S.b_base(cur);
    GE_STAGE_B(GE_SB(0, 0), cB); GE_STAGE(GE_SA(0, 0), cA, c00, c01); GE_STAGE_B(GE_SB(0, 1), cB + hstepB); GE_STAGE(GE_SA(0, 1), cA, c10, c11);
    if (wr == 1) GE_BAR;
    GE_WAIT_V(4); GE_BAR;
    GE_STAGE_B(GE_SB(1, 0), cB + kstep); GE_STAGE(GE_SA(1, 0), cA + kstep, c00, c01); GE_STAGE_B(GE_SB(1, 1), cB + hstepB + kstep);
    GE_WAIT_V(6); GE_BAR;
    for (;;) {
        const bool has_nn = has_next ? S.next(ui + 2, nn) : false;
        const char* nA = has_next ? S.a_base(nxt) : cA; const char* nB = has_next ? S.b_base(nxt) : cB;
        if constexpr (GATHER) {
            if (has_next) { n00 = (unsigned)(rn0 * lda + Cc[0]) * 2u; n01 = (unsigned)(rn1 * lda + Cc[1]) * 2u; n10 = (unsigned)(rn2 * lda + Cc[0]) * 2u; n11 = (unsigned)(rn3 * lda + Cc[1]) * 2u; }
            else { n00 = c00; n01 = c01; n10 = c10; n11 = c11; }
            if (has_nn) { rq0 = S.a_row(nn, Rr[0]); rq1 = S.a_row(nn, Rr[1]); rq2 = S.a_row(nn, HALF + Rr[0]); rq3 = S.a_row(nn, HALF + Rr[1]); }
        }
#pragma unroll 1
        for (int t = 0; t < nt; t += 2) {
            const bool last = (t == nt - 2);
            const char* a1 = cA + (size_t)(t + 1) * kstep;
            const char* a2 = last ? nA : cA + (size_t)(t + 2) * kstep; const char* b2 = last ? nB : cB + (size_t)(t + 2) * kstep;
            const char* a3 = a2 + kstep; const char* b3 = b2 + kstep;
            unsigned x00 = c00, x01 = c01, x10 = c10, x11 = c11;
            if constexpr (GATHER) { if (last) { x00 = n00; x01 = n01; x10 = n10; x11 = n11; } }
            GE_LDB(B0, 0, 0); GE_SCHED; GE_LDA(At, 0, 0); GE_STAGE(GE_SA(1, 1), a1, c10, c11);
            GE_WAIT_L(8); GE_BAR; GE_WAIT_L(0); GE_MMA(0, 0, At, B0); GE_BAR; GE_SCHED;
            GE_LDB(B1, 0, 1); GE_STAGE_B(GE_SB(0, 0), b2);
            GE_BAR; GE_WAIT_L(0); GE_MMA(0, 1, At, B1); GE_BAR;
            GE_LDA(At, 0, 1); GE_STAGE(GE_SA(0, 0), a2, x00, x01);
            GE_BAR; GE_WAIT_L(0); GE_MMA(1, 0, At, B0); GE_BAR; GE_SCHED;
            GE_STAGE_B(GE_SB(0, 1), b2 + hstepB);
            GE_WAIT_V(6); GE_BAR; GE_MMA(1, 1, At, B1); GE_BAR;
            GE_LDB(B0, 1, 0); GE_SCHED; GE_LDA(At, 1, 0); GE_STAGE(GE_SA(0, 1), a2, x10, x11);
            GE_WAIT_L(8); GE_BAR; GE_WAIT_L(0); GE_MMA(0, 0, At, B0); GE_BAR; GE_SCHED;
            GE_LDB(B1, 1, 1); GE_STAGE_B(GE_SB(1, 0), b3);
            GE_BAR; GE_WAIT_L(0); GE_MMA(0, 1, At, B1); GE_BAR;
            GE_LDA(At, 1, 1); GE_STAGE(GE_SA(1, 0), a3, x00, x01);
            GE_BAR; GE_WAIT_L(0); GE_MMA(1, 0, At, B0); GE_BAR; GE_SCHED;
            GE_STAGE_B(GE_SB(1, 1), b3 + hstepB);
            GE_WAIT_V(6); GE_BAR; GE_MMA(1, 1, At, B1); GE_BAR;
        }
        E(acc, cur, wr, wc, fr, fq);
        if (!has_next) break;
#pragma unroll
        for (int a = 0; a < 2; ++a)
#pragma unroll
            for (int b = 0; b < 2; ++b)
#pragma unroll
                for (int m = 0; m < 4; ++m)
#pragma unroll
                    for (int n = 0; n < 2; ++n) acc[a][b][m][n] = (f32x4){0.f, 0.f, 0.f, 0.f};
        cur = nxt; nxt = nn; has_next = has_nn; cA = nA; cB = nB; ++ui;
        if constexpr (GATHER) { c00 = n00; c01 = n01; c10 = n10; c11 = n11; rn0 = rq0; rn1 = rq1; rn2 = rq2; rn3 = rq3; }
    }
    GE_WAIT_V(0);
    if (wr == 0) GE_BAR;
    GE_BAR;
#undef GE_SA
#undef GE_SB
#undef GE_STAGE
#undef GE_STAGE_B
#undef GE_LDA
#undef GE_LDB
#undef GE_MMA
#undef GE_WAIT_V
#undef GE_WAIT_L
#undef GE_BAR
#undef GE_SCHED
}

template <class Epi, class Sched, bool GATHER>
__device__ __forceinline__ void gemm_phase_f8(LAS unsigned char* lds, const int K, const int lda, const int ldb, const Sched& S, const Epi& E) {
    int tid = threadIdx.x; asm volatile("" : "+v"(tid));
    const int wid = __builtin_amdgcn_readfirstlane(tid >> 6), lane = tid & 63, wr = wid >> 2, wc = wid & 3, fr = lane & 15, fq = lane >> 4;
    const int nt = K / BK;
    const size_t kstep = (size_t)(BK * 2);
    const size_t hstepB = (size_t)HALF * ldb * 2;
    const unsigned ldsw = (unsigned)wid * 1024u;
    const int aoff = lds_byte(wr * 64 + fr, fq * 8), boff = lds_byte(wc * 32 + fr, fq * 8);
#define GE_SA(b, h) (((b) * 2 + (h)) * HTB)
#define GE_SB(b, h) ((4 + (b) * 2 + (h)) * HTB)
#define GE_STAGE(bufoff, gbase, v0, v1) do { \
        __builtin_amdgcn_global_load_lds((const unsigned*)((const char*)(gbase) + (v0)), (LAS unsigned*)(lds + (bufoff) + ldsw), 16, 0, 0); \
        __builtin_amdgcn_global_load_lds((const unsigned*)((const char*)(gbase) + (v1)), (LAS unsigned*)(lds + (bufoff) + ldsw + 8192), 16, 0, 0); } while (0)
#define GE_RC() int t2_ = tid; asm volatile("" : "+v"(t2_)); int R0_, C0_, R1_, C1_; stage_rc(t2_ * 16, R0_, C0_); stage_rc(t2_ * 16 + 8192, R1_, C1_)
#define GE_STAGE_B(bufoff, gbase) do { GE_RC(); const int Rb0_ = Epi::PERM ? ((R0_ & ~31) + perm32(R0_ & 31)) : R0_, Rb1_ = Epi::PERM ? ((R1_ & ~31) + perm32(R1_ & 31)) : R1_; \
        GE_STAGE(bufoff, gbase, (unsigned)(Rb0_ * ldb + C0_) * 2u, (unsigned)(Rb1_ * ldb + C1_) * 2u); } while (0)
#define GE_LDA(dst, b, h) do { _Pragma("unroll") for (int m = 0; m < 4; ++m) { const i32x4 lo_ = *(const LAS i32x4*)(lds + GE_SA(b, h) + aoff + m * 2048), hi_ = *(const LAS i32x4*)(lds + GE_SA(b, h) + aoff + m * 2048 + 1024); dst[m] = __builtin_shufflevector(lo_, hi_, 0, 1, 2, 3, 4, 5, 6, 7); } } while (0)
#define GE_LDB(dst, b, h) do { _Pragma("unroll") for (int n = 0; n < 2; ++n) { const i32x4 lo_ = *(const LAS i32x4*)(lds + GE_SB(b, h) + boff + n * 2048), hi_ = *(const LAS i32x4*)(lds + GE_SB(b, h) + boff + n * 2048 + 1024); dst[n] = __builtin_shufflevector(lo_, hi_, 0, 1, 2, 3, 4, 5, 6, 7); } } while (0)
#define GE_MMA(ai, bj, At, Bt) do { __builtin_amdgcn_s_setprio(1); _Pragma("unroll") for (int m = 0; m < 4; ++m) _Pragma("unroll") for (int n = 0; n < 2; ++n) \
        acc[ai][bj][m][n] = __builtin_amdgcn_mfma_scale_f32_16x16x128_f8f6f4(Bt[n], At[m], acc[ai][bj][m][n], 0, 0, 0, 0x7a7a7a7a, 0, 0x7f7f7f7f); __builtin_amdgcn_s_setprio(0); } while (0)
#define GE_WAIT_V(n) asm volatile("s_waitcnt vmcnt(" #n ")" ::: "memory")
#define GE_WAIT_L(n) asm volatile("s_waitcnt lgkmcnt(" #n ")" ::: "memory")
#define GE_BAR __builtin_amdgcn_s_barrier()
#define GE_SCHED __builtin_amdgcn_sched_barrier(0)
    Unit cur, nxt, nn; int ui = 0;
    if (!S.next(0, cur)) return;
    bool has_next = S.next(1, nxt);
#define GE_STG(bufoff, gbase, u_, h) do { GE_RC(); GE_STAGE(bufoff, gbase, (unsigned)(S.a_row(u_, (h) * HALF + R0_) * lda + C0_) * 2u, (unsigned)(S.a_row(u_, (h) * HALF + R1_) * lda + C1_) * 2u); } while (0)
    f32x4 acc[2][2][4][2];
#pragma unroll
    for (int a = 0; a < 2; ++a)
#pragma unroll
        for (int b = 0; b < 2; ++b)
#pragma unroll
            for (int m = 0; m < 4; ++m)
#pragma unroll
                for (int n = 0; n < 2; ++n) acc[a][b][m][n] = (f32x4){0.f, 0.f, 0.f, 0.f};
    i32x8 At[4], B0[2], B1[2];
    const char* cA = S.a_base(cur); const char* cB = S.b_base(cur);
    GE_STAGE_B(GE_SB(0, 0), cB); GE_STG(GE_SA(0, 0), cA, cur, 0); GE_STAGE_B(GE_SB(0, 1), cB + hstepB); GE_STG(GE_SA(0, 1), cA, cur, 1);
    if (wr == 1) GE_BAR;
    GE_WAIT_V(4); GE_BAR;
    GE_STAGE_B(GE_SB(1, 0), cB + kstep); GE_STG(GE_SA(1, 0), cA + kstep, cur, 0); GE_STAGE_B(GE_SB(1, 1), cB + hstepB + kstep);
    GE_WAIT_V(6); GE_BAR;
    for (;;) {
        const bool has_nn = has_next ? S.next(ui + 2, nn) : false;
        typename Epi::Pre pre = E.pre(cur, wr, wc, fr, fq);
        const char* nA = has_next ? S.a_base(nxt) : cA; const char* nB = has_next ? S.b_base(nxt) : cB;
#pragma unroll 1
        for (int t = 0; t < nt; t += 2) {
            const bool last = (t == nt - 2);
            const char* a1 = cA + (size_t)(t + 1) * kstep;
            const char* a2 = last ? nA : cA + (size_t)(t + 2) * kstep; const char* b2 = last ? nB : cB + (size_t)(t + 2) * kstep;
            const char* a3 = a2 + kstep; const char* b3 = b2 + kstep;
            Unit xu = cur; if (last && has_next) xu = nxt;
            GE_LDB(B0, 0, 0); GE_SCHED; GE_LDA(At, 0, 0); GE_STG(GE_SA(1, 1), a1, cur, 1);
            GE_WAIT_L(8); GE_BAR; GE_WAIT_L(0); GE_MMA(0, 0, At, B0); GE_BAR; GE_SCHED;
            GE_LDB(B1, 0, 1); GE_STAGE_B(GE_SB(0, 0), b2);
            GE_BAR; GE_WAIT_L(0); GE_MMA(0, 1, At, B1); GE_BAR;
            GE_LDA(At, 0, 1); GE_STG(GE_SA(0, 0), a2, xu, 0);
            GE_BAR; GE_WAIT_L(0); GE_MMA(1, 0, At, B0); GE_BAR; GE_SCHED;
            GE_STAGE_B(GE_SB(0, 1), b2 + hstepB);
            GE_WAIT_V(6); GE_BAR; GE_MMA(1, 1, At, B1); GE_BAR;
            GE_LDB(B0, 1, 0); GE_SCHED; GE_LDA(At, 1, 0); GE_STG(GE_SA(0, 1), a2, xu, 1);
            GE_WAIT_L(8); GE_BAR; GE_WAIT_L(0); GE_MMA(0, 0, At, B0); GE_BAR; GE_SCHED;
            GE_LDB(B1, 1, 1); GE_STAGE_B(GE_SB(1, 0), b3);
            GE_BAR; GE_WAIT_L(0); GE_MMA(0, 1, At, B1); GE_BAR;
            GE_LDA(At, 1, 1); GE_STG(GE_SA(1, 0), a3, xu, 0);
            GE_BAR; GE_WAIT_L(0); GE_MMA(1, 0, At, B0); GE_BAR; GE_SCHED;
            GE_STAGE_B(GE_SB(1, 1), b3 + hstepB);
            GE_WAIT_V(6); GE_BAR; GE_MMA(1, 1, At, B1); GE_BAR;
        }
        E(acc, cur, wr, wc, fr, fq, pre);
        if (!has_next) break;
#pragma unroll
        for (int a = 0; a < 2; ++a)
#pragma unroll
            for (int b = 0; b < 2; ++b)
#pragma unroll
                for (int m = 0; m < 4; ++m)
#pragma unroll
                    for (int n = 0; n < 2; ++n) acc[a][b][m][n] = (f32x4){0.f, 0.f, 0.f, 0.f};
        cur = nxt; nxt = nn; has_next = has_nn; cA = nA; cB = nB; ++ui;
    }
    GE_WAIT_V(0);
    if (wr == 0) GE_BAR;
    GE_BAR;
#undef GE_SA
#undef GE_SB
#undef GE_STAGE
#undef GE_STAGE_B
#undef GE_STG
#undef GE_RC
#undef GE_LDA
#undef GE_LDB
#undef GE_MMA
#undef GE_WAIT_V
#undef GE_WAIT_L
#undef GE_BAR
#undef GE_SCHED
}

template <class Epi, class Sched>
__device__ __forceinline__ void gemm_phase_v(LAS unsigned char* lds, const Sched& S, const Epi& E) {
    int tid = threadIdx.x; asm volatile("" : "+v"(tid));
    const int wid = __builtin_amdgcn_readfirstlane(tid >> 6), lane = tid & 63, wr = wid >> 2, wc = wid & 3, fr = lane & 15, fq = lane >> 4;
    int Rr[2], Rbb[2]; unsigned C2[2];
#pragma unroll
    for (int i = 0; i < 2; ++i) { int R, C; stage_rc(tid * 16 + i * 8192, R, C); Rr[i] = R; C2[i] = (unsigned)C * 2u; Rbb[i] = Epi::PERM ? ((R & ~31) + perm32(R & 31)) : R; }
    const size_t kstep = (size_t)(BK * 2);
    const unsigned ldsw = (unsigned)wid * 1024u;
    const int aoff = lds_byte(wr * 64 + fr, fq * 8), boff = lds_byte(wc * 32 + fr, fq * 8);
#define GE_SA(b, h) (((b) * 2 + (h)) * HTB)
#define GE_SB(b, h) ((4 + (b) * 2 + (h)) * HTB)
#define GE_STAGE(bufoff, gbase, v0, v1) do { \
        __builtin_amdgcn_global_load_lds((const unsigned*)((const char*)(gbase) + (v0)), (LAS unsigned*)(lds + (bufoff) + ldsw), 16, 0, 0); \
        __builtin_amdgcn_global_load_lds((const unsigned*)((const char*)(gbase) + (v1)), (LAS unsigned*)(lds + (bufoff) + ldsw + 8192), 16, 0, 0); } while (0)
#define GE_LDA(dst, b, h) do { _Pragma("unroll") for (int m = 0; m < 4; ++m) _Pragma("unroll") for (int k = 0; k < 2; ++k) dst[m][k] = *(const LAS bf16x8*)(lds + GE_SA(b, h) + aoff + m * 2048 + k * 1024); } while (0)
#define GE_LDB(dst, b, h) do { _Pragma("unroll") for (int n = 0; n < 2; ++n) _Pragma("unroll") for (int k = 0; k < 2; ++k) dst[n][k] = *(const LAS bf16x8*)(lds + GE_SB(b, h) + boff + n * 2048 + k * 1024); } while (0)
#define GE_MMA(ai, bj, At, Bt) do { __builtin_amdgcn_s_setprio(1); _Pragma("unroll") for (int m = 0; m < 4; ++m) _Pragma("unroll") for (int n = 0; n < 2; ++n) _Pragma("unroll") for (int k = 0; k < 2; ++k) \
        acc[ai][bj][m][n] = __builtin_amdgcn_mfma_f32_16x16x32_bf16(Bt[n][k], At[m][k], acc[ai][bj][m][n], 0, 0, 0); __builtin_amdgcn_s_setprio(0); } while (0)
#define GE_WAIT_V(n) asm volatile("s_waitcnt vmcnt(" #n ")" ::: "memory")
#define GE_WAIT_L(n) asm volatile("s_waitcnt lgkmcnt(" #n ")" ::: "memory")
#define GE_BAR __builtin_amdgcn_s_barrier()
#define GE_SCHED __builtin_amdgcn_sched_barrier(0)
#define GE_STA(bufoff, gbase, pitch, h) GE_STAGE(bufoff, gbase, __umul24((unsigned)(Rr[0] + (h) * HALF), (unsigned)(pitch)) + C2[0], __umul24((unsigned)(Rr[1] + (h) * HALF), (unsigned)(pitch)) + C2[1])
#define GE_STB(bufoff, gbase, pitch, h) GE_STAGE(bufoff, gbase, __umul24((unsigned)(Rbb[0] + (h) * HALF), (unsigned)(pitch)) + C2[0], __umul24((unsigned)(Rbb[1] + (h) * HALF), (unsigned)(pitch)) + C2[1])
    Unit cur, nxt; int ui = 0;
    if (!S.next(0, cur)) return;
    int cpa = S.lda(cur) * 2, cpb = S.ldb(cur) * 2, npa = cpa, npb = cpb;
    f32x4 acc[2][2][4][2];
#pragma unroll
    for (int a = 0; a < 2; ++a)
#pragma unroll
        for (int b = 0; b < 2; ++b)
#pragma unroll
            for (int m = 0; m < 4; ++m)
#pragma unroll
                for (int n = 0; n < 2; ++n) acc[a][b][m][n] = (f32x4){0.f, 0.f, 0.f, 0.f};
    bf16x8 At[4][2], B0[2][2], B1[2][2];
    const char* cA = S.a_base(cur); const char* cB = S.b_base(cur);
    GE_STB(GE_SB(0, 0), cB, cpb, 0); GE_STA(GE_SA(0, 0), cA, cpa, 0); GE_STB(GE_SB(0, 1), cB, cpb, 1); GE_STA(GE_SA(0, 1), cA, cpa, 1);
    if (wr == 1) GE_BAR;
    GE_WAIT_V(4); GE_BAR;
    GE_STB(GE_SB(1, 0), cB + kstep, cpb, 0); GE_STA(GE_SA(1, 0), cA + kstep, cpa, 0); GE_STB(GE_SB(1, 1), cB + kstep, cpb, 1);
    GE_WAIT_V(6); GE_BAR;
    for (;;) {
        const bool has_next = S.next(ui + 1, nxt);
        const char* nA = has_next ? S.a_base(nxt) : cA; const char* nB = has_next ? S.b_base(nxt) : cB;
        if (has_next) { npa = S.lda(nxt) * 2; npb = S.ldb(nxt) * 2; } else { npa = cpa; npb = cpb; }
        const int nt = S.nt(cur);
#pragma unroll 1
        for (int t = 0; t < nt; t += 2) {
            const bool last = (t == nt - 2);
            const char* a1 = cA + (size_t)(t + 1) * kstep;
            const char* a2 = last ? nA : cA + (size_t)(t + 2) * kstep; const char* b2 = last ? nB : cB + (size_t)(t + 2) * kstep;
            const char* a3 = a2 + kstep; const char* b3 = b2 + kstep;
            const int xpa = last ? npa : cpa, xpb = last ? npb : cpb;
            GE_LDB(B0, 0, 0); GE_SCHED; GE_LDA(At, 0, 0); GE_STA(GE_SA(1, 1), a1, cpa, 1);
            GE_WAIT_L(8); GE_BAR; GE_WAIT_L(0); GE_MMA(0, 0, At, B0); GE_BAR; GE_SCHED;
            GE_LDB(B1, 0, 1); GE_STB(GE_SB(0, 0), b2, xpb, 0);
            GE_BAR; GE_WAIT_L(0); GE_MMA(0, 1, At, B1); GE_BAR;
            GE_LDA(At, 0, 1); GE_STA(GE_SA(0, 0), a2, xpa, 0);
            GE_BAR; GE_WAIT_L(0); GE_MMA(1, 0, At, B0); GE_BAR; GE_SCHED;
            GE_STB(GE_SB(0, 1), b2, xpb, 1);
            GE_WAIT_V(6); GE_BAR; GE_MMA(1, 1, At, B1); GE_BAR;
            GE_LDB(B0, 1, 0); GE_SCHED; GE_LDA(At, 1, 0); GE_STA(GE_SA(0, 1), a2, xpa, 1);
            GE_WAIT_L(8); GE_BAR; GE_WAIT_L(0); GE_MMA(0, 0, At, B0); GE_BAR; GE_SCHED;
            GE_LDB(B1, 1, 1); GE_STB(GE_SB(1, 0), b3, xpb, 0);
            GE_BAR; GE_WAIT_L(0); GE_MMA(0, 1, At, B1); GE_BAR;
            GE_LDA(At, 1, 1); GE_STA(GE_SA(1, 0), a3, xpa, 0);
            GE_BAR; GE_WAIT_L(0); GE_MMA(1, 0, At, B0); GE_BAR; GE_SCHED;
            GE_STB(GE_SB(1, 1), b3, xpb, 1);
            GE_WAIT_V(6); GE_BAR; GE_MMA(1, 1, At, B1); GE_BAR;
        }
        const bool keep = E(acc, cur, wr, wc, fr, fq);
        if (!has_next) break;
        if (!keep) {
#pragma unroll
            for (int a = 0; a < 2; ++a)
#pragma unroll
                for (int b = 0; b < 2; ++b)
#pragma unroll
                    for (int m = 0; m < 4; ++m)
#pragma unroll
                        for (int n = 0; n < 2; ++n) acc[a][b][m][n] = (f32x4){0.f, 0.f, 0.f, 0.f};
        }
        cur = nxt; cA = nA; cB = nB; ++ui;
        cpa = npa; cpb = npb;
    }
    GE_WAIT_V(0);
    if (wr == 0) GE_BAR;
    GE_BAR;
#undef GE_SA
#undef GE_SB
#undef GE_STAGE
#undef GE_LDA
#undef GE_LDB
#undef GE_MMA
#undef GE_WAIT_V
#undef GE_WAIT_L
#undef GE_BAR
#undef GE_SCHED
#undef GE_STA
#undef GE_STB
}
}
constexpr size_t MiB = (size_t)1 << 20;
constexpr size_t OFF_BAR    = 0;
constexpr size_t OFF_CNT    = 16 * 1024;
constexpr size_t OFF_BLKE   = 32 * 1024;
constexpr size_t OFF_MOD    = 64 * 1024;
constexpr size_t OFF_PAIR   = 192 * 1024;
constexpr size_t OFF_EIDX   = 1 * MiB;
constexpr size_t OFF_WTS    = 2 * MiB;
constexpr size_t OFF_APOS   = 3 * MiB;
constexpr size_t OFF_ROWTOK = 4 * MiB;
constexpr size_t OFF_WINT   = 8 * MiB;
constexpr size_t OFF_GLUT   = 20 * MiB;
constexpr size_t OFF_PAT    = OFF_GLUT + 128 * 1024;
constexpr size_t OFF_PBT    = OFF_PAT + 512 * 1024;
constexpr size_t OFF_WOUTT  = OFF_PBT + 1536 * 1024;
constexpr size_t OFF_U      = 34 * MiB;
constexpr size_t OFF_H      = 62 * MiB;
constexpr size_t OFF_Z      = 128 * MiB;
constexpr size_t OFF_YPART  = 62 * MiB;
constexpr size_t OFF_YA     = 26 * MiB;
constexpr size_t OFF_YB     = 42 * MiB;
constexpr size_t OFF_BT2    = 40 * MiB;
constexpr size_t OFF_HID1   = 92 * MiB;
constexpr size_t OFF_HID2   = 208 * MiB;
constexpr size_t OFF_H2     = 232 * MiB;
constexpr size_t OFF_BT1    = 57 * MiB;
constexpr size_t OFF_Y2     = 232 * MiB;
constexpr size_t DO_OF = 0, DO_OB = 48 * MiB, DO_X1 = 0;

constexpr size_t OFF_BCNT = 6 * MiB;
constexpr size_t OFF_LIST = 504 * MiB;
constexpr size_t OFF_ROWDST = 90 * MiB;
constexpr size_t OFF_Y2S = 8 * MiB;
constexpr size_t OFF_WRT = 6 * MiB + 512 * 1024;

struct Params {
    const float *x, *c, *ctx, *c_ctx, *w_ada, *b_ada, *norm1_g, *norm2_g, *w_in, *lam_re, *lam_im, *log_dt, *b_re, *b_im, *c_re, *c_im, *s5_d, *w_glu, *lb_logits, *hg_norm_g,
                *p_a, *p_b, *w_out, *w_router, *b_router, *w1, *w3, *w2, *ws1, *ws3, *ws2, *final_g;
    unsigned char* ws; unsigned char* out;
};
constexpr bool Z_FP8 = true;
constexpr size_t DO_H8 = 0, DO_W8 = 40 * MiB;
__device__ __forceinline__ void ada_phase(const Params& p, LAS unsigned char* lds) {
    LAS float* sc = (LAS float*)lds;
    LAS float* red = (LAS float*)(lds + 5 * 1024 * 4);
    const int tid = threadIdx.x;
    float* mod = (float*)(p.ws + OFF_MOD);
    bool loaded = false;
    for (int item = blockIdx.x; item < 192; item += gridDim.x) {
        if (!loaded) {
            for (int i = tid; i < 5 * 1024; i += 512) { const int r = i >> 10, k = i & 1023; const float v = (r < 4) ? p.c[r * 1024 + k] : p.c_ctx[k]; sc[i] = siluf_(v); }
            loaded = true; __syncthreads();
        }
        const int n0 = item * 32, ks = tid >> 5, col = tid & 31;
        float a0 = 0.f, a1 = 0.f, a2 = 0.f, a3 = 0.f, a4 = 0.f;
#pragma unroll 16
        for (int k = ks * 64; k < ks * 64 + 64; ++k) {
            const float w = p.w_ada[(size_t)k * NIN + n0 + col];
            a0 += sc[k] * w; a1 += sc[1024 + k] * w; a2 += sc[2048 + k] * w; a3 += sc[3072 + k] * w; a4 += sc[4096 + k] * w;
        }
        red[(ks * 5 + 0) * 32 + col] = a0; red[(ks * 5 + 1) * 32 + col] = a1; red[(ks * 5 + 2) * 32 + col] = a2; red[(ks * 5 + 3) * 32 + col] = a3; red[(ks * 5 + 4) * 32 + col] = a4;
        __syncthreads();
        if (tid < 160) { const int r = tid >> 5, cc = tid & 31; float s = 0.f;
            for (int q = 0; q < 16; ++q) s += red[(q * 5 + r) * 32 + cc];
            mod[r * NIN + n0 + cc] = s + p.b_ada[n0 + cc]; }
        __syncthreads();
    }
}

__device__ __forceinline__ unsigned cvt_pack_fp8x4(float a, float b, float c, float d) {
    a = __builtin_amdgcn_fmed3f(a, -448.f, 448.f); b = __builtin_amdgcn_fmed3f(b, -448.f, 448.f); c = __builtin_amdgcn_fmed3f(c, -448.f, 448.f); d = __builtin_amdgcn_fmed3f(d, -448.f, 448.f);
    int w = 0; w = __builtin_amdgcn_cvt_pk_fp8_f32(a, b, w, false); w = __builtin_amdgcn_cvt_pk_fp8_f32(c, d, w, true); return (unsigned)w; }
template <bool F8 = false, class F>
__device__ __forceinline__ void cvt_tile(const float* src, int ld, int k0, int n0, bf16_t* dst, int ldd, int kdst0, F rowmap, LAS unsigned char* lds) {
    LAS float* t = (LAS float*)lds;
    const int tid = threadIdx.x;
#pragma unroll
    for (int j = 0; j < 2; ++j) { const int kr = (tid >> 4) + 32 * j, nc = (tid & 15) * 4;
        const f32x4 v = *(const f32x4*)(src + (size_t)(k0 + kr) * ld + n0 + nc);
        t[kr * 65 + nc] = v[0]; t[kr * 65 + nc + 1] = v[1]; t[kr * 65 + nc + 2] = v[2]; t[kr * 65 + nc + 3] = v[3]; }
    __syncthreads();
    { const int n = tid >> 3, kc = (tid & 7) * 8; float v[8];
#pragma unroll
      for (int j = 0; j < 8; ++j) v[j] = t[(kc + j) * 65 + n];
      if constexpr (F8) { u32x2 w; w.x = cvt_pack_fp8x4(v[0] * 32.f, v[1] * 32.f, v[2] * 32.f, v[3] * 32.f); w.y = cvt_pack_fp8x4(v[4] * 32.f, v[5] * 32.f, v[6] * 32.f, v[7] * 32.f);
          *(u32x2*)((unsigned char*)dst + (size_t)rowmap(n0 + n) * ldd + kdst0 + k0 + kc) = w; }
      else { u32x4 w; w.x = cvt_pk_bf16(v[0], v[1]); w.y = cvt_pk_bf16(v[2], v[3]); w.z = cvt_pk_bf16(v[4], v[5]); w.w = cvt_pk_bf16(v[6], v[7]);
          *(u32x4*)(dst + (size_t)rowmap(n0 + n) * ldd + kdst0 + k0 + kc) = w; } }
    __syncthreads();
}

__device__ __forceinline__ void cvt_dense_phase(const Params& p, LAS unsigned char* lds) {
    bf16_t* WinT = (bf16_t*)(p.ws + OFF_WINT); bf16_t* gluT = (bf16_t*)(p.ws + OFF_GLUT); bf16_t* PaT = (bf16_t*)(p.ws + OFF_PAT); bf16_t* PbT = (bf16_t*)(p.ws + OFF_PBT); bf16_t* WoutT = (bf16_t*)(p.ws + OFF_WOUTT);
    auto id = [](int n) { return n; };
    constexpr int T_WIN = 16 * 96, T_GLU = 4 * 4, T_PA = 4 * 16, T_PB = 12 * 16, T_WO = 16 * 16, T_ALL = T_WIN + T_GLU + T_PA + T_PB + T_WO;
    for (int it = blockIdx.x; it < T_ALL; it += gridDim.x) {
        int i = it;
        if (i < T_WIN) { if constexpr (Z_FP8) cvt_tile<true>(p.w_in, NIN, (i / 96) * 64, (i % 96) * 64, (bf16_t*)(p.out + DO_W8), 1024, 0, id, lds);
                         else cvt_tile<false>(p.w_in, NIN, (i / 96) * 64, (i % 96) * 64, WinT, 1024, 0, id, lds); continue; } i -= T_WIN;
        if (i < T_GLU) { cvt_tile(p.w_glu, 256, (i / 4) * 64, (i % 4) * 64, gluT, 256, 0, id, lds); continue; } i -= T_GLU;
        if (i < T_PA) { cvt_tile(p.p_a, 1024, (i / 16) * 64, (i % 16) * 64, PaT, 256, 0, id, lds); continue; } i -= T_PA;
        if (i < T_PB) { cvt_tile(p.p_b, 1024, (i / 16) * 64, (i % 16) * 64, PbT, 768, 0, id, lds); continue; } i -= T_PB;
        cvt_tile(p.w_out, 1024, (i / 16) * 64, (i % 16) * 64, WoutT, 1024, 0, id, lds);
    }
}

__device__ __forceinline__ unsigned moe_pack_fp8x4(float a, float b, float c, float d) {
    a = __builtin_amdgcn_fmed3f(a, -448.f, 448.f); b = __builtin_amdgcn_fmed3f(b, -448.f, 448.f); c = __builtin_amdgcn_fmed3f(c, -448.f, 448.f); d = __builtin_amdgcn_fmed3f(d, -448.f, 448.f);
    int w = 0; w = __builtin_amdgcn_cvt_pk_fp8_f32(a, b, w, false); w = __builtin_amdgcn_cvt_pk_fp8_f32(c, d, w, true); return (unsigned)w; }
struct MoeStrip { const float* src; int ld; unsigned char* dst; int ldd; int mode; };
__device__ __forceinline__ MoeStrip moe_strip(const Params& p, int it) {
    const int e = it / 48, j = it % 48, which = j >> 4, t = j & 15; MoeStrip s;
    unsigned char* Bt1 = p.ws + OFF_BT1 + (size_t)e * 512 * 1024; unsigned char* Bt2 = p.ws + OFF_BT2 + (size_t)e * 1024 * 256;
    if (which == 0) { s.src = ((e < 64) ? p.w1 + (size_t)e * 1024 * 256 : p.ws1) + (size_t)(t * 64) * 256; s.ld = 256; s.dst = Bt1 + t * 64; s.ldd = 1024; s.mode = 0; }
    else if (which == 1) { s.src = ((e < 64) ? p.w3 + (size_t)e * 1024 * 256 : p.ws3) + (size_t)(t * 64) * 256; s.ld = 256; s.dst = Bt1 + t * 64; s.ldd = 1024; s.mode = 1; }
    else { const int kt = t >> 2, nt = t & 3; s.src = ((e < 64) ? p.w2 + (size_t)e * 256 * 1024 : p.ws2) + (size_t)(kt * 64) * 1024 + nt * 256; s.ld = 1024; s.dst = Bt2 + (size_t)(nt * 256) * 256 + kt * 64; s.ldd = 256; s.mode = 2; }
    return s;
}
__device__ __forceinline__ void cvt_moe_phase(const Params& p, LAS unsigned char* lds) {
    int tid = threadIdx.x; asm volatile("" : "+v"(tid));
    LAS float* tl = (LAS float*)lds;
    const int NIT = 65 * 48;
    f32x4 r[8];
    int it = blockIdx.x;
    if (it < NIT) { const MoeStrip s = moe_strip(p, it);
#pragma unroll
        for (int j = 0; j < 8; ++j) r[j] = *(const f32x4*)(s.src + (size_t)((tid >> 6) + 8 * j) * s.ld + (tid & 63) * 4); }
    for (; it < NIT; it += gridDim.x) {
        const MoeStrip s = moe_strip(p, it);
#pragma unroll
        for (int j = 0; j < 8; ++j) { const int kr = (tid >> 6) + 8 * j, nc = (tid & 63) * 4; tl[kr * 257 + nc] = r[j][0]; tl[kr * 257 + nc + 1] = r[j][1]; tl[kr * 257 + nc + 2] = r[j][2]; tl[kr * 257 + nc + 3] = r[j][3]; }
        __syncthreads();
        if (it + (int)gridDim.x < NIT) { const MoeStrip s2 = moe_strip(p, it + gridDim.x);
#pragma unroll
            for (int j = 0; j < 8; ++j) r[j] = *(const f32x4*)(s2.src + (size_t)((tid >> 6) + 8 * j) * s2.ld + (tid & 63) * 4); }
        { const int k8 = (tid & 7) * 8;
#pragma unroll
          for (int c = 0; c < 4; ++c) { const int n = (tid >> 3) + 64 * c;
              const int row = (s.mode == 2) ? n : ((n >> 7) * 256 + (s.mode == 1 ? 128 : 0) + (n & 127));
              float v[8];
#pragma unroll
              for (int q = 0; q < 8; ++q) v[q] = tl[(k8 + q) * 257 + n];
              { u32x2 w; w.x = moe_pack_fp8x4(v[0] * 32.f, v[1] * 32.f, v[2] * 32.f, v[3] * 32.f); w.y = moe_pack_fp8x4(v[4] * 32.f, v[5] * 32.f, v[6] * 32.f, v[7] * 32.f);
                  *(u32x2*)(s.dst + (size_t)row * s.ldd + k8) = w; } } }
        __syncthreads();
    }
}

__device__ __forceinline__ void norm1_phase(const Params& p) {
    const int wid = threadIdx.x >> 6, lane = threadIdx.x & 63;
    const float* mod = (const float*)(p.ws + OFF_MOD); bf16_t* H = (bf16_t*)(p.ws + OFF_H);
    for (int r = blockIdx.x * 8 + wid; r < NROWS; r += gridDim.x * 8) {
        const float* src = (r < NTOK) ? p.x + (size_t)r * 1024 : p.ctx + (size_t)(r - NTOK) * 1024;
        const float* mr = mod + ((r < NTOK) ? (r / SEQ) : 4) * NIN;
        f32x4 v[4]; float ss = 0.f;
#pragma unroll
        for (int j = 0; j < 4; ++j) { v[j] = *(const f32x4*)(src + j * 256 + lane * 4); ss += v[j][0] * v[j][0] + v[j][1] * v[j][1] + v[j][2] * v[j][2] + v[j][3] * v[j][3]; }
        ss = wave_sum(ss);
        const float rstd = rsqrtf(ss * (1.0f / 1024.0f) + EPSF);
#pragma unroll
        for (int j = 0; j < 4; ++j) { const int k = j * 256 + lane * 4;
            const f32x4 g = *(const f32x4*)(p.norm1_g + k), sh = *(const f32x4*)(mr + k), scv = *(const f32x4*)(mr + 1024 + k);
            float o[4];
#pragma unroll
            for (int q = 0; q < 4; ++q) o[q] = v[j][q] * rstd * g[q] * (1.0f + scv[q]) + sh[q];
            if constexpr (Z_FP8) *(unsigned*)(p.out + DO_H8 + (size_t)r * 1024 + k) = cvt_pack_fp8x4(o[0], o[1], o[2], o[3]);
            else { u32x2 w; w.x = cvt_pk_bf16(o[0], o[1]); w.y = cvt_pk_bf16(o[2], o[3]); *(u32x2*)(H + (size_t)r * 1024 + k) = w; } }
    }
}
struct PlainSched {
    ge::GridOrder go; const char* A; const char* B; size_t atile, btile;
    __device__ void init(const void* A_, int lda, const void* B_, int ldb, int nM, int nN) { A = (const char*)A_; B = (const char*)B_; atile = (size_t)256 * lda * 2; btile = (size_t)256 * ldb * 2; go.init(nM, nN, (int)gridDim.x, (int)blockIdx.x); }
    __device__ __forceinline__ bool next(int i, ge::Unit& u) const { u.e = 0; return go.tile(i, u.pm, u.pn); }
    __device__ __forceinline__ const char* a_base(const ge::Unit& u) const { return A + (size_t)u.pm * atile; }
    __device__ __forceinline__ const char* b_base(const ge::Unit& u) const { return B + (size_t)u.pn * btile; }
    __device__ __forceinline__ int a_row(const ge::Unit&, int) const { return 0; }
};

struct ZSchedF8 {
    ge::GridOrder go; const char* A; const char* B;
    __device__ void init(const void* A_, const void* B_) { A = (const char*)A_; B = (const char*)B_; go.init(NROWS / 256, NIN / 256, (int)gridDim.x, (int)blockIdx.x); }
    __device__ __forceinline__ bool next(int i, ge::Unit& u) const { u.e = 0; return go.tile(i, u.pm, u.pn); }
    __device__ __forceinline__ const char* a_base(const ge::Unit& u) const { return A + (size_t)u.pm * 256 * 1024; }
    __device__ __forceinline__ const char* b_base(const ge::Unit& u) const { return B + (size_t)u.pn * 256 * 1024; }
    __device__ __forceinline__ int a_row(const ge::Unit&, int r) const { return r; }
};
struct ZSchedBf {
    ge::GridOrder go; const char* A; const char* B;
    __device__ void init(const void* A_, const void* B_) { A = (const char*)A_; B = (const char*)B_; go.init(NROWS / 256, 1, (int)gridDim.x, (int)blockIdx.x); }
    __device__ __forceinline__ bool next(int i, ge::Unit& u) const { u.e = 0; int j; if (!go.tile(i, u.pm, j)) return false; u.pn = j; return true; }
    __device__ __forceinline__ const char* a_base(const ge::Unit& u) const { return A + (size_t)u.pm * 256 * 1024 * 2; }
    __device__ __forceinline__ const char* b_base(const ge::Unit& u) const { return B + (size_t)u.pn * 256 * 1024 * 2; }
    __device__ __forceinline__ int a_row(const ge::Unit&, int) const { return 0; }
};
struct EpiZ {
    static constexpr bool PERM = true;
    bf16_t* U; bf16_t* Z;
    __device__ __forceinline__ void operator()(const f32x4 (&acc)[2][2][4][2], const ge::Unit& u, int wr, int wc, int fr, int fq) const {
        const int row0 = u.pm * 256 + wr * 64 + fr, cl = wc * 32 + 8 * fq;
        bf16_t* base; int ld;
        if (u.pn == 0) { base = U + cl; ld = 256; } else { base = Z + (u.pn - 1) * 256 + cl; ld = ZC; }
#pragma unroll
        for (int ai = 0; ai < 2; ++ai)
#pragma unroll
            for (int m = 0; m < 4; ++m) { bf16_t* rowp = base + (size_t)(row0 + ai * 128 + m * 16) * ld;
#pragma unroll
                for (int bj = 0; bj < 2; ++bj) { const f32x4 v0 = acc[ai][bj][m][0], v1 = acc[ai][bj][m][1];
                    u32x4 w; w.x = cvt_pk_bf16(v0[0], v0[1]); w.y = cvt_pk_bf16(v0[2], v0[3]); w.z = cvt_pk_bf16(v1[0], v1[1]); w.w = cvt_pk_bf16(v1[2], v1[3]);
                    *(u32x4*)(rowp + bj * 128) = w; } }
    }
};


struct EpiZ2 {
    static constexpr bool PERM = true;
    bf16_t* Ae; bf16_t* Uc; bf16_t* Z;
    struct Pre {}; __device__ __forceinline__ Pre pre(const ge::Unit&, int, int, int, int) const { return Pre{}; }
    __device__ __forceinline__ void operator()(const f32x4 (&acc)[2][2][4][2], const ge::Unit& u, int wr, int wc, int fr, int fq, const Pre&) const { (*this)(acc, u, wr, wc, fr, fq); }
    __device__ __forceinline__ void operator()(const f32x4 (&acc)[2][2][4][2], const ge::Unit& u, int wr, int wc, int fr, int fq) const {
        const int row0 = u.pm * 256 + wr * 64 + fr, cl = wc * 32 + 8 * fq;
#pragma unroll
        for (int ai = 0; ai < 2; ++ai)
#pragma unroll
            for (int m = 0; m < 4; ++m) { const int r = row0 + ai * 128 + m * 16;
#pragma unroll
                for (int bj = 0; bj < 2; ++bj) { const f32x4 v0 = acc[ai][bj][m][0], v1 = acc[ai][bj][m][1];
                    u32x4 w; w.x = cvt_pk_bf16(v0[0], v0[1]); w.y = cvt_pk_bf16(v0[2], v0[3]); w.z = cvt_pk_bf16(v1[0], v1[1]); w.w = cvt_pk_bf16(v1[2], v1[3]);
                    bf16_t* dst;
                    if (u.pn == 0) { const int col = bj * 128 + cl, g = col >> 4, c0 = col & 15;
                        if (u.pm < NTOK / 256) { const int b = r >> 13, l = r & (SEQ - 1); dst = Ae + (size_t)(g * 512 + b * 128 + (l >> 6)) * 1280 + (l & 63) * 16 + c0; }
                        else dst = Uc + (size_t)(r - NTOK) * 256 + col; }
                    else dst = Z + (size_t)r * ZC + (u.pn - 1) * 256 + cl + bj * 128;
                    *(u32x4*)dst = w; } }
    }
};

struct EpiYa {
    static constexpr bool PERM = true;
    const bf16_t* Y; bf16_t* Ya;
    __device__ __forceinline__ void operator()(const f32x4 (&acc)[2][2][4][2], const ge::Unit& u, int wr, int wc, int fr, int fq) const {
        const int row0 = u.pm * 256 + wr * 64 + fr, col0 = u.pn * 256 + wc * 32 + 8 * fq;
        u32x4 cur[2][2], nxt[2][2];
#pragma unroll
        for (int mm = 0; mm < 2; ++mm)
#pragma unroll
            for (int bj = 0; bj < 2; ++bj) cur[mm][bj] = *(const u32x4*)(Y + (size_t)(row0 + mm * 16) * 256 + col0 + bj * 128);
#pragma unroll
        for (int gi = 0; gi < 4; ++gi) { const int ai = gi >> 1, mh = gi & 1;
            if (gi < 3) { const int ai2 = (gi + 1) >> 1, mh2 = (gi + 1) & 1;
#pragma unroll
                for (int mm = 0; mm < 2; ++mm)
#pragma unroll
                    for (int bj = 0; bj < 2; ++bj) nxt[mm][bj] = *(const u32x4*)(Y + (size_t)(row0 + ai2 * 128 + (2 * mh2 + mm) * 16) * 256 + col0 + bj * 128); }
#pragma unroll
            for (int mm = 0; mm < 2; ++mm)
#pragma unroll
                for (int bj = 0; bj < 2; ++bj) { const int m = 2 * mh + mm; const f32x4 v0 = acc[ai][bj][m][0], v1 = acc[ai][bj][m][1]; const u32x4 y4 = cur[mm][bj];
                    float o[8];
                    o[0] = bf_lo(y4.x) * sigmoidf_(v0[0]); o[1] = bf_hi(y4.x) * sigmoidf_(v0[1]); o[2] = bf_lo(y4.y) * sigmoidf_(v0[2]); o[3] = bf_hi(y4.y) * sigmoidf_(v0[3]);
                    o[4] = bf_lo(y4.z) * sigmoidf_(v1[0]); o[5] = bf_hi(y4.z) * sigmoidf_(v1[1]); o[6] = bf_lo(y4.w) * sigmoidf_(v1[2]); o[7] = bf_hi(y4.w) * sigmoidf_(v1[3]);
                    u32x4 w; w.x = cvt_pk_bf16(o[0], o[1]); w.y = cvt_pk_bf16(o[2], o[3]); w.z = cvt_pk_bf16(o[4], o[5]); w.w = cvt_pk_bf16(o[6], o[7]);
                    *(u32x4*)(Ya + (size_t)(row0 + ai * 128 + m * 16) * 256 + col0 + bj * 128) = w; }
#pragma unroll
            for (int mm = 0; mm < 2; ++mm)
#pragma unroll
                for (int bj = 0; bj < 2; ++bj) cur[mm][bj] = nxt[mm][bj];
            asm volatile("" ::: "memory"); }
    }
};

template <bool ADD> struct EpiMerge {
    static constexpr bool PERM = true;
    const bf16_t* Z; int gcol0; bf16_t* Mg;
    __device__ __forceinline__ void operator()(const f32x4 (&acc)[2][2][4][2], const ge::Unit& u, int wr, int wc, int fr, int fq) const {
        const int row0 = u.pm * 256 + wr * 64 + fr, col0 = u.pn * 256 + wc * 32 + 8 * fq;
        u32x4 gc[2][2], gn[2][2], pc[2][2], pn_[2][2];
#pragma unroll
        for (int mm = 0; mm < 2; ++mm)
#pragma unroll
            for (int bj = 0; bj < 2; ++bj) { const size_t row = (size_t)(row0 + mm * 16); gc[mm][bj] = *(const u32x4*)(Z + row * ZC + gcol0 + col0 + bj * 128); if (ADD) pc[mm][bj] = *(const u32x4*)(Mg + row * 1024 + col0 + bj * 128); }
#pragma unroll
        for (int gi = 0; gi < 4; ++gi) { const int ai = gi >> 1, mh = gi & 1;
            if (gi < 3) { const int ai2 = (gi + 1) >> 1, mh2 = (gi + 1) & 1;
#pragma unroll
                for (int mm = 0; mm < 2; ++mm)
#pragma unroll
                    for (int bj = 0; bj < 2; ++bj) { const size_t row = (size_t)(row0 + ai2 * 128 + (2 * mh2 + mm) * 16); gn[mm][bj] = *(const u32x4*)(Z + row * ZC + gcol0 + col0 + bj * 128); if (ADD) pn_[mm][bj] = *(const u32x4*)(Mg + row * 1024 + col0 + bj * 128); } }
#pragma unroll
            for (int mm = 0; mm < 2; ++mm)
#pragma unroll
                for (int bj = 0; bj < 2; ++bj) { const int m = 2 * mh + mm; const size_t row = (size_t)(row0 + ai * 128 + m * 16);
                    const f32x4 v0 = acc[ai][bj][m][0], v1 = acc[ai][bj][m][1]; const u32x4 g4 = gc[mm][bj];
                    float o[8];
                    o[0] = sigmoidf_(bf_lo(g4.x)) * v0[0]; o[1] = sigmoidf_(bf_hi(g4.x)) * v0[1]; o[2] = sigmoidf_(bf_lo(g4.y)) * v0[2]; o[3] = sigmoidf_(bf_hi(g4.y)) * v0[3];
                    o[4] = sigmoidf_(bf_lo(g4.z)) * v1[0]; o[5] = sigmoidf_(bf_hi(g4.z)) * v1[1]; o[6] = sigmoidf_(bf_lo(g4.w)) * v1[2]; o[7] = sigmoidf_(bf_hi(g4.w)) * v1[3];
                    if (ADD) { const u32x4 p4 = pc[mm][bj];
                        o[0] += bf_lo(p4.x); o[1] += bf_hi(p4.x); o[2] += bf_lo(p4.y); o[3] += bf_hi(p4.y); o[4] += bf_lo(p4.z); o[5] += bf_hi(p4.z); o[6] += bf_lo(p4.w); o[7] += bf_hi(p4.w); }
                    u32x4 w; w.x = cvt_pk_bf16(o[0], o[1]); w.y = cvt_pk_bf16(o[2], o[3]); w.z = cvt_pk_bf16(o[4], o[5]); w.w = cvt_pk_bf16(o[6], o[7]);
                    *(u32x4*)(Mg + row * 1024 + col0 + bj * 128) = w; }
#pragma unroll
            for (int mm = 0; mm < 2; ++mm)
#pragma unroll
                for (int bj = 0; bj < 2; ++bj) { gc[mm][bj] = gn[mm][bj]; if (ADD) pc[mm][bj] = pn_[mm][bj]; }
            asm volatile("" ::: "memory"); }
    }
};


struct MergeSched {
    ge::GridOrder go; const char* Ya; const char* Yb; const char* Pa; const char* Pb;
    __device__ void init(const void* ya, const void* yb, const void* pa, const void* pb) { Ya = (const char*)ya; Yb = (const char*)yb; Pa = (const char*)pa; Pb = (const char*)pb; go.init(NTOK / 256, 4, (int)gridDim.x, (int)blockIdx.x); }
    __device__ __forceinline__ bool next(int i, ge::Unit& u) const { u.e = i & 1; return go.tile(i >> 1, u.pm, u.pn); }
    __device__ __forceinline__ const char* a_base(const ge::Unit& u) const { return u.e ? Yb + (size_t)u.pm * 256 * 768 * 2 : Ya + (size_t)u.pm * 256 * 256 * 2; }
    __device__ __forceinline__ const char* b_base(const ge::Unit& u) const { return u.e ? Pb + (size_t)u.pn * 256 * 768 * 2 : Pa + (size_t)u.pn * 256 * 256 * 2; }
    __device__ __forceinline__ int nt(const ge::Unit& u) const { return u.e ? 12 : 4; }
    __device__ __forceinline__ int lda(const ge::Unit& u) const { return u.e ? 768 : 256; }
    __device__ __forceinline__ int ldb(const ge::Unit& u) const { return u.e ? 768 : 256; }
};
template <bool WT = false> struct EpiMergeF {
    static constexpr bool PERM = true;
    const bf16_t* Z; bf16_t* Mg; int ldm;
    __device__ __forceinline__ bool operator()(f32x4 (&acc)[2][2][4][2], const ge::Unit& u, int wr, int wc, int fr, int fq) const {
        const int row0 = u.pm * 256 + wr * 64 + fr, col0 = u.pn * 256 + wc * 32 + 8 * fq;
        __amdgpu_buffer_rsrc_t rs = __builtin_amdgcn_make_buffer_rsrc((void*)Mg, 0, 0x7ffffff0, 0x00020000);
        if (u.e == 0) {
#pragma unroll
            for (int gi = 0; gi < 4; ++gi) { const int ai = gi >> 1, mh = gi & 1;
                u32x4 ga[2][2], gb[2][2];
#pragma unroll
                for (int mm = 0; mm < 2; ++mm)
#pragma unroll
                    for (int bj = 0; bj < 2; ++bj) { const bf16_t* zr = Z + (size_t)(row0 + ai * 128 + (2 * mh + mm) * 16) * ZC + col0 + bj * 128; ga[mm][bj] = *(const u32x4*)(zr + ZGA); gb[mm][bj] = *(const u32x4*)(zr + ZGB); }
#pragma unroll
                for (int mm = 0; mm < 2; ++mm)
#pragma unroll
                    for (int bj = 0; bj < 2; ++bj) { const int m = 2 * mh + mm; const u32x4 a4 = ga[mm][bj], b4 = gb[mm][bj];
#define MF_R(aw, bw, lo) ((1.0f + __expf(-(lo ? bf_lo(bw) : bf_hi(bw)))) * frcp_(1.0f + __expf(-(lo ? bf_lo(aw) : bf_hi(aw)))))
                        acc[ai][bj][m][0][0] *= MF_R(a4.x, b4.x, true); acc[ai][bj][m][0][1] *= MF_R(a4.x, b4.x, false); acc[ai][bj][m][0][2] *= MF_R(a4.y, b4.y, true); acc[ai][bj][m][0][3] *= MF_R(a4.y, b4.y, false);
                        acc[ai][bj][m][1][0] *= MF_R(a4.z, b4.z, true); acc[ai][bj][m][1][1] *= MF_R(a4.z, b4.z, false); acc[ai][bj][m][1][2] *= MF_R(a4.w, b4.w, true); acc[ai][bj][m][1][3] *= MF_R(a4.w, b4.w, false);
#undef MF_R
                    }
                asm volatile("" ::: "memory"); }
            return true;
        }
#pragma unroll
        for (int gi = 0; gi < 4; ++gi) { const int ai = gi >> 1, mh = gi & 1;
            u32x4 gb[2][2];
#pragma unroll
            for (int mm = 0; mm < 2; ++mm)
#pragma unroll
                for (int bj = 0; bj < 2; ++bj) gb[mm][bj] = *(const u32x4*)(Z + (size_t)(row0 + ai * 128 + (2 * mh + mm) * 16) * ZC + ZGB + col0 + bj * 128);
#pragma unroll
            for (int mm = 0; mm < 2; ++mm)
#pragma unroll
                for (int bj = 0; bj < 2; ++bj) { const int m = 2 * mh + mm; const f32x4 v0 = acc[ai][bj][m][0], v1 = acc[ai][bj][m][1]; const u32x4 g4 = gb[mm][bj];
                    float o[8];
                    o[0] = sigmoidf_(bf_lo(g4.x)) * v0[0]; o[1] = sigmoidf_(bf_hi(g4.x)) * v0[1]; o[2] = sigmoidf_(bf_lo(g4.y)) * v0[2]; o[3] = sigmoidf_(bf_hi(g4.y)) * v0[3];
                    o[4] = sigmoidf_(bf_lo(g4.z)) * v1[0]; o[5] = sigmoidf_(bf_hi(g4.z)) * v1[1]; o[6] = sigmoidf_(bf_lo(g4.w)) * v1[2]; o[7] = sigmoidf_(bf_hi(g4.w)) * v1[3];
                    u32x4 w; w.x = cvt_pk_bf16(o[0], o[1]); w.y = cvt_pk_bf16(o[2], o[3]); w.z = cvt_pk_bf16(o[4], o[5]); w.w = cvt_pk_bf16(o[6], o[7]);
                    if constexpr (WT) __builtin_amdgcn_raw_buffer_store_b128(w, rs, (int)(((unsigned)(row0 + ai * 128 + m * 16) * (unsigned)ldm + (unsigned)(col0 + bj * 128)) * 2u), 0, 16);
                    else *(u32x4*)(Mg + (size_t)(row0 + ai * 128 + m * 16) * ldm + col0 + bj * 128) = w; }
            asm volatile("" ::: "memory"); }
        return false;
    }
};


struct OneUnitSched {
    const char* A; const char* B; int pm;
    __device__ __forceinline__ bool next(int i, ge::Unit& u) const { if (i) return false; u.pm = pm; u.pn = 0; u.e = 0; return true; }
    __device__ __forceinline__ const char* a_base(const ge::Unit& u) const { return A + (size_t)u.pm * 256 * 256 * 2; }
    __device__ __forceinline__ const char* b_base(const ge::Unit&) const { return B; }
    __device__ __forceinline__ int a_row(const ge::Unit&, int) const { return 0; }
};
struct PanelMergeSched {
    const char* Ya; const char* Yb; const char* Pa; const char* Pb; int pm, pn0;
    __device__ __forceinline__ bool next(int i, ge::Unit& u) const { if (i >= 4) return false; u.pm = pm; u.pn = pn0 + (i >> 1); u.e = i & 1; return true; }
    __device__ __forceinline__ const char* a_base(const ge::Unit& u) const { return u.e ? Yb + (size_t)u.pm * 256 * 768 * 2 : Ya + (size_t)u.pm * 256 * 256 * 2; }
    __device__ __forceinline__ const char* b_base(const ge::Unit& u) const { return u.e ? Pb + (size_t)u.pn * 256 * 768 * 2 : Pa + (size_t)u.pn * 256 * 256 * 2; }
    __device__ __forceinline__ int nt(const ge::Unit& u) const { return u.e ? 12 : 4; }
    __device__ __forceinline__ int lda(const ge::Unit& u) const { return u.e ? 768 : 256; }
    __device__ __forceinline__ int ldb(const ge::Unit& u) const { return u.e ? 768 : 256; }
};

template <bool WT = false> struct EpiX1 {
    static constexpr bool PERM = false;
    const float* X; const float* mod; float* X1;
    __device__ __forceinline__ void operator()(const f32x4 (&acc)[2][2][4][2], const ge::Unit& u, int wr, int wc, int fr, int fq) const {
        const int row0 = u.pm * 256 + wr * 64 + fr, col0 = u.pn * 256 + wc * 32 + 4 * fq;
        const float* g1 = mod + (size_t)((u.pm * 256) / SEQ) * NIN + 2048;
        f32x4 gv[2][2];
#pragma unroll
        for (int bj = 0; bj < 2; ++bj)
#pragma unroll
            for (int n = 0; n < 2; ++n) gv[bj][n] = *(const f32x4*)(g1 + col0 + bj * 128 + n * 16);
        __amdgpu_buffer_rsrc_t rs = __builtin_amdgcn_make_buffer_rsrc((void*)X1, 0, 0x7ffffff0, 0x00020000);
        f32x4 cur[2][2], nxt[2][2];
#pragma unroll
        for (int bj = 0; bj < 2; ++bj)
#pragma unroll
            for (int n = 0; n < 2; ++n) cur[bj][n] = *(const f32x4*)(X + (size_t)row0 * 1024 + col0 + bj * 128 + n * 16);
#pragma unroll
        for (int gi = 0; gi < 8; ++gi) { const int ai = gi >> 2, m = gi & 3;
            if (gi < 7) { const int ai2 = (gi + 1) >> 2, m2 = (gi + 1) & 3;
#pragma unroll
                for (int bj = 0; bj < 2; ++bj)
#pragma unroll
                    for (int n = 0; n < 2; ++n) nxt[bj][n] = *(const f32x4*)(X + (size_t)(row0 + ai2 * 128 + m2 * 16) * 1024 + col0 + bj * 128 + n * 16); }
#pragma unroll
            for (int bj = 0; bj < 2; ++bj)
#pragma unroll
                for (int n = 0; n < 2; ++n) { const f32x4 r = cur[bj][n] + gv[bj][n] * acc[ai][bj][m][n];
                    if constexpr (WT) __builtin_amdgcn_raw_buffer_store_b128(__builtin_bit_cast(u32x4, r), rs, (int)(((unsigned)(row0 + ai * 128 + m * 16) * 1024u + (unsigned)(col0 + bj * 128 + n * 16)) * 4u), 0, 16);
                    else *(f32x4*)(X1 + (size_t)(row0 + ai * 128 + m * 16) * 1024 + col0 + bj * 128 + n * 16) = r; }
#pragma unroll
            for (int bj = 0; bj < 2; ++bj)
#pragma unroll
                for (int n = 0; n < 2; ++n) cur[bj][n] = nxt[bj][n];
            asm volatile("" ::: "memory"); }
    }
};


__device__ __forceinline__ void pair_sync(unsigned* cnt, unsigned target, unsigned* tmo) {
    asm volatile("s_waitcnt vmcnt(0)" ::: "memory");
    __syncthreads();
    if (threadIdx.x == 0) {
        (void)__hip_atomic_fetch_add(cnt, 1u, __ATOMIC_RELAXED, __HIP_MEMORY_SCOPE_AGENT);
        unsigned sp = 0;
        while (__hip_atomic_load(cnt, __ATOMIC_RELAXED, __HIP_MEMORY_SCOPE_AGENT) < target) { __builtin_amdgcn_s_sleep(1);
            if ((++sp & 255u) == 0u) { if (__hip_atomic_load(tmo, __ATOMIC_RELAXED, __HIP_MEMORY_SCOPE_AGENT)) break; if (sp > (1u << 20)) { atomicAdd(tmo, 1u); break; } } }
        __builtin_amdgcn_fence(__ATOMIC_ACQUIRE, "agent");
        asm volatile("s_waitcnt vmcnt(0)" ::: "memory");
    }
    __syncthreads();
}
struct PanelX1Sched {
    const char* A; const char* B; int pm, pn0, nu;
    __device__ __forceinline__ bool next(int i, ge::Unit& u) const { if (i >= nu) return false; u.pm = pm; u.pn = pn0 + i; u.e = 0; return true; }
    __device__ __forceinline__ const char* a_base(const ge::Unit& u) const { return A + (size_t)u.pm * 256 * ZC * 2; }
    __device__ __forceinline__ const char* b_base(const ge::Unit& u) const { return B + (size_t)u.pn * 256 * 1024 * 2; }
    __device__ __forceinline__ int a_row(const ge::Unit&, int) const { return 0; }
};

__device__ __forceinline__ unsigned pack_fp8x4(float a, float b, float c, float d) {
    a = __builtin_amdgcn_fmed3f(a, -448.f, 448.f); b = __builtin_amdgcn_fmed3f(b, -448.f, 448.f); c = __builtin_amdgcn_fmed3f(c, -448.f, 448.f); d = __builtin_amdgcn_fmed3f(d, -448.f, 448.f);
    int w = 0; w = __builtin_amdgcn_cvt_pk_fp8_f32(a, b, w, false); w = __builtin_amdgcn_cvt_pk_fp8_f32(c, d, w, true); return (unsigned)w;
}

__device__ __forceinline__ bf16_t* hid_rows(unsigned char* ws, unsigned char* out, int rb) {
    (void)out; return (bf16_t*)(ws + OFF_HID1 + (size_t)rb * 256 * EH);
}
__device__ __forceinline__ int xcd_perm(int c, int G) { return (G & 7) ? c : (c & 7) * (G >> 3) + (c >> 3); }
struct MoeSched1 {
    const int* blk_e; const int* nblk; const int* row_tok; const char* h2; const char* bt1; int G, c;
    __device__ __forceinline__ bool next(int i, ge::Unit& u) const { const int rb = (i >> 1) * G + xcd_perm(c, G); if (rb >= *nblk) return false; u.pm = rb; u.pn = i & 1; u.e = blk_e[rb]; return true; }
    __device__ __forceinline__ const char* a_base(const ge::Unit&) const { return h2; }
    __device__ __forceinline__ const char* b_base(const ge::Unit& u) const { return bt1 + ((size_t)u.e * 512 + (size_t)u.pn * 256) * 1024 * 2; }
    __device__ __forceinline__ int a_row(const ge::Unit& u, int r) const { return row_tok[u.pm * 256 + r]; }
};

constexpr int MP_BASE = 131072, MP_TOT = MP_BASE, MP_PS = MP_BASE + 256, MP_PART = MP_BASE + 1024, MP_MINE = MP_BASE + 3072, MP_PREF = MP_BASE + 4096, MP_RT = MP_BASE + 9216;
constexpr int MP_MAXRB = 5;
__device__ __forceinline__ void moe_pull_prep(const Params& p, LAS unsigned char* lds) {
    int tid = threadIdx.x; asm volatile("" : "+v"(tid));
    const int nb = (int)gridDim.x, bid = (int)blockIdx.x, lane = tid & 63, wid = tid >> 6;
    const int* bc = (const int*)(p.ws + OFF_BCNT); const int* lst = (const int*)(p.ws + OFF_LIST);
    int* cnt = (int*)(p.ws + OFF_CNT); int* pstart = cnt + 128; int* nblk_g = cnt + 256; int* blk_e = (int*)(p.ws + OFF_BLKE); int* row_dst = (int*)(p.ws + OFF_ROWDST);
    LAS int* tot = (LAS int*)(lds + MP_TOT); LAS int* ps = (LAS int*)(lds + MP_PS); LAS int* part = (LAS int*)(lds + MP_PART); LAS int* mine = (LAS int*)(lds + MP_MINE);
    LAS int* pref = (LAS int*)(lds + MP_PREF); LAS int* rt = (LAS int*)(lds + MP_RT);
    { const int e = tid & 63, pg = tid >> 6, per = (nb + 7) / 8; int t = 0;
#pragma unroll 8
      for (int wg = pg * per; wg < (pg + 1) * per; ++wg) if (wg < nb) t += bc[wg * 64 + e];
      part[pg * 64 + e] = t; }
    __syncthreads();
    if (tid < 64) { int t = 0;
#pragma unroll
        for (int pg = 0; pg < 8; ++pg) t += part[pg * 64 + tid];
        tot[tid] = t; }
    __syncthreads();
    if (tid == 0) { int a = 0; for (int e = 0; e < 64; ++e) { ps[e] = a; a += (tot[e] + 255) / 256 * 256; } ps[64] = a; ps[65] = a + NTOK;
        const int nblk = ps[65] / 256; int n = 0;
        for (int i = 0; i < MP_MAXRB; ++i) { const int rb = i * nb + xcd_perm(bid, nb); if (rb < nblk) { int e = 0; while (e < 64 && rb * 256 >= ps[e + 1]) ++e; mine[1 + 3 * n] = rb; mine[2 + 3 * n] = e; mine[3 + 3 * n] = rb * 256 - ps[e]; ++n; } }
        mine[0] = n; }
    __syncthreads();
    const int nmine = mine[0];
    for (int j = 0; j < (MP_MAXRB + 1) / 2; ++j) { const int sl = 2 * j + (wid >> 2), b = (wid & 3) * 64 + lane; const bool act = sl < nmine && mine[2 + 3 * sl] < 64;
        int v = (act && b < nb) ? bc[b * 64 + mine[2 + 3 * (act ? sl : 0)]] : 0; const int own = v;
#pragma unroll
        for (int o = 1; o < 64; o <<= 1) { const int u = __shfl_up(v, o); if (lane >= o) v += u; }
        if (lane == 63) part[wid] = v;
        __syncthreads();
        int base = 0;
#pragma unroll
        for (int q = 0; q < 4; ++q) if (q < (wid & 3)) base += part[(wid & ~3) + q];
        if (act) pref[sl * 256 + b] = base + v - own;
        __syncthreads(); }
    for (int j = 0; j < (MP_MAXRB + 1) / 2; ++j) { const int sl = 2 * j + (tid >> 8), r = tid & 255;
        if (sl < nmine) { const int rb = mine[1 + 3 * sl], e = mine[2 + 3 * sl], jrow = mine[3 + 3 * sl] + r; int tokv, dst;
            if (e >= 64) { tokv = jrow; dst = -1; }
            else if (jrow >= tot[e]) { tokv = NTOK; dst = -1; }
            else { int lo = 0, hi = (nb < 256 ? nb : 256) - 1;
                while (lo < hi) { const int mid = (lo + hi + 1) >> 1; if (pref[sl * 256 + mid] <= jrow) lo = mid; else hi = mid - 1; }
                dst = lst[((size_t)lo * 64 + e) * 128 + (jrow - pref[sl * 256 + lo])]; tokv = dst >> 3; }
            rt[sl * 256 + r] = tokv; if (e < 64) row_dst[rb * 256 + r] = dst; } }
    if (bid == 0) {
        if (tid < 66) pstart[tid] = ps[tid];
        if (tid == 0) *nblk_g = ps[65] / 256;
        for (int rb = tid; rb < ps[65] / 256; rb += 512) { int e = 0; while (e < 64 && rb * 256 >= ps[e + 1]) ++e; blk_e[rb] = e; }
    }
    __syncthreads();
}
struct MoeSched1P {
    LAS unsigned char* lds; const char* h2; const char* bt1;
    __device__ __forceinline__ bool next(int i, ge::Unit& u) const { const LAS int* mine = (const LAS int*)(lds + MP_MINE); const int k = i >> 1; if (k >= mine[0]) return false; u.k = k; u.pm = mine[1 + 3 * k]; u.e = mine[2 + 3 * k]; u.pn = i & 1; return true; }
    __device__ __forceinline__ const char* a_base(const ge::Unit&) const { return h2; }
    __device__ __forceinline__ const char* b_base(const ge::Unit& u) const { return bt1 + ((size_t)u.e * 512 + (size_t)u.pn * 256) * 1024; }
    __device__ __forceinline__ int a_row(const ge::Unit& u, int r) const { return ((const LAS int*)(lds + MP_RT))[u.k * 256 + r]; }
};
struct EpiHid {
    static constexpr bool PERM = true;
    unsigned char* ws; unsigned char* out;
    struct Pre {}; __device__ __forceinline__ Pre pre(const ge::Unit&, int, int, int, int) const { return Pre{}; }
    __device__ __forceinline__ void operator()(const f32x4 (&acc)[2][2][4][2], const ge::Unit& u, int wr, int wc, int fr, int fq, const Pre&) const {
        unsigned char* base = (unsigned char*)hid_rows(ws, out, u.pm) + (size_t)(wr * 64 + fr) * EH + u.pn * 128 + wc * 32 + 8 * fq;
#pragma unroll
        for (int ai = 0; ai < 2; ++ai)
#pragma unroll
            for (int m = 0; m < 4; ++m) { const f32x4 a0 = acc[ai][0][m][0], a1 = acc[ai][0][m][1], b0 = acc[ai][1][m][0], b1 = acc[ai][1][m][1];
                const f32x4 z0 = a0 * (-1.4426950408889634f), z1 = a1 * (-1.4426950408889634f);
                f32x4 d0, d1;
#pragma unroll
                for (int q = 0; q < 4; ++q) { d0[q] = frcp_(1.0f + __builtin_amdgcn_exp2f(z0[q])); d1[q] = frcp_(1.0f + __builtin_amdgcn_exp2f(z1[q])); }
                const f32x4 h0 = a0 * b0 * d0, h1 = a1 * b1 * d1;
                u32x2 w; w.x = pack_fp8x4(h0[0], h0[1], h0[2], h0[3]); w.y = pack_fp8x4(h1[0], h1[1], h1[2], h1[3]);
                *(u32x2*)(base + (size_t)(ai * 128 + m * 16) * EH) = w; }
    }
};
struct MoeSched2 {
    const int* blk_e; const int* nblk; unsigned char* ws; unsigned char* out; const char* bt2; int G, c;
    __device__ __forceinline__ bool next(int i, ge::Unit& u) const { const int rb = (i >> 2) * G + xcd_perm(c, G); if (rb >= *nblk) return false; u.pm = rb; u.pn = i & 3; u.e = blk_e[rb]; return true; }
    __device__ __forceinline__ const char* a_base(const ge::Unit& u) const { return (const char*)hid_rows(ws, out, u.pm); }
    __device__ __forceinline__ const char* b_base(const ge::Unit& u) const { return bt2 + ((size_t)u.e * 1024 + (size_t)u.pn * 256) * EH; }
    __device__ __forceinline__ int a_row(const ge::Unit&, int r) const { return r; }
};
struct EpiY2 {
    static constexpr bool PERM = true;
    unsigned char* Y2; unsigned char* Y2s; const int* pstart; const int* row_dst;
    struct Pre { int rd[2][2]; };
    __device__ __forceinline__ Pre pre(const ge::Unit& u, int wr, int wc, int fr, int fq) const { Pre q; const int rl = u.pm * 256 + wr * 64 + fr + (fq & 1) * 16; (void)wc;
#pragma unroll
        for (int ai = 0; ai < 2; ++ai)
#pragma unroll
            for (int mp = 0; mp < 2; ++mp) q.rd[ai][mp] = (u.e < NEXP) ? row_dst[rl + ai * 128 + mp * 32] : 0;
        return q; }
    __device__ __forceinline__ void operator()(const f32x4 (&acc)[2][2][4][2], const ge::Unit& u, int wr, int wc, int fr, int fq, const Pre& pq) const {
        const int r0 = u.pm * 256 + wr * 64 + fr, colg = u.pn * 256 + wc * 32 + 8 * fq;
        if (u.e < NEXP) {
            const int cl2 = colg - (fq & 1) * 8;
            int rd[2][2];
#pragma unroll
            for (int ai = 0; ai < 2; ++ai)
#pragma unroll
                for (int mp = 0; mp < 2; ++mp) rd[ai][mp] = pq.rd[ai][mp];
#pragma unroll
            for (int ai = 0; ai < 2; ++ai)
#pragma unroll
                for (int mp = 0; mp < 2; ++mp)
#pragma unroll
                    for (int bj = 0; bj < 2; ++bj) { const f32x4 v0 = acc[ai][bj][2 * mp][0], v1 = acc[ai][bj][2 * mp][1], v2 = acc[ai][bj][2 * mp + 1][0], v3 = acc[ai][bj][2 * mp + 1][1];
                        unsigned ax = pack_fp8x4(v0[0], v0[1], v0[2], v0[3]), ay = pack_fp8x4(v1[0], v1[1], v1[2], v1[3]), bx = pack_fp8x4(v2[0], v2[1], v2[2], v2[3]), by = pack_fp8x4(v3[0], v3[1], v3[2], v3[3]);
                        { auto r = __builtin_amdgcn_permlane16_swap(ax, bx, false, false); ax = r[0]; bx = r[1]; }
                        { auto r = __builtin_amdgcn_permlane16_swap(ay, by, false, false); ay = r[0]; by = r[1]; }
                        u32x4 w; w.x = ax; w.y = ay; w.z = bx; w.w = by;
                        if (rd[ai][mp] >= 0) *(u32x4*)(Y2 + (size_t)rd[ai][mp] * 1024 + cl2 + bj * 128) = w; }
        } else {
            const int t0 = r0 - pstart[NEXP] + (fq & 1) * 16, cl2 = colg - (fq & 1) * 8;
#pragma unroll
            for (int ai = 0; ai < 2; ++ai)
#pragma unroll
                for (int mp = 0; mp < 2; ++mp)
#pragma unroll
                    for (int bj = 0; bj < 2; ++bj) { const f32x4 v0 = acc[ai][bj][2 * mp][0], v1 = acc[ai][bj][2 * mp][1], v2 = acc[ai][bj][2 * mp + 1][0], v3 = acc[ai][bj][2 * mp + 1][1];
                        unsigned ax = pack_fp8x4(v0[0], v0[1], v0[2], v0[3]), ay = pack_fp8x4(v1[0], v1[1], v1[2], v1[3]), bx = pack_fp8x4(v2[0], v2[1], v2[2], v2[3]), by = pack_fp8x4(v3[0], v3[1], v3[2], v3[3]);
                        { auto r = __builtin_amdgcn_permlane16_swap(ax, bx, false, false); ax = r[0]; bx = r[1]; }
                        { auto r = __builtin_amdgcn_permlane16_swap(ay, by, false, false); ay = r[0]; by = r[1]; }
                        u32x4 w; w.x = ax; w.y = ay; w.z = bx; w.w = by;
                        *(u32x4*)(Y2s + (size_t)(t0 + ai * 128 + mp * 32) * 1024 + cl2 + bj * 128) = w; }
        }
    }
};

struct EpiNull { static constexpr bool PERM = true; float* sink;
    __device__ __forceinline__ void operator()(const f32x4 (&acc)[2][2][4][2], const ge::Unit& u, int wr, int wc, int fr, int fq) const {
        float s = 0.f;
#pragma unroll
        for (int ai = 0; ai < 2; ++ai)
#pragma unroll
            for (int bj = 0; bj < 2; ++bj)
#pragma unroll
                for (int m = 0; m < 4; ++m)
#pragma unroll
                    for (int n = 0; n < 2; ++n) s += acc[ai][bj][m][n][0] + acc[ai][bj][m][n][1] + acc[ai][bj][m][n][2] + acc[ai][bj][m][n][3];
        if (s == 12345.678f) sink[0] = s; } };
struct MoeSched2R {
    const int* blk_e; const int* pstart; unsigned char* ws; unsigned char* out; const char* bt2; int G, c;
    __device__ __forceinline__ bool next(int i, ge::Unit& u) const { const int rb = (i >> 2) * G + c; if (rb >= pstart[NEXP] / 256) return false; u.pm = rb; u.pn = i & 3; u.e = blk_e[rb]; return true; }
    __device__ __forceinline__ const char* a_base(const ge::Unit& u) const { return (const char*)hid_rows(ws, out, u.pm); }
    __device__ __forceinline__ const char* b_base(const ge::Unit& u) const { return bt2 + ((size_t)u.e * 1024 + (size_t)u.pn * 256) * EH * 2; }
    __device__ __forceinline__ int a_row(const ge::Unit&, int) const { return 0; }
};
constexpr size_t DO_LP = 120 * MiB, DO_BBAR = DO_LP + 1088 * 1024, DO_KTAB = DO_BBAR + 256 * 1024, DO_UC = 124 * MiB;
constexpr size_t OFF_MG = 26 * MiB, OFF_AEXT = 34 * MiB, OFF_XEND = 54 * MiB, OFF_WEXT = 62 * MiB, OFF_YS5 = 102 * MiB;
constexpr int AEK = 1280;

__device__ __forceinline__ void s5_tab1_phase(const Params& p) {
    f32x2* Lp = (f32x2*)(p.out + DO_LP); f32x2* Bb = (f32x2*)(p.out + DO_BBAR);
    const int gt = blockIdx.x * blockDim.x + threadIdx.x, gs = gridDim.x * blockDim.x;
    for (int i = gt; i < 2048 * 65; i += gs) { const int pi = i / 65, j = i % 65, dg = pi >> 6;
        const double lre = fmin((double)p.lam_re[pi], -1e-4), lim = (double)p.lam_im[pi], dt = exp((double)p.log_dt[dg]);
        const double er = exp(lre * dt * (double)j), th = lim * dt * (double)j;
        Lp[i] = (f32x2){(float)(er * cos(th)), (float)(er * sin(th))}; }
    for (int i = gt; i < 2048 * 16; i += gs) { const int pi = i >> 4, dg = pi >> 6;
        const double lre = fmin((double)p.lam_re[pi], -1e-4), lim = (double)p.lam_im[pi], dt = exp((double)p.log_dt[dg]);
        const double er = exp(lre * dt), th = lim * dt, nr = er * cos(th) - 1.0, ni = er * sin(th), den = lre * lre + lim * lim;
        const double cfr = (nr * lre + ni * lim) / den, cfi = (ni * lre - nr * lim) / den;
        const double br = p.b_re[i], bi = p.b_im[i];
        Bb[i] = (f32x2){(float)(cfr * br - cfi * bi), (float)(cfr * bi + cfi * br)}; }
}
__device__ __forceinline__ void s5_tab2_phase(const Params& p, int vb, int nvb) {
    const f32x2* Lp = (const f32x2*)(p.out + DO_LP); const f32x2* Bb = (const f32x2*)(p.out + DO_BBAR); float* Kt = (float*)(p.out + DO_KTAB); bf16_t* Mg = (bf16_t*)(p.ws + OFF_MG);
    const int gt = vb * 512 + threadIdx.x, gs = nvb * 512;
    for (int i = gt; i < 2 * 16 * 64 * 256; i += gs) { const int cp = i & 15, c = (i >> 4) & 15, j = (i >> 8) & 63, dg = i >> 14, g = dg & 15;
        float s = 0.f;
#pragma unroll 16
        for (int pp = 0; pp < 64; ++pp) { const f32x2 l = Lp[(dg * 64 + pp) * 65 + j], b = Bb[(dg * 64 + pp) * 16 + cp];
            const float xr = l.x * b.x - l.y * b.y, xi = l.x * b.y + l.y * b.x;
            s += p.c_re[(g * 16 + c) * 64 + pp] * xr - p.c_im[(g * 16 + c) * 64 + pp] * xi; }
        Kt[i] = s; }
    for (int i = gt; i < 16 * 256 * 128; i += gs) { const int k8 = i & 127, n = (i >> 7) & 255, g = i >> 15;
        const int dir = n >> 7, part = (n >> 6) & 1, pp = n & 63, s = k8 >> 1, c0 = (k8 & 1) * 8, dg = dir * 16 + g;
        const f32x2 l = Lp[(dg * 64 + pp) * 65 + (dir ? s : 63 - s)];
        float v[8];
#pragma unroll
        for (int q = 0; q < 8; ++q) { const f32x2 b = Bb[(dg * 64 + pp) * 16 + c0 + q]; v[q] = part ? (l.x * b.y + l.y * b.x) : (l.x * b.x - l.y * b.y); }
        u32x4 w; w.x = cvt_pk_bf16(v[0], v[1]); w.y = cvt_pk_bf16(v[2], v[3]); w.z = cvt_pk_bf16(v[4], v[5]); w.w = cvt_pk_bf16(v[6], v[7]);
        *(u32x4*)(Mg + ((size_t)(g * 256 + n)) * 1024 + k8 * 8) = w; }
}
__device__ __forceinline__ void s5_wfill_phase(const Params& p, int vb, int nvb) {
    const f32x2* Lp = (const f32x2*)(p.out + DO_LP); const float* Kt = (const float*)(p.out + DO_KTAB); bf16_t* W = (bf16_t*)(p.ws + OFF_WEXT);
    for (int i = vb * 512 + threadIdx.x; i < 16 * 1024 * 160; i += nvb * 512) { const int k8 = i % 160, n = (i / 160) & 1023, g = i / (160 * 1024), t = n >> 4, c = n & 15;
        float v[8];
        if (k8 < 128) { const int s = k8 >> 1, c0 = (k8 & 1) * 8;
            if (s < t) { const float* kp = Kt + ((((0 * 16 + g) * 64 + (t - s)) * 16 + c) * 16 + c0);
#pragma unroll
                for (int q = 0; q < 8; ++q) v[q] = kp[q]; }
            else if (s > t) { const float* kp = Kt + ((((1 * 16 + g) * 64 + (s - t)) * 16 + c) * 16 + c0);
#pragma unroll
                for (int q = 0; q < 8; ++q) v[q] = kp[q]; }
            else { const float* kf = Kt + ((((0 * 16 + g) * 64) * 16 + c) * 16 + c0); const float* kb = Kt + ((((1 * 16 + g) * 64) * 16 + c) * 16 + c0);
#pragma unroll
                for (int q = 0; q < 8; ++q) v[q] = kf[q] + kb[q] + ((c0 + q == c) ? p.s5_d[g * 16 + c] : 0.f); }
        } else { const int kk = (k8 - 128) * 8, dir = kk >> 7, part = (kk >> 6) & 1, p0 = kk & 63, dg = dir * 16 + g, e = dir ? (64 - t) : (t + 1);
#pragma unroll
            for (int q = 0; q < 8; ++q) { const f32x2 l = Lp[(dg * 64 + p0 + q) * 65 + e]; const float cr = p.c_re[(g * 16 + c) * 64 + p0 + q], ci = p.c_im[(g * 16 + c) * 64 + p0 + q];
                v[q] = part ? -(cr * l.y + ci * l.x) : (cr * l.x - ci * l.y); } }
        u32x4 w; w.x = cvt_pk_bf16(v[0], v[1]); w.y = cvt_pk_bf16(v[2], v[3]); w.z = cvt_pk_bf16(v[4], v[5]); w.w = cvt_pk_bf16(v[6], v[7]);
        *(u32x4*)(W + ((size_t)(g * 1024 + n)) * AEK + k8 * 8) = w; }
}

struct S5aSched {
    const char* A; const char* B; int G, c;
    __device__ __forceinline__ bool next(int i, ge::Unit& u) const { const int L = i * G + c; if (L >= 32) return false; u.e = L >> 1; u.pm = L & 1; u.pn = 0; return true; }
    __device__ __forceinline__ const char* a_base(const ge::Unit& u) const { return A + (size_t)(u.e * 512 + u.pm * 256) * AEK * 2; }
    __device__ __forceinline__ const char* b_base(const ge::Unit& u) const { return B + (size_t)u.e * 256 * 1024 * 2; }
    __device__ __forceinline__ int a_row(const ge::Unit&, int) const { return 0; }
};
struct EpiXend {
    static constexpr bool PERM = false;
    float* X;
    __device__ __forceinline__ void operator()(const f32x4 (&acc)[2][2][4][2], const ge::Unit& u, int wr, int wc, int fr, int fq) const {
        float* base = X + (size_t)(u.e * 512 + u.pm * 256 + wr * 64 + fr) * 256 + wc * 32 + 4 * fq;
#pragma unroll
        for (int ai = 0; ai < 2; ++ai)
#pragma unroll
            for (int m = 0; m < 4; ++m)
#pragma unroll
                for (int bj = 0; bj < 2; ++bj)
#pragma unroll
                    for (int n = 0; n < 2; ++n) *(f32x4*)(base + (size_t)(ai * 128 + m * 16) * 256 + bj * 128 + n * 16) = acc[ai][bj][m][n];
    }
};
__device__ __forceinline__ void s5a_phase(const Params& p, LAS unsigned char* lds, int vb, int nvb) {
    S5aSched S{(const char*)(p.ws + OFF_AEXT), (const char*)(p.ws + OFF_MG), nvb, vb};
    EpiXend E{(float*)(p.ws + OFF_XEND)};
    ge::gemm_phase<EpiXend, S5aSched, false>(lds, 1024, AEK, 1024, S, E);
    for (int L = vb; L < 32; L += nvb) {
        const int g = L >> 1, pm = L & 1; int tid = threadIdx.x; asm volatile("" : "+v"(tid));
        const f32x2* Lp = (const f32x2*)(p.out + DO_LP); const f32x2* Bb = (const f32x2*)(p.out + DO_BBAR); const bf16_t* uc = (const bf16_t*)(p.out + DO_UC);
        LAS float* us = (LAS float*)lds; LAS f32x2* xh = (LAS f32x2*)(lds + 32768);
        for (int i = tid; i < 2 * CTXL * 2; i += 512) { const int half = i & 1, row = i >> 1;
            const u32x4 u0 = *(const u32x4*)(uc + (size_t)((pm * 2 + (row >> 8)) * CTXL + (row & 255)) * 256 + g * 16 + half * 8);
            LAS float* d = us + row * 16 + half * 8;
            d[0] = bf_lo(u0.x); d[1] = bf_hi(u0.x); d[2] = bf_lo(u0.y); d[3] = bf_hi(u0.y); d[4] = bf_lo(u0.z); d[5] = bf_hi(u0.z); d[6] = bf_lo(u0.w); d[7] = bf_hi(u0.w); }
        __syncthreads();
        const int hq = tid >> 8, t2 = tid & 255, bb = t2 >> 7, dir = (t2 >> 6) & 1, pp = t2 & 63, b = pm * 2 + bb, dg = dir * 16 + g;
        const f32x2 l1 = Lp[(dg * 64 + pp) * 65 + 1], l64 = Lp[(dg * 64 + pp) * 65 + 64];
        float xr = 0.f, xi = 0.f;
        { float Br[16], Bi[16];
#pragma unroll
          for (int q = 0; q < 16; ++q) { const f32x2 tq = Bb[(dg * 64 + pp) * 16 + q]; Br[q] = tq.x; Bi[q] = tq.y; }
#pragma unroll 4
          for (int s = hq * 128; s < hq * 128 + 128; ++s) { const int lc = dir ? (CTXL - 1 - s) : s;
              const LAS float* up = us + (bb * CTXL + lc) * 16;
              const f32x4 ua = *(const LAS f32x4*)up, ub = *(const LAS f32x4*)(up + 4), uc4 = *(const LAS f32x4*)(up + 8), ud = *(const LAS f32x4*)(up + 12);
              float bur = 0.f, bui = 0.f;
#pragma unroll
              for (int q = 0; q < 4; ++q) { bur += Br[q] * ua[q] + Br[4 + q] * ub[q] + Br[8 + q] * uc4[q] + Br[12 + q] * ud[q]; bui += Bi[q] * ua[q] + Bi[4 + q] * ub[q] + Bi[8 + q] * uc4[q] + Bi[12 + q] * ud[q]; }
              const float nr = l1.x * xr - l1.y * xi + bur, ni = l1.x * xi + l1.y * xr + bui; xr = nr; xi = ni; } }
        if (hq == 1) xh[t2] = (f32x2){xr, xi};
        __syncthreads();
        if (hq == 0) {
            const float l128r = l64.x * l64.x - l64.y * l64.y, l128i = 2.0f * l64.x * l64.y; const f32x2 x2 = xh[t2];
            { const float nr = l128r * xr - l128i * xi + x2.x, ni = l128r * xi + l128i * xr + x2.y; xr = nr; xi = ni; }
            const float* Xe = (const float*)(p.ws + OFF_XEND); bf16_t* Ae = (bf16_t*)(p.ws + OFF_AEXT);
#pragma unroll 8
            for (int s = 0; s < 128; ++s) { const int m = dir ? (127 - s) : s; const size_t row = (size_t)(g * 512 + b * 128 + m);
                Ae[row * AEK + 1024 + dir * 128 + pp] = f2bf(xr); Ae[row * AEK + 1024 + dir * 128 + 64 + pp] = f2bf(xi);
                const float er = Xe[row * 256 + dir * 128 + pp], ei = Xe[row * 256 + dir * 128 + 64 + pp];
                const float nr = l64.x * xr - l64.y * xi + er, ni = l64.x * xi + l64.y * xr + ei; xr = nr; xi = ni; }
        }
        __syncthreads();
    }
}

struct S5bSched {
    const char* A; const char* B; int G, c;
    __device__ __forceinline__ bool next(int i, ge::Unit& u) const { const int L = i * G + c; if (L >= 128) return false; u.e = L >> 3; u.pm = (L >> 2) & 1; u.pn = L & 3; return true; }
    __device__ __forceinline__ const char* a_base(const ge::Unit& u) const { return A + (size_t)(u.e * 512 + u.pm * 256) * AEK * 2; }
    __device__ __forceinline__ const char* b_base(const ge::Unit& u) const { return B + (size_t)(u.e * 1024 + u.pn * 256) * AEK * 2; }
    __device__ __forceinline__ int a_row(const ge::Unit&, int) const { return 0; }
};
struct EpiYs5 {
    static constexpr bool PERM = true;
    bf16_t* Y;
    __device__ __forceinline__ void operator()(const f32x4 (&acc)[2][2][4][2], const ge::Unit& u, int wr, int wc, int fr, int fq) const {
        bf16_t* rp = Y + ((size_t)(u.pm * 256 + wr * 64 + fr) * 64 + u.pn * 16 + wc * 2 + (fq >> 1)) * 256 + u.e * 16 + 8 * (fq & 1);
#pragma unroll
        for (int ai = 0; ai < 2; ++ai)
#pragma unroll
            for (int m = 0; m < 4; ++m) {
#pragma unroll
                for (int bj = 0; bj < 2; ++bj) { f32x4 v0 = acc[ai][bj][m][0], v1 = acc[ai][bj][m][1];
                    asm volatile("" : "+v"(v0), "+v"(v1));
                    u32x4 w; w.x = cvt_pk_bf16(gelu_tanh(v0[0]), gelu_tanh(v0[1])); w.y = cvt_pk_bf16(gelu_tanh(v0[2]), gelu_tanh(v0[3]));
                    w.z = cvt_pk_bf16(gelu_tanh(v1[0]), gelu_tanh(v1[1])); w.w = cvt_pk_bf16(gelu_tanh(v1[2]), gelu_tanh(v1[3]));
                    *(u32x4*)(rp + bj * 8 * 256) = w; asm volatile("" ::: "memory"); }
                rp += (m == 3) ? (size_t)(128 - 48) * 64 * 256 : (size_t)16 * 64 * 256;
                asm volatile("" : "+v"(rp)); }
    }
};
__device__ __forceinline__ void s5b_phase(const Params& p, LAS unsigned char* lds, int vb, int nvb) {
    S5bSched S{(const char*)(p.ws + OFF_AEXT), (const char*)(p.ws + OFF_WEXT), nvb, vb};
    EpiYs5 E{(bf16_t*)(p.ws + OFF_YS5)};
    ge::gemm_phase<EpiYs5, S5bSched, false>(lds, AEK, AEK, AEK, S, E);
}
constexpr size_t DO_KV = 96 * MiB, DO_DEC = 125 * MiB;
constexpr int GLA_SLOTS = 16;
constexpr int GL_QI = 0, GL_KI = 17408, GL_KIT = 34816, GL_VT = 53248, GL_P = 71680, GL_TOT = 80896, GL_EREF = 89088, GL_ETOT = 89600;
constexpr int GLA_NSEG = 8, GLA_SEGC = 16;

template <bool PASS1, int VAR = 0>
__device__ __forceinline__ void gla_unit(const Params& p, LAS unsigned char* lds, const int chain, const int ch0, const int nch, const int nfold) {
    int tid = threadIdx.x; asm volatile("" : "+v"(tid));
    const int w = __builtin_amdgcn_readfirstlane(tid >> 6), lane = tid & 63, vloc = lane & 15, rq = lane >> 4;
    const int dir = chain & 1, h = (chain >> 1) % 6, b = chain / 12;
    const bf16_t* Z = (const bf16_t*)(p.ws + OFF_Z);
    bf16_t* O = (bf16_t*)(p.out + (dir ? DO_OB : DO_OF));
    float* KV = (float*)(p.out + DO_KV); float* DEC = (float*)(p.out + DO_DEC);
    const bool isctx = false; const int slot = 0; (void)slot;
    static_assert(!PASS1, "pass 1 uses gla_pass1_unit");
    const float l0a = p.lb_logits[h * 128 + 2 * lane], l1a = p.lb_logits[768 + h * 128 + 2 * lane], l0b = p.lb_logits[h * 128 + 2 * lane + 1], l1b = p.lb_logits[768 + h * 128 + 2 * lane + 1];
    const float lb0 = frcp_(1.0f + __expf(l1a - l0a)), lb1 = frcp_(1.0f + __expf(l1b - l0b));
    const int colf = (dir ? ZFB : ZFF) + h * 128 + 2 * lane, colq = ZQ + h * 128 + 2 * lane, colv = ZI + h * 128 + 2 * lane;
    auto chunk_rows = [&](int ci, int& base, int& stride) {
        if (isctx) { if (dir == 0) { base = NTOK + b * CTXL + 64 * ci; stride = 1; } else { base = NTOK + b * CTXL + 255 - 64 * ci; stride = -1; } }
        else { const int n = ch0 + ci;
            if (dir == 0) { base = b * SEQ + 4096 * (n & 1) + (n >> 1); stride = 64; }
            else { const int n2 = 127 - n; base = b * SEQ + 4096 * (n2 & 1) + (n2 >> 1) + 64 * 63; stride = -64; } }
    };
    f32x4 S[8];
    if (PASS1) {
#pragma unroll
        for (int it = 0; it < 8; ++it) S[it] = (f32x4){0.f, 0.f, 0.f, 0.f};
    } else {
#pragma unroll
        for (int it = 0; it < 8; ++it) S[it] = (f32x4){0.f, 0.f, 0.f, 0.f};
        for (int sl = 0; sl < nfold; ++sl) {
            const unsigned* kv = (const unsigned*)KV + ((size_t)(chain * GLA_SLOTS + sl) * 8 + w) * 16 * 64 + lane; const float* dc = DEC + (size_t)(chain * GLA_SLOTS + sl) * 128;
#pragma unroll
            for (int it = 0; it < 8; ++it) { const f32x4 d = *(const f32x4*)(dc + 16 * it + 4 * rq); const unsigned w0 = kv[(it * 2) * 64], w1 = kv[(it * 2 + 1) * 64];
                S[it][0] = d[0] * S[it][0] + bf_lo(w0); S[it][1] = d[1] * S[it][1] + bf_hi(w0); S[it][2] = d[2] * S[it][2] + bf_lo(w1); S[it][3] = d[3] * S[it][3] + bf_hi(w1); }
        }
    }
    float dsum0 = 1.f, dsum1 = 1.f;
    unsigned nz[8], nv[8], nq[8];
    { int base, stride; chunk_rows(0, base, stride);
#pragma unroll
      for (int r = 0; r < 8; ++r) { const size_t ro = (size_t)(base + stride * (8 * w + r)) * ZC; nz[r] = *(const unsigned*)(Z + ro + colf); nv[r] = *(const unsigned*)(Z + ro + colv); if (!PASS1) nq[r] = *(const unsigned*)(Z + ro + colq); } }
    for (int ci = 0; ci < nch; ++ci) {
        unsigned cz[8], cv[8], cq[8];
#pragma unroll
        for (int r = 0; r < 8; ++r) { cz[r] = nz[r]; cv[r] = nv[r]; if (!PASS1) cq[r] = nq[r]; }
        int base, stride; chunk_rows(ci, base, stride);
        if (ci + 1 < nch) { int nb_, ns_; chunk_rows(ci + 1, nb_, ns_);
#pragma unroll
            for (int r = 0; r < 8; ++r) { const size_t ro = (size_t)(nb_ + ns_ * (8 * w + r)) * ZC; nz[r] = *(const unsigned*)(Z + ro + colf); nv[r] = *(const unsigned*)(Z + ro + colv); if (!PASS1) nq[r] = *(const unsigned*)(Z + ro + colq); } }
        f32x2 cp[8], kk[8]; f32x2 run = (f32x2){1.0f, 1.0f};
        const f32x2 lbv = (f32x2){lb0, lb1}, one = (f32x2){1.0f, 1.0f}, omlb = one - lbv;
#pragma unroll
        for (int r = 0; r < 8; ++r) { const f32x2 z = (f32x2){bf_lo(cz[r]), bf_hi(cz[r])}; const f32x2 zz = z * (-1.4426950408889634f);
            f32x2 E; E.x = __builtin_amdgcn_exp2f(zz.x); E.y = __builtin_amdgcn_exp2f(zz.y);
            const f32x2 d = one + E; f32x2 D; D.x = frcp_(d.x); D.y = frcp_(d.y);
            const f32x2 f = (one + lbv * E) * D;
            kk[r] = omlb * E * D;
            run = run * f; cp[r] = run; }
        *(LAS f32x2*)(lds + GL_TOT + (w * 128 + 2 * lane) * 4) = run;
        __syncthreads();
        f32x2 pre = one, refp = one, totp = one;
#pragma unroll
        for (int ww = 0; ww < 8; ++ww) { const f32x2 tv = *(const LAS f32x2*)(lds + GL_TOT + (ww * 128 + 2 * lane) * 4);
            if (ww < w) pre = pre * tv; if (ww < 4) refp = refp * tv; totp = totp * tv; }
        dsum0 *= totp.x; dsum1 *= totp.y;
        f32x2 invR; invR.x = frcp_(refp.x); invR.y = frcp_(refp.y);
        { const f32x2 s_q = pre * invR; f32x2 ki[8];
#pragma unroll
          for (int r = 0; r < 8; ++r) { const f32x2 e = s_q * cp[r]; f32x2 ie; ie.x = frcp_(e.x); ie.y = frcp_(e.y);
              ki[r] = kk[r] * ie;
              const int t = 8 * w + r;
              if (!PASS1) { const f32x2 qv = (f32x2){bf_lo(cq[r]), bf_hi(cq[r])} * e;
                            *(LAS unsigned*)(lds + GL_QI + t * 272 + lane * 4) = cvt_pk_bf16(qv.x, qv.y);
                            *(LAS unsigned*)(lds + GL_KI + t * 272 + lane * 4) = cvt_pk_bf16(ki[r].x, ki[r].y); } }
          u32x4 a, bq;
          a.x = cvt_pk_bf16(ki[0].x, ki[1].x); a.y = cvt_pk_bf16(ki[2].x, ki[3].x); a.z = cvt_pk_bf16(ki[4].x, ki[5].x); a.w = cvt_pk_bf16(ki[6].x, ki[7].x);
          bq.x = cvt_pk_bf16(ki[0].y, ki[1].y); bq.y = cvt_pk_bf16(ki[2].y, ki[3].y); bq.z = cvt_pk_bf16(ki[4].y, ki[5].y); bq.w = cvt_pk_bf16(ki[6].y, ki[7].y);
          *(LAS u32x4*)(lds + GL_KIT + (2 * lane) * 144 + 16 * w) = a; *(LAS u32x4*)(lds + GL_KIT + (2 * lane + 1) * 144 + 16 * w) = bq;
          u32x4 va, vb2;
          va.x = (cv[0] & 0xffffu) | (cv[1] << 16); va.y = (cv[2] & 0xffffu) | (cv[3] << 16); va.z = (cv[4] & 0xffffu) | (cv[5] << 16); va.w = (cv[6] & 0xffffu) | (cv[7] << 16);
          vb2.x = (cv[0] >> 16) | (cv[1] & 0xffff0000u); vb2.y = (cv[2] >> 16) | (cv[3] & 0xffff0000u); vb2.z = (cv[4] >> 16) | (cv[5] & 0xffff0000u); vb2.w = (cv[6] >> 16) | (cv[7] & 0xffff0000u);
          *(LAS u32x4*)(lds + GL_VT + (2 * lane) * 144 + 16 * w) = va; *(LAS u32x4*)(lds + GL_VT + (2 * lane + 1) * 144 + 16 * w) = vb2; }
        if (w == 0) { *(LAS f32x2*)(lds + GL_EREF + 2 * lane * 4) = refp; *(LAS f32x2*)(lds + GL_ETOT + 2 * lane * 4) = totp * invR; }
        __syncthreads();
#pragma unroll
        for (int it = 0; it < 8; ++it) { const f32x4 er = *(const LAS f32x4*)(lds + GL_EREF + (16 * it + 4 * rq) * 4); S[it] = S[it] * er; }
        f32x4 o[4];
        if (!PASS1 && VAR != 2) {
            bf16x8 Sb[4];
#pragma unroll
            for (int c = 0; c < 4; ++c) { u32x4 t; t.x = cvt_pk_bf16(S[2 * c][0], S[2 * c][1]); t.y = cvt_pk_bf16(S[2 * c][2], S[2 * c][3]); t.z = cvt_pk_bf16(S[2 * c + 1][0], S[2 * c + 1][1]); t.w = cvt_pk_bf16(S[2 * c + 1][2], S[2 * c + 1][3]); Sb[c] = __builtin_bit_cast(bf16x8, t); }
#pragma unroll
            for (int tt = 0; tt < 4; ++tt) { o[tt] = (f32x4){0.f, 0.f, 0.f, 0.f};
#pragma unroll
                for (int c = 0; c < (VAR == 4 ? 0 : 4); ++c) { const LAS unsigned char* qa = lds + GL_QI + (16 * tt + vloc) * 272 + (32 * c + 4 * rq) * 2;
                    const u32x2 lo = *(const LAS u32x2*)qa, hi = *(const LAS u32x2*)(qa + 32);
                    u32x4 t; t.x = lo.x; t.y = lo.y; t.z = hi.x; t.w = hi.y;
                    o[tt] = __builtin_amdgcn_mfma_f32_16x16x32_bf16(__builtin_bit_cast(bf16x8, t), Sb[c], o[tt], 0, 0, 0); } }
            { const int tt = w >> 1;
#pragma unroll
              for (int sh = 0; sh < (VAR == 5 ? 0 : 2); ++sh) { const int st = 2 * (w & 1) + sh; f32x4 pacc = (f32x4){0.f, 0.f, 0.f, 0.f};
#pragma unroll
                  for (int c = 0; c < 4; ++c) { const bf16x8 ka = *(const LAS bf16x8*)(lds + GL_KI + (16 * st + vloc) * 272 + (32 * c + 8 * rq) * 2);
                      const bf16x8 qb = *(const LAS bf16x8*)(lds + GL_QI + (16 * tt + vloc) * 272 + (32 * c + 8 * rq) * 2);
                      pacc = __builtin_amdgcn_mfma_f32_16x16x32_bf16(ka, qb, pacc, 0, 0, 0); }
                  const int tg = 16 * tt + vloc, sg = 16 * st + 4 * rq;
                  u32x2 pw; pw.x = cvt_pk_bf16(sg + 0 <= tg ? pacc[0] : 0.f, sg + 1 <= tg ? pacc[1] : 0.f); pw.y = cvt_pk_bf16(sg + 2 <= tg ? pacc[2] : 0.f, sg + 3 <= tg ? pacc[3] : 0.f);
                  *(LAS u32x2*)(lds + GL_P + tg * 144 + sg * 2) = pw; } }
        }
        __syncthreads();
        if (VAR != 2) { bf16x8 vb[2];
#pragma unroll
          for (int c = 0; c < 2; ++c) vb[c] = *(const LAS bf16x8*)(lds + GL_VT + (16 * w + vloc) * 144 + (32 * c + 8 * rq) * 2);
          if (!PASS1) {
#pragma unroll
              for (int tt = 0; tt < (VAR == 5 ? 0 : 4); ++tt)
#pragma unroll
                  for (int c = 0; c < 2; ++c) { const bf16x8 pa = *(const LAS bf16x8*)(lds + GL_P + (16 * tt + vloc) * 144 + (32 * c + 8 * rq) * 2); o[tt] = __builtin_amdgcn_mfma_f32_16x16x32_bf16(pa, vb[c], o[tt], 0, 0, 0); }
          }
#pragma unroll
          for (int it = 0; it < 8; ++it)
#pragma unroll
              for (int c = 0; c < 2; ++c) { const bf16x8 ka = *(const LAS bf16x8*)(lds + GL_KIT + (16 * it + vloc) * 144 + (32 * c + 8 * rq) * 2); S[it] = __builtin_amdgcn_mfma_f32_16x16x32_bf16(ka, vb[c], S[it], 0, 0, 0); }
#pragma unroll
          for (int it = 0; it < 8; ++it) { const f32x4 et = *(const LAS f32x4*)(lds + GL_ETOT + (16 * it + 4 * rq) * 4); S[it] = S[it] * et; }
          if (!PASS1) {
#pragma unroll
              for (int tt = 0; tt < 4; ++tt)
#pragma unroll
                  for (int j = 0; j < 4; ++j) { const int t = 16 * tt + 4 * rq + j; if (VAR == 0 || o[tt][j] == 1.2345e-30f) O[(size_t)(base + stride * t) * 768 + h * 128 + 16 * w + vloc] = f2bf(o[tt][j]); }
          } }
    }
    __syncthreads();
}

constexpr int G1_KIT = 0, G1_VT = 34816, G1_TOT = 69632, G1_EREF = 77824, G1_ETOT = 78336;
__device__ __forceinline__ void gla_pass1_unit(const Params& p, LAS unsigned char* lds, const int chain, const int slot) {
    int tid = threadIdx.x; asm volatile("" : "+v"(tid));
    const int w = __builtin_amdgcn_readfirstlane(tid >> 6), lane = tid & 63, vloc = lane & 15, rq = lane >> 4;
    const int dir = chain & 1, h = (chain >> 1) % 6, b = chain / 12;
    const bf16_t* Z = (const bf16_t*)(p.ws + OFF_Z);
    float* KV = (float*)(p.out + DO_KV); float* DEC = (float*)(p.out + DO_DEC);
    const bool isctx = slot == 0;
    const int nst = isctx ? 2 : 4, col0 = isctx ? 0 : (slot - 1) * 4;
    const float l0a = p.lb_logits[h * 128 + 2 * lane], l1a = p.lb_logits[768 + h * 128 + 2 * lane], l0b = p.lb_logits[h * 128 + 2 * lane + 1], l1b = p.lb_logits[768 + h * 128 + 2 * lane + 1];
    const float lb0 = frcp_(1.0f + __expf(l1a - l0a)), lb1 = frcp_(1.0f + __expf(l1b - l0b));
    const int colf = (dir ? ZFB : ZFF) + h * 128 + 2 * lane, colv = ZI + h * 128 + 2 * lane;
    auto step_rows = [&](int j, int& base, int& stride) {
        if (isctx) { if (dir == 0) { base = NTOK + b * CTXL + 128 * j; stride = 1; } else { base = NTOK + b * CTXL + 255 - 128 * j; stride = -1; } }
        else { const int c = col0 + j;
            if (dir == 0) { base = b * SEQ + c; stride = 64; } else { base = b * SEQ + (63 - c) + 64 * 127; stride = -64; } }
    };
    f32x4 S[8];
#pragma unroll
    for (int it = 0; it < 8; ++it) S[it] = (f32x4){0.f, 0.f, 0.f, 0.f};
    float dsum0 = 1.f, dsum1 = 1.f;
    unsigned nz[16], nv[16];
    { int base, stride; step_rows(0, base, stride);
#pragma unroll
      for (int r = 0; r < 16; ++r) { const size_t ro = (size_t)(base + stride * (16 * w + r)) * ZC; nz[r] = *(const unsigned*)(Z + ro + colf); nv[r] = *(const unsigned*)(Z + ro + colv); } }
    for (int j = 0; j < nst; ++j) {
        unsigned cz[16], cv[16];
#pragma unroll
        for (int r = 0; r < 16; ++r) { cz[r] = nz[r]; cv[r] = nv[r]; }
        if (j + 1 < nst) { int nb_, ns_; step_rows(j + 1, nb_, ns_);
#pragma unroll
            for (int r = 0; r < 16; ++r) { const size_t ro = (size_t)(nb_ + ns_ * (16 * w + r)) * ZC; nz[r] = *(const unsigned*)(Z + ro + colf); nv[r] = *(const unsigned*)(Z + ro + colv); } }
        f32x2 cp[16], kk[16]; f32x2 run = (f32x2){1.0f, 1.0f};
        const f32x2 lbv = (f32x2){lb0, lb1}, one = (f32x2){1.0f, 1.0f}, omlb = one - lbv;
#pragma unroll
        for (int r = 0; r < 16; ++r) { const f32x2 z = (f32x2){bf_lo(cz[r]), bf_hi(cz[r])}; const f32x2 zz = z * (-1.4426950408889634f);
            f32x2 E; E.x = __builtin_amdgcn_exp2f(zz.x); E.y = __builtin_amdgcn_exp2f(zz.y);
            const f32x2 d = one + E; f32x2 D; D.x = frcp_(d.x); D.y = frcp_(d.y);
            const f32x2 f = (one + lbv * E) * D; kk[r] = omlb * E * D; run = run * f; cp[r] = run; }
        *(LAS f32x2*)(lds + G1_TOT + (w * 128 + 2 * lane) * 4) = run;
        __syncthreads();
        f32x2 pre = one, refp = one, totp = one;
#pragma unroll
        for (int ww = 0; ww < 8; ++ww) { const f32x2 tv = *(const LAS f32x2*)(lds + G1_TOT + (ww * 128 + 2 * lane) * 4);
            if (ww < w) pre = pre * tv; if (ww < 4) refp = refp * tv; totp = totp * tv; }
        dsum0 *= totp.x; dsum1 *= totp.y;
        f32x2 invR; invR.x = frcp_(refp.x); invR.y = frcp_(refp.y);
        { unsigned k0p[8], k1p[8], v0p[8], v1p[8]; const f32x2 s_q = pre * invR;
#pragma unroll
          for (int r = 0; r < 16; r += 2) { const f32x2 ea = s_q * cp[r], eb = s_q * cp[r + 1]; f32x2 ia, ib; ia.x = frcp_(ea.x); ia.y = frcp_(ea.y); ib.x = frcp_(eb.x); ib.y = frcp_(eb.y);
              const f32x2 ka_ = kk[r] * ia, kb_ = kk[r + 1] * ib;
              k0p[r >> 1] = cvt_pk_bf16(ka_.x, kb_.x); k1p[r >> 1] = cvt_pk_bf16(ka_.y, kb_.y);
              v0p[r >> 1] = (cv[r] & 0xffffu) | (cv[r + 1] << 16); v1p[r >> 1] = (cv[r] >> 16) | (cv[r + 1] & 0xffff0000u); }
          LAS unsigned char* ka = lds + G1_KIT + (2 * lane) * 272 + 32 * w; LAS unsigned char* va = lds + G1_VT + (2 * lane) * 272 + 32 * w;
          *(LAS u32x4*)ka = (u32x4){k0p[0], k0p[1], k0p[2], k0p[3]}; *(LAS u32x4*)(ka + 16) = (u32x4){k0p[4], k0p[5], k0p[6], k0p[7]};
          *(LAS u32x4*)(ka + 272) = (u32x4){k1p[0], k1p[1], k1p[2], k1p[3]}; *(LAS u32x4*)(ka + 272 + 16) = (u32x4){k1p[4], k1p[5], k1p[6], k1p[7]};
          *(LAS u32x4*)va = (u32x4){v0p[0], v0p[1], v0p[2], v0p[3]}; *(LAS u32x4*)(va + 16) = (u32x4){v0p[4], v0p[5], v0p[6], v0p[7]};
          *(LAS u32x4*)(va + 272) = (u32x4){v1p[0], v1p[1], v1p[2], v1p[3]}; *(LAS u32x4*)(va + 272 + 16) = (u32x4){v1p[4], v1p[5], v1p[6], v1p[7]}; }
        if (w == 0) { *(LAS f32x2*)(lds + G1_EREF + 2 * lane * 4) = refp; *(LAS f32x2*)(lds + G1_ETOT + 2 * lane * 4) = totp * invR; }
        __syncthreads();
#pragma unroll
        for (int it = 0; it < 8; ++it) { const f32x4 er = *(const LAS f32x4*)(lds + G1_EREF + (16 * it + 4 * rq) * 4); S[it] = S[it] * er; }
        { bf16x8 vb[4];
#pragma unroll
          for (int c = 0; c < 4; ++c) vb[c] = *(const LAS bf16x8*)(lds + G1_VT + (16 * w + vloc) * 272 + (32 * c + 8 * rq) * 2);
#pragma unroll
          for (int it = 0; it < 8; ++it)
#pragma unroll
              for (int c = 0; c < 4; ++c) { const bf16x8 ka = *(const LAS bf16x8*)(lds + G1_KIT + (16 * it + vloc) * 272 + (32 * c + 8 * rq) * 2); S[it] = __builtin_amdgcn_mfma_f32_16x16x32_bf16(ka, vb[c], S[it], 0, 0, 0); } }
#pragma unroll
        for (int it = 0; it < 8; ++it) { const f32x4 et = *(const LAS f32x4*)(lds + G1_ETOT + (16 * it + 4 * rq) * 4); S[it] = S[it] * et; }
    }
    unsigned* kv = (unsigned*)KV + ((size_t)(chain * GLA_SLOTS + slot) * 8 + w) * 16 * 64 + lane;
#pragma unroll
    for (int it = 0; it < 8; ++it) { kv[(it * 2) * 64] = cvt_pk_bf16(S[it][0], S[it][1]); kv[(it * 2 + 1) * 64] = cvt_pk_bf16(S[it][2], S[it][3]); }
    if (w == 0) *(f32x2*)(DEC + (size_t)(chain * GLA_SLOTS + slot) * 128 + 2 * lane) = (f32x2){dsum0, dsum1};
    __syncthreads();
}

constexpr int G3_IMG = 73728, G3_QI = 0, G3_KI = 17408, G3_KIT = 34816, G3_VT = 53248, G3_EREF = 71680, G3_ETOT = 72192, G3_P = 147456, G3_TOT = 156672;
__device__ __forceinline__ void gla_unit_p3(const Params& p, LAS unsigned char* lds, const int chain, const int ch0, const int nch, const int nfold) {
    int tid = threadIdx.x; asm volatile("" : "+v"(tid));
    const int w = __builtin_amdgcn_readfirstlane(tid >> 6), lane = tid & 63, vloc = lane & 15, rq = lane >> 4;
    const int dir = chain & 1, h = (chain >> 1) % 6, b = chain / 12;
    const bf16_t* Z = (const bf16_t*)(p.ws + OFF_Z);
    bf16_t* O = (bf16_t*)(p.out + (dir ? DO_OB : DO_OF));
    const float* KV = (const float*)(p.out + DO_KV); const float* DEC = (const float*)(p.out + DO_DEC);
    const float l0a = p.lb_logits[h * 128 + 2 * lane], l1a = p.lb_logits[768 + h * 128 + 2 * lane], l0b = p.lb_logits[h * 128 + 2 * lane + 1], l1b = p.lb_logits[768 + h * 128 + 2 * lane + 1];
    const float lb0 = frcp_(1.0f + __expf(l1a - l0a)), lb1 = frcp_(1.0f + __expf(l1b - l0b));
    const int colf = (dir ? ZFB : ZFF) + h * 128 + 2 * lane, colq = ZQ + h * 128 + 2 * lane, colv = ZI + h * 128 + 2 * lane;
    auto chunk_rows = [&](int ci, int& base, int& stride) { const int n = ch0 + ci;
        if (dir == 0) { base = b * SEQ + 4096 * (n & 1) + (n >> 1); stride = 64; }
        else { const int n2 = 127 - n; base = b * SEQ + 4096 * (n2 & 1) + (n2 >> 1) + 64 * 63; stride = -64; } };
    unsigned zA[8], qB[8], vB[8];
    float cl0[8], cl1[8], kk0[8], kk1[8];
    f32x4 S[8], o[4];
#define G3_LOADZ(ci) do { int b_, s_; chunk_rows(ci, b_, s_); _Pragma("unroll") for (int r = 0; r < 8; ++r) zA[r] = *(const unsigned*)(Z + (size_t)(b_ + s_ * (8 * w + r)) * ZC + colf); } while (0)
#define G3_LOADQV(ci) do { int b_, s_; chunk_rows(ci, b_, s_); _Pragma("unroll") for (int r = 0; r < 8; ++r) { const size_t ro = (size_t)(b_ + s_ * (8 * w + r)) * ZC; qB[r] = *(const unsigned*)(Z + ro + colq); vB[r] = *(const unsigned*)(Z + ro + colv); } } while (0)
#define G3_STAGE_A() do { float c0 = 0.f, c1 = 0.f; \
        _Pragma("unroll") for (int r = 0; r < 8; ++r) { const float s0 = sigmoidf_(bf_lo(zA[r])), s1 = sigmoidf_(bf_hi(zA[r])); \
            const float f0 = lb0 + (1.0f - lb0) * s0, f1 = lb1 + (1.0f - lb1) * s1; \
            c0 += __logf(f0); c1 += __logf(f1); cl0[r] = c0; cl1[r] = c1; kk0[r] = (1.0f - lb0) * (1.0f - s0); kk1[r] = (1.0f - lb1) * (1.0f - s1); } \
        *(LAS f32x2*)(lds + G3_TOT + (w * 128 + 2 * lane) * 4) = (f32x2){c0, c1}; } while (0)
#define G3_STAGE_B(IB) do { float pre0 = 0.f, pre1 = 0.f, ref0 = 0.f, ref1 = 0.f, tot0 = 0.f, tot1 = 0.f; \
        _Pragma("unroll") for (int ww = 0; ww < 8; ++ww) { const f32x2 tv = *(const LAS f32x2*)(lds + G3_TOT + (ww * 128 + 2 * lane) * 4); \
            if (ww < w) { pre0 += tv.x; pre1 += tv.y; } if (ww < 4) { ref0 += tv.x; ref1 += tv.y; } tot0 += tv.x; tot1 += tv.y; } \
        float ki0[8], ki1[8]; \
        _Pragma("unroll") for (int r = 0; r < 8; ++r) { const float e0 = __expf(pre0 + cl0[r] - ref0), e1 = __expf(pre1 + cl1[r] - ref1); \
            ki0[r] = kk0[r] * frcp_(e0); ki1[r] = kk1[r] * frcp_(e1); const int t = 8 * w + r; \
            *(LAS unsigned*)(lds + (IB) + G3_QI + t * 272 + lane * 4) = cvt_pk_bf16(bf_lo(qB[r]) * e0, bf_hi(qB[r]) * e1); \
            *(LAS unsigned*)(lds + (IB) + G3_KI + t * 272 + lane * 4) = cvt_pk_bf16(ki0[r], ki1[r]); } \
        u32x4 a_, b_; \
        a_.x = cvt_pk_bf16(ki0[0], ki0[1]); a_.y = cvt_pk_bf16(ki0[2], ki0[3]); a_.z = cvt_pk_bf16(ki0[4], ki0[5]); a_.w = cvt_pk_bf16(ki0[6], ki0[7]); \
        b_.x = cvt_pk_bf16(ki1[0], ki1[1]); b_.y = cvt_pk_bf16(ki1[2], ki1[3]); b_.z = cvt_pk_bf16(ki1[4], ki1[5]); b_.w = cvt_pk_bf16(ki1[6], ki1[7]); \
        *(LAS u32x4*)(lds + (IB) + G3_KIT + (2 * lane) * 144 + 16 * w) = a_; *(LAS u32x4*)(lds + (IB) + G3_KIT + (2 * lane + 1) * 144 + 16 * w) = b_; \
        u32x4 va, vb2; \
        va.x = (vB[0] & 0xffffu) | (vB[1] << 16); va.y = (vB[2] & 0xffffu) | (vB[3] << 16); va.z = (vB[4] & 0xffffu) | (vB[5] << 16); va.w = (vB[6] & 0xffffu) | (vB[7] << 16); \
        vb2.x = (vB[0] >> 16) | (vB[1] & 0xffff0000u); vb2.y = (vB[2] >> 16) | (vB[3] & 0xffff0000u); vb2.z = (vB[4] >> 16) | (vB[5] & 0xffff0000u); vb2.w = (vB[6] >> 16) | (vB[7] & 0xffff0000u); \
        *(LAS u32x4*)(lds + (IB) + G3_VT + (2 * lane) * 144 + 16 * w) = va; *(LAS u32x4*)(lds + (IB) + G3_VT + (2 * lane + 1) * 144 + 16 * w) = vb2; \
        if (w == 0) { *(LAS f32x2*)(lds + (IB) + G3_EREF + 2 * lane * 4) = (f32x2){__expf(ref0), __expf(ref1)}; *(LAS f32x2*)(lds + (IB) + G3_ETOT + 2 * lane * 4) = (f32x2){__expf(tot0 - ref0), __expf(tot1 - ref1)}; } } while (0)
#define G3_STAGE_C(IB) do { \
        _Pragma("unroll") for (int it = 0; it < 8; ++it) { const f32x4 er = *(const LAS f32x4*)(lds + (IB) + G3_EREF + (16 * it + 4 * rq) * 4); S[it] = S[it] * er; } \
        bf16x8 Sb[4]; \
        _Pragma("unroll") for (int c = 0; c < 4; ++c) { u32x4 t; t.x = cvt_pk_bf16(S[2 * c][0], S[2 * c][1]); t.y = cvt_pk_bf16(S[2 * c][2], S[2 * c][3]); t.z = cvt_pk_bf16(S[2 * c + 1][0], S[2 * c + 1][1]); t.w = cvt_pk_bf16(S[2 * c + 1][2], S[2 * c + 1][3]); Sb[c] = __builtin_bit_cast(bf16x8, t); } \
        _Pragma("unroll") for (int tt = 0; tt < 4; ++tt) { o[tt] = (f32x4){0.f, 0.f, 0.f, 0.f}; \
            _Pragma("unroll") for (int c = 0; c < 4; ++c) { const LAS unsigned char* qa = lds + (IB) + G3_QI + (16 * tt + vloc) * 272 + (32 * c + 4 * rq) * 2; \
                const u32x2 lo = *(const LAS u32x2*)qa, hi = *(const LAS u32x2*)(qa + 32); u32x4 t; t.x = lo.x; t.y = lo.y; t.z = hi.x; t.w = hi.y; \
                o[tt] = __builtin_amdgcn_mfma_f32_16x16x32_bf16(__builtin_bit_cast(bf16x8, t), Sb[c], o[tt], 0, 0, 0); } } \
        { const int tt = w >> 1; \
          _Pragma("unroll") for (int sh = 0; sh < 2; ++sh) { const int st = 2 * (w & 1) + sh; f32x4 pacc = (f32x4){0.f, 0.f, 0.f, 0.f}; \
              _Pragma("unroll") for (int c = 0; c < 4; ++c) { const bf16x8 ka = *(const LAS bf16x8*)(lds + (IB) + G3_KI + (16 * st + vloc) * 272 + (32 * c + 8 * rq) * 2); \
                  const bf16x8 qb = *(const LAS bf16x8*)(lds + (IB) + G3_QI + (16 * tt + vloc) * 272 + (32 * c + 8 * rq) * 2); \
                  pacc = __builtin_amdgcn_mfma_f32_16x16x32_bf16(ka, qb, pacc, 0, 0, 0); } \
              const int tg = 16 * tt + vloc, sg = 16 * st + 4 * rq; \
              u32x2 pw; pw.x = cvt_pk_bf16(sg + 0 <= tg ? pacc[0] : 0.f, sg + 1 <= tg ? pacc[1] : 0.f); pw.y = cvt_pk_bf16(sg + 2 <= tg ? pacc[2] : 0.f, sg + 3 <= tg ? pacc[3] : 0.f); \
              *(LAS u32x2*)(lds + G3_P + tg * 144 + sg * 2) = pw; } } } while (0)
#define G3_STAGE_D(IB, CI) do { bf16x8 vb[2]; \
        _Pragma("unroll") for (int c = 0; c < 2; ++c) vb[c] = *(const LAS bf16x8*)(lds + (IB) + G3_VT + (16 * w + vloc) * 144 + (32 * c + 8 * rq) * 2); \
        _Pragma("unroll") for (int tt = 0; tt < 4; ++tt) _Pragma("unroll") for (int c = 0; c < 2; ++c) { const bf16x8 pa = *(const LAS bf16x8*)(lds + G3_P + (16 * tt + vloc) * 144 + (32 * c + 8 * rq) * 2); o[tt] = __builtin_amdgcn_mfma_f32_16x16x32_bf16(pa, vb[c], o[tt], 0, 0, 0); } \
        _Pragma("unroll") for (int it = 0; it < 8; ++it) _Pragma("unroll") for (int c = 0; c < 2; ++c) { const bf16x8 ka = *(const LAS bf16x8*)(lds + (IB) + G3_KIT + (16 * it + vloc) * 144 + (32 * c + 8 * rq) * 2); S[it] = __builtin_amdgcn_mfma_f32_16x16x32_bf16(ka, vb[c], S[it], 0, 0, 0); } \
        _Pragma("unroll") for (int it = 0; it < 8; ++it) { const f32x4 et = *(const LAS f32x4*)(lds + (IB) + G3_ETOT + (16 * it + 4 * rq) * 4); S[it] = S[it] * et; } \
        { int b_, s_; chunk_rows(CI, b_, s_); \
          _Pragma("unroll") for (int tt = 0; tt < 4; ++tt) _Pragma("unroll") for (int j = 0; j < 4; ++j) { const int t = 16 * tt + 4 * rq + j; O[(size_t)(b_ + s_ * t) * 768 + h * 128 + 16 * w + vloc] = f2bf(o[tt][j]); } } } while (0)
    G3_LOADZ(0); G3_LOADQV(0);
#pragma unroll
    for (int it = 0; it < 8; ++it) S[it] = (f32x4){0.f, 0.f, 0.f, 0.f};
    for (int sl = 0; sl < nfold; ++sl) {
        const unsigned* kv = (const unsigned*)KV + ((size_t)(chain * GLA_SLOTS + sl) * 8 + w) * 16 * 64 + lane; const float* dc = DEC + (size_t)(chain * GLA_SLOTS + sl) * 128;
#pragma unroll
        for (int it = 0; it < 8; ++it) { const f32x4 d = *(const f32x4*)(dc + 16 * it + 4 * rq); const unsigned w0 = kv[(it * 2) * 64], w1 = kv[(it * 2 + 1) * 64];
            S[it][0] = d[0] * S[it][0] + bf_lo(w0); S[it][1] = d[1] * S[it][1] + bf_hi(w0); S[it][2] = d[2] * S[it][2] + bf_lo(w1); S[it][3] = d[3] * S[it][3] + bf_hi(w1); }
    }
    G3_STAGE_A();
    if (1 < nch) G3_LOADZ(1);
    __syncthreads();
    G3_STAGE_B(0);
    if (1 < nch) G3_LOADQV(1);
    __syncthreads();
    if (1 < nch) { G3_STAGE_A(); if (2 < nch) G3_LOADZ(2); }
    __syncthreads();
    for (int n = 0; n < nch; ++n) {
        const int ib = (n & 1) * G3_IMG, ib1 = ((n + 1) & 1) * G3_IMG;
        if (w < 4) { G3_STAGE_C(ib); G3_STAGE_B(ib1); } else { G3_STAGE_B(ib1); G3_STAGE_C(ib); }
        G3_LOADQV(n + 2 < nch ? n + 2 : nch - 1);
        __syncthreads();
        if (w < 4) { G3_STAGE_D(ib, n); G3_STAGE_A(); } else { G3_STAGE_A(); G3_STAGE_D(ib, n); }
        G3_LOADZ(n + 3 < nch ? n + 3 : nch - 1);
        __syncthreads();
    }
#undef G3_LOADZ
#undef G3_LOADQV
#undef G3_STAGE_A
#undef G3_STAGE_B
#undef G3_STAGE_C
#undef G3_STAGE_D
}
__device__ __forceinline__ void yb_rows(const Params& p, const int r0, const int nrows) {
    int tid = threadIdx.x; asm volatile("" : "+v"(tid));
    const int wid = tid >> 6, lane = tid & 63;
    const bf16_t* Of = (const bf16_t*)(p.out + DO_OF); const bf16_t* Ob = (const bf16_t*)(p.out + DO_OB); const bf16_t* Z = (const bf16_t*)(p.ws + OFF_Z); bf16_t* Yb = (bf16_t*)(p.ws + OFF_YB);
    const float gn0 = p.hg_norm_g[lane * 2], gn1 = p.hg_norm_g[lane * 2 + 1];
    for (int t = r0 + wid; t < r0 + nrows; t += 8) {
        unsigned a[6], bb[6], gw[6];
#pragma unroll
        for (int h = 0; h < 6; ++h) { const int col = h * 128 + lane * 2; a[h] = *(const unsigned*)(Of + (size_t)t * 768 + col); bb[h] = *(const unsigned*)(Ob + (size_t)t * 768 + col); gw[h] = *(const unsigned*)(Z + (size_t)t * ZC + ZGO + col); }
#pragma unroll
        for (int h = 0; h < 6; ++h) {
            const int col = h * 128 + lane * 2;
            const float o0 = bf_lo(a[h]) + bf_lo(bb[h]), o1 = bf_hi(a[h]) + bf_hi(bb[h]);
            const float ss = wave_sum(o0 * o0 + o1 * o1);
            const float rstd = rsqrtf(ss * (1.0f / 128.0f) + EPSF);
            *(unsigned*)(Yb + (size_t)t * 768 + col) = cvt_pk_bf16(o0 * rstd * gn0 * siluf_(bf_lo(gw[h])), o1 * rstd * gn1 * siluf_(bf_hi(gw[h])));
        }
    }
}

constexpr int RT_AHI = 0, RT_ALO = 66048, RT_LG = 132096, RT_ROW = 2064, RT_HIST = 144 * 1024 - 1024 + 256;
__device__ __forceinline__ void router_w_phase(const Params& p) {
    bf16_t* hi = (bf16_t*)(p.ws + OFF_WRT); bf16_t* lo = hi + 64 * 1024;
    for (int i = blockIdx.x * blockDim.x + threadIdx.x; i < 64 * 1024; i += gridDim.x * blockDim.x) { const int k = i >> 6, e = i & 63;
        const float w = p.w_router[i]; const bf16_t h = f2bf(w); hi[e * 1024 + k] = h; lo[e * 1024 + k] = f2bf(w - bf2f(h)); }
}
__device__ __forceinline__ void route_phase(const Params& p, LAS unsigned char* lds) {
    int tid = threadIdx.x; asm volatile("" : "+v"(tid));
    const int wid = __builtin_amdgcn_readfirstlane(tid >> 6), lane = tid & 63, vloc = lane & 15, rq = lane >> 4;
    LAS int* hist = (LAS int*)(lds + RT_HIST);
    const float* X1 = (const float*)(p.out + DO_X1); const float* mod = (const float*)(p.ws + OFF_MOD);
    const bf16_t* Whi = (const bf16_t*)(p.ws + OFF_WRT); const bf16_t* Wlo = Whi + 64 * 1024;
    unsigned char* H2 = p.ws + OFF_H2;
    int* eidx = (int*)(p.ws + OFF_EIDX); float* wts = (float*)(p.ws + OFF_WTS); int* lrank = (int*)(p.ws + OFF_APOS); int* lst = (int*)(p.ws + OFF_LIST);
    const int nb = (int)gridDim.x, TPB = (NTOK + nb - 1) / nb, tb0 = (int)blockIdx.x * TPB;
    if (blockIdx.x == 0) for (int i = tid; i < 256; i += 512) *(unsigned*)(H2 + (size_t)NTOK * 1024 + i * 4) = 0u;
    if (tid < 64) hist[tid] = 0;
    const float brl = p.b_router[lane];
    const int tm = wid >> 2, tn = wid & 3;
    const bool onebatch = (tb0 / SEQ) == ((tb0 + TPB - 1) / SEQ);
    f32x4 gq[4], shq[4], scq[4];
    { const float* mr = mod + (size_t)(tb0 / SEQ) * NIN;
#pragma unroll
      for (int j = 0; j < 4; ++j) { const int k = j * 256 + lane * 4; gq[j] = *(const f32x4*)(p.norm2_g + k); shq[j] = *(const f32x4*)(mr + 3072 + k); scq[j] = *(const f32x4*)(mr + 4096 + k); } }
    f32x4 vq[4][4];
    { const int t0 = tb0 + wid * 4;
#pragma unroll
      for (int q = 0; q < 4; ++q) { const int t = (t0 + q < NTOK) ? t0 + q : NTOK - 1;
#pragma unroll
          for (int j = 0; j < 4; ++j) vq[q][j] = *(const f32x4*)(X1 + (size_t)t * 1024 + j * 256 + lane * 4); } }
    for (int it = 0; it * 32 < TPB; ++it) {
        const int t0 = tb0 + it * 32 + wid * 4;
#pragma unroll
        for (int q = 0; q < 4; ++q) { const int t = t0 + q, row = wid * 4 + q;
            if (t < NTOK && t < tb0 + TPB) { const float* mr = mod + (size_t)(t / SEQ) * NIN;
                f32x4 v[4]; float ss = 0.f;
#pragma unroll
                for (int j = 0; j < 4; ++j) { v[j] = vq[q][j]; ss += v[j][0] * v[j][0] + v[j][1] * v[j][1] + v[j][2] * v[j][2] + v[j][3] * v[j][3]; }
                ss = wave_sum(ss); const float rstd = rsqrtf(ss * (1.0f / 1024.0f) + EPSF);
#pragma unroll
                for (int j = 0; j < 4; ++j) { const int k = j * 256 + lane * 4;
                    f32x4 g = gq[j], sh = shq[j], scv = scq[j];
                    if (!onebatch) { sh = *(const f32x4*)(mr + 3072 + k); scv = *(const f32x4*)(mr + 4096 + k); }
                    f32x4 o;
#pragma unroll
                    for (int e = 0; e < 4; ++e) o[e] = v[j][e] * rstd * g[e] * (1.0f + scv[e]) + sh[e];
                    u32x2 wh; wh.x = cvt_pk_bf16(o[0], o[1]); wh.y = cvt_pk_bf16(o[2], o[3]);
                    u32x2 wl; wl.x = cvt_pk_bf16(o[0] - bf_lo(wh.x), o[1] - bf_hi(wh.x)); wl.y = cvt_pk_bf16(o[2] - bf_lo(wh.y), o[3] - bf_hi(wh.y));
                    *(LAS u32x2*)(lds + RT_AHI + row * RT_ROW + k * 2) = wh; *(LAS u32x2*)(lds + RT_ALO + row * RT_ROW + k * 2) = wl;
                    *(unsigned*)(H2 + (size_t)t * 1024 + k) = pack_fp8x4(o[0], o[1], o[2], o[3]); } }
            else {
#pragma unroll
                for (int j = 0; j < 4; ++j) { const int k = j * 256 + lane * 4; *(LAS u32x2*)(lds + RT_AHI + row * RT_ROW + k * 2) = (u32x2){0u, 0u}; *(LAS u32x2*)(lds + RT_ALO + row * RT_ROW + k * 2) = (u32x2){0u, 0u}; } } }
        if ((it + 1) * 32 < TPB) { const int t1 = t0 + 32;
#pragma unroll
            for (int q = 0; q < 4; ++q) { const int t = (t1 + q < NTOK) ? t1 + q : NTOK - 1;
#pragma unroll
                for (int j = 0; j < 4; ++j) vq[q][j] = *(const f32x4*)(X1 + (size_t)t * 1024 + j * 256 + lane * 4); } }
        __syncthreads();
        { f32x4 acc = (f32x4){0.f, 0.f, 0.f, 0.f};
          const LAS unsigned char* ah_p = lds + RT_AHI + (16 * tm + vloc) * RT_ROW + rq * 16; const LAS unsigned char* al_p = lds + RT_ALO + (16 * tm + vloc) * RT_ROW + rq * 16;
          const bf16_t* bh_p = Whi + (size_t)(16 * tn + vloc) * 1024 + rq * 8; const bf16_t* bl_p = Wlo + (size_t)(16 * tn + vloc) * 1024 + rq * 8;
#pragma unroll 8
          for (int c = 0; c < 32; ++c) { const bf16x8 ah = *(const LAS bf16x8*)(ah_p + c * 64), al = *(const LAS bf16x8*)(al_p + c * 64);
              const bf16x8 bh = *(const bf16x8*)(bh_p + c * 32), bl = *(const bf16x8*)(bl_p + c * 32);
              acc = __builtin_amdgcn_mfma_f32_16x16x32_bf16(ah, bh, acc, 0, 0, 0); acc = __builtin_amdgcn_mfma_f32_16x16x32_bf16(al, bh, acc, 0, 0, 0); acc = __builtin_amdgcn_mfma_f32_16x16x32_bf16(ah, bl, acc, 0, 0, 0); }
          LAS float* lg = (LAS float*)(lds + RT_LG);
#pragma unroll
          for (int j = 0; j < 4; ++j) lg[(16 * tm + 4 * rq + j) * 64 + 16 * tn + vloc] = acc[j]; }
        __syncthreads();
#pragma unroll
        for (int q = 0; q < 4; ++q) { const int t = t0 + q; const float logit = ((const LAS float*)(lds + RT_LG))[(wid * 4 + q) * 64 + lane];
            if (t < NTOK && t < tb0 + TPB) {
                const float sc = 1.0f / (1.0f + __expf(-logit)), bs = sc + brl;
                float m1 = bs;
                m1 = fmaxf(m1, dpp_mov_<0xB1>(m1)); m1 = fmaxf(m1, dpp_mov_<0x4E>(m1)); m1 = fmaxf(m1, dpp_mov_<0x141>(m1));
                const unsigned long long ism = __ballot(bs == m1);
                const int gbase = lane & ~7; const unsigned gm = (unsigned)((ism >> gbase) & 0xffull);
                const int first = gbase + __builtin_ctz(gm);
                float m2 = (lane == first) ? -INFINITY : bs;
                m2 = fmaxf(m2, dpp_mov_<0xB1>(m2)); m2 = fmaxf(m2, dpp_mov_<0x4E>(m2)); m2 = fmaxf(m2, dpp_mov_<0x141>(m2));
                const float gs = m1 + m2; const int gid = lane >> 3;
                int grank = 0;
#pragma unroll
                for (int g2 = 0; g2 < 8; ++g2) { const float og = __int_as_float(__builtin_amdgcn_readlane(__float_as_int(gs), g2 * 8)); grank += (og > gs || (og == gs && g2 < gid)) ? 1 : 0; }
                const bool gok = grank < 4;
                const float mk = gok ? bs : -INFINITY;
                int rank = 0;
#pragma unroll
                for (int e2 = 0; e2 < 64; ++e2) { const float ov = __int_as_float(__builtin_amdgcn_readlane(__float_as_int(mk), e2)); rank += (ov > mk || (ov == mk && e2 < lane)) ? 1 : 0; }
                const bool sel = gok && rank < TOPK;
                const float wsum = wave_sum(sel ? sc : 0.f);
                if (sel) { const int lr = __hip_atomic_fetch_add(hist + lane, 1, __ATOMIC_RELAXED, __HIP_MEMORY_SCOPE_WORKGROUP);
                    eidx[t * 8 + rank] = lane; wts[t * 8 + rank] = sc / wsum * 2.5f; lrank[t * 8 + rank] = lr; lst[((size_t)blockIdx.x * 64 + lane) * 128 + lr] = t * 8 + rank; } } }
    }
    __syncthreads();
    if (tid < 64) ((int*)(p.ws + OFF_BCNT))[blockIdx.x * 64 + tid] = hist[tid];
    __syncthreads();
}

__device__ __forceinline__ void scatter_phase(const Params& p, LAS unsigned char* lds) {
    int tid = threadIdx.x; asm volatile("" : "+v"(tid));
    int* cnt = (int*)(p.ws + OFF_CNT); int* pstart = cnt + 128; int* nblk = cnt + 256; int* blk_e = (int*)(p.ws + OFF_BLKE);
    const int* bc = (const int*)(p.ws + OFF_BCNT);
    const int* eidx = (const int*)(p.ws + OFF_EIDX); int* apos = (int*)(p.ws + OFF_APOS); int* row_tok = (int*)(p.ws + OFF_ROWTOK);
    LAS int* tot = (LAS int*)lds; LAS int* ps = tot + 64; LAS int* ms = ps + 72;
    const int nb = (int)gridDim.x, bid = (int)blockIdx.x, TPB = (NTOK + nb - 1) / nb, tb0 = bid * TPB;
    LAS int* part = ms + 64;
    { const int e = tid & 63, pg = tid >> 6, per = (nb + 7) / 8; int t = 0, bl = 0;
#pragma unroll 8
      for (int wg = pg * per; wg < (pg + 1) * per; ++wg) if (wg < nb) { const int c = bc[wg * 64 + e]; if (wg < bid) bl += c; t += c; }
      part[(pg * 2 + 0) * 64 + e] = t; part[(pg * 2 + 1) * 64 + e] = bl; }
    __syncthreads();
    int below = 0;
    if (tid < 64) { int t = 0;
#pragma unroll
        for (int pg = 0; pg < 8; ++pg) { t += part[(pg * 2 + 0) * 64 + tid]; below += part[(pg * 2 + 1) * 64 + tid]; }
        tot[tid] = t; }
    __syncthreads();
    if (tid == 0) { int a = 0; for (int e = 0; e < 64; ++e) { ps[e] = a; a += (tot[e] + 255) / 256 * 256; } ps[64] = a; ps[65] = a + NTOK; }
    __syncthreads();
    if (tid < 64) ms[tid] = ps[tid] + below;
    __syncthreads();
    int* row_dst = (int*)(p.ws + OFF_ROWDST);
    for (int i = tid; i < TPB * 8; i += 512) { const int t = tb0 + (i >> 3); if (t < NTOK) { const int idx = t * 8 + (i & 7); const int e = eidx[idx]; const int pos = ms[e] + apos[idx]; row_tok[pos] = t; row_dst[pos] = idx; } }
    for (int e = bid; e < 64; e += nb) for (int j = tid; j < 256; j += 512) { const int pos = ps[e] + tot[e] + j; if (pos < ps[e + 1]) { row_tok[pos] = NTOK; row_dst[pos] = -1; } }
    for (int i = tid; i < TPB; i += 512) { const int t = tb0 + i; if (t < NTOK) row_tok[ps[64] + t] = t; }
    if (bid == 0) {
        if (tid < 66) pstart[tid] = ps[tid];
        if (tid == 0) *nblk = ps[65] / 256;
        for (int rb = tid; rb < ps[65] / 256; rb += 512) { int e = 0; while (e < 64 && rb * 256 >= ps[e + 1]) ++e; blk_e[rb] = e; }
    }
    __syncthreads();
}

__device__ __forceinline__ void combine_phase(const Params& p) {
    int tid = threadIdx.x; asm volatile("" : "+v"(tid));
    const int wid = tid >> 6, lane = tid & 63;
    const float* X1 = (const float*)(p.out + DO_X1); const float* mod = (const float*)(p.ws + OFF_MOD); const unsigned char* Y2 = (const unsigned char*)(p.ws + OFF_Y2);
    const unsigned char* Y2s = (const unsigned char*)(p.ws + OFF_Y2S);
    const float* wts = (const float*)(p.ws + OFF_WTS); float* out = (float*)p.out;
    f32x4 gf[4];
#pragma unroll
    for (int j = 0; j < 4; ++j) gf[j] = *(const f32x4*)(p.final_g + lane * 16 + 4 * j);
    const int stride = gridDim.x * 8;
    int t = blockIdx.x * 8 + wid;
    u32x4 yv[8]; float wk[8]; f32x4 xv[4]; u32x4 sv;
    if (t < NTOK) {
#pragma unroll
        for (int k = 0; k < TOPK; ++k) { wk[k] = wts[t * 8 + k]; yv[k] = *(const u32x4*)(Y2 + (size_t)(t * 8 + k) * 1024 + lane * 16); }
#pragma unroll
        for (int j = 0; j < 4; ++j) xv[j] = *(const f32x4*)(X1 + (size_t)t * 1024 + lane * 16 + 4 * j);
        sv = *(const u32x4*)(Y2s + (size_t)t * 1024 + lane * 16); }
    for (; t < NTOK; t += stride) {
        const float* g2 = mod + (size_t)(t / SEQ) * NIN + 5120 + lane * 16;
        f32x4 a[4];
#pragma unroll
        for (int j = 0; j < 4; ++j) { const int wd = (int)sv[j]; const f32x2 lo = __builtin_amdgcn_cvt_pk_f32_fp8(wd, false), hi = __builtin_amdgcn_cvt_pk_f32_fp8(wd, true); a[j] = (f32x4){lo.x, lo.y, hi.x, hi.y}; }
#pragma unroll
        for (int k = 0; k < TOPK; ++k) {
#pragma unroll
            for (int j = 0; j < 4; ++j) { const int wd = (int)yv[k][j]; const f32x2 lo = __builtin_amdgcn_cvt_pk_f32_fp8(wd, false), hi = __builtin_amdgcn_cvt_pk_f32_fp8(wd, true);
                a[j][0] += wk[k] * lo.x; a[j][1] += wk[k] * lo.y; a[j][2] += wk[k] * hi.x; a[j][3] += wk[k] * hi.y; } }
        f32x4 xo[4]; float ss = 0.f;
#pragma unroll
        for (int j = 0; j < 4; ++j) { const f32x4 gv = *(const f32x4*)(g2 + 4 * j); xo[j] = xv[j] + gv * a[j]; ss += xo[j][0] * xo[j][0] + xo[j][1] * xo[j][1] + xo[j][2] * xo[j][2] + xo[j][3] * xo[j][3]; }
        asm volatile("" : "+v"(xo[0]), "+v"(xo[1]), "+v"(xo[2]), "+v"(xo[3]));
        const int t2 = t + stride;
        if (t2 < NTOK) {
#pragma unroll
            for (int k = 0; k < TOPK; ++k) { wk[k] = wts[t2 * 8 + k]; yv[k] = *(const u32x4*)(Y2 + (size_t)(t2 * 8 + k) * 1024 + lane * 16); }
#pragma unroll
            for (int j = 0; j < 4; ++j) xv[j] = *(const f32x4*)(X1 + (size_t)t2 * 1024 + lane * 16 + 4 * j);
            sv = *(const u32x4*)(Y2s + (size_t)t2 * 1024 + lane * 16); }
        ss = wave_sum(ss); const float rstd = rsqrtf(ss * (1.0f / 1024.0f) + EPSF);
        float* op = out + (size_t)t * 1024 + lane * 16;
#pragma unroll
        for (int j = 0; j < 4; ++j) *(f32x4*)(op + 4 * j) = xo[j] * rstd * gf[j];
    }
}
constexpr int FUSED_LDS = 144 * 1024;
constexpr int PROBE_DUP = 0;
constexpr int PROBE_PHASE = -1;

template <int PA, int PB> __global__ __launch_bounds__(512, 2) void k_fwd(Params p) {
    extern __shared__ __attribute__((aligned(16))) unsigned char shm[];
    LAS unsigned char* lds = (LAS unsigned char*)shm;
    LAS unsigned* xbw = (LAS unsigned*)(lds + FUSED_LDS - 1024);
    if (threadIdx.x == 0) { xbw[0] = 0u; xbw[1] = 0u; xbw[2] = 0u; xbw[3] = 0u; }
    __syncthreads();
    XcdBarrier bar = xcd_barrier_post((unsigned*)(p.ws + OFF_BAR), (volatile LAS unsigned*)xbw);
    const int nb = (int)gridDim.x, bid = (int)blockIdx.x;
    unsigned long long t_start = 0, t_mark = 0, w_acc = 0; if constexpr (PROBE_PHASE >= 0) t_start = __builtin_amdgcn_s_memrealtime();
    const int* cnt = (const int*)(p.ws + OFF_CNT);
#define PH(k) if constexpr (PA <= (k) && (k) < PB)
#define BARRIER(k) if constexpr (PROBE_PHASE == 100) { if ((k) == 13 && threadIdx.x == 0) atomicAdd((unsigned long long*)(p.ws + OFF_PAIR), w_acc); const unsigned long long t_a = __builtin_amdgcn_s_memrealtime(); xcd_barrier(bar); w_acc += __builtin_amdgcn_s_memrealtime() - t_a; if ((k) == 13) t_mark = *(volatile unsigned long long*)(p.ws + OFF_PAIR) / gridDim.x; } else { if constexpr (PA <= (k) && (k) + 1 < PB) xcd_barrier(bar); if constexpr ((k) == PROBE_PHASE) t_mark = __builtin_amdgcn_s_memrealtime() - t_start; }
    PH(0) { if (bid == 0 && threadIdx.x < 128) ((int*)(p.ws + OFF_CNT))[threadIdx.x] = 0;
            ada_phase(p, lds); s5_tab1_phase(p); }
    BARRIER(0);
    PH(1) { cvt_dense_phase(p, lds); if constexpr (PROBE_DUP == 15) cvt_dense_phase(p, lds); norm1_phase(p); if constexpr (PROBE_DUP == 1) norm1_phase(p); s5_tab2_phase(p, bid, nb); router_w_phase(p); }
    BARRIER(1);
    PH(2) { EpiZ2 E{(bf16_t*)(p.ws + OFF_AEXT), (bf16_t*)(p.out + DO_UC), (bf16_t*)(p.ws + OFF_Z)};
      if constexpr (Z_FP8) { { ZSchedF8 S; S.init(p.out + DO_H8, p.out + DO_W8); ge::gemm_phase_f8<EpiZ2, ZSchedF8, true>(lds, 512, 512, 512, S, E); }
 }
      else { PlainSched S; S.init(p.ws + OFF_H, 1024, p.ws + OFF_WINT, 1024, NROWS / 256, NIN / 256); ge::gemm_phase<EpiZ2, PlainSched, false>(lds, 1024, 1024, 1024, S, E); } }
    BARRIER(2);
    PH(3) { if (bid < 32) s5a_phase(p, lds, bid, 32);
            else for (int u = bid - 32; u < 48 * GLA_SLOTS; u += nb - 32) gla_pass1_unit(p, lds, u >> 4, u & 15);
            s5_wfill_phase(p, bid, nb); if constexpr (PROBE_DUP == 12) s5_wfill_phase(p, bid, nb); }
    BARRIER(3);
    PH(4) { if (nb == 256) {
                if (bid < 240) { const int chain = bid / 5, q = bid % 5; gla_unit<false>(p, lds, chain, 24 * q, 24, 3 * q + 1);
                    const int r = q * 48 + chain; if (r < 128) s5b_phase(p, lds, r, 128); }
                else for (int k = 0; k < 3; ++k) gla_unit<false>(p, lds, (bid - 240) * 3 + k, 120, 8, 16);
            } else {
                for (int u = bid; u < 48 * 6; u += nb) { const int chain = u / 6, q = u % 6; gla_unit<false>(p, lds, chain, 24 * q, q < 5 ? 24 : 8, 3 * q + 1); }
                s5b_phase(p, lds, bid, nb);
            } }
    BARRIER(4);
    PH(5) { for (int item = bid; item < (NTOK / 256) * 2; item += nb) { const int pm = item >> 1, half = item & 1;
                yb_rows(p, pm * 256, 256);
                { OneUnitSched S{(const char*)(p.ws + OFF_YS5), (const char*)(p.ws + OFF_GLUT), pm};
                  EpiYa E{(const bf16_t*)(p.ws + OFF_YS5), (bf16_t*)(p.ws + OFF_YA)};
                  ge::gemm_phase<EpiYa, OneUnitSched, false>(lds, 256, 256, 256, S, E); }
                { PanelMergeSched S{(const char*)(p.ws + OFF_YA), (const char*)(p.ws + OFF_YB), (const char*)(p.ws + OFF_PAT), (const char*)(p.ws + OFF_PBT), pm, 2 * half};
                  EpiMergeF<false> E{(const bf16_t*)(p.ws + OFF_Z), (bf16_t*)(p.ws + OFF_Z), ZC};
                  ge::gemm_phase_v<EpiMergeF<false>, PanelMergeSched>(lds, S, E); } } }
    BARRIER(5);
    PH(6) { }
    PH(7) { }
    PH(8) { if (bid & 1) cvt_moe_phase(p, lds);
      { PlainSched S; S.init(p.ws + OFF_Z, ZC, p.ws + OFF_WOUTT, 1024, NTOK / 256, 4);
        EpiX1<false> E{p.x, (const float*)(p.ws + OFF_MOD), (float*)(p.out + DO_X1)};
        ge::gemm_phase<EpiX1<false>, PlainSched, false>(lds, 1024, ZC, 1024, S, E); }
      if (!(bid & 1)) cvt_moe_phase(p, lds); }
    BARRIER(8);
    PH(9) { route_phase(p, lds); if constexpr (PROBE_DUP == 5) route_phase(p, lds); }
    BARRIER(9);
    PH(10) { }
    PH(11) { }
    PH(12) { moe_pull_prep(p, lds);
      MoeSched1P S{lds, (const char*)(p.ws + OFF_H2), (const char*)(p.ws + OFF_BT1)};
      EpiHid E{p.ws, p.out};
      ge::gemm_phase_f8<EpiHid, MoeSched1P, true>(lds, 512, 512, 512, S, E); }
    BARRIER(12);
    PH(13) { MoeSched2 S{(const int*)(p.ws + OFF_BLKE), cnt + 256, p.ws, p.out, (const char*)(p.ws + OFF_BT2), nb, bid};
      EpiY2 E{(unsigned char*)(p.ws + OFF_Y2), (unsigned char*)(p.ws + OFF_Y2S), cnt + 128, (const int*)(p.ws + OFF_ROWDST)};
      ge::gemm_phase_f8<EpiY2, MoeSched2, true>(lds, 128, 128, 128, S, E); }
    if constexpr (PROBE_DUP == 6) { MoeSched2R S{(const int*)(p.ws + OFF_BLKE), cnt + 128, p.ws, p.out, (const char*)(p.ws + OFF_BT2), nb, bid};
      EpiY2 E{(unsigned char*)(p.ws + OFF_Y2), (unsigned char*)(p.ws + OFF_Y2S), cnt + 128, (const int*)(p.ws + OFF_ROWDST)};
      ge::gemm_phase<EpiY2, MoeSched2R, false>(lds, 256, 256, 256, S, E); }
    if constexpr (PROBE_DUP == 7) { MoeSched2R S{(const int*)(p.ws + OFF_BLKE), cnt + 128, p.ws, p.out, (const char*)(p.ws + OFF_BT2), nb, bid};
      EpiNull E{(float*)(p.ws + OFF_BCNT)};
      ge::gemm_phase<EpiNull, MoeSched2R, false>(lds, 256, 256, 256, S, E); }
    BARRIER(13);
    PH(14) { combine_phase(p); if constexpr (PROBE_DUP == 3) combine_phase(p); if constexpr (PROBE_DUP == 4) { for (int r = 0; r < 10; ++r) xcd_barrier(bar); } }
#undef PH
#undef BARRIER
    if constexpr (PROBE_PHASE >= 0) { if (bid == 0 && threadIdx.x == 0) { const unsigned long long t0 = __builtin_amdgcn_s_memrealtime(); while (__builtin_amdgcn_s_memrealtime() - t0 < t_mark) __builtin_amdgcn_s_sleep(8); } }
}


static Params make_params(void* const* d_in, void* d_out, void* d_ws) {
    Params p{};
    const float** f = (const float**)&p;
    for (int i = 0; i < 32; ++i) f[i] = (const float*)d_in[i];
    p.ws = (unsigned char*)d_ws; p.out = (unsigned char*)d_out;
    return p;
}

extern "C" void kernel_launch(void* const* d_in, const int* in_sizes, int n_in, void* d_out, int out_size, void* d_ws, size_t ws_size, hipStream_t stream) {
    (void)in_sizes; (void)n_in; (void)out_size; (void)ws_size;
    static int grid = 0;
    if (!grid) {
        (void)hipFuncSetAttribute((const void*)k_fwd<0, 17>, hipFuncAttributeMaxDynamicSharedMemorySize, FUSED_LDS);
        int dev = 0, cus = 0, per_cu = 0;
        (void)hipGetDevice(&dev);
        (void)hipDeviceGetAttribute(&cus, hipDeviceAttributeMultiprocessorCount, dev);
        (void)hipOccupancyMaxActiveBlocksPerMultiprocessor(&per_cu, (const void*)k_fwd<0, 17>, 512, FUSED_LDS);
        if (per_cu < 1) { fprintf(stderr, "k_fwd: occupancy query says 0 blocks per CU\n"); per_cu = 1; }
        grid = cus;
    }
    const Params p = make_params(d_in, d_out, d_ws);
    (void)hipMemsetAsync((unsigned char*)d_ws + OFF_BAR, 0, XCD_BAR_WORDS * sizeof(unsigned), stream);
    if (PROBE_PHASE == 100) (void)hipMemsetAsync((unsigned char*)d_ws + OFF_PAIR, 0, 256, stream);
    hipLaunchKernelGGL((k_fwd<0, 17>), dim3(grid), dim3(512), FUSED_LDS, stream, p);
}
```

```cpp
#include <hip/hip_runtime.h>
#include <stdint.h>
#include <stdio.h>

#define LAS __attribute__((address_space(3)))
typedef unsigned short bf16_t;
typedef short bf16x8 __attribute__((ext_vector_type(8)));
typedef float f32x4 __attribute__((ext_vector_type(4)));
typedef float f32x2 __attribute__((ext_vector_type(2)));
typedef unsigned u32x4 __attribute__((ext_vector_type(4)));
typedef unsigned u32x2 __attribute__((ext_vector_type(2)));

constexpr int NB = 4, SEQ = 8192, DM = 1024, NTOK = NB * SEQ, CTXL = 256, NCTX = NB * CTXL, NROWS = NTOK + NCTX;
constexpr int NIN = 6144, ZC = 5888;
constexpr int ZQ = 0, ZFF = 768, ZFB = 1536, ZI = 2304, ZGO = 3072, ZGA = 3840, ZGB = 4864;
constexpr int NEXP = 64, TOPK = 8, EH = 256;
constexpr int CAP_ROUTED = NTOK * TOPK + NEXP * 256;
constexpr int CAP_ROWS = CAP_ROUTED + NTOK;
constexpr int HID1_RB = 1024;
constexpr float EPSF = 1e-6f;

__device__ __forceinline__ unsigned cvt_pk_bf16(float lo, float hi) { unsigned r; asm volatile("v_cvt_pk_bf16_f32 %0, %1, %2" : "=v"(r) : "v"(lo), "v"(hi)); return r; }
__device__ __forceinline__ float bf_lo(unsigned w) { return __uint_as_float(w << 16); }
__device__ __forceinline__ float bf_hi(unsigned w) { return __uint_as_float(w & 0xffff0000u); }
__device__ __forceinline__ float bf2f(bf16_t b) { return __uint_as_float(((unsigned)b) << 16); }
__device__ __forceinline__ bf16_t f2bf(float f) { return (bf16_t)(cvt_pk_bf16(f, 0.f) & 0xffffu); }
__device__ __forceinline__ float frcp_(float x) { return __builtin_amdgcn_rcpf(x); }
__device__ __forceinline__ float sigmoidf_(float x) { return frcp_(1.0f + __expf(-x)); }
__device__ __forceinline__ float siluf_(float x) { return x * frcp_(1.0f + __expf(-x)); }
template <int CTRL> __device__ __forceinline__ float dpp_mov_(float v) { return __int_as_float(__builtin_amdgcn_update_dpp(0, __float_as_int(v), CTRL, 0xf, 0xf, true)); }
__device__ __forceinline__ float wave_sum(float v) {
    v += dpp_mov_<0xB1>(v); v += dpp_mov_<0x4E>(v); v += dpp_mov_<0x141>(v); v += dpp_mov_<0x140>(v);
    const float a = __int_as_float(__builtin_amdgcn_readlane(__float_as_int(v), 0)), b = __int_as_float(__builtin_amdgcn_readlane(__float_as_int(v), 16));
    const float c = __int_as_float(__builtin_amdgcn_readlane(__float_as_int(v), 32)), d = __int_as_float(__builtin_amdgcn_readlane(__float_as_int(v), 48));
    return (a + b) + (c + d);
}
__device__ __forceinline__ float gelu_tanh(float y) {
    const float u = 0.7978845608028654f * (y + 0.044715f * y * y * y);
    const float e = __expf(2.0f * u);
    const float t = 1.0f - 2.0f * frcp_(e + 1.0f);
    return 0.5f * y * (1.0f + t);
}
#define XB_TMO      128
#define XB_XCNT(j)  (256  + 64 * (j))
#define XB_XSUB(j)  (1280 + 64 * (j))
#define XB_XGEN(j)  (2304 + 64 * (j))
#define XB_TOP      3328
#define XB_TOPGEN   3392
#define XCD_BAR_WORDS 3456
#define XB_SPIN_CAP (1u << 18)

__device__ __forceinline__ unsigned xb_ld(unsigned* p)              { return __hip_atomic_load(p, __ATOMIC_RELAXED, __HIP_MEMORY_SCOPE_AGENT); }
__device__ __forceinline__ unsigned xb_add(unsigned* p, unsigned v) { return __hip_atomic_fetch_add(p, v, __ATOMIC_RELAXED, __HIP_MEMORY_SCOPE_AGENT); }
__device__ __forceinline__ unsigned xb_xcc_id() { return (unsigned)__builtin_amdgcn_s_getreg((3 << 11) | 20) & 0xFu; }
#define XB_SPIN(cond, bar) do { unsigned _sp = 0; while (cond) { __builtin_amdgcn_s_sleep(1); \
    if ((++_sp & 255u) == 0u) { if (xb_ld(&(bar)[XB_TMO])) break; if (_sp > XB_SPIN_CAP) { atomicAdd(&(bar)[XB_TMO], 1u); break; } } } } while (0)

struct XcdBarrier {
    unsigned* bar; unsigned x;
    volatile LAS unsigned* st;
};

__device__ __forceinline__ XcdBarrier xcd_barrier_post(unsigned* bar, volatile LAS unsigned* st) {
    XcdBarrier b; b.bar = bar; b.x = xb_xcc_id(); b.st = st;
    if (threadIdx.x == 0) (void)xb_add(&bar[XB_XCNT(b.x)], 1u);
    return b;
}
__device__ __forceinline__ void xcd_barrier_complete(unsigned* bar, unsigned x, unsigned& nloc, unsigned& nx) {
    const unsigned G = gridDim.x * gridDim.y * gridDim.z;
    unsigned sum, cnt, mine, sp = 0u;
    for (;;) {
        sum = 0u; cnt = 0u; mine = 0u;
#pragma unroll
        for (unsigned j = 0; j < 16; ++j) { const unsigned c = xb_ld(&bar[XB_XCNT(j)]); sum += c; cnt += (c > 0u) ? 1u : 0u; mine = (j == x) ? c : mine; }
        if (sum == G) break;
        __builtin_amdgcn_s_sleep(1);
        if ((++sp & 255u) == 0u) { if (xb_ld(&bar[XB_TMO])) break; if (sp > XB_SPIN_CAP) { atomicAdd(&bar[XB_TMO], 1u); break; } }
    }
    nloc = mine > 0u ? mine : 1u; nx = cnt > 0u ? cnt : 1u;
}

__device__ __forceinline__ void xcd_barrier(const XcdBarrier& b) {
    asm volatile("s_waitcnt vmcnt(0)" ::: "memory");
    __syncthreads();
    if (threadIdx.x == 0) {
        unsigned* bar = b.bar;
        __builtin_amdgcn_s_waitcnt(0);
        unsigned nloc = b.st[0], nx = b.st[1];
        if (nloc == 0u) { xcd_barrier_complete(bar, b.x, nloc, nx); b.st[0] = nloc; b.st[1] = nx; }
        const unsigned old = xb_add(&bar[XB_XSUB(b.x)], 1u);
        const unsigned gen = old / nloc;
        if (old + 1u == (gen + 1u) * nloc) {
            __builtin_amdgcn_fence(__ATOMIC_RELEASE, "agent");
            asm volatile("s_waitcnt vmcnt(0)" ::: "memory");
            const unsigned og = xb_add(&bar[XB_TOP], 1u);
            const unsigned tg = og / nx;
            if (og + 1u == (tg + 1u) * nx) xb_add(&bar[XB_TOPGEN], 1u);
            else XB_SPIN(xb_ld(&bar[XB_TOPGEN]) == tg, bar);
            __builtin_amdgcn_fence(__ATOMIC_ACQUIRE, "agent");
            xb_add(&bar[XB_XGEN(b.x)], 1u);
            asm volatile("s_waitcnt vmcnt(0)" ::: "memory");
        } else {
            XB_SPIN(xb_ld(&bar[XB_XGEN(b.x)]) == gen, bar);
            __builtin_amdgcn_fence(__ATOMIC_ACQUIRE, "agent");
            asm volatile("s_waitcnt vmcnt(0)" ::: "memory");
        }
    }
    __syncthreads();
}

namespace ge {
typedef int i32x4 __attribute__((ext_vector_type(4)));
typedef int i32x8 __attribute__((ext_vector_type(8)));
constexpr int BM = 256, BK = 64, HALF = 128, HTB = HALF * BK * 2, STAGE_BYTES = 8 * HTB, NXCD = 8, WGM = 8;
__host__ __device__ __forceinline__ int lds_byte(int r, int c) { const int st = (r >> 4) * 2 + (c >> 5), rr = r & 15, cc = c & 31, ob = rr * 64 + cc * 2; return st * 1024 + (ob ^ (((ob >> 9) & 1) << 5)); }
__host__ __device__ __forceinline__ void stage_rc(int b, int& R, int& C) { const int st = b / 1024, sb = b % 1024, swz = sb ^ (((sb >> 9) & 1) << 5); R = (st >> 1) * 16 + swz / 64; C = (st & 1) * 32 + (swz % 64) / 2; }
__host__ __device__ __forceinline__ int perm32(int rho) { const int n = rho >> 4, i = rho & 15; return 8 * (i >> 2) + 4 * n + (i & 3); }

struct Unit { int pm, pn, e, k; };

struct GridOrder {
    int nM, nN, nwg, G, c;
    __device__ void init(int nM_, int nN_, int G_, int c_) { nM = nM_; nN = nN_; nwg = nM * nN; G = G_; c = c_; }
    __device__ bool tile(int i, int& pm, int& pn) const {
        const long L = (long)i * G + c; if (L >= nwg) return false;
        int wgid = (int)L; { const int q = nwg / NXCD, r = nwg % NXCD, xcd = wgid % NXCD, off = wgid / NXCD; wgid = (xcd < r ? xcd * (q + 1) : r * (q + 1) + (xcd - r) * q) + off; }
        const int nig = WGM * nN, gid = wgid / nig, fm = gid * WGM, gsz = (nM - fm) < WGM ? (nM - fm) : WGM;
        pm = fm + ((wgid % nig) % gsz); pn = (wgid % nig) / gsz; return true;
    }
};

template <class Epi, class Sched, bool GATHER>
__device__ __forceinline__ void gemm_phase(LAS unsigned char* lds, const int K, const int lda, const int ldb, const Sched& S, const Epi& E) {
    int tid = threadIdx.x; asm volatile("" : "+v"(tid));
    const int wid = __builtin_amdgcn_readfirstlane(tid >> 6), lane = tid & 63, wr = wid >> 2, wc = wid & 3, fr = lane & 15, fq = lane >> 4;
    const int nt = K / BK;
    int Rr[2], Cc[2]; unsigned voffB[2];
#pragma unroll
    for (int i = 0; i < 2; ++i) { int R, C; stage_rc(tid * 16 + i * 8192, R, C); Rr[i] = R; Cc[i] = C; const int Rb = Epi::PERM ? ((R & ~31) + perm32(R & 31)) : R; voffB[i] = (unsigned)(Rb * ldb + C) * 2u; }
    const size_t kstep = (size_t)(BK * 2);
    const size_t hstepB = (size_t)HALF * ldb * 2;
    const unsigned ldsw = (unsigned)wid * 1024u;
    const int aoff = lds_byte(wr * 64 + fr, fq * 8), boff = lds_byte(wc * 32 + fr, fq * 8);
#define GE_SA(b, h) (((b) * 2 + (h)) * HTB)
#define GE_SB(b, h) ((4 + (b) * 2 + (h)) * HTB)
#define GE_STAGE(bufoff, gbase, v0, v1) do { \
        __builtin_amdgcn_global_load_lds((const unsigned*)((const char*)(gbase) + (v0)), (LAS unsigned*)(lds + (bufoff) + ldsw), 16, 0, 0); \
        __builtin_amdgcn_global_load_lds((const unsigned*)((const char*)(gbase) + (v1)), (LAS unsigned*)(lds + (bufoff) + ldsw + 8192), 16, 0, 0); } while (0)
#define GE_STAGE_B(bufoff, gbase) GE_STAGE(bufoff, gbase, voffB[0], voffB[1])
#define GE_LDA(dst, b, h) do { _Pragma("unroll") for (int m = 0; m < 4; ++m) _Pragma("unroll") for (int k = 0; k < 2; ++k) dst[m][k] = *(const LAS bf16x8*)(lds + GE_SA(b, h) + aoff + m * 2048 + k * 1024); } while (0)
#define GE_LDB(dst, b, h) do { _Pragma("unroll") for (int n = 0; n < 2; ++n) _Pragma("unroll") for (int k = 0; k < 2; ++k) dst[n][k] = *(const LAS bf16x8*)(lds + GE_SB(b, h) + boff + n * 2048 + k * 1024); } while (0)
#define GE_MMA(ai, bj, At, Bt) do { __builtin_amdgcn_s_setprio(1); _Pragma("unroll") for (int m = 0; m < 4; ++m) _Pragma("unroll") for (int n = 0; n < 2; ++n) _Pragma("unroll") for (int k = 0; k < 2; ++k) \
        acc[ai][bj][m][n] = __builtin_amdgcn_mfma_f32_16x16x32_bf16(Bt[n][k], At[m][k], acc[ai][bj][m][n], 0, 0, 0); __builtin_amdgcn_s_setprio(0); } while (0)
#define GE_WAIT_V(n) asm volatile("s_waitcnt vmcnt(" #n ")" ::: "memory")
#define GE_WAIT_L(n) asm volatile("s_waitcnt lgkmcnt(" #n ")" ::: "memory")
#define GE_BAR __builtin_amdgcn_s_barrier()
#define GE_SCHED __builtin_amdgcn_sched_barrier(0)
    Unit cur, nxt, nn; int ui = 0;
    if (!S.next(0, cur)) return;
    bool has_next = S.next(1, nxt);
    unsigned c00, c01, c10, c11, n00, n01, n10, n11; int rn0 = 0, rn1 = 0, rn2 = 0, rn3 = 0, rq0 = 0, rq1 = 0, rq2 = 0, rq3 = 0;
    if constexpr (GATHER) {
        c00 = (unsigned)(S.a_row(cur, Rr[0]) * lda + Cc[0]) * 2u; c01 = (unsigned)(S.a_row(cur, Rr[1]) * lda + Cc[1]) * 2u;
        c10 = (unsigned)(S.a_row(cur, HALF + Rr[0]) * lda + Cc[0]) * 2u; c11 = (unsigned)(S.a_row(cur, HALF + Rr[1]) * lda + Cc[1]) * 2u;
        if (has_next) { rn0 = S.a_row(nxt, Rr[0]); rn1 = S.a_row(nxt, Rr[1]); rn2 = S.a_row(nxt, HALF + Rr[0]); rn3 = S.a_row(nxt, HALF + Rr[1]); }
    } else {
        c00 = (unsigned)(Rr[0] * lda + Cc[0]) * 2u; c01 = (unsigned)(Rr[1] * lda + Cc[1]) * 2u;
        c10 = c00 + (unsigned)(HALF * lda * 2); c11 = c01 + (unsigned)(HALF * lda * 2);
    }
    n00 = c00; n01 = c01; n10 = c10; n11 = c11;
    f32x4 acc[2][2][4][2];
#pragma unroll
    for (int a = 0; a < 2; ++a)
#pragma unroll
        for (int b = 0; b < 2; ++b)
#pragma unroll
            for (int m = 0; m < 4; ++m)
#pragma unroll
                for (int n = 0; n < 2; ++n) acc[a][b][m][n] = (f32x4){0.f, 0.f, 0.f, 0.f};
    bf16x8 At[4][2], B0[2][2], B1[2][2];
    const char* cA = S.a_base(cur); const char* cB = S.b_base(cur);
    GE_STAGE_B(GE_SB(0, 0), cB); GE_STAGE(GE_SA(0, 0), cA, c00, c01); GE_STAGE_B(GE_SB(0, 1), cB + hstepB); GE_STAGE(GE_SA(0, 1), cA, c10, c11);
    if (wr == 1) GE_BAR;
    GE_WAIT_V(4); GE_BAR;
    GE_STAGE_B(GE_SB(1, 0), cB + kstep); GE_STAGE(GE_SA(1, 0), cA + kstep, c00, c01); GE_STAGE_B(GE_SB(1, 1), cB + hstepB + kstep);
    GE_WAIT_V(6); GE_BAR;
    for (;;) {
        const bool has_nn = has_next ? S.next(ui + 2, nn) : false;
        const char* nA = has_next ? S.a_base(nxt) : cA; const char* nB = has_next ? S.b_base(nxt) : cB;
        if constexpr (GATHER) {
            if (has_next) { n00 = (unsigned)(rn0 * lda + Cc[0]) * 2u; n01 = (unsigned)(rn1 * lda + Cc[1]) * 2u; n10 = (unsigned)(rn2 * lda + Cc[0]) * 2u; n11 = (unsigned)(rn3 * lda + Cc[1]) * 2u; }
            else { n00 = c00; n01 = c01; n10 = c10; n11 = c11; }
            if (has_nn) { rq0 = S.a_row(nn, Rr[0]); rq1 = S.a_row(nn, Rr[1]); rq2 = S.a_row(nn, HALF + Rr[0]); rq3 = S.a_row(nn, HALF + Rr[1]); }
        }
#pragma unroll 1
        for (int t = 0; t < nt; t += 2) {
            const bool last = (t == nt - 2);
            const char* a1 = cA + (size_t)(t + 1) * kstep;
            const char* a2 = last ? nA : cA + (size_t)(t + 2) * kstep; const char* b2 = last ? nB : cB + (size_t)(t + 2) * kstep;
            const char* a3 = a2 + kstep; const char* b3 = b2 + kstep;
            unsigned x00 = c00, x01 = c01, x10 = c10, x11 = c11;
            if constexpr (GATHER) { if (last) { x00 = n00; x01 = n01; x10 = n10; x11 = n11; } }
            GE_LDB(B0, 0, 0); GE_SCHED; GE_LDA(At, 0, 0); GE_STAGE(GE_SA(1, 1), a1, c10, c11);
            GE_WAIT_L(8); GE_BAR; GE_WAIT_L(0); GE_MMA(0, 0, At, B0); GE_BAR; GE_SCHED;
            GE_LDB(B1, 0, 1); GE_STAGE_B(GE_SB(0, 0), b2);
            GE_BAR; GE_WAIT_L(0); GE_MMA(0, 1, At, B1); GE_BAR;
            GE_LDA(At, 0, 1); GE_STAGE(GE_SA(0, 0), a2, x00, x01);
            GE_BAR; GE_WAIT_L(0); GE_MMA(1, 0, At, B0); GE_BAR; GE_SCHED;
            GE_STAGE_B(GE_SB(0, 1), b2 + hstepB);
            GE_WAIT_V(6); GE_BAR; GE_MMA(1, 1, At, B1); GE_BAR;
            GE_LDB(B0, 1, 0); GE_SCHED; GE_LDA(At, 1, 0); GE_STAGE(GE_SA(0, 1), a2, x10, x11);
            GE_WAIT_L(8); GE_BAR; GE_WAIT_L(0); GE_MMA(0, 0, At, B0); GE_BAR; GE_SCHED;
            GE_LDB(B1, 1, 1); GE_STAGE_B(GE_SB(1, 0), b3);
            GE_BAR; GE_WAIT_L(0); GE_MMA(0, 1, At, B1); GE_BAR;
            GE_LDA(At, 1, 1); GE_STAGE(GE_SA(1, 0), a3, x00, x01);
            GE_BAR; GE_WAIT_L(0); GE_MMA(1, 0, At, B0); GE_BAR; GE_SCHED;
            GE_STAGE_B(GE_SB(1, 1), b3 + hstepB);
            GE_WAIT_V(6); GE_BAR; GE_MMA(1, 1, At, B1); GE_BAR;
        }
        E(acc, cur, wr, wc, fr, fq);
        if (!has_next) break;
#pragma unroll
        for (int a = 0; a < 2; ++a)
#pragma unroll
            for (int b = 0; b < 2; ++b)
#pragma unroll
                for (int m = 0; m < 4; ++m)
#pragma unroll
                    for (int n = 0; n < 2; ++n) acc[a][b][m][n] = (f32x4){0.f, 0.f, 0.f, 0.f};
        cur = nxt; nxt = nn; has_next = has_nn; cA = nA; cB = nB; ++ui;
        if constexpr (GATHER) { c00 = n00; c01 = n01; c10 = n10; c11 = n11; rn0 = rq0; rn1 = rq1; rn2 = rq2; rn3 = rq3; }
    }
    GE_WAIT_V(0);
    if (wr == 0) GE_BAR;
    GE_BAR;
#undef GE_SA
#undef GE_SB
#undef GE_STAGE
#undef GE_STAGE_B
#undef GE_LDA
#undef GE_LDB
#undef GE_MMA
#undef GE_WAIT_V
#undef GE_WAIT_L
#undef GE_BAR
#undef GE_SCHED
}

template <class Epi, class Sched, bool GATHER>
__device__ __forceinline__ void gemm_phase_f8(LAS unsigned char* lds, const int K, const int lda, const int ldb, const Sched& S, const Epi& E) {
    int tid = threadIdx.x; asm volatile("" : "+v"(tid));
    const int wid = __builtin_amdgcn_readfirstlane(tid >> 6), lane = tid & 63, wr = wid >> 2, wc = wid & 3, fr = lane & 15, fq = lane >> 4;
    const int nt = K / BK;
    const size_t kstep = (size_t)(BK * 2);
    const size_t hstepB = (size_t)HALF * ldb * 2;
    const unsigned ldsw = (unsigned)wid * 1024u;
    const int aoff = lds_byte(wr * 64 + fr, fq * 8), boff = lds_byte(wc * 32 + fr, fq * 8);
#define GE_SA(b, h) (((b) * 2 + (h)) * HTB)
#define GE_SB(b, h) ((4 + (b) * 2 + (h)) * HTB)
#define GE_STAGE(bufoff, gbase, v0, v1) do { \
        __builtin_amdgcn_global_load_lds((const unsigned*)((const char*)(gbase) + (v0)), (LAS unsigned*)(lds + (bufoff) + ldsw), 16, 0, 0); \
        __builtin_amdgcn_global_load_lds((const unsigned*)((const char*)(gbase) + (v1)), (LAS unsigned*)(lds + (bufoff) + ldsw + 8192), 16, 0, 0); } while (0)
#define GE_RC() int t2_ = tid; asm volatile("" : "+v"(t2_)); int R0_, C0_, R1_, C1_; stage_rc(t2_ * 16, R0_, C0_); stage_rc(t2_ * 16 + 8192, R1_, C1_)
#define GE_STAGE_B(bufoff, gbase) do { GE_RC(); const int Rb0_ = Epi::PERM ? ((R0_ & ~31) + perm32(R0_ & 31)) : R0_, Rb1_ = Epi::PERM ? ((R1_ & ~31) + perm32(R1_ & 31)) : R1_; \
        GE_STAGE(bufoff, gbase, (unsigned)(Rb0_ * ldb + C0_) * 2u, (unsigned)(Rb1_ * ldb + C1_) * 2u); } while (0)
#define GE_LDA(dst, b, h) do { _Pragma("unroll") for (int m = 0; m < 4; ++m) { const i32x4 lo_ = *(const LAS i32x4*)(lds + GE_SA(b, h) + aoff + m * 2048), hi_ = *(const LAS i32x4*)(lds + GE_SA(b, h) + aoff + m * 2048 + 1024); dst[m] = __builtin_shufflevector(lo_, hi_, 0, 1, 2, 3, 4, 5, 6, 7); } } while (0)
#define GE_LDB(dst, b, h) do { _Pragma("unroll") for (int n = 0; n < 2; ++n) { const i32x4 lo_ = *(const LAS i32x4*)(lds + GE_SB(b, h) + boff + n * 2048), hi_ = *(const LAS i32x4*)(lds + GE_SB(b, h) + boff + n * 2048 + 1024); dst[n] = __builtin_shufflevector(lo_, hi_, 0, 1, 2, 3, 4, 5, 6, 7); } } while (0)
#define GE_MMA(ai, bj, At, Bt) do { __builtin_amdgcn_s_setprio(1); _Pragma("unroll") for (int m = 0; m < 4; ++m) _Pragma("unroll") for (int n = 0; n < 2; ++n) \
        acc[ai][bj][m][n] = __builtin_amdgcn_mfma_scale_f32_16x16x128_f8f6f4(Bt[n], At[m], acc[ai][bj][m][n], 0, 0, 0, 0x7a7a7a7a, 0, 0x7f7f7f7f); __builtin_amdgcn_s_setprio(0); } while (0)
#define GE_WAIT_V(n) asm volatile("s_waitcnt vmcnt(" #n ")" ::: "memory")
#define GE_WAIT_L(n) asm volatile("s_waitcnt lgkmcnt(" #n ")" ::: "memory")
#define GE_BAR __builtin_amdgcn_s_barrier()
#define GE_SCHED __builtin_amdgcn_sched_barrier(0)
    Unit cur, nxt, nn; int ui = 0;
    if (!S.next(0, cur)) return;
    bool has_next = S.next(1, nxt);
#define GE_STG(bufoff, gbase, u_, h) do { GE_RC(); GE_STAGE(bufoff, gbase, (unsigned)(S.a_row(u_, (h) * HALF + R0_) * lda + C0_) * 2u, (unsigned)(S.a_row(u_, (h) * HALF + R1_) * lda + C1_) * 2u); } while (0)
    f32x4 acc[2][2][4][2];
#pragma unroll
    for (int a = 0; a < 2; ++a)
#pragma unroll
        for (int b = 0; b < 2; ++b)
#pragma unroll
            for (int m = 0; m < 4; ++m)
#pragma unroll
                for (int n = 0; n < 2; ++n) acc[a][b][m][n] = (f32x4){0.f, 0.f, 0.f, 0.f};
    i32x8 At[4], B0[2], B1[2];
    const char* cA = S.a_base(cur); const char* cB = S.b_base(cur);
    GE_STAGE_B(GE_SB(0, 0), cB); GE_STG(GE_SA(0, 0), cA, cur, 0); GE_STAGE_B(GE_SB(0, 1), cB + hstepB); GE_STG(GE_SA(0, 1), cA, cur, 1);
    if (wr == 1) GE_BAR;
    GE_WAIT_V(4); GE_BAR;
    GE_STAGE_B(GE_SB(1, 0), cB + kstep); GE_STG(GE_SA(1, 0), cA + kstep, cur, 0); GE_STAGE_B(GE_SB(1, 1), cB + hstepB + kstep);
    GE_WAIT_V(6); GE_BAR;
    for (;;) {
        const bool has_nn = has_next ? S.next(ui + 2, nn) : false;
        typename Epi::Pre pre = E.pre(cur, wr, wc, fr, fq);
        const char* nA = has_next ? S.a_base(nxt) : cA; const char* nB = has_next ? S.b_base(nxt) : cB;
#pragma unroll 1
        for (int t = 0; t < nt; t += 2) {
            const bool last = (t == nt - 2);
            const char* a1 = cA + (size_t)(t + 1) * kstep;
            const char* a2 = last ? nA : cA + (size_t)(t + 2) * kstep; const char* b2 = last ? nB : cB + (size_t)(t + 2) * kstep;
            const char* a3 = a2 + kstep; const char* b3 = b2 + kstep;
            Unit xu = cur; if (last && has_next) xu = nxt;
            GE_LDB(B0, 0, 0); GE_SCHED; GE_LDA(At, 0, 0); GE_STG(GE_SA(1, 1), a1, cur, 1);
            GE_WAIT_L(8); GE_BAR; GE_WAIT_L(0); GE_MMA(0, 0, At, B0); GE_BAR; GE_SCHED;
            GE_LDB(B1, 0, 1); GE_STAGE_B(GE_SB(0, 0), b2);
            GE_BAR; GE_WAIT_L(0); GE_MMA(0, 1, At, B1); GE_BAR;
            GE_LDA(At, 0, 1); GE_STG(GE_SA(0, 0), a2, xu, 0);
            GE_BAR; GE_WAIT_L(0); GE_MMA(1, 0, At, B0); GE_BAR; GE_SCHED;
            GE_STAGE_B(GE_SB(0, 1), b2 + hstepB);
            GE_WAIT_V(6); GE_BAR; GE_MMA(1, 1, At, B1); GE_BAR;
            GE_LDB(B0, 1, 0); GE_SCHED; GE_LDA(At, 1, 0); GE_STG(GE_SA(0, 1), a2, xu, 1);
            GE_WAIT_L(8); GE_BAR; GE_WAIT_L(0); GE_MMA(0, 0, At, B0); GE_BAR; GE_SCHED;
            GE_LDB(B1, 1, 1); GE_STAGE_B(GE_SB(1, 0), b3);
            GE_BAR; GE_WAIT_L(0); GE_MMA(0, 1, At, B1); GE_BAR;
            GE_LDA(At, 1, 1); GE_STG(GE_SA(1, 0), a3, xu, 0);
            GE_BAR; GE_WAIT_L(0); GE_MMA(1, 0, At, B0); GE_BAR; GE_SCHED;
            GE_STAGE_B(GE_SB(1, 1), b3 + hstepB);
            GE_WAIT_V(6); GE_BAR; GE_MMA(1, 1, At, B1); GE_BAR;
        }
        E(acc, cur, wr, wc, fr, fq, pre);
        if (!has_next) break;
#pragma unroll
        for (int a = 0; a < 2; ++a)
#pragma unroll
            for (int b = 0; b < 2; ++b)
#pragma unroll
                for (int m = 0; m < 4; ++m)
#pragma unroll
                    for (int n = 0; n < 2; ++n) acc[a][b][m][n] = (f32x4){0.f, 0.f, 0.f, 0.f};
        cur = nxt; nxt = nn; has_next = has_nn; cA = nA; cB = nB; ++ui;
    }
    GE_WAIT_V(0);
    if (wr == 0) GE_BAR;
    GE_BAR;
#undef GE_SA
#undef GE_SB
#undef GE_STAGE
#undef GE_STAGE_B
#undef GE_STG
#undef GE_RC
#undef GE_LDA
#undef GE_LDB
#undef GE_MMA
#undef GE_WAIT_V
#undef GE_WAIT_L
#undef GE_BAR
#undef GE_SCHED
}

template <class Epi, class Sched>
__device__ __forceinline__ void gemm_phase_v(LAS unsigned char* lds, const Sched& S, const Epi& E) {
    int tid = threadIdx.x; asm volatile("" : "+v"(tid));
    const int wid = __builtin_amdgcn_readfirstlane(tid >> 6), lane = tid & 63, wr = wid >> 2, wc = wid & 3, fr = lane & 15, fq = lane >> 4;
    int Rr[2], Rbb[2]; unsigned C2[2];
#pragma unroll
    for (int i = 0; i < 2; ++i) { int R, C; stage_rc(tid * 16 + i * 8192, R, C); Rr[i] = R; C2[i] = (unsigned)C * 2u; Rbb[i] = Epi::PERM ? ((R & ~31) + perm32(R & 31)) : R; }
    const size_t kstep = (size_t)(BK * 2);
    const unsigned ldsw = (unsigned)wid * 1024u;
    const int aoff = lds_byte(wr * 64 + fr, fq * 8), boff = lds_byte(wc * 32 + fr, fq * 8);
#define GE_SA(b, h) (((b) * 2 + (h)) * HTB)
#define GE_SB(b, h) ((4 + (b) * 2 + (h)) * HTB)
#define GE_STAGE(bufoff, gbase, v0, v1) do { \
        __builtin_amdgcn_global_load_lds((const unsigned*)((const char*)(gbase) + (v0)), (LAS unsigned*)(lds + (bufoff) + ldsw), 16, 0, 0); \
        __builtin_amdgcn_global_load_lds((const unsigned*)((const char*)(gbase) + (v1)), (LAS unsigned*)(lds + (bufoff) + ldsw + 8192), 16, 0, 0); } while (0)
#define GE_LDA(dst, b, h) do { _Pragma("unroll") for (int m = 0; m < 4; ++m) _Pragma("unroll") for (int k = 0; k < 2; ++k) dst[m][k] = *(const LAS bf16x8*)(lds + GE_SA(b, h) + aoff + m * 2048 + k * 1024); } while (0)
#define GE_LDB(dst, b, h) do { _Pragma("unroll") for (int n = 0; n < 2; ++n) _Pragma("unroll") for (int k = 0; k < 2; ++k) dst[n][k] = *(const LAS bf16x8*)(lds + GE_SB(b, h) + boff + n * 2048 + k * 1024); } while (0)
#define GE_MMA(ai, bj, At, Bt) do { __builtin_amdgcn_s_setprio(1); _Pragma("unroll") for (int m = 0; m < 4; ++m) _Pragma("unroll") for (int n = 0; n < 2; ++n) _Pragma("unroll") for (int k = 0; k < 2; ++k) \
        acc[ai][bj][m][n] = __builtin_amdgcn_mfma_f32_16x16x32_bf16(Bt[n][k], At[m][k], acc[ai][bj][m][n], 0, 0, 0); __builtin_amdgcn_s_setprio(0); } while (0)
#define GE_WAIT_V(n) asm volatile("s_waitcnt vmcnt(" #n ")" ::: "memory")
#define GE_WAIT_L(n) asm volatile("s_waitcnt lgkmcnt(" #n ")" ::: "memory")
#define GE_BAR __builtin_amdgcn_s_barrier()
#define GE_SCHED __builtin_amdgcn_sched_barrier(0)
#define GE_STA(bufoff, gbase, pitch, h) GE_STAGE(bufoff, gbase, __umul24((unsigned)(Rr[0] + (h) * HALF), (unsigned)(pitch)) + C2[0], __umul24((unsigned)(Rr[1] + (h) * HALF), (unsigned)(pitch)) + C2[1])
#define GE_STB(bufoff, gbase, pitch, h) GE_STAGE(bufoff, gbase, __umul24((unsigned)(Rbb[0] + (h) * HALF), (unsigned)(pitch)) + C2[0], __umul24((unsigned)(Rbb[1] + (h) * HALF), (unsigned)(pitch)) + C2[1])
    Unit cur, nxt; int ui = 0;
    if (!S.next(0, cur)) return;
    int cpa = S.lda(cur) * 2, cpb = S.ldb(cur) * 2, npa = cpa, npb = cpb;
    f32x4 acc[2][2][4][2];
#pragma unroll
    for (int a = 0; a < 2; ++a)
#pragma unroll
        for (int b = 0; b < 2; ++b)
#pragma unroll
            for (int m = 0; m < 4; ++m)
#pragma unroll
                for (int n = 0; n < 2; ++n) acc[a][b][m][n] = (f32x4){0.f, 0.f, 0.f, 0.f};
    bf16x8 At[4][2], B0[2][2], B1[2][2];
    const char* cA = S.a_base(cur); const char* cB = S.b_base(cur);
    GE_STB(GE_SB(0, 0), cB, cpb, 0); GE_STA(GE_SA(0, 0), cA, cpa, 0); GE_STB(GE_SB(0, 1), cB, cpb, 1); GE_STA(GE_SA(0, 1), cA, cpa, 1);
    if (wr == 1) GE_BAR;
    GE_WAIT_V(4); GE_BAR;
    GE_STB(GE_SB(1, 0), cB + kstep, cpb, 0); GE_STA(GE_SA(1, 0), cA + kstep, cpa, 0); GE_STB(GE_SB(1, 1), cB + kstep, cpb, 1);
    GE_WAIT_V(6); GE_BAR;
    for (;;) {
        const bool has_next = S.next(ui + 1, nxt);
        const char* nA = has_next ? S.a_base(nxt) : cA; const char* nB = has_next ? S.b_base(nxt) : cB;
        if (has_next) { npa = S.lda(nxt) * 2; npb = S.ldb(nxt) * 2; } else { npa = cpa; npb = cpb; }
        const int nt = S.nt(cur);
#pragma unroll 1
        for (int t = 0; t < nt; t += 2) {
            const bool last = (t == nt - 2);
            const char* a1 = cA + (size_t)(t + 1) * kstep;
            const char* a2 = last ? nA : cA + (size_t)(t + 2) * kstep; const char* b2 = last ? nB : cB + (size_t)(t + 2) * kstep;
            const char* a3 = a2 + kstep; const char* b3 = b2 + kstep;
            const int xpa = last ? npa : cpa, xpb = last ? npb : cpb;
            GE_LDB(B0, 0, 0); GE_SCHED; GE_LDA(At, 0, 0); GE_STA(GE_SA(1, 1), a1, cpa, 1);
            GE_WAIT_L(8); GE_BAR; GE_WAIT_L(0); GE_MMA(0, 0, At, B0); GE_BAR; GE_SCHED;
            GE_LDB(B1, 0, 1); GE_STB(GE_SB(0, 0), b2, xpb, 0);
            GE_BAR; GE_WAIT_L(0); GE_MMA(0, 1, At, B1); GE_BAR;
            GE_LDA(At, 0, 1); GE_STA(GE_SA(0, 0), a2, xpa, 0);
            GE_BAR; GE_WAIT_L(0); GE_MMA(1, 0, At, B0); GE_BAR; GE_SCHED;
            GE_STB(GE_SB(0, 1), b2, xpb, 1);
            GE_WAIT_V(6); GE_BAR; GE_MMA(1, 1, At, B1); GE_BAR;
            GE_LDB(B0, 1, 0); GE_SCHED; GE_LDA(At, 1, 0); GE_STA(GE_SA(0, 1), a2, xpa, 1);
            GE_WAIT_L(8); GE_BAR; GE_WAIT_L(0); GE_MMA(0, 0, At, B0); GE_BAR; GE_SCHED;
            GE_LDB(B1, 1, 1); GE_STB(GE_SB(1, 0), b3, xpb, 0);
            GE_BAR; GE_WAIT_L(0); GE_MMA(0, 1, At, B1); GE_BAR;
            GE_LDA(At, 1, 1); GE_STA(GE_SA(1, 0), a3, xpa, 0);
            GE_BAR; GE_WAIT_L(0); GE_MMA(1, 0, At, B0); GE_BAR; GE_SCHED;
            GE_STB(GE_SB(1, 1), b3, xpb, 1);
            GE_WAIT_V(6); GE_BAR; GE_MMA(1, 1, At, B1); GE_BAR;
        }
        const bool keep = E(acc, cur, wr, wc, fr, fq);
        if (!has_next) break;
        if (!keep) {
#pragma unroll
            for (int a = 0; a < 2; ++a)
#pragma unroll
                for (int b = 0; b < 2; ++b)
#pragma unroll
                    for (int m = 0; m < 4; ++m)
#pragma unroll
                        for (int n = 0; n < 2; ++n) acc[a][b][m][n] = (f32x4){0.f, 0.f, 0.f, 0.f};
        }
        cur = nxt; cA = nA; cB = nB; ++ui;
        cpa = npa; cpb = npb;
    }
    GE_WAIT_V(0);
    if (wr == 0) GE_BAR;
    GE_BAR;
#undef GE_SA
#undef GE_SB
#undef GE_STAGE
#undef GE_LDA
#undef GE_LDB
#undef GE_MMA
#undef GE_WAIT_V
#undef GE_WAIT_L
#undef GE_BAR
#undef GE_SCHED
#undef GE_STA
#undef GE_STB
}
}
constexpr size_t MiB = (size_t)1 << 20;
constexpr size_t OFF_BAR    = 0;
constexpr size_t OFF_CNT    = 16 * 1024;
constexpr size_t OFF_BLKE   = 32 * 1024;
constexpr size_t OFF_MOD    = 64 * 1024;
constexpr size_t OFF_PAIR   = 192 * 1024;
constexpr size_t OFF_EIDX   = 1 * MiB;
constexpr size_t OFF_WTS    = 2 * MiB;
constexpr size_t OFF_APOS   = 3 * MiB;
constexpr size_t OFF_ROWTOK = 4 * MiB;
constexpr size_t OFF_WINT   = 8 * MiB;
constexpr size_t OFF_GLUT   = 20 * MiB;
constexpr size_t OFF_PAT    = OFF_GLUT + 128 * 1024;
constexpr size_t OFF_PBT    = OFF_PAT + 512 * 1024;
constexpr size_t OFF_WOUTT  = OFF_PBT + 1536 * 1024;
constexpr size_t OFF_U      = 34 * MiB;
constexpr size_t OFF_H      = 62 * MiB;
constexpr size_t OFF_Z      = 128 * MiB;
constexpr size_t OFF_YPART  = 62 * MiB;
constexpr size_t OFF_YA     = 26 * MiB;
constexpr size_t OFF_YB     = 42 * MiB;
constexpr size_t OFF_BT2    = 40 * MiB;
constexpr size_t OFF_HID1   = 92 * MiB;
constexpr size_t OFF_HID2   = 208 * MiB;
constexpr size_t OFF_H2     = 232 * MiB;
constexpr size_t OFF_BT1    = 57 * MiB;
constexpr size_t OFF_Y2     = 232 * MiB;
constexpr size_t DO_OF = 0, DO_OB = 48 * MiB, DO_X1 = 0;

constexpr size_t OFF_BCNT = 6 * MiB;
constexpr size_t OFF_LIST = 504 * MiB;
constexpr size_t OFF_ROWDST = 90 * MiB;
constexpr size_t OFF_Y2S = 8 * MiB;
constexpr size_t OFF_WRT = 6 * MiB + 512 * 1024;

constexpr int X1P = 2048;

struct Params {
    const float *x, *c, *ctx, *c_ctx, *w_ada, *b_ada, *norm1_g, *norm2_g, *w_in, *lam_re, *lam_im, *log_dt, *b_re, *b_im, *c_re, *c_im, *s5_d, *w_glu, *lb_logits, *hg_norm_g,
                *p_a, *p_b, *w_out, *w_router, *b_router, *w1, *w3, *w2, *ws1, *ws3, *ws2, *final_g;
    unsigned char* ws; unsigned char* out;
};
constexpr bool Z_FP8 = true;
constexpr size_t DO_H8 = 0, DO_W8 = 40 * MiB;
__device__ __forceinline__ void ada_phase(const Params& p, LAS unsigned char* lds) {
    LAS float* sc = (LAS float*)lds;
    LAS float* red = (LAS float*)(lds + 5 * 1024 * 4);
    const int tid = threadIdx.x;
    float* mod = (float*)(p.ws + OFF_MOD);
    bool loaded = false;
    for (int item = blockIdx.x; item < 192; item += gridDim.x) {
        if (!loaded) {
            for (int i = tid; i < 5 * 1024; i += 512) { const int r = i >> 10, k = i & 1023; const float v = (r < 4) ? p.c[r * 1024 + k] : p.c_ctx[k]; sc[i] = siluf_(v); }
            loaded = true; __syncthreads();
        }
        const int n0 = item * 32, ks = tid >> 5, col = tid & 31;
        float a0 = 0.f, a1 = 0.f, a2 = 0.f, a3 = 0.f, a4 = 0.f;
#pragma unroll 16
        for (int k = ks * 64; k < ks * 64 + 64; ++k) {
            const float w = p.w_ada[(size_t)k * NIN + n0 + col];
            a0 += sc[k] * w; a1 += sc[1024 + k] * w; a2 += sc[2048 + k] * w; a3 += sc[3072 + k] * w; a4 += sc[4096 + k] * w;
        }
        red[(ks * 5 + 0) * 32 + col] = a0; red[(ks * 5 + 1) * 32 + col] = a1; red[(ks * 5 + 2) * 32 + col] = a2; red[(ks * 5 + 3) * 32 + col] = a3; red[(ks * 5 + 4) * 32 + col] = a4;
        __syncthreads();
        if (tid < 160) { const int r = tid >> 5, cc = tid & 31; float s = 0.f;
            for (int q = 0; q < 16; ++q) s += red[(q * 5 + r) * 32 + cc];
            mod[r * NIN + n0 + cc] = s + p.b_ada[n0 + cc]; }
        __syncthreads();
    }
}

__device__ __forceinline__ unsigned cvt_pack_fp8x4(float a, float b, float c, float d) {
    a = __builtin_amdgcn_fmed3f(a, -448.f, 448.f); b = __builtin_amdgcn_fmed3f(b, -448.f, 448.f); c = __builtin_amdgcn_fmed3f(c, -448.f, 448.f); d = __builtin_amdgcn_fmed3f(d, -448.f, 448.f);
    int w = 0; w = __builtin_amdgcn_cvt_pk_fp8_f32(a, b, w, false); w = __builtin_amdgcn_cvt_pk_fp8_f32(c, d, w, true); return (unsigned)w; }
template <bool F8 = false, class F>
__device__ __forceinline__ void cvt_tile(const float* src, int ld, int k0, int n0, bf16_t* dst, int ldd, int kdst0, F rowmap, LAS unsigned char* lds) {
    LAS float* t = (LAS float*)lds;
    const int tid = threadIdx.x;
#pragma unroll
    for (int j = 0; j < 2; ++j) { const int kr = (tid >> 4) + 32 * j, nc = (tid & 15) * 4;
        const f32x4 v = *(const f32x4*)(src + (size_t)(k0 + kr) * ld + n0 + nc);
        t[kr * 65 + nc] = v[0]; t[kr * 65 + nc + 1] = v[1]; t[kr * 65 + nc + 2] = v[2]; t[kr * 65 + nc + 3] = v[3]; }
    __syncthreads();
    { const int n = tid >> 3, kc = (tid & 7) * 8; float v[8];
#pragma unroll
      for (int j = 0; j < 8; ++j) v[j] = t[(kc + j) * 65 + n];
      if constexpr (F8) { u32x2 w; w.x = cvt_pack_fp8x4(v[0] * 32.f, v[1] * 32.f, v[2] * 32.f, v[3] * 32.f); w.y = cvt_pack_fp8x4(v[4] * 32.f, v[5] * 32.f, v[6] * 32.f, v[7] * 32.f);
          *(u32x2*)((unsigned char*)dst + (size_t)rowmap(n0 + n) * ldd + kdst0 + k0 + kc) = w; }
      else { u32x4 w; w.x = cvt_pk_bf16(v[0], v[1]); w.y = cvt_pk_bf16(v[2], v[3]); w.z = cvt_pk_bf16(v[4], v[5]); w.w = cvt_pk_bf16(v[6], v[7]);
          *(u32x4*)(dst + (size_t)rowmap(n0 + n) * ldd + kdst0 + k0 + kc) = w; } }
    __syncthreads();
}

__device__ __forceinline__ void cvt_dense_phase(const Params& p, LAS unsigned char* lds) {
    bf16_t* WinT = (bf16_t*)(p.ws + OFF_WINT); bf16_t* gluT = (bf16_t*)(p.ws + OFF_GLUT); bf16_t* PaT = (bf16_t*)(p.ws + OFF_PAT); bf16_t* PbT = (bf16_t*)(p.ws + OFF_PBT); bf16_t* WoutT = (bf16_t*)(p.ws + OFF_WOUTT);
    auto id = [](int n) { return n; };
    constexpr int T_WIN = 16 * 96, T_GLU = 4 * 4, T_PA = 4 * 16, T_PB = 12 * 16, T_WO = 16 * 16, T_ALL = T_WIN + T_GLU + T_PA + T_PB + T_WO;
    for (int it = blockIdx.x; it < T_ALL; it += gridDim.x) {
        int i = it;
        if (i < T_WIN) { if constexpr (Z_FP8) cvt_tile<true>(p.w_in, NIN, (i / 96) * 64, (i % 96) * 64, (bf16_t*)(p.out + DO_W8), 1024, 0, id, lds);
                         else cvt_tile<false>(p.w_in, NIN, (i / 96) * 64, (i % 96) * 64, WinT, 1024, 0, id, lds); continue; } i -= T_WIN;
        if (i < T_GLU) { cvt_tile(p.w_glu, 256, (i / 4) * 64, (i % 4) * 64, gluT, 256, 0, id, lds); continue; } i -= T_GLU;
        if (i < T_PA) { cvt_tile(p.p_a, 1024, (i / 16) * 64, (i % 16) * 64, PaT, 256, 0, id, lds); continue; } i -= T_PA;
        if (i < T_PB) { cvt_tile(p.p_b, 1024, (i / 16) * 64, (i % 16) * 64, PbT, 768, 0, id, lds); continue; } i -= T_PB;
        cvt_tile(p.w_out, 1024, (i / 16) * 64, (i % 16) * 64, WoutT, 1024, 0, id, lds);
    }
}

__device__ __forceinline__ unsigned moe_pack_fp8x4(float a, float b, float c, float d) {
    a = __builtin_amdgcn_fmed3f(a, -448.f, 448.f); b = __builtin_amdgcn_fmed3f(b, -448.f, 448.f); c = __builtin_amdgcn_fmed3f(c, -448.f, 448.f); d = __builtin_amdgcn_fmed3f(d, -448.f, 448.f);
    int w = 0; w = __builtin_amdgcn_cvt_pk_fp8_f32(a, b, w, false); w = __builtin_amdgcn_cvt_pk_fp8_f32(c, d, w, true); return (unsigned)w; }
struct MoeStrip { const float* src; int ld; unsigned char* dst; int ldd; int mode; };
__device__ __forceinline__ MoeStrip moe_strip(const Params& p, int it) {
    const int e = it / 48, j = it % 48, which = j >> 4, t = j & 15; MoeStrip s;
    unsigned char* Bt1 = p.ws + OFF_BT1 + (size_t)e * 512 * 1024; unsigned char* Bt2 = p.ws + OFF_BT2 + (size_t)e * 1024 * 256;
    if (which == 0) { s.src = ((e < 64) ? p.w1 + (size_t)e * 1024 * 256 : p.ws1) + (size_t)(t * 64) * 256; s.ld = 256; s.dst = Bt1 + t * 64; s.ldd = 1024; s.mode = 0; }
    else if (which == 1) { s.src = ((e < 64) ? p.w3 + (size_t)e * 1024 * 256 : p.ws3) + (size_t)(t * 64) * 256; s.ld = 256; s.dst = Bt1 + t * 64; s.ldd = 1024; s.mode = 1; }
    else { const int kt = t >> 2, nt = t & 3; s.src = ((e < 64) ? p.w2 + (size_t)e * 256 * 1024 : p.ws2) + (size_t)(kt * 64) * 1024 + nt * 256; s.ld = 1024; s.dst = Bt2 + (size_t)(nt * 256) * 256 + kt * 64; s.ldd = 256; s.mode = 2; }
    return s;
}
__device__ __forceinline__ void cvt_moe_phase(const Params& p, LAS unsigned char* lds) {
    int tid = threadIdx.x; asm volatile("" : "+v"(tid));
    LAS float* tl = (LAS float*)lds;
    const int NIT = 65 * 48;
    f32x4 r[8];
    int it = blockIdx.x;
    if (it < NIT) { const MoeStrip s = moe_strip(p, it);
#pragma unroll
        for (int j = 0; j < 8; ++j) r[j] = *(const f32x4*)(s.src + (size_t)((tid >> 6) + 8 * j) * s.ld + (tid & 63) * 4); }
    for (; it < NIT; it += gridDim.x) {
        const MoeStrip s = moe_strip(p, it);
#pragma unroll
        for (int j = 0; j < 8; ++j) { const int kr = (tid >> 6) + 8 * j, nc = (tid & 63) * 4; tl[kr * 257 + nc] = r[j][0]; tl[kr * 257 + nc + 1] = r[j][1]; tl[kr * 257 + nc + 2] = r[j][2]; tl[kr * 257 + nc + 3] = r[j][3]; }
        __syncthreads();
        if (it + (int)gridDim.x < NIT) { const MoeStrip s2 = moe_strip(p, it + gridDim.x);
#pragma unroll
            for (int j = 0; j < 8; ++j) r[j] = *(const f32x4*)(s2.src + (size_t)((tid >> 6) + 8 * j) * s2.ld + (tid & 63) * 4); }
        { const int k8 = (tid & 7) * 8;
#pragma unroll
          for (int c = 0; c < 4; ++c) { const int n = (tid >> 3) + 64 * c;
              const int row = (s.mode == 2) ? n : ((n >> 7) * 256 + (s.mode == 1 ? 128 : 0) + (n & 127));
              float v[8];
#pragma unroll
              for (int q = 0; q < 8; ++q) v[q] = tl[(k8 + q) * 257 + n];
              { u32x2 w; w.x = moe_pack_fp8x4(v[0] * 32.f, v[1] * 32.f, v[2] * 32.f, v[3] * 32.f); w.y = moe_pack_fp8x4(v[4] * 32.f, v[5] * 32.f, v[6] * 32.f, v[7] * 32.f);
                  *(u32x2*)(s.dst + (size_t)row * s.ldd + k8) = w; } } }
        __syncthreads();
    }
}

__device__ __forceinline__ void norm1_phase(const Params& p) {
    const int wid = threadIdx.x >> 6, lane = threadIdx.x & 63;
    const float* mod = (const float*)(p.ws + OFF_MOD); bf16_t* H = (bf16_t*)(p.ws + OFF_H);
    for (int r = blockIdx.x * 8 + wid; r < NROWS; r += gridDim.x * 8) {
        const float* src = (r < NTOK) ? p.x + (size_t)r * 1024 : p.ctx + (size_t)(r - NTOK) * 1024;
        const float* mr = mod + ((r < NTOK) ? (r / SEQ) : 4) * NIN;
        f32x4 v[4]; float ss = 0.f;
#pragma unroll
        for (int j = 0; j < 4; ++j) { v[j] = *(const f32x4*)(src + j * 256 + lane * 4); ss += v[j][0] * v[j][0] + v[j][1] * v[j][1] + v[j][2] * v[j][2] + v[j][3] * v[j][3]; }
        ss = wave_sum(ss);
        const float rstd = rsqrtf(ss * (1.0f / 1024.0f) + EPSF);
#pragma unroll
        for (int j = 0; j < 4; ++j) { const int k = j * 256 + lane * 4;
            const f32x4 g = *(const f32x4*)(p.norm1_g + k), sh = *(const f32x4*)(mr + k), scv = *(const f32x4*)(mr + 1024 + k);
            float o[4];
#pragma unroll
            for (int q = 0; q < 4; ++q) o[q] = v[j][q] * rstd * g[q] * (1.0f + scv[q]) + sh[q];
            if constexpr (Z_FP8) *(unsigned*)(p.out + DO_H8 + (size_t)r * 1024 + k) = cvt_pack_fp8x4(o[0], o[1], o[2], o[3]);
            else { u32x2 w; w.x = cvt_pk_bf16(o[0], o[1]); w.y = cvt_pk_bf16(o[2], o[3]); *(u32x2*)(H + (size_t)r * 1024 + k) = w; } }
    }
}
struct PlainSched {
    ge::GridOrder go; const char* A; const char* B; size_t atile, btile;
    __device__ void init(const void* A_, int lda, const void* B_, int ldb, int nM, int nN) { A = (const char*)A_; B = (const char*)B_; atile = (size_t)256 * lda * 2; btile = (size_t)256 * ldb * 2; go.init(nM, nN, (int)gridDim.x, (int)blockIdx.x); }
    __device__ __forceinline__ bool next(int i, ge::Unit& u) const { u.e = 0; return go.tile(i, u.pm, u.pn); }
    __device__ __forceinline__ const char* a_base(const ge::Unit& u) const { return A + (size_t)u.pm * atile; }
    __device__ __forceinline__ const char* b_base(const ge::Unit& u) const { return B + (size_t)u.pn * btile; }
    __device__ __forceinline__ int a_row(const ge::Unit&, int) const { return 0; }
};

struct ZSchedF8 {
    ge::GridOrder go; const char* A; const char* B;
    __device__ void init(const void* A_, const void* B_) { A = (const char*)A_; B = (const char*)B_; go.init(NROWS / 256, NIN / 256, (int)gridDim.x, (int)blockIdx.x); }
    __device__ __forceinline__ bool next(int i, ge::Unit& u) const { u.e = 0; return go.tile(i, u.pm, u.pn); }
    __device__ __forceinline__ const char* a_base(const ge::Unit& u) const { return A + (size_t)u.pm * 256 * 1024; }
    __device__ __forceinline__ const char* b_base(const ge::Unit& u) const { return B + (size_t)u.pn * 256 * 1024; }
    __device__ __forceinline__ int a_row(const ge::Unit&, int r) const { return r; }
};
struct ZSchedBf {
    ge::GridOrder go; const char* A; const char* B;
    __device__ void init(const void* A_, const void* B_) { A = (const char*)A_; B = (const char*)B_; go.init(NROWS / 256, 1, (int)gridDim.x, (int)blockIdx.x); }
    __device__ __forceinline__ bool next(int i, ge::Unit& u) const { u.e = 0; int j; if (!go.tile(i, u.pm, j)) return false; u.pn = j; return true; }
    __device__ __forceinline__ const char* a_base(const ge::Unit& u) const { return A + (size_t)u.pm * 256 * 1024 * 2; }
    __device__ __forceinline__ const char* b_base(const ge::Unit& u) const { return B + (size_t)u.pn * 256 * 1024 * 2; }
    __device__ __forceinline__ int a_row(const ge::Unit&, int) const { return 0; }
};
struct EpiZ {
    static constexpr bool PERM = true;
    bf16_t* U; bf16_t* Z;
    __device__ __forceinline__ void operator()(const f32x4 (&acc)[2][2][4][2], const ge::Unit& u, int wr, int wc, int fr, int fq) const {
        const int row0 = u.pm * 256 + wr * 64 + fr, cl = wc * 32 + 8 * fq;
        bf16_t* base; int ld;
        if (u.pn == 0) { base = U + cl; ld = 256; } else { base = Z + (u.pn - 1) * 256 + cl; ld = ZC; }
#pragma unroll
        for (int ai = 0; ai < 2; ++ai)
#pragma unroll
            for (int m = 0; m < 4; ++m) { bf16_t* rowp = base + (size_t)(row0 + ai * 128 + m * 16) * ld;
#pragma unroll
                for (int bj = 0; bj < 2; ++bj) { const f32x4 v0 = acc[ai][bj][m][0], v1 = acc[ai][bj][m][1];
                    u32x4 w; w.x = cvt_pk_bf16(v0[0], v0[1]); w.y = cvt_pk_bf16(v0[2], v0[3]); w.z = cvt_pk_bf16(v1[0], v1[1]); w.w = cvt_pk_bf16(v1[2], v1[3]);
                    *(u32x4*)(rowp + bj * 128) = w; } }
    }
};


struct EpiZ2 {
    static constexpr bool PERM = true;
    bf16_t* Ae; bf16_t* Uc; bf16_t* Z;
    struct Pre {}; __device__ __forceinline__ Pre pre(const ge::Unit&, int, int, int, int) const { return Pre{}; }
    __device__ __forceinline__ void operator()(const f32x4 (&acc)[2][2][4][2], const ge::Unit& u, int wr, int wc, int fr, int fq, const Pre&) const { (*this)(acc, u, wr, wc, fr, fq); }
    __device__ __forceinline__ void operator()(const f32x4 (&acc)[2][2][4][2], const ge::Unit& u, int wr, int wc, int fr, int fq) const {
        const int row0 = u.pm * 256 + wr * 64 + fr, cl = wc * 32 + 8 * fq;
#pragma unroll
        for (int ai = 0; ai < 2; ++ai)
#pragma unroll
            for (int m = 0; m < 4; ++m) { const int r = row0 + ai * 128 + m * 16;
#pragma unroll
                for (int bj = 0; bj < 2; ++bj) { const f32x4 v0 = acc[ai][bj][m][0], v1 = acc[ai][bj][m][1];
                    u32x4 w; w.x = cvt_pk_bf16(v0[0], v0[1]); w.y = cvt_pk_bf16(v0[2], v0[3]); w.z = cvt_pk_bf16(v1[0], v1[1]); w.w = cvt_pk_bf16(v1[2], v1[3]);
                    bf16_t* dst;
                    if (u.pn == 0) { const int col = bj * 128 + cl, g = col >> 4, c0 = col & 15;
                        if (u.pm < NTOK / 256) { const int b = r >> 13, l = r & (SEQ - 1); dst = Ae + (size_t)(g * 512 + b * 128 + (l >> 6)) * 1280 + (l & 63) * 16 + c0; }
                        else dst = Uc + (size_t)(r - NTOK) * 256 + col; }
                    else dst = Z + (size_t)r * ZC + (u.pn - 1) * 256 + cl + bj * 128;
                    *(u32x4*)dst = w; } }
    }
};

struct EpiYa {
    static constexpr bool PERM = true;
    const bf16_t* Y; bf16_t* Ya;
    __device__ __forceinline__ void operator()(const f32x4 (&acc)[2][2][4][2], const ge::Unit& u, int wr, int wc, int fr, int fq) const {
        const int row0 = u.pm * 256 + wr * 64 + fr, col0 = u.pn * 256 + wc * 32 + 8 * fq;
        u32x4 cur[2][2], nxt[2][2];
#pragma unroll
        for (int mm = 0; mm < 2; ++mm)
#pragma unroll
            for (int bj = 0; bj < 2; ++bj) cur[mm][bj] = *(const u32x4*)(Y + (size_t)(row0 + mm * 16) * 256 + col0 + bj * 128);
#pragma unroll
        for (int gi = 0; gi < 4; ++gi) { const int ai = gi >> 1, mh = gi & 1;
            if (gi < 3) { const int ai2 = (gi + 1) >> 1, mh2 = (gi + 1) & 1;
#pragma unroll
                for (int mm = 0; mm < 2; ++mm)
#pragma unroll
                    for (int bj = 0; bj < 2; ++bj) nxt[mm][bj] = *(const u32x4*)(Y + (size_t)(row0 + ai2 * 128 + (2 * mh2 + mm) * 16) * 256 + col0 + bj * 128); }
#pragma unroll
            for (int mm = 0; mm < 2; ++mm)
#pragma unroll
                for (int bj = 0; bj < 2; ++bj) { const int m = 2 * mh + mm; const f32x4 v0 = acc[ai][bj][m][0], v1 = acc[ai][bj][m][1]; const u32x4 y4 = cur[mm][bj];
                    float o[8];
                    o[0] = bf_lo(y4.x) * sigmoidf_(v0[0]); o[1] = bf_hi(y4.x) * sigmoidf_(v0[1]); o[2] = bf_lo(y4.y) * sigmoidf_(v0[2]); o[3] = bf_hi(y4.y) * sigmoidf_(v0[3]);
                    o[4] = bf_lo(y4.z) * sigmoidf_(v1[0]); o[5] = bf_hi(y4.z) * sigmoidf_(v1[1]); o[6] = bf_lo(y4.w) * sigmoidf_(v1[2]); o[7] = bf_hi(y4.w) * sigmoidf_(v1[3]);
                    u32x4 w; w.x = cvt_pk_bf16(o[0], o[1]); w.y = cvt_pk_bf16(o[2], o[3]); w.z = cvt_pk_bf16(o[4], o[5]); w.w = cvt_pk_bf16(o[6], o[7]);
                    *(u32x4*)(Ya + (size_t)(row0 + ai * 128 + m * 16) * 256 + col0 + bj * 128) = w; }
#pragma unroll
            for (int mm = 0; mm < 2; ++mm)
#pragma unroll
                for (int bj = 0; bj < 2; ++bj) cur[mm][bj] = nxt[mm][bj];
            asm volatile("" ::: "memory"); }
    }
};

template <bool ADD> struct EpiMerge {
    static constexpr bool PERM = true;
    const bf16_t* Z; int gcol0; bf16_t* Mg;
    __device__ __forceinline__ void operator()(const f32x4 (&acc)[2][2][4][2], const ge::Unit& u, int wr, int wc, int fr, int fq) const {
        const int row0 = u.pm * 256 + wr * 64 + fr, col0 = u.pn * 256 + wc * 32 + 8 * fq;
        u32x4 gc[2][2], gn[2][2], pc[2][2], pn_[2][2];
#pragma unroll
        for (int mm = 0; mm < 2; ++mm)
#pragma unroll
            for (int bj = 0; bj < 2; ++bj) { const size_t row = (size_t)(row0 + mm * 16); gc[mm][bj] = *(const u32x4*)(Z + row * ZC + gcol0 + col0 + bj * 128); if (ADD) pc[mm][bj] = *(const u32x4*)(Mg + row * 1024 + col0 + bj * 128); }
#pragma unroll
        for (int gi = 0; gi < 4; ++gi) { const int ai = gi >> 1, mh = gi & 1;
            if (gi < 3) { const int ai2 = (gi + 1) >> 1, mh2 = (gi + 1) & 1;
#pragma unroll
                for (int mm = 0; mm < 2; ++mm)
#pragma unroll
                    for (int bj = 0; bj < 2; ++bj) { const size_t row = (size_t)(row0 + ai2 * 128 + (2 * mh2 + mm) * 16); gn[mm][bj] = *(const u32x4*)(Z + row * ZC + gcol0 + col0 + bj * 128); if (ADD) pn_[mm][bj] = *(const u32x4*)(Mg + row * 1024 + col0 + bj * 128); } }
#pragma unroll
            for (int mm = 0; mm < 2; ++mm)
#pragma unroll
                for (int bj = 0; bj < 2; ++bj) { const int m = 2 * mh + mm; const size_t row = (size_t)(row0 + ai * 128 + m * 16);
                    const f32x4 v0 = acc[ai][bj][m][0], v1 = acc[ai][bj][m][1]; const u32x4 g4 = gc[mm][bj];
                    float o[8];
                    o[0] = sigmoidf_(bf_lo(g4.x)) * v0[0]; o[1] = sigmoidf_(bf_hi(g4.x)) * v0[1]; o[2] = sigmoidf_(bf_lo(g4.y)) * v0[2]; o[3] = sigmoidf_(bf_hi(g4.y)) * v0[3];
                    o[4] = sigmoidf_(bf_lo(g4.z)) * v1[0]; o[5] = sigmoidf_(bf_hi(g4.z)) * v1[1]; o[6] = sigmoidf_(bf_lo(g4.w)) * v1[2]; o[7] = sigmoidf_(bf_hi(g4.w)) * v1[3];
                    if (ADD) { const u32x4 p4 = pc[mm][bj];
                        o[0] += bf_lo(p4.x); o[1] += bf_hi(p4.x); o[2] += bf_lo(p4.y); o[3] += bf_hi(p4.y); o[4] += bf_lo(p4.z); o[5] += bf_hi(p4.z); o[6] += bf_lo(p4.w); o[7] += bf_hi(p4.w); }
                    u32x4 w; w.x = cvt_pk_bf16(o[0], o[1]); w.y = cvt_pk_bf16(o[2], o[3]); w.z = cvt_pk_bf16(o[4], o[5]); w.w = cvt_pk_bf16(o[6], o[7]);
                    *(u32x4*)(Mg + row * 1024 + col0 + bj * 128) = w; }
#pragma unroll
            for (int mm = 0; mm < 2; ++mm)
#pragma unroll
                for (int bj = 0; bj < 2; ++bj) { gc[mm][bj] = gn[mm][bj]; if (ADD) pc[mm][bj] = pn_[mm][bj]; }
            asm volatile("" ::: "memory"); }
    }
};


struct MergeSched {
    ge::GridOrder go; const char* Ya; const char* Yb; const char* Pa; const char* Pb;
    __device__ void init(const void* ya, const void* yb, const void* pa, const void* pb) { Ya = (const char*)ya; Yb = (const char*)yb; Pa = (const char*)pa; Pb = (const char*)pb; go.init(NTOK / 256, 4, (int)gridDim.x, (int)blockIdx.x); }
    __device__ __forceinline__ bool next(int i, ge::Unit& u) const { u.e = i & 1; return go.tile(i >> 1, u.pm, u.pn); }
    __device__ __forceinline__ const char* a_base(const ge::Unit& u) const { return u.e ? Yb + (size_t)u.pm * 256 * 768 * 2 : Ya + (size_t)u.pm * 256 * 256 * 2; }
    __device__ __forceinline__ const char* b_base(const ge::Unit& u) const { return u.e ? Pb + (size_t)u.pn * 256 * 768 * 2 : Pa + (size_t)u.pn * 256 * 256 * 2; }
    __device__ __forceinline__ int nt(const ge::Unit& u) const { return u.e ? 12 : 4; }
    __device__ __forceinline__ int lda(const ge::Unit& u) const { return u.e ? 768 : 256; }
    __device__ __forceinline__ int ldb(const ge::Unit& u) const { return u.e ? 768 : 256; }
};
template <bool WT = false> struct EpiMergeF {
    static constexpr bool PERM = true;
    const bf16_t* Z; bf16_t* Mg; int ldm;
    __device__ __forceinline__ bool operator()(f32x4 (&acc)[2][2][4][2], const ge::Unit& u, int wr, int wc, int fr, int fq) const {
        const int row0 = u.pm * 256 + wr * 64 + fr, col0 = u.pn * 256 + wc * 32 + 8 * fq;
        __amdgpu_buffer_rsrc_t rs = __builtin_amdgcn_make_buffer_rsrc((void*)Mg, 0, 0x7ffffff0, 0x00020000);
        if (u.e == 0) {
#pragma unroll
            for (int gi = 0; gi < 4; ++gi) { const int ai = gi >> 1, mh = gi & 1;
                u32x4 ga[2][2], gb[2][2];
#pragma unroll
                for (int mm = 0; mm < 2; ++mm)
#pragma unroll
                    for (int bj = 0; bj < 2; ++bj) { const bf16_t* zr = Z + (size_t)(row0 + ai * 128 + (2 * mh + mm) * 16) * ZC + col0 + bj * 128; ga[mm][bj] = *(const u32x4*)(zr + ZGA); gb[mm][bj] = *(const u32x4*)(zr + ZGB); }
#pragma unroll
                for (int mm = 0; mm < 2; ++mm)
#pragma unroll
                    for (int bj = 0; bj < 2; ++bj) { const int m = 2 * mh + mm; const u32x4 a4 = ga[mm][bj], b4 = gb[mm][bj];
#define MF_R(aw, bw, lo) ((1.0f + __expf(-(lo ? bf_lo(bw) : bf_hi(bw)))) * frcp_(1.0f + __expf(-(lo ? bf_lo(aw) : bf_hi(aw)))))
                        acc[ai][bj][m][0][0] *= MF_R(a4.x, b4.x, true); acc[ai][bj][m][0][1] *= MF_R(a4.x, b4.x, false); acc[ai][bj][m][0][2] *= MF_R(a4.y, b4.y, true); acc[ai][bj][m][0][3] *= MF_R(a4.y, b4.y, false);
                        acc[ai][bj][m][1][0] *= MF_R(a4.z, b4.z, true); acc[ai][bj][m][1][1] *= MF_R(a4.z, b4.z, false); acc[ai][bj][m][1][2] *= MF_R(a4.w, b4.w, true); acc[ai][bj][m][1][3] *= MF_R(a4.w, b4.w, false);
#undef MF_R
                    }
                asm volatile("" ::: "memory"); }
            return true;
        }
#pragma unroll
        for (int gi = 0; gi < 4; ++gi) { const int ai = gi >> 1, mh = gi & 1;
            u32x4 gb[2][2];
#pragma unroll
            for (int mm = 0; mm < 2; ++mm)
#pragma unroll
                for (int bj = 0; bj < 2; ++bj) gb[mm][bj] = *(const u32x4*)(Z + (size_t)(row0 + ai * 128 + (2 * mh + mm) * 16) * ZC + ZGB + col0 + bj * 128);
#pragma unroll
            for (int mm = 0; mm < 2; ++mm)
#pragma unroll
                for (int bj = 0; bj < 2; ++bj) { const int m = 2 * mh + mm; const f32x4 v0 = acc[ai][bj][m][0], v1 = acc[ai][bj][m][1]; const u32x4 g4 = gb[mm][bj];
                    float o[8];
                    o[0] = sigmoidf_(bf_lo(g4.x)) * v0[0]; o[1] = sigmoidf_(bf_hi(g4.x)) * v0[1]; o[2] = sigmoidf_(bf_lo(g4.y)) * v0[2]; o[3] = sigmoidf_(bf_hi(g4.y)) * v0[3];
                    o[4] = sigmoidf_(bf_lo(g4.z)) * v1[0]; o[5] = sigmoidf_(bf_hi(g4.z)) * v1[1]; o[6] = sigmoidf_(bf_lo(g4.w)) * v1[2]; o[7] = sigmoidf_(bf_hi(g4.w)) * v1[3];
                    u32x4 w; w.x = cvt_pk_bf16(o[0], o[1]); w.y = cvt_pk_bf16(o[2], o[3]); w.z = cvt_pk_bf16(o[4], o[5]); w.w = cvt_pk_bf16(o[6], o[7]);
                    if constexpr (WT) __builtin_amdgcn_raw_buffer_store_b128(w, rs, (int)(((unsigned)(row0 + ai * 128 + m * 16) * (unsigned)ldm + (unsigned)(col0 + bj * 128)) * 2u), 0, 16);
                    else *(u32x4*)(Mg + (size_t)(row0 + ai * 128 + m * 16) * ldm + col0 + bj * 128) = w; }
            asm volatile("" ::: "memory"); }
        return false;
    }
};


struct OneUnitSched {
    const char* A; const char* B; int pm;
    __device__ __forceinline__ bool next(int i, ge::Unit& u) const { if (i) return false; u.pm = pm; u.pn = 0; u.e = 0; return true; }
    __device__ __forceinline__ const char* a_base(const ge::Unit& u) const { return A + (size_t)u.pm * 256 * 256 * 2; }
    __device__ __forceinline__ const char* b_base(const ge::Unit&) const { return B; }
    __device__ __forceinline__ int a_row(const ge::Unit&, int) const { return 0; }
};
struct PanelMergeSched {
    const char* Ya; const char* Yb; const char* Pa; const char* Pb; int pm, pn0;
    __device__ __forceinline__ bool next(int i, ge::Unit& u) const { if (i >= 4) return false; u.pm = pm; u.pn = pn0 + (i >> 1); u.e = i & 1; return true; }
    __device__ __forceinline__ const char* a_base(const ge::Unit& u) const { return u.e ? Yb + (size_t)u.pm * 256 * 768 * 2 : Ya + (size_t)u.pm * 256 * 256 * 2; }
    __device__ __forceinline__ const char* b_base(const ge::Unit& u) const { return u.e ? Pb + (size_t)u.pn * 256 * 768 * 2 : Pa + (size_t)u.pn * 256 * 256 * 2; }
    __device__ __forceinline__ int nt(const ge::Unit& u) const { return u.e ? 12 : 4; }
    __device__ __forceinline__ int lda(const ge::Unit& u) const { return u.e ? 768 : 256; }
    __device__ __forceinline__ int ldb(const ge::Unit& u) const { return u.e ? 768 : 256; }
};

template <bool WT = false> struct EpiX1 {
    static constexpr bool PERM = false;
    const float* X; const float* mod; float* X1;
    __device__ __forceinline__ void operator()(const f32x4 (&acc)[2][2][4][2], const ge::Unit& u, int wr, int wc, int fr, int fq) const {
        const int row0 = u.pm * 256 + wr * 64 + fr, col0 = u.pn * 256 + wc * 32 + 4 * fq;
        const float* g1 = mod + (size_t)((u.pm * 256) / SEQ) * NIN + 2048;
        f32x4 gv[2][2];
#pragma unroll
        for (int bj = 0; bj < 2; ++bj)
#pragma unroll
            for (int n = 0; n < 2; ++n) gv[bj][n] = *(const f32x4*)(g1 + col0 + bj * 128 + n * 16);
        __amdgpu_buffer_rsrc_t rs = __builtin_amdgcn_make_buffer_rsrc((void*)X1, 0, 0x7ffffff0, 0x00020000);
        f32x4 cur[2][2], nxt[2][2];
#pragma unroll
        for (int bj = 0; bj < 2; ++bj)
#pragma unroll
            for (int n = 0; n < 2; ++n) cur[bj][n] = *(const f32x4*)(X + (size_t)row0 * 1024 + col0 + bj * 128 + n * 16);
#pragma unroll
        for (int gi = 0; gi < 8; ++gi) { const int ai = gi >> 2, m = gi & 3;
            if (gi < 7) { const int ai2 = (gi + 1) >> 2, m2 = (gi + 1) & 3;
#pragma unroll
                for (int bj = 0; bj < 2; ++bj)
#pragma unroll
                    for (int n = 0; n < 2; ++n) nxt[bj][n] = *(const f32x4*)(X + (size_t)(row0 + ai2 * 128 + m2 * 16) * 1024 + col0 + bj * 128 + n * 16); }
#pragma unroll
            for (int bj = 0; bj < 2; ++bj)
#pragma unroll
                for (int n = 0; n < 2; ++n) { const f32x4 r = cur[bj][n] + gv[bj][n] * acc[ai][bj][m][n];
                    if constexpr (WT) __builtin_amdgcn_raw_buffer_store_b128(__builtin_bit_cast(u32x4, r), rs, (int)(((unsigned)(row0 + ai * 128 + m * 16) * 1024u + (unsigned)(col0 + bj * 128 + n * 16)) * 4u), 0, 16);
                    else *(f32x4*)(X1 + (size_t)(row0 + ai * 128 + m * 16) * 1024 + col0 + bj * 128 + n * 16) = r; }
#pragma unroll
            for (int bj = 0; bj < 2; ++bj)
#pragma unroll
                for (int n = 0; n < 2; ++n) cur[bj][n] = nxt[bj][n];
            asm volatile("" ::: "memory"); }
    }
};


struct EpiX1b {
    static constexpr bool PERM = true;
    const float* X; const float* mod; bf16_t* X1;
    __device__ __forceinline__ void operator()(const f32x4 (&acc)[2][2][4][2], const ge::Unit& u, int wr, int wc, int fr, int fq) const {
        const int row0 = u.pm * 256 + wr * 64 + fr, col0 = u.pn * 256 + wc * 32 + 8 * fq;
        const float* g1 = mod + (size_t)((u.pm * 256) / SEQ) * NIN + 2048;
        f32x4 gv[2][2];
#pragma unroll
        for (int bj = 0; bj < 2; ++bj)
#pragma unroll
            for (int n = 0; n < 2; ++n) gv[bj][n] = *(const f32x4*)(g1 + col0 + bj * 128 + n * 4);
        f32x4 cur[2][2], nxt[2][2];
#pragma unroll
        for (int bj = 0; bj < 2; ++bj)
#pragma unroll
            for (int n = 0; n < 2; ++n) cur[bj][n] = *(const f32x4*)(X + (size_t)row0 * 1024 + col0 + bj * 128 + n * 4);
#pragma unroll
        for (int gi = 0; gi < 8; ++gi) { const int ai = gi >> 2, m = gi & 3;
            if (gi < 7) { const int ai2 = (gi + 1) >> 2, m2 = (gi + 1) & 3;
#pragma unroll
                for (int bj = 0; bj < 2; ++bj)
#pragma unroll
                    for (int n = 0; n < 2; ++n) nxt[bj][n] = *(const f32x4*)(X + (size_t)(row0 + ai2 * 128 + m2 * 16) * 1024 + col0 + bj * 128 + n * 4); }
#pragma unroll
            for (int bj = 0; bj < 2; ++bj) { const f32x4 r0 = cur[bj][0] + gv[bj][0] * acc[ai][bj][m][0], r1 = cur[bj][1] + gv[bj][1] * acc[ai][bj][m][1];
                u32x4 w; w.x = cvt_pk_bf16(r0[0], r0[1]); w.y = cvt_pk_bf16(r0[2], r0[3]); w.z = cvt_pk_bf16(r1[0], r1[1]); w.w = cvt_pk_bf16(r1[2], r1[3]);
                *(u32x4*)(X1 + (size_t)(row0 + ai * 128 + m * 16) * X1P + col0 + bj * 128) = w; }
#pragma unroll
            for (int bj = 0; bj < 2; ++bj)
#pragma unroll
                for (int n = 0; n < 2; ++n) cur[bj][n] = nxt[bj][n];
            asm volatile("" ::: "memory"); }
    }
};

__device__ __forceinline__ void pair_sync(unsigned* cnt, unsigned target, unsigned* tmo) {
    asm volatile("s_waitcnt vmcnt(0)" ::: "memory");
    __syncthreads();
    if (threadIdx.x == 0) {
        (void)__hip_atomic_fetch_add(cnt, 1u, __ATOMIC_RELAXED, __HIP_MEMORY_SCOPE_AGENT);
        unsigned sp = 0;
        while (__hip_atomic_load(cnt, __ATOMIC_RELAXED, __HIP_MEMORY_SCOPE_AGENT) < target) { __builtin_amdgcn_s_sleep(1);
            if ((++sp & 255u) == 0u) { if (__hip_atomic_load(tmo, __ATOMIC_RELAXED, __HIP_MEMORY_SCOPE_AGENT)) break; if (sp > (1u << 20)) { atomicAdd(tmo, 1u); break; } } }
        __builtin_amdgcn_fence(__ATOMIC_ACQUIRE, "agent");
        asm volatile("s_waitcnt vmcnt(0)" ::: "memory");
    }
    __syncthreads();
}
struct PanelX1Sched {
    const char* A; const char* B; int pm, pn0, nu;
    __device__ __forceinline__ bool next(int i, ge::Unit& u) const { if (i >= nu) return false; u.pm = pm; u.pn = pn0 + i; u.e = 0; return true; }
    __device__ __forceinline__ const char* a_base(const ge::Unit& u) const { return A + (size_t)u.pm * 256 * ZC * 2; }
    __device__ __forceinline__ const char* b_base(const ge::Unit& u) const { return B + (size_t)u.pn * 256 * 1024 * 2; }
    __device__ __forceinline__ int a_row(const ge::Unit&, int) const { return 0; }
};

__device__ __forceinline__ unsigned pack_fp8x4(float a, float b, float c, float d) {
    a = __builtin_amdgcn_fmed3f(a, -448.f, 448.f); b = __builtin_amdgcn_fmed3f(b, -448.f, 448.f); c = __builtin_amdgcn_fmed3f(c, -448.f, 448.f); d = __builtin_amdgcn_fmed3f(d, -448.f, 448.f);
    int w = 0; w = __builtin_amdgcn_cvt_pk_fp8_f32(a, b, w, false); w = __builtin_amdgcn_cvt_pk_fp8_f32(c, d, w, true); return (unsigned)w;
}

__device__ __forceinline__ bf16_t* hid_rows(unsigned char* ws, unsigned char* out, int rb) {
    (void)out; return (bf16_t*)(ws + OFF_HID1 + (size_t)rb * 256 * EH);
}
__device__ __forceinline__ int xcd_perm(int c, int G) { return (G & 7) ? c : (c & 7) * (G >> 3) + (c >> 3); }
struct MoeSched1 {
    const int* blk_e; const int* nblk; const int* row_tok; const char* h2; const char* bt1; int G, c;
    __device__ __forceinline__ bool next(int i, ge::Unit& u) const { const int rb = (i >> 1) * G + xcd_perm(c, G); if (rb >= *nblk) return false; u.pm = rb; u.pn = i & 1; u.e = blk_e[rb]; return true; }
    __device__ __forceinline__ const char* a_base(const ge::Unit&) const { return h2; }
    __device__ __forceinline__ const char* b_base(const ge::Unit& u) const { return bt1 + ((size_t)u.e * 512 + (size_t)u.pn * 256) * 1024 * 2; }
    __device__ __forceinline__ int a_row(const ge::Unit& u, int r) const { return row_tok[u.pm * 256 + r]; }
};

constexpr int MP_BASE = 131072, MP_TOT = MP_BASE, MP_PS = MP_BASE + 256, MP_PART = MP_BASE + 1024, MP_MINE = MP_BASE + 3072, MP_PREF = MP_BASE + 4096, MP_RT = MP_BASE + 9216;
constexpr int MP_MAXRB = 5;
__device__ __forceinline__ void moe_pull_prep(const Params& p, LAS unsigned char* lds) {
    int tid = threadIdx.x; asm volatile("" : "+v"(tid));
    const int nb = (int)gridDim.x, bid = (int)blockIdx.x, lane = tid & 63, wid = tid >> 6;
    const int* bc = (const int*)(p.ws + OFF_BCNT); const int* lst = (const int*)(p.ws + OFF_LIST);
    int* cnt = (int*)(p.ws + OFF_CNT); int* pstart = cnt + 128; int* nblk_g = cnt + 256; int* blk_e = (int*)(p.ws + OFF_BLKE); int* row_dst = (int*)(p.ws + OFF_ROWDST);
    LAS int* tot = (LAS int*)(lds + MP_TOT); LAS int* ps = (LAS int*)(lds + MP_PS); LAS int* part = (LAS int*)(lds + MP_PART); LAS int* mine = (LAS int*)(lds + MP_MINE);
    LAS int* pref = (LAS int*)(lds + MP_PREF); LAS int* rt = (LAS int*)(lds + MP_RT);
    { const int e = tid & 63, pg = tid >> 6, per = (nb + 7) / 8; int t = 0;
#pragma unroll 8
      for (int wg = pg * per; wg < (pg + 1) * per; ++wg) if (wg < nb) t += bc[wg * 64 + e];
      part[pg * 64 + e] = t; }
    __syncthreads();
    if (tid < 64) { int t = 0;
#pragma unroll
        for (int pg = 0; pg < 8; ++pg) t += part[pg * 64 + tid];
        tot[tid] = t; }
    __syncthreads();
    if (tid == 0) { int a = 0; for (int e = 0; e < 64; ++e) { ps[e] = a; a += (tot[e] + 255) / 256 * 256; } ps[64] = a; ps[65] = a + NTOK;
        const int nblk = ps[65] / 256; int n = 0;
        for (int i = 0; i < MP_MAXRB; ++i) { const int rb = i * nb + xcd_perm(bid, nb); if (rb < nblk) { int e = 0; while (e < 64 && rb * 256 >= ps[e + 1]) ++e; mine[1 + 3 * n] = rb; mine[2 + 3 * n] = e; mine[3 + 3 * n] = rb * 256 - ps[e]; ++n; } }
        mine[0] = n; }
    __syncthreads();
    const int nmine = mine[0];
    for (int j = 0; j < (MP_MAXRB + 1) / 2; ++j) { const int sl = 2 * j + (wid >> 2), b = (wid & 3) * 64 + lane; const bool act = sl < nmine && mine[2 + 3 * sl] < 64;
        int v = (act && b < nb) ? bc[b * 64 + mine[2 + 3 * (act ? sl : 0)]] : 0; const int own = v;
#pragma unroll
        for (int o = 1; o < 64; o <<= 1) { const int u = __shfl_up(v, o); if (lane >= o) v += u; }
        if (lane == 63) part[wid] = v;
        __syncthreads();
        int base = 0;
#pragma unroll
        for (int q = 0; q < 4; ++q) if (q < (wid & 3)) base += part[(wid & ~3) + q];
        if (act) pref[sl * 256 + b] = base + v - own;
        __syncthreads(); }
    for (int j = 0; j < (MP_MAXRB + 1) / 2; ++j) { const int sl = 2 * j + (tid >> 8), r = tid & 255;
        if (sl < nmine) { const int rb = mine[1 + 3 * sl], e = mine[2 + 3 * sl], jrow = mine[3 + 3 * sl] + r; int tokv, dst;
            if (e >= 64) { tokv = jrow; dst = -1; }
            else if (jrow >= tot[e]) { tokv = NTOK; dst = -1; }
            else { int lo = 0, hi = (nb < 256 ? nb : 256) - 1;
                while (lo < hi) { const int mid = (lo + hi + 1) >> 1; if (pref[sl * 256 + mid] <= jrow) lo = mid; else hi = mid - 1; }
                dst = lst[((size_t)lo * 64 + e) * 128 + (jrow - pref[sl * 256 + lo])]; tokv = dst >> 3; }
            rt[sl * 256 + r] = tokv; if (e < 64) row_dst[rb * 256 + r] = dst; } }
    if (bid == 0) {
        if (tid < 66) pstart[tid] = ps[tid];
        if (tid == 0) *nblk_g = ps[65] / 256;
        for (int rb = tid; rb < ps[65] / 256; rb += 512) { int e = 0; while (e < 64 && rb * 256 >= ps[e + 1]) ++e; blk_e[rb] = e; }
    }
    __syncthreads();
}
struct MoeSched1P {
    LAS unsigned char* lds; const char* h2; const char* bt1;
    __device__ __forceinline__ bool next(int i, ge::Unit& u) const { const LAS int* mine = (const LAS int*)(lds + MP_MINE); const int k = i >> 1; if (k >= mine[0]) return false; u.k = k; u.pm = mine[1 + 3 * k]; u.e = mine[2 + 3 * k]; u.pn = i & 1; return true; }
    __device__ __forceinline__ const char* a_base(const ge::Unit&) const { return h2; }
    __device__ __forceinline__ const char* b_base(const ge::Unit& u) const { return bt1 + ((size_t)u.e * 512 + (size_t)u.pn * 256) * 1024; }
    __device__ __forceinline__ int a_row(const ge::Unit& u, int r) const { return ((const LAS int*)(lds + MP_RT))[u.k * 256 + r]; }
};
struct EpiHid {
    static constexpr bool PERM = true;
    unsigned char* ws; unsigned char* out;
    struct Pre {}; __device__ __forceinline__ Pre pre(const ge::Unit&, int, int, int, int) const { return Pre{}; }
    __device__ __forceinline__ void operator()(const f32x4 (&acc)[2][2][4][2], const ge::Unit& u, int wr, int wc, int fr, int fq, const Pre&) const {
        unsigned char* base = (unsigned char*)hid_rows(ws, out, u.pm) + (size_t)(wr * 64 + fr) * EH + u.pn * 128 + wc * 32 + 8 * fq;
#pragma unroll
        for (int ai = 0; ai < 2; ++ai)
#pragma unroll
            for (int m = 0; m < 4; ++m) { const f32x4 a0 = acc[ai][0][m][0], a1 = acc[ai][0][m][1], b0 = acc[ai][1][m][0], b1 = acc[ai][1][m][1];
                const f32x4 z0 = a0 * (-1.4426950408889634f), z1 = a1 * (-1.4426950408889634f);
                f32x4 d0, d1;
#pragma unroll
                for (int q = 0; q < 4; ++q) { d0[q] = frcp_(1.0f + __builtin_amdgcn_exp2f(z0[q])); d1[q] = frcp_(1.0f + __builtin_amdgcn_exp2f(z1[q])); }
                const f32x4 h0 = a0 * b0 * d0, h1 = a1 * b1 * d1;
                u32x2 w; w.x = pack_fp8x4(h0[0], h0[1], h0[2], h0[3]); w.y = pack_fp8x4(h1[0], h1[1], h1[2], h1[3]);
                *(u32x2*)(base + (size_t)(ai * 128 + m * 16) * EH) = w; }
    }
};
struct MoeSched2 {
    const int* blk_e; const int* nblk; unsigned char* ws; unsigned char* out; const char* bt2; int G, c;
    __device__ __forceinline__ bool next(int i, ge::Unit& u) const { const int rb = (i >> 2) * G + xcd_perm(c, G); if (rb >= *nblk) return false; u.pm = rb; u.pn = i & 3; u.e = blk_e[rb]; return true; }
    __device__ __forceinline__ const char* a_base(const ge::Unit& u) const { return (const char*)hid_rows(ws, out, u.pm); }
    __device__ __forceinline__ const char* b_base(const ge::Unit& u) const { return bt2 + ((size_t)u.e * 1024 + (size_t)u.pn * 256) * EH; }
    __device__ __forceinline__ int a_row(const ge::Unit&, int r) const { return r; }
};
struct EpiY2 {
    static constexpr bool PERM = true;
    unsigned char* Y2; unsigned char* Y2s; const int* pstart; const int* row_dst;
    struct Pre { int rd[2][2]; };
    __device__ __forceinline__ Pre pre(const ge::Unit& u, int wr, int wc, int fr, int fq) const { Pre q; const int rl = u.pm * 256 + wr * 64 + fr + (fq & 1) * 16; (void)wc;
#pragma unroll
        for (int ai = 0; ai < 2; ++ai)
#pragma unroll
            for (int mp = 0; mp < 2; ++mp) q.rd[ai][mp] = (u.e < NEXP) ? row_dst[rl + ai * 128 + mp * 32] : 0;
        return q; }
    __device__ __forceinline__ void operator()(const f32x4 (&acc)[2][2][4][2], const ge::Unit& u, int wr, int wc, int fr, int fq, const Pre& pq) const {
        const int r0 = u.pm * 256 + wr * 64 + fr, colg = u.pn * 256 + wc * 32 + 8 * fq;
        if (u.e < NEXP) {
            const int cl2 = colg - (fq & 1) * 8;
            int rd[2][2];
#pragma unroll
            for (int ai = 0; ai < 2; ++ai)
#pragma unroll
                for (int mp = 0; mp < 2; ++mp) rd[ai][mp] = pq.rd[ai][mp];
#pragma unroll
            for (int ai = 0; ai < 2; ++ai)
#pragma unroll
                for (int mp = 0; mp < 2; ++mp)
#pragma unroll
                    for (int bj = 0; bj < 2; ++bj) { const f32x4 v0 = acc[ai][bj][2 * mp][0], v1 = acc[ai][bj][2 * mp][1], v2 = acc[ai][bj][2 * mp + 1][0], v3 = acc[ai][bj][2 * mp + 1][1];
                        unsigned ax = pack_fp8x4(v0[0], v0[1], v0[2], v0[3]), ay = pack_fp8x4(v1[0], v1[1], v1[2], v1[3]), bx = pack_fp8x4(v2[0], v2[1], v2[2], v2[3]), by = pack_fp8x4(v3[0], v3[1], v3[2], v3[3]);
                        { auto r = __builtin_amdgcn_permlane16_swap(ax, bx, false, false); ax = r[0]; bx = r[1]; }
                        { auto r = __builtin_amdgcn_permlane16_swap(ay, by, false, false); ay = r[0]; by = r[1]; }
                        u32x4 w; w.x = ax; w.y = ay; w.z = bx; w.w = by;
                        if (rd[ai][mp] >= 0) *(u32x4*)(Y2 + (size_t)rd[ai][mp] * 1024 + cl2 + bj * 128) = w; }
        } else {
            const int t0 = r0 - pstart[NEXP] + (fq & 1) * 16, cl2 = colg - (fq & 1) * 8;
#pragma unroll
            for (int ai = 0; ai < 2; ++ai)
#pragma unroll
                for (int mp = 0; mp < 2; ++mp)
#pragma unroll
                    for (int bj = 0; bj < 2; ++bj) { const f32x4 v0 = acc[ai][bj][2 * mp][0], v1 = acc[ai][bj][2 * mp][1], v2 = acc[ai][bj][2 * mp + 1][0], v3 = acc[ai][bj][2 * mp + 1][1];
                        unsigned ax = pack_fp8x4(v0[0], v0[1], v0[2], v0[3]), ay = pack_fp8x4(v1[0], v1[1], v1[2], v1[3]), bx = pack_fp8x4(v2[0], v2[1], v2[2], v2[3]), by = pack_fp8x4(v3[0], v3[1], v3[2], v3[3]);
                        { auto r = __builtin_amdgcn_permlane16_swap(ax, bx, false, false); ax = r[0]; bx = r[1]; }
                        { auto r = __builtin_amdgcn_permlane16_swap(ay, by, false, false); ay = r[0]; by = r[1]; }
                        u32x4 w; w.x = ax; w.y = ay; w.z = bx; w.w = by;
                        *(u32x4*)(Y2s + (size_t)(t0 + ai * 128 + mp * 32) * 1024 + cl2 + bj * 128) = w; }
        }
    }
};

struct EpiNull { static constexpr bool PERM = true; float* sink;
    __device__ __forceinline__ void operator()(const f32x4 (&acc)[2][2][4][2], const ge::Unit& u, int wr, int wc, int fr, int fq) const {
        float s = 0.f;
#pragma unroll
        for (int ai = 0; ai < 2; ++ai)
#pragma unroll
            for (int bj = 0; bj < 2; ++bj)
#pragma unroll
                for (int m = 0; m < 4; ++m)
#pragma unroll
                    for (int n = 0; n < 2; ++n) s += acc[ai][bj][m][n][0] + acc[ai][bj][m][n][1] + acc[ai][bj][m][n][2] + acc[ai][bj][m][n][3];
        if (s == 12345.678f) sink[0] = s; } };
struct MoeSched2R {
    const int* blk_e; const int* pstart; unsigned char* ws; unsigned char* out; const char* bt2; int G, c;
    __device__ __forceinline__ bool next(int i, ge::Unit& u) const { const int rb = (i >> 2) * G + c; if (rb >= pstart[NEXP] / 256) return false; u.pm = rb; u.pn = i & 3; u.e = blk_e[rb]; return true; }
    __device__ __forceinline__ const char* a_base(const ge::Unit& u) const { return (const char*)hid_rows(ws, out, u.pm); }
    __device__ __forceinline__ const char* b_base(const ge::Unit& u) const { return bt2 + ((size_t)u.e * 1024 + (size_t)u.pn * 256) * EH * 2; }
    __device__ __forceinline__ int a_row(const ge::Unit&, int) const { return 0; }
};
constexpr size_t DO_LP = 120 * MiB, DO_BBAR = DO_LP + 1088 * 1024, DO_KTAB = DO_BBAR + 256 * 1024, DO_UC = 124 * MiB;
constexpr size_t OFF_MG = 26 * MiB, OFF_AEXT = 34 * MiB, OFF_XEND = 54 * MiB, OFF_WEXT = 62 * MiB, OFF_YS5 = 102 * MiB;
constexpr int AEK = 1280;

__device__ __forceinline__ void s5_tab1_phase(const Params& p) {
    f32x2* Lp = (f32x2*)(p.out + DO_LP); f32x2* Bb = (f32x2*)(p.out + DO_BBAR);
    const int gt = blockIdx.x * blockDim.x + threadIdx.x, gs = gridDim.x * blockDim.x;
    for (int i = gt; i < 2048 * 65; i += gs) { const int pi = i / 65, j = i % 65, dg = pi >> 6;
        const double lre = fmin((double)p.lam_re[pi], -1e-4), lim = (double)p.lam_im[pi], dt = exp((double)p.log_dt[dg]);
        const double er = exp(lre * dt * (double)j), th = lim * dt * (double)j;
        Lp[i] = (f32x2){(float)(er * cos(th)), (float)(er * sin(th))}; }
    for (int i = gt; i < 2048 * 16; i += gs) { const int pi = i >> 4, dg = pi >> 6;
        const double lre = fmin((double)p.lam_re[pi], -1e-4), lim = (double)p.lam_im[pi], dt = exp((double)p.log_dt[dg]);
        const double er = exp(lre * dt), th = lim * dt, nr = er * cos(th) - 1.0, ni = er * sin(th), den = lre * lre + lim * lim;
        const double cfr = (nr * lre + ni * lim) / den, cfi = (ni * lre - nr * lim) / den;
        const double br = p.b_re[i], bi = p.b_im[i];
        Bb[i] = (f32x2){(float)(cfr * br - cfi * bi), (float)(cfr * bi + cfi * br)}; }
}
__device__ __forceinline__ void s5_tab2_phase(const Params& p, int vb, int nvb) {
    const f32x2* Lp = (const f32x2*)(p.out + DO_LP); const f32x2* Bb = (const f32x2*)(p.out + DO_BBAR); float* Kt = (float*)(p.out + DO_KTAB); bf16_t* Mg = (bf16_t*)(p.ws + OFF_MG);
    const int gt = vb * 512 + threadIdx.x, gs = nvb * 512;
    for (int i = gt; i < 2 * 16 * 64 * 256; i += gs) { const int cp = i & 15, c = (i >> 4) & 15, j = (i >> 8) & 63, dg = i >> 14, g = dg & 15;
        float s = 0.f;
#pragma unroll 16
        for (int pp = 0; pp < 64; ++pp) { const f32x2 l = Lp[(dg * 64 + pp) * 65 + j], b = Bb[(dg * 64 + pp) * 16 + cp];
            const float xr = l.x * b.x - l.y * b.y, xi = l.x * b.y + l.y * b.x;
            s += p.c_re[(g * 16 + c) * 64 + pp] * xr - p.c_im[(g * 16 + c) * 64 + pp] * xi; }
        Kt[i] = s; }
    for (int i = gt; i < 16 * 256 * 128; i += gs) { const int k8 = i & 127, n = (i >> 7) & 255, g = i >> 15;
        const int dir = n >> 7, part = (n >> 6) & 1, pp = n & 63, s = k8 >> 1, c0 = (k8 & 1) * 8, dg = dir * 16 + g;
        const f32x2 l = Lp[(dg * 64 + pp) * 65 + (dir ? s : 63 - s)];
        float v[8];
#pragma unroll
        for (int q = 0; q < 8; ++q) { const f32x2 b = Bb[(dg * 64 + pp) * 16 + c0 + q]; v[q] = part ? (l.x * b.y + l.y * b.x) : (l.x * b.x - l.y * b.y); }
        u32x4 w; w.x = cvt_pk_bf16(v[0], v[1]); w.y = cvt_pk_bf16(v[2], v[3]); w.z = cvt_pk_bf16(v[4], v[5]); w.w = cvt_pk_bf16(v[6], v[7]);
        *(u32x4*)(Mg + ((size_t)(g * 256 + n)) * 1024 + k8 * 8) = w; }
}
__device__ __forceinline__ void s5_wfill_phase(const Params& p, int vb, int nvb) {
    const f32x2* Lp = (const f32x2*)(p.out + DO_LP); const float* Kt = (const float*)(p.out + DO_KTAB); bf16_t* W = (bf16_t*)(p.ws + OFF_WEXT);
    for (int i = vb * 512 + threadIdx.x; i < 16 * 1024 * 160; i += nvb * 512) { const int k8 = i % 160, n = (i / 160) & 1023, g = i / (160 * 1024), t = n >> 4, c = n & 15;
        float v[8];
        if (k8 < 128) { const int s = k8 >> 1, c0 = (k8 & 1) * 8;
            if (s < t) { const float* kp = Kt + ((((0 * 16 + g) * 64 + (t - s)) * 16 + c) * 16 + c0);
#pragma unroll
                for (int q = 0; q < 8; ++q) v[q] = kp[q]; }
            else if (s > t) { const float* kp = Kt + ((((1 * 16 + g) * 64 + (s - t)) * 16 + c) * 16 + c0);
#pragma unroll
                for (int q = 0; q < 8; ++q) v[q] = kp[q]; }
            else { const float* kf = Kt + ((((0 * 16 + g) * 64) * 16 + c) * 16 + c0); const float* kb = Kt + ((((1 * 16 + g) * 64) * 16 + c) * 16 + c0);
#pragma unroll
                for (int q = 0; q < 8; ++q) v[q] = kf[q] + kb[q] + ((c0 + q == c) ? p.s5_d[g * 16 + c] : 0.f); }
        } else { const int kk = (k8 - 128) * 8, dir = kk >> 7, part = (kk >> 6) & 1, p0 = kk & 63, dg = dir * 16 + g, e = dir ? (64 - t) : (t + 1);
#pragma unroll
            for (int q = 0; q < 8; ++q) { const f32x2 l = Lp[(dg * 64 + p0 + q) * 65 + e]; const float cr = p.c_re[(g * 16 + c) * 64 + p0 + q], ci = p.c_im[(g * 16 + c) * 64 + p0 + q];
                v[q] = part ? -(cr * l.y + ci * l.x) : (cr * l.x - ci * l.y); } }
        u32x4 w; w.x = cvt_pk_bf16(v[0], v[1]); w.y = cvt_pk_bf16(v[2], v[3]); w.z = cvt_pk_bf16(v[4], v[5]); w.w = cvt_pk_bf16(v[6], v[7]);
        *(u32x4*)(W + ((size_t)(g * 1024 + n)) * AEK + k8 * 8) = w; }
}

struct S5aSched {
    const char* A; const char* B; int G, c;
    __device__ __forceinline__ bool next(int i, ge::Unit& u) const { const int L = i * G + c; if (L >= 32) return false; u.e = L >> 1; u.pm = L & 1; u.pn = 0; return true; }
    __device__ __forceinline__ const char* a_base(const ge::Unit& u) const { return A + (size_t)(u.e * 512 + u.pm * 256) * AEK * 2; }
    __device__ __forceinline__ const char* b_base(const ge::Unit& u) const { return B + (size_t)u.e * 256 * 1024 * 2; }
    __device__ __forceinline__ int a_row(const ge::Unit&, int) const { return 0; }
};
struct EpiXend {
    static constexpr bool PERM = false;
    float* X;
    __device__ __forceinline__ void operator()(const f32x4 (&acc)[2][2][4][2], const ge::Unit& u, int wr, int wc, int fr, int fq) const {
        float* base = X + (size_t)(u.e * 512 + u.pm * 256 + wr * 64 + fr) * 256 + wc * 32 + 4 * fq;
#pragma unroll
        for (int ai = 0; ai < 2; ++ai)
#pragma unroll
            for (int m = 0; m < 4; ++m)
#pragma unroll
                for (int bj = 0; bj < 2; ++bj)
#pragma unroll
                    for (int n = 0; n < 2; ++n) *(f32x4*)(base + (size_t)(ai * 128 + m * 16) * 256 + bj * 128 + n * 16) = acc[ai][bj][m][n];
    }
};
__device__ __forceinline__ void s5a_phase(const Params& p, LAS unsigned char* lds, int vb, int nvb) {
    S5aSched S{(const char*)(p.ws + OFF_AEXT), (const char*)(p.ws + OFF_MG), nvb, vb};
    EpiXend E{(float*)(p.ws + OFF_XEND)};
    ge::gemm_phase<EpiXend, S5aSched, false>(lds, 1024, AEK, 1024, S, E);
    for (int L = vb; L < 32; L += nvb) {
        const int g = L >> 1, pm = L & 1; int tid = threadIdx.x; asm volatile("" : "+v"(tid));
        const f32x2* Lp = (const f32x2*)(p.out + DO_LP); const f32x2* Bb = (const f32x2*)(p.out + DO_BBAR); const bf16_t* uc = (const bf16_t*)(p.out + DO_UC);
        LAS float* us = (LAS float*)lds; LAS f32x2* xh = (LAS f32x2*)(lds + 32768);
        for (int i = tid; i < 2 * CTXL * 2; i += 512) { const int half = i & 1, row = i >> 1;
            const u32x4 u0 = *(const u32x4*)(uc + (size_t)((pm * 2 + (row >> 8)) * CTXL + (row & 255)) * 256 + g * 16 + half * 8);
            LAS float* d = us + row * 16 + half * 8;
            d[0] = bf_lo(u0.x); d[1] = bf_hi(u0.x); d[2] = bf_lo(u0.y); d[3] = bf_hi(u0.y); d[4] = bf_lo(u0.z); d[5] = bf_hi(u0.z); d[6] = bf_lo(u0.w); d[7] = bf_hi(u0.w); }
        __syncthreads();
        const int hq = tid >> 8, t2 = tid & 255, bb = t2 >> 7, dir = (t2 >> 6) & 1, pp = t2 & 63, b = pm * 2 + bb, dg = dir * 16 + g;
        const f32x2 l1 = Lp[(dg * 64 + pp) * 65 + 1], l64 = Lp[(dg * 64 + pp) * 65 + 64];
        float xr = 0.f, xi = 0.f;
        { float Br[16], Bi[16];
#pragma unroll
          for (int q = 0; q < 16; ++q) { const f32x2 tq = Bb[(dg * 64 + pp) * 16 + q]; Br[q] = tq.x; Bi[q] = tq.y; }
#pragma unroll 4
          for (int s = hq * 128; s < hq * 128 + 128; ++s) { const int lc = dir ? (CTXL - 1 - s) : s;
              const LAS float* up = us + (bb * CTXL + lc) * 16;
              const f32x4 ua = *(const LAS f32x4*)up, ub = *(const LAS f32x4*)(up + 4), uc4 = *(const LAS f32x4*)(up + 8), ud = *(const LAS f32x4*)(up + 12);
              float bur = 0.f, bui = 0.f;
#pragma unroll
              for (int q = 0; q < 4; ++q) { bur += Br[q] * ua[q] + Br[4 + q] * ub[q] + Br[8 + q] * uc4[q] + Br[12 + q] * ud[q]; bui += Bi[q] * ua[q] + Bi[4 + q] * ub[q] + Bi[8 + q] * uc4[q] + Bi[12 + q] * ud[q]; }
              const float nr = l1.x * xr - l1.y * xi + bur, ni = l1.x * xi + l1.y * xr + bui; xr = nr; xi = ni; } }
        if (hq == 1) xh[t2] = (f32x2){xr, xi};
        __syncthreads();
        if (hq == 0) {
            const float l128r = l64.x * l64.x - l64.y * l64.y, l128i = 2.0f * l64.x * l64.y; const f32x2 x2 = xh[t2];
            { const float nr = l128r * xr - l128i * xi + x2.x, ni = l128r * xi + l128i * xr + x2.y; xr = nr; xi = ni; }
            const float* Xe = (const float*)(p.ws + OFF_XEND); bf16_t* Ae = (bf16_t*)(p.ws + OFF_AEXT);
#pragma unroll 8
            for (int s = 0; s < 128; ++s) { const int m = dir ? (127 - s) : s; const size_t row = (size_t)(g * 512 + b * 128 + m);
                Ae[row * AEK + 1024 + dir * 128 + pp] = f2bf(xr); Ae[row * AEK + 1024 + dir * 128 + 64 + pp] = f2bf(xi);
                const float er = Xe[row * 256 + dir * 128 + pp], ei = Xe[row * 256 + dir * 128 + 64 + pp];
                const float nr = l64.x * xr - l64.y * xi + er, ni = l64.x * xi + l64.y * xr + ei; xr = nr; xi = ni; }
        }
        __syncthreads();
    }
}

struct S5bSched {
    const char* A; const char* B; int G, c;
    __device__ __forceinline__ bool next(int i, ge::Unit& u) const { const int L = i * G + c; if (L >= 128) return false; u.e = L >> 3; u.pm = (L >> 2) & 1; u.pn = L & 3; return true; }
    __device__ __forceinline__ const char* a_base(const ge::Unit& u) const { return A + (size_t)(u.e * 512 + u.pm * 256) * AEK * 2; }
    __device__ __forceinline__ const char* b_base(const ge::Unit& u) const { return B + (size_t)(u.e * 1024 + u.pn * 256) * AEK * 2; }
    __device__ __forceinline__ int a_row(const ge::Unit&, int) const { return 0; }
};
struct EpiYs5 {
    static constexpr bool PERM = true;
    bf16_t* Y;
    __device__ __forceinline__ void operator()(const f32x4 (&acc)[2][2][4][2], const ge::Unit& u, int wr, int wc, int fr, int fq) const {
        bf16_t* rp = Y + ((size_t)(u.pm * 256 + wr * 64 + fr) * 64 + u.pn * 16 + wc * 2 + (fq >> 1)) * 256 + u.e * 16 + 8 * (fq & 1);
#pragma unroll
        for (int ai = 0; ai < 2; ++ai)
#pragma unroll
            for (int m = 0; m < 4; ++m) {
#pragma unroll
                for (int bj = 0; bj < 2; ++bj) { f32x4 v0 = acc[ai][bj][m][0], v1 = acc[ai][bj][m][1];
                    asm volatile("" : "+v"(v0), "+v"(v1));
                    u32x4 w; w.x = cvt_pk_bf16(gelu_tanh(v0[0]), gelu_tanh(v0[1])); w.y = cvt_pk_bf16(gelu_tanh(v0[2]), gelu_tanh(v0[3]));
                    w.z = cvt_pk_bf16(gelu_tanh(v1[0]), gelu_tanh(v1[1])); w.w = cvt_pk_bf16(gelu_tanh(v1[2]), gelu_tanh(v1[3]));
                    *(u32x4*)(rp + bj * 8 * 256) = w; asm volatile("" ::: "memory"); }
                rp += (m == 3) ? (size_t)(128 - 48) * 64 * 256 : (size_t)16 * 64 * 256;
                asm volatile("" : "+v"(rp)); }
    }
};
__device__ __forceinline__ void s5b_phase(const Params& p, LAS unsigned char* lds, int vb, int nvb) {
    S5bSched S{(const char*)(p.ws + OFF_AEXT), (const char*)(p.ws + OFF_WEXT), nvb, vb};
    EpiYs5 E{(bf16_t*)(p.ws + OFF_YS5)};
    ge::gemm_phase<EpiYs5, S5bSched, false>(lds, AEK, AEK, AEK, S, E);
}
constexpr size_t DO_KV = 96 * MiB, DO_DEC = 125 * MiB;
constexpr int GLA_SLOTS = 16;
constexpr int GL_QI = 0, GL_KI = 17408, GL_KIT = 34816, GL_VT = 53248, GL_P = 71680, GL_TOT = 80896, GL_EREF = 89088, GL_ETOT = 89600;
constexpr int GLA_NSEG = 8, GLA_SEGC = 16;

template <bool PASS1, int VAR = 0>
__device__ __forceinline__ void gla_unit(const Params& p, LAS unsigned char* lds, const int chain, const int ch0, const int nch, const int nfold) {
    int tid = threadIdx.x; asm volatile("" : "+v"(tid));
    const int w = __builtin_amdgcn_readfirstlane(tid >> 6), lane = tid & 63, vloc = lane & 15, rq = lane >> 4;
    const int dir = chain & 1, h = (chain >> 1) % 6, b = chain / 12;
    const bf16_t* Z = (const bf16_t*)(p.ws + OFF_Z);
    bf16_t* O = (bf16_t*)(p.out + (dir ? DO_OB : DO_OF));
    float* KV = (float*)(p.out + DO_KV); float* DEC = (float*)(p.out + DO_DEC);
    const bool isctx = false; const int slot = 0; (void)slot;
    static_assert(!PASS1, "pass 1 uses gla_pass1_unit");
    const float l0a = p.lb_logits[h * 128 + 2 * lane], l1a = p.lb_logits[768 + h * 128 + 2 * lane], l0b = p.lb_logits[h * 128 + 2 * lane + 1], l1b = p.lb_logits[768 + h * 128 + 2 * lane + 1];
    const float lb0 = frcp_(1.0f + __expf(l1a - l0a)), lb1 = frcp_(1.0f + __expf(l1b - l0b));
    const int colf = (dir ? ZFB : ZFF) + h * 128 + 2 * lane, colq = ZQ + h * 128 + 2 * lane, colv = ZI + h * 128 + 2 * lane;
    auto chunk_rows = [&](int ci, int& base, int& stride) {
        if (isctx) { if (dir == 0) { base = NTOK + b * CTXL + 64 * ci; stride = 1; } else { base = NTOK + b * CTXL + 255 - 64 * ci; stride = -1; } }
        else { const int n = ch0 + ci;
            if (dir == 0) { base = b * SEQ + 4096 * (n & 1) + (n >> 1); stride = 64; }
            else { const int n2 = 127 - n; base = b * SEQ + 4096 * (n2 & 1) + (n2 >> 1) + 64 * 63; stride = -64; } }
    };
    f32x4 S[8];
    if (PASS1) {
#pragma unroll
        for (int it = 0; it < 8; ++it) S[it] = (f32x4){0.f, 0.f, 0.f, 0.f};
    } else {
#pragma unroll
        for (int it = 0; it < 8; ++it) S[it] = (f32x4){0.f, 0.f, 0.f, 0.f};
        for (int sl = 0; sl < nfold; ++sl) {
            const unsigned* kv = (const unsigned*)KV + ((size_t)(chain * GLA_SLOTS + sl) * 8 + w) * 16 * 64 + lane; const float* dc = DEC + (size_t)(chain * GLA_SLOTS + sl) * 128;
#pragma unroll
            for (int it = 0; it < 8; ++it) { const f32x4 d = *(const f32x4*)(dc + 16 * it + 4 * rq); const unsigned w0 = kv[(it * 2) * 64], w1 = kv[(it * 2 + 1) * 64];
                S[it][0] = d[0] * S[it][0] + bf_lo(w0); S[it][1] = d[1] * S[it][1] + bf_hi(w0); S[it][2] = d[2] * S[it][2] + bf_lo(w1); S[it][3] = d[3] * S[it][3] + bf_hi(w1); }
        }
    }
    float dsum0 = 1.f, dsum1 = 1.f;
    unsigned nz[8], nv[8], nq[8];
    { int base, stride; chunk_rows(0, base, stride);
#pragma unroll
      for (int r = 0; r < 8; ++r) { const size_t ro = (size_t)(base + stride * (8 * w + r)) * ZC; nz[r] = *(const unsigned*)(Z + ro + colf); nv[r] = *(const unsigned*)(Z + ro + colv); if (!PASS1) nq[r] = *(const unsigned*)(Z + ro + colq); } }
    for (int ci = 0; ci < nch; ++ci) {
        unsigned cz[8], cv[8], cq[8];
#pragma unroll
        for (int r = 0; r < 8; ++r) { cz[r] = nz[r]; cv[r] = nv[r]; if (!PASS1) cq[r] = nq[r]; }
        int base, stride; chunk_rows(ci, base, stride);
        if (ci + 1 < nch) { int nb_, ns_; chunk_rows(ci + 1, nb_, ns_);
#pragma unroll
            for (int r = 0; r < 8; ++r) { const size_t ro = (size_t)(nb_ + ns_ * (8 * w + r)) * ZC; nz[r] = *(const unsigned*)(Z + ro + colf); nv[r] = *(const unsigned*)(Z + ro + colv); if (!PASS1) nq[r] = *(const unsigned*)(Z + ro + colq); } }
        f32x2 cp[8], kk[8]; f32x2 run = (f32x2){1.0f, 1.0f};
        const f32x2 lbv = (f32x2){lb0, lb1}, one = (f32x2){1.0f, 1.0f}, omlb = one - lbv;
#pragma unroll
        for (int r = 0; r < 8; ++r) { const f32x2 z = (f32x2){bf_lo(cz[r]), bf_hi(cz[r])}; const f32x2 zz = z * (-1.4426950408889634f);
            f32x2 E; E.x = __builtin_amdgcn_exp2f(zz.x); E.y = __builtin_amdgcn_exp2f(zz.y);
            const f32x2 d = one + E; f32x2 D; D.x = frcp_(d.x); D.y = frcp_(d.y);
            const f32x2 f = (one + lbv * E) * D;
            kk[r] = omlb * E * D;
            run = run * f; cp[r] = run; }
        *(LAS f32x2*)(lds + GL_TOT + (w * 128 + 2 * lane) * 4) = run;
        __syncthreads();
        f32x2 pre = one, refp = one, totp = one;
#pragma unroll
        for (int ww = 0; ww < 8; ++ww) { const f32x2 tv = *(const LAS f32x2*)(lds + GL_TOT + (ww * 128 + 2 * lane) * 4);
            if (ww < w) pre = pre * tv; if (ww < 4) refp = refp * tv; totp = totp * tv; }
        dsum0 *= totp.x; dsum1 *= totp.y;
        f32x2 invR; invR.x = frcp_(refp.x); invR.y = frcp_(refp.y);
        { const f32x2 s_q = pre * invR; f32x2 ki[8];
#pragma unroll
          for (int r = 0; r < 8; ++r) { const f32x2 e = s_q * cp[r]; f32x2 ie; ie.x = frcp_(e.x); ie.y = frcp_(e.y);
              ki[r] = kk[r] * ie;
              const int t = 8 * w + r;
              if (!PASS1) { const f32x2 qv = (f32x2){bf_lo(cq[r]), bf_hi(cq[r])} * e;
                            *(LAS unsigned*)(lds + GL_QI + t * 272 + lane * 4) = cvt_pk_bf16(qv.x, qv.y);
                            *(LAS unsigned*)(lds + GL_KI + t * 272 + lane * 4) = cvt_pk_bf16(ki[r].x, ki[r].y); } }
          u32x4 a, bq;
          a.x = cvt_pk_bf16(ki[0].x, ki[1].x); a.y = cvt_pk_bf16(ki[2].x, ki[3].x); a.z = cvt_pk_bf16(ki[4].x, ki[5].x); a.w = cvt_pk_bf16(ki[6].x, ki[7].x);
          bq.x = cvt_pk_bf16(ki[0].y, ki[1].y); bq.y = cvt_pk_bf16(ki[2].y, ki[3].y); bq.z = cvt_pk_bf16(ki[4].y, ki[5].y); bq.w = cvt_pk_bf16(ki[6].y, ki[7].y);
          *(LAS u32x4*)(lds + GL_KIT + (2 * lane) * 144 + 16 * w) = a; *(LAS u32x4*)(lds + GL_KIT + (2 * lane + 1) * 144 + 16 * w) = bq;
          u32x4 va, vb2;
          va.x = (cv[0] & 0xffffu) | (cv[1] << 16); va.y = (cv[2] & 0xffffu) | (cv[3] << 16); va.z = (cv[4] & 0xffffu) | (cv[5] << 16); va.w = (cv[6] & 0xffffu) | (cv[7] << 16);
          vb2.x = (cv[0] >> 16) | (cv[1] & 0xffff0000u); vb2.y = (cv[2] >> 16) | (cv[3] & 0xffff0000u); vb2.z = (cv[4] >> 16) | (cv[5] & 0xffff0000u); vb2.w = (cv[6] >> 16) | (cv[7] & 0xffff0000u);
          *(LAS u32x4*)(lds + GL_VT + (2 * lane) * 144 + 16 * w) = va; *(LAS u32x4*)(lds + GL_VT + (2 * lane + 1) * 144 + 16 * w) = vb2; }
        if (w == 0) { *(LAS f32x2*)(lds + GL_EREF + 2 * lane * 4) = refp; *(LAS f32x2*)(lds + GL_ETOT + 2 * lane * 4) = totp * invR; }
        __syncthreads();
#pragma unroll
        for (int it = 0; it < 8; ++it) { const f32x4 er = *(const LAS f32x4*)(lds + GL_EREF + (16 * it + 4 * rq) * 4); S[it] = S[it] * er; }
        f32x4 o[4];
        if (!PASS1 && VAR != 2) {
            bf16x8 Sb[4];
#pragma unroll
            for (int c = 0; c < 4; ++c) { u32x4 t; t.x = cvt_pk_bf16(S[2 * c][0], S[2 * c][1]); t.y = cvt_pk_bf16(S[2 * c][2], S[2 * c][3]); t.z = cvt_pk_bf16(S[2 * c + 1][0], S[2 * c + 1][1]); t.w = cvt_pk_bf16(S[2 * c + 1][2], S[2 * c + 1][3]); Sb[c] = __builtin_bit_cast(bf16x8, t); }
#pragma unroll
            for (int tt = 0; tt < 4; ++tt) { o[tt] = (f32x4){0.f, 0.f, 0.f, 0.f};
#pragma unroll
                for (int c = 0; c < (VAR == 4 ? 0 : 4); ++c) { const LAS unsigned char* qa = lds + GL_QI + (16 * tt + vloc) * 272 + (32 * c + 4 * rq) * 2;
                    const u32x2 lo = *(const LAS u32x2*)qa, hi = *(const LAS u32x2*)(qa + 32);
                    u32x4 t; t.x = lo.x; t.y = lo.y; t.z = hi.x; t.w = hi.y;
                    o[tt] = __builtin_amdgcn_mfma_f32_16x16x32_bf16(__builtin_bit_cast(bf16x8, t), Sb[c], o[tt], 0, 0, 0); } }
            { const int tt = w >> 1;
#pragma unroll
              for (int sh = 0; sh < (VAR == 5 ? 0 : 2); ++sh) { const int st = 2 * (w & 1) + sh; f32x4 pacc = (f32x4){0.f, 0.f, 0.f, 0.f};
#pragma unroll
                  for (int c = 0; c < 4; ++c) { const bf16x8 ka = *(const LAS bf16x8*)(lds + GL_KI + (16 * st + vloc) * 272 + (32 * c + 8 * rq) * 2);
                      const bf16x8 qb = *(const LAS bf16x8*)(lds + GL_QI + (16 * tt + vloc) * 272 + (32 * c + 8 * rq) * 2);
                      pacc = __builtin_amdgcn_mfma_f32_16x16x32_bf16(ka, qb, pacc, 0, 0, 0); }
                  const int tg = 16 * tt + vloc, sg = 16 * st + 4 * rq;
                  u32x2 pw; pw.x = cvt_pk_bf16(sg + 0 <= tg ? pacc[0] : 0.f, sg + 1 <= tg ? pacc[1] : 0.f); pw.y = cvt_pk_bf16(sg + 2 <= tg ? pacc[2] : 0.f, sg + 3 <= tg ? pacc[3] : 0.f);
                  *(LAS u32x2*)(lds + GL_P + tg * 144 + sg * 2) = pw; } }
        }
        __syncthreads();
        if (VAR != 2) { bf16x8 vb[2];
#pragma unroll
          for (int c = 0; c < 2; ++c) vb[c] = *(const LAS bf16x8*)(lds + GL_VT + (16 * w + vloc) * 144 + (32 * c + 8 * rq) * 2);
          if (!PASS1) {
#pragma unroll
              for (int tt = 0; tt < (VAR == 5 ? 0 : 4); ++tt)
#pragma unroll
                  for (int c = 0; c < 2; ++c) { const bf16x8 pa = *(const LAS bf16x8*)(lds + GL_P + (16 * tt + vloc) * 144 + (32 * c + 8 * rq) * 2); o[tt] = __builtin_amdgcn_mfma_f32_16x16x32_bf16(pa, vb[c], o[tt], 0, 0, 0); }
          }
#pragma unroll
          for (int it = 0; it < 8; ++it)
#pragma unroll
              for (int c = 0; c < 2; ++c) { const bf16x8 ka = *(const LAS bf16x8*)(lds + GL_KIT + (16 * it + vloc) * 144 + (32 * c + 8 * rq) * 2); S[it] = __builtin_amdgcn_mfma_f32_16x16x32_bf16(ka, vb[c], S[it], 0, 0, 0); }
#pragma unroll
          for (int it = 0; it < 8; ++it) { const f32x4 et = *(const LAS f32x4*)(lds + GL_ETOT + (16 * it + 4 * rq) * 4); S[it] = S[it] * et; }
          if (!PASS1) {
#pragma unroll
              for (int tt = 0; tt < 4; ++tt)
#pragma unroll
                  for (int j = 0; j < 4; ++j) { const int t = 16 * tt + 4 * rq + j; if (VAR == 0 || o[tt][j] == 1.2345e-30f) O[(size_t)(base + stride * t) * 768 + h * 128 + 16 * w + vloc] = f2bf(o[tt][j]); }
          } }
    }
    __syncthreads();
}

constexpr int G1_KIT = 0, G1_VT = 34816, G1_TOT = 69632, G1_EREF = 77824, G1_ETOT = 78336;
__device__ __forceinline__ void gla_pass1_unit(const Params& p, LAS unsigned char* lds, const int chain, const int slot) {
    int tid = threadIdx.x; asm volatile("" : "+v"(tid));
    const int w = __builtin_amdgcn_readfirstlane(tid >> 6), lane = tid & 63, vloc = lane & 15, rq = lane >> 4;
    const int dir = chain & 1, h = (chain >> 1) % 6, b = chain / 12;
    const bf16_t* Z = (const bf16_t*)(p.ws + OFF_Z);
    float* KV = (float*)(p.out + DO_KV); float* DEC = (float*)(p.out + DO_DEC);
    const bool isctx = slot == 0;
    const int nst = isctx ? 2 : 4, col0 = isctx ? 0 : (slot - 1) * 4;
    const float l0a = p.lb_logits[h * 128 + 2 * lane], l1a = p.lb_logits[768 + h * 128 + 2 * lane], l0b = p.lb_logits[h * 128 + 2 * lane + 1], l1b = p.lb_logits[768 + h * 128 + 2 * lane + 1];
    const float lb0 = frcp_(1.0f + __expf(l1a - l0a)), lb1 = frcp_(1.0f + __expf(l1b - l0b));
    const int colf = (dir ? ZFB : ZFF) + h * 128 + 2 * lane, colv = ZI + h * 128 + 2 * lane;
    auto step_rows = [&](int j, int& base, int& stride) {
        if (isctx) { if (dir == 0) { base = NTOK + b * CTXL + 128 * j; stride = 1; } else { base = NTOK + b * CTXL + 255 - 128 * j; stride = -1; } }
        else { const int c = col0 + j;
            if (dir == 0) { base = b * SEQ + c; stride = 64; } else { base = b * SEQ + (63 - c) + 64 * 127; stride = -64; } }
    };
    f32x4 S[8];
#pragma unroll
    for (int it = 0; it < 8; ++it) S[it] = (f32x4){0.f, 0.f, 0.f, 0.f};
    float dsum0 = 1.f, dsum1 = 1.f;
    unsigned nz[16], nv[16];
    { int base, stride; step_rows(0, base, stride);
#pragma unroll
      for (int r = 0; r < 16; ++r) { const size_t ro = (size_t)(base + stride * (16 * w + r)) * ZC; nz[r] = *(const unsigned*)(Z + ro + colf); nv[r] = *(const unsigned*)(Z + ro + colv); } }
    for (int j = 0; j < nst; ++j) {
        unsigned cz[16], cv[16];
#pragma unroll
        for (int r = 0; r < 16; ++r) { cz[r] = nz[r]; cv[r] = nv[r]; }
        if (j + 1 < nst) { int nb_, ns_; step_rows(j + 1, nb_, ns_);
#pragma unroll
            for (int r = 0; r < 16; ++r) { const size_t ro = (size_t)(nb_ + ns_ * (16 * w + r)) * ZC; nz[r] = *(const unsigned*)(Z + ro + colf); nv[r] = *(const unsigned*)(Z + ro + colv); } }
        f32x2 cp[16], kk[16]; f32x2 run = (f32x2){1.0f, 1.0f};
        const f32x2 lbv = (f32x2){lb0, lb1}, one = (f32x2){1.0f, 1.0f}, omlb = one - lbv;
#pragma unroll
        for (int r = 0; r < 16; ++r) { const f32x2 z = (f32x2){bf_lo(cz[r]), bf_hi(cz[r])}; const f32x2 zz = z * (-1.4426950408889634f);
            f32x2 E; E.x = __builtin_amdgcn_exp2f(zz.x); E.y = __builtin_amdgcn_exp2f(zz.y);
            const f32x2 d = one + E; f32x2 D; D.x = frcp_(d.x); D.y = frcp_(d.y);
            const f32x2 f = (one + lbv * E) * D; kk[r] = omlb * E * D; run = run * f; cp[r] = run; }
        *(LAS f32x2*)(lds + G1_TOT + (w * 128 + 2 * lane) * 4) = run;
        __syncthreads();
        f32x2 pre = one, refp = one, totp = one;
#pragma unroll
        for (int ww = 0; ww < 8; ++ww) { const f32x2 tv = *(const LAS f32x2*)(lds + G1_TOT + (ww * 128 + 2 * lane) * 4);
            if (ww < w) pre = pre * tv; if (ww < 4) refp = refp * tv; totp = totp * tv; }
        dsum0 *= totp.x; dsum1 *= totp.y;
        f32x2 invR; invR.x = frcp_(refp.x); invR.y = frcp_(refp.y);
        { unsigned k0p[8], k1p[8], v0p[8], v1p[8]; const f32x2 s_q = pre * invR;
#pragma unroll
          for (int r = 0; r < 16; r += 2) { const f32x2 ea = s_q * cp[r], eb = s_q * cp[r + 1]; f32x2 ia, ib; ia.x = frcp_(ea.x); ia.y = frcp_(ea.y); ib.x = frcp_(eb.x); ib.y = frcp_(eb.y);
              const f32x2 ka_ = kk[r] * ia, kb_ = kk[r + 1] * ib;
              k0p[r >> 1] = cvt_pk_bf16(ka_.x, kb_.x); k1p[r >> 1] = cvt_pk_bf16(ka_.y, kb_.y);
              v0p[r >> 1] = (cv[r] & 0xffffu) | (cv[r + 1] << 16); v1p[r >> 1] = (cv[r] >> 16) | (cv[r + 1] & 0xffff0000u); }
          LAS unsigned char* ka = lds + G1_KIT + (2 * lane) * 272 + 32 * w; LAS unsigned char* va = lds + G1_VT + (2 * lane) * 272 + 32 * w;
          *(LAS u32x4*)ka = (u32x4){k0p[0], k0p[1], k0p[2], k0p[3]}; *(LAS u32x4*)(ka + 16) = (u32x4){k0p[4], k0p[5], k0p[6], k0p[7]};
          *(LAS u32x4*)(ka + 272) = (u32x4){k1p[0], k1p[1], k1p[2], k1p[3]}; *(LAS u32x4*)(ka + 272 + 16) = (u32x4){k1p[4], k1p[5], k1p[6], k1p[7]};
          *(LAS u32x4*)va = (u32x4){v0p[0], v0p[1], v0p[2], v0p[3]}; *(LAS u32x4*)(va + 16) = (u32x4){v0p[4], v0p[5], v0p[6], v0p[7]};
          *(LAS u32x4*)(va + 272) = (u32x4){v1p[0], v1p[1], v1p[2], v1p[3]}; *(LAS u32x4*)(va + 272 + 16) = (u32x4){v1p[4], v1p[5], v1p[6], v1p[7]}; }
        if (w == 0) { *(LAS f32x2*)(lds + G1_EREF + 2 * lane * 4) = refp; *(LAS f32x2*)(lds + G1_ETOT + 2 * lane * 4) = totp * invR; }
        __syncthreads();
#pragma unroll
        for (int it = 0; it < 8; ++it) { const f32x4 er = *(const LAS f32x4*)(lds + G1_EREF + (16 * it + 4 * rq) * 4); S[it] = S[it] * er; }
        { bf16x8 vb[4];
#pragma unroll
          for (int c = 0; c < 4; ++c) vb[c] = *(const LAS bf16x8*)(lds + G1_VT + (16 * w + vloc) * 272 + (32 * c + 8 * rq) * 2);
#pragma unroll
          for (int it = 0; it < 8; ++it)
#pragma unroll
              for (int c = 0; c < 4; ++c) { const bf16x8 ka = *(const LAS bf16x8*)(lds + G1_KIT + (16 * it + vloc) * 272 + (32 * c + 8 * rq) * 2); S[it] = __builtin_amdgcn_mfma_f32_16x16x32_bf16(ka, vb[c], S[it], 0, 0, 0); } }
#pragma unroll
        for (int it = 0; it < 8; ++it) { const f32x4 et = *(const LAS f32x4*)(lds + G1_ETOT + (16 * it + 4 * rq) * 4); S[it] = S[it] * et; }
    }
    unsigned* kv = (unsigned*)KV + ((size_t)(chain * GLA_SLOTS + slot) * 8 + w) * 16 * 64 + lane;
#pragma unroll
    for (int it = 0; it < 8; ++it) { kv[(it * 2) * 64] = cvt_pk_bf16(S[it][0], S[it][1]); kv[(it * 2 + 1) * 64] = cvt_pk_bf16(S[it][2], S[it][3]); }
    if (w == 0) *(f32x2*)(DEC + (size_t)(chain * GLA_SLOTS + slot) * 128 + 2 * lane) = (f32x2){dsum0, dsum1};
    __syncthreads();
}

constexpr int G3_IMG = 73728, G3_QI = 0, G3_KI = 17408, G3_KIT = 34816, G3_VT = 53248, G3_EREF = 71680, G3_ETOT = 72192, G3_P = 147456, G3_TOT = 156672;
__device__ __forceinline__ void gla_unit_p3(const Params& p, LAS unsigned char* lds, const int chain, const int ch0, const int nch, const int nfold) {
    int tid = threadIdx.x; asm volatile("" : "+v"(tid));
    const int w = __builtin_amdgcn_readfirstlane(tid >> 6), lane = tid & 63, vloc = lane & 15, rq = lane >> 4;
    const int dir = chain & 1, h = (chain >> 1) % 6, b = chain / 12;
    const bf16_t* Z = (const bf16_t*)(p.ws + OFF_Z);
    bf16_t* O = (bf16_t*)(p.out + (dir ? DO_OB : DO_OF));
    const float* KV = (const float*)(p.out + DO_KV); const float* DEC = (const float*)(p.out + DO_DEC);
    const float l0a = p.lb_logits[h * 128 + 2 * lane], l1a = p.lb_logits[768 + h * 128 + 2 * lane], l0b = p.lb_logits[h * 128 + 2 * lane + 1], l1b = p.lb_logits[768 + h * 128 + 2 * lane + 1];
    const float lb0 = frcp_(1.0f + __expf(l1a - l0a)), lb1 = frcp_(1.0f + __expf(l1b - l0b));
    const int colf = (dir ? ZFB : ZFF) + h * 128 + 2 * lane, colq = ZQ + h * 128 + 2 * lane, colv = ZI + h * 128 + 2 * lane;
    auto chunk_rows = [&](int ci, int& base, int& stride) { const int n = ch0 + ci;
        if (dir == 0) { base = b * SEQ + 4096 * (n & 1) + (n >> 1); stride = 64; }
        else { const int n2 = 127 - n; base = b * SEQ + 4096 * (n2 & 1) + (n2 >> 1) + 64 * 63; stride = -64; } };
    unsigned zA[8], qB[8], vB[8];
    float cl0[8], cl1[8], kk0[8], kk1[8];
    f32x4 S[8], o[4];
#define G3_LOADZ(ci) do { int b_, s_; chunk_rows(ci, b_, s_); _Pragma("unroll") for (int r = 0; r < 8; ++r) zA[r] = *(const unsigned*)(Z + (size_t)(b_ + s_ * (8 * w + r)) * ZC + colf); } while (0)
#define G3_LOADQV(ci) do { int b_, s_; chunk_rows(ci, b_, s_); _Pragma("unroll") for (int r = 0; r < 8; ++r) { const size_t ro = (size_t)(b_ + s_ * (8 * w + r)) * ZC; qB[r] = *(const unsigned*)(Z + ro + colq); vB[r] = *(const unsigned*)(Z + ro + colv); } } while (0)
#define G3_STAGE_A() do { float c0 = 0.f, c1 = 0.f; \
        _Pragma("unroll") for (int r = 0; r < 8; ++r) { const float s0 = sigmoidf_(bf_lo(zA[r])), s1 = sigmoidf_(bf_hi(zA[r])); \
            const float f0 = lb0 + (1.0f - lb0) * s0, f1 = lb1 + (1.0f - lb1) * s1; \
            c0 += __logf(f0); c1 += __logf(f1); cl0[r] = c0; cl1[r] = c1; kk0[r] = (1.0f - lb0) * (1.0f - s0); kk1[r] = (1.0f - lb1) * (1.0f - s1); } \
        *(LAS f32x2*)(lds + G3_TOT + (w * 128 + 2 * lane) * 4) = (f32x2){c0, c1}; } while (0)
#define G3_STAGE_B(IB) do { float pre0 = 0.f, pre1 = 0.f, ref0 = 0.f, ref1 = 0.f, tot0 = 0.f, tot1 = 0.f; \
        _Pragma("unroll") for (int ww = 0; ww < 8; ++ww) { const f32x2 tv = *(const LAS f32x2*)(lds + G3_TOT + (ww * 128 + 2 * lane) * 4); \
            if (ww < w) { pre0 += tv.x; pre1 += tv.y; } if (ww < 4) { ref0 += tv.x; ref1 += tv.y; } tot0 += tv.x; tot1 += tv.y; } \
        float ki0[8], ki1[8]; \
        _Pragma("unroll") for (int r = 0; r < 8; ++r) { const float e0 = __expf(pre0 + cl0[r] - ref0), e1 = __expf(pre1 + cl1[r] - ref1); \
            ki0[r] = kk0[r] * frcp_(e0); ki1[r] = kk1[r] * frcp_(e1); const int t = 8 * w + r; \
            *(LAS unsigned*)(lds + (IB) + G3_QI + t * 272 + lane * 4) = cvt_pk_bf16(bf_lo(qB[r]) * e0, bf_hi(qB[r]) * e1); \
            *(LAS unsigned*)(lds + (IB) + G3_KI + t * 272 + lane * 4) = cvt_pk_bf16(ki0[r], ki1[r]); } \
        u32x4 a_, b_; \
        a_.x = cvt_pk_bf16(ki0[0], ki0[1]); a_.y = cvt_pk_bf16(ki0[2], ki0[3]); a_.z = cvt_pk_bf16(ki0[4], ki0[5]); a_.w = cvt_pk_bf16(ki0[6], ki0[7]); \
        b_.x = cvt_pk_bf16(ki1[0], ki1[1]); b_.y = cvt_pk_bf16(ki1[2], ki1[3]); b_.z = cvt_pk_bf16(ki1[4], ki1[5]); b_.w = cvt_pk_bf16(ki1[6], ki1[7]); \
        *(LAS u32x4*)(lds + (IB) + G3_KIT + (2 * lane) * 144 + 16 * w) = a_; *(LAS u32x4*)(lds + (IB) + G3_KIT + (2 * lane + 1) * 144 + 16 * w) = b_; \
        u32x4 va, vb2; \
        va.x = (vB[0] & 0xffffu) | (vB[1] << 16); va.y = (vB[2] & 0xffffu) | (vB[3] << 16); va.z = (vB[4] & 0xffffu) | (vB[5] << 16); va.w = (vB[6] & 0xffffu) | (vB[7] << 16); \
        vb2.x = (vB[0] >> 16) | (vB[1] & 0xffff0000u); vb2.y = (vB[2] >> 16) | (vB[3] & 0xffff0000u); vb2.z = (vB[4] >> 16) | (vB[5] & 0xffff0000u); vb2.w = (vB[6] >> 16) | (vB[7] & 0xffff0000u); \
        *(LAS u32x4*)(lds + (IB) + G3_VT + (2 * lane) * 144 + 16 * w) = va; *(LAS u32x4*)(lds + (IB) + G3_VT + (2 * lane + 1) * 144 + 16 * w) = vb2; \
        if (w == 0) { *(LAS f32x2*)(lds + (IB) + G3_EREF + 2 * lane * 4) = (f32x2){__expf(ref0), __expf(ref1)}; *(LAS f32x2*)(lds + (IB) + G3_ETOT + 2 * lane * 4) = (f32x2){__expf(tot0 - ref0), __expf(tot1 - ref1)}; } } while (0)
#define G3_STAGE_C(IB) do { \
        _Pragma("unroll") for (int it = 0; it < 8; ++it) { const f32x4 er = *(const LAS f32x4*)(lds + (IB) + G3_EREF + (16 * it + 4 * rq) * 4); S[it] = S[it] * er; } \
        bf16x8 Sb[4]; \
        _Pragma("unroll") for (int c = 0; c < 4; ++c) { u32x4 t; t.x = cvt_pk_bf16(S[2 * c][0], S[2 * c][1]); t.y = cvt_pk_bf16(S[2 * c][2], S[2 * c][3]); t.z = cvt_pk_bf16(S[2 * c + 1][0], S[2 * c + 1][1]); t.w = cvt_pk_bf16(S[2 * c + 1][2], S[2 * c + 1][3]); Sb[c] = __builtin_bit_cast(bf16x8, t); } \
        _Pragma("unroll") for (int tt = 0; tt < 4; ++tt) { o[tt] = (f32x4){0.f, 0.f, 0.f, 0.f}; \
            _Pragma("unroll") for (int c = 0; c < 4; ++c) { const LAS unsigned char* qa = lds + (IB) + G3_QI + (16 * tt + vloc) * 272 + (32 * c + 4 * rq) * 2; \
                const u32x2 lo = *(const LAS u32x2*)qa, hi = *(const LAS u32x2*)(qa + 32); u32x4 t; t.x = lo.x; t.y = lo.y; t.z = hi.x; t.w = hi.y; \
                o[tt] = __builtin_amdgcn_mfma_f32_16x16x32_bf16(__builtin_bit_cast(bf16x8, t), Sb[c], o[tt], 0, 0, 0); } } \
        { const int tt = w >> 1; \
          _Pragma("unroll") for (int sh = 0; sh < 2; ++sh) { const int st = 2 * (w & 1) + sh; f32x4 pacc = (f32x4){0.f, 0.f, 0.f, 0.f}; \
              _Pragma("unroll") for (int c = 0; c < 4; ++c) { const bf16x8 ka = *(const LAS bf16x8*)(lds + (IB) + G3_KI + (16 * st + vloc) * 272 + (32 * c + 8 * rq) * 2); \
                  const bf16x8 qb = *(const LAS bf16x8*)(lds + (IB) + G3_QI + (16 * tt + vloc) * 272 + (32 * c + 8 * rq) * 2); \
                  pacc = __builtin_amdgcn_mfma_f32_16x16x32_bf16(ka, qb, pacc, 0, 0, 0); } \
              const int tg = 16 * tt + vloc, sg = 16 * st + 4 * rq; \
              u32x2 pw; pw.x = cvt_pk_bf16(sg + 0 <= tg ? pacc[0] : 0.f, sg + 1 <= tg ? pacc[1] : 0.f); pw.y = cvt_pk_bf16(sg + 2 <= tg ? pacc[2] : 0.f, sg + 3 <= tg ? pacc[3] : 0.f); \
              *(LAS u32x2*)(lds + G3_P + tg * 144 + sg * 2) = pw; } } } while (0)
#define G3_STAGE_D(IB, CI) do { bf16x8 vb[2]; \
        _Pragma("unroll") for (int c = 0; c < 2; ++c) vb[c] = *(const LAS bf16x8*)(lds + (IB) + G3_VT + (16 * w + vloc) * 144 + (32 * c + 8 * rq) * 2); \
        _Pragma("unroll") for (int tt = 0; tt < 4; ++tt) _Pragma("unroll") for (int c = 0; c < 2; ++c) { const bf16x8 pa = *(const LAS bf16x8*)(lds + G3_P + (16 * tt + vloc) * 144 + (32 * c + 8 * rq) * 2); o[tt] = __builtin_amdgcn_mfma_f32_16x16x32_bf16(pa, vb[c], o[tt], 0, 0, 0); } \
        _Pragma("unroll") for (int it = 0; it < 8; ++it) _Pragma("unroll") for (int c = 0; c < 2; ++c) { const bf16x8 ka = *(const LAS bf16x8*)(lds + (IB) + G3_KIT + (16 * it + vloc) * 144 + (32 * c + 8 * rq) * 2); S[it] = __builtin_amdgcn_mfma_f32_16x16x32_bf16(ka, vb[c], S[it], 0, 0, 0); } \
        _Pragma("unroll") for (int it = 0; it < 8; ++it) { const f32x4 et = *(const LAS f32x4*)(lds + (IB) + G3_ETOT + (16 * it + 4 * rq) * 4); S[it] = S[it] * et; } \
        { int b_, s_; chunk_rows(CI, b_, s_); \
          _Pragma("unroll") for (int tt = 0; tt < 4; ++tt) _Pragma("unroll") for (int j = 0; j < 4; ++j) { const int t = 16 * tt + 4 * rq + j; O[(size_t)(b_ + s_ * t) * 768 + h * 128 + 16 * w + vloc] = f2bf(o[tt][j]); } } } while (0)
    G3_LOADZ(0); G3_LOADQV(0);
#pragma unroll
    for (int it = 0; it < 8; ++it) S[it] = (f32x4){0.f, 0.f, 0.f, 0.f};
    for (int sl = 0; sl < nfold; ++sl) {
        const unsigned* kv = (const unsigned*)KV + ((size_t)(chain * GLA_SLOTS + sl) * 8 + w) * 16 * 64 + lane; const float* dc = DEC + (size_t)(chain * GLA_SLOTS + sl) * 128;
#pragma unroll
        for (int it = 0; it < 8; ++it) { const f32x4 d = *(const f32x4*)(dc + 16 * it + 4 * rq); const unsigned w0 = kv[(it * 2) * 64], w1 = kv[(it * 2 + 1) * 64];
            S[it][0] = d[0] * S[it][0] + bf_lo(w0); S[it][1] = d[1] * S[it][1] + bf_hi(w0); S[it][2] = d[2] * S[it][2] + bf_lo(w1); S[it][3] = d[3] * S[it][3] + bf_hi(w1); }
    }
    G3_STAGE_A();
    if (1 < nch) G3_LOADZ(1);
    __syncthreads();
    G3_STAGE_B(0);
    if (1 < nch) G3_LOADQV(1);
    __syncthreads();
    if (1 < nch) { G3_STAGE_A(); if (2 < nch) G3_LOADZ(2); }
    __syncthreads();
    for (int n = 0; n < nch; ++n) {
        const int ib = (n & 1) * G3_IMG, ib1 = ((n + 1) & 1) * G3_IMG;
        if (w < 4) { G3_STAGE_C(ib); G3_STAGE_B(ib1); } else { G3_STAGE_B(ib1); G3_STAGE_C(ib); }
        G3_LOADQV(n + 2 < nch ? n + 2 : nch - 1);
        __syncthreads();
        if (w < 4) { G3_STAGE_D(ib, n); G3_STAGE_A(); } else { G3_STAGE_A(); G3_STAGE_D(ib, n); }
        G3_LOADZ(n + 3 < nch ? n + 3 : nch - 1);
        __syncthreads();
    }
#undef G3_LOADZ
#undef G3_LOADQV
#undef G3_STAGE_A
#undef G3_STAGE_B
#undef G3_STAGE_C
#undef G3_STAGE_D
}
__device__ __forceinline__ void yb_rows(const Params& p, const int r0, const int nrows) {
    int tid = threadIdx.x; asm volatile("" : "+v"(tid));
    const int wid = tid >> 6, lane = tid & 63;
    const bf16_t* Of = (const bf16_t*)(p.out + DO_OF); const bf16_t* Ob = (const bf16_t*)(p.out + DO_OB); const bf16_t* Z = (const bf16_t*)(p.ws + OFF_Z); bf16_t* Yb = (bf16_t*)(p.ws + OFF_YB);
    const float gn0 = p.hg_norm_g[lane * 2], gn1 = p.hg_norm_g[lane * 2 + 1];
    for (int t = r0 + wid; t < r0 + nrows; t += 8) {
        unsigned a[6], bb[6], gw[6];
#pragma unroll
        for (int h = 0; h < 6; ++h) { const int col = h * 128 + lane * 2; a[h] = *(const unsigned*)(Of + (size_t)t * 768 + col); bb[h] = *(const unsigned*)(Ob + (size_t)t * 768 + col); gw[h] = *(const unsigned*)(Z + (size_t)t * ZC + ZGO + col); }
#pragma unroll
        for (int h = 0; h < 6; ++h) {
            const int col = h * 128 + lane * 2;
            const float o0 = bf_lo(a[h]) + bf_lo(bb[h]), o1 = bf_hi(a[h]) + bf_hi(bb[h]);
            const float ss = wave_sum(o0 * o0 + o1 * o1);
            const float rstd = rsqrtf(ss * (1.0f / 128.0f) + EPSF);
            *(unsigned*)(Yb + (size_t)t * 768 + col) = cvt_pk_bf16(o0 * rstd * gn0 * siluf_(bf_lo(gw[h])), o1 * rstd * gn1 * siluf_(bf_hi(gw[h])));
        }
    }
}

constexpr int RT_AHI = 0, RT_ALO = 66048, RT_LG = 132096, RT_ROW = 2064, RT_HIST = 144 * 1024 - 1024 + 256;
__device__ __forceinline__ void router_w_phase(const Params& p) {
    bf16_t* hi = (bf16_t*)(p.ws + OFF_WRT); bf16_t* lo = hi + 64 * 1024;
    for (int i = blockIdx.x * blockDim.x + threadIdx.x; i < 64 * 1024; i += gridDim.x * blockDim.x) { const int k = i >> 6, e = i & 63;
        const float w = p.w_router[i]; const bf16_t h = f2bf(w); hi[e * 1024 + k] = h; lo[e * 1024 + k] = f2bf(w - bf2f(h)); }
}
__device__ __forceinline__ void route_phase(const Params& p, LAS unsigned char* lds) {
    int tid = threadIdx.x; asm volatile("" : "+v"(tid));
    const int wid = __builtin_amdgcn_readfirstlane(tid >> 6), lane = tid & 63, vloc = lane & 15, rq = lane >> 4;
    LAS int* hist = (LAS int*)(lds + RT_HIST);
    const bf16_t* X1 = (const bf16_t*)(p.out); const float* mod = (const float*)(p.ws + OFF_MOD);
    const bf16_t* Whi = (const bf16_t*)(p.ws + OFF_WRT); const bf16_t* Wlo = Whi + 64 * 1024;
    unsigned char* H2 = p.ws + OFF_H2;
    int* eidx = (int*)(p.ws + OFF_EIDX); float* wts = (float*)(p.ws + OFF_WTS); int* lrank = (int*)(p.ws + OFF_APOS); int* lst = (int*)(p.ws + OFF_LIST);
    const int nb = (int)gridDim.x, TPB = (NTOK + nb - 1) / nb, tb0 = (int)blockIdx.x * TPB;
    if (blockIdx.x == 0) for (int i = tid; i < 256; i += 512) *(unsigned*)(H2 + (size_t)NTOK * 1024 + i * 4) = 0u;
    if (tid < 64) hist[tid] = 0;
    const float brl = p.b_router[lane];
    const int tm = wid >> 2, tn = wid & 3;
    const bool onebatch = (tb0 / SEQ) == ((tb0 + TPB - 1) / SEQ);
    f32x4 gq[4], shq[4], scq[4];
    { const float* mr = mod + (size_t)(tb0 / SEQ) * NIN;
#pragma unroll
      for (int j = 0; j < 4; ++j) { const int k = j * 256 + lane * 4; gq[j] = *(const f32x4*)(p.norm2_g + k); shq[j] = *(const f32x4*)(mr + 3072 + k); scq[j] = *(const f32x4*)(mr + 4096 + k); } }
    u32x2 vq[4][4];
    { const int t0 = tb0 + wid * 4;
#pragma unroll
      for (int q = 0; q < 4; ++q) { const int t = (t0 + q < NTOK) ? t0 + q : NTOK - 1;
#pragma unroll
          for (int j = 0; j < 4; ++j) vq[q][j] = *(const u32x2*)(X1 + (size_t)t * X1P + j * 256 + lane * 4); } }
    for (int it = 0; it * 32 < TPB; ++it) {
        const int t0 = tb0 + it * 32 + wid * 4;
#pragma unroll
        for (int q = 0; q < 4; ++q) { const int t = t0 + q, row = wid * 4 + q;
            if (t < NTOK && t < tb0 + TPB) { const float* mr = mod + (size_t)(t / SEQ) * NIN;
                f32x4 v[4]; float ss = 0.f;
#pragma unroll
                for (int j = 0; j < 4; ++j) { v[j] = (f32x4){bf_lo(vq[q][j].x), bf_hi(vq[q][j].x), bf_lo(vq[q][j].y), bf_hi(vq[q][j].y)}; ss += v[j][0] * v[j][0] + v[j][1] * v[j][1] + v[j][2] * v[j][2] + v[j][3] * v[j][3]; }
                ss = wave_sum(ss); const float rstd = rsqrtf(ss * (1.0f / 1024.0f) + EPSF);
#pragma unroll
                for (int j = 0; j < 4; ++j) { const int k = j * 256 + lane * 4;
                    f32x4 g = gq[j], sh = shq[j], scv = scq[j];
                    if (!onebatch) { sh = *(const f32x4*)(mr + 3072 + k); scv = *(const f32x4*)(mr + 4096 + k); }
                    f32x4 o;
#pragma unroll
                    for (int e = 0; e < 4; ++e) o[e] = v[j][e] * rstd * g[e] * (1.0f + scv[e]) + sh[e];
                    u32x2 wh; wh.x = cvt_pk_bf16(o[0], o[1]); wh.y = cvt_pk_bf16(o[2], o[3]);
                    u32x2 wl; wl.x = cvt_pk_bf16(o[0] - bf_lo(wh.x), o[1] - bf_hi(wh.x)); wl.y = cvt_pk_bf16(o[2] - bf_lo(wh.y), o[3] - bf_hi(wh.y));
                    *(LAS u32x2*)(lds + RT_AHI + row * RT_ROW + k * 2) = wh; *(LAS u32x2*)(lds + RT_ALO + row * RT_ROW + k * 2) = wl;
                    *(unsigned*)(H2 + (size_t)t * 1024 + k) = pack_fp8x4(o[0], o[1], o[2], o[3]); } }
            else {
#pragma unroll
                for (int j = 0; j < 4; ++j) { const int k = j * 256 + lane * 4; *(LAS u32x2*)(lds + RT_AHI + row * RT_ROW + k * 2) = (u32x2){0u, 0u}; *(LAS u32x2*)(lds + RT_ALO + row * RT_ROW + k * 2) = (u32x2){0u, 0u}; } } }
        if ((it + 1) * 32 < TPB) { const int t1 = t0 + 32;
#pragma unroll
            for (int q = 0; q < 4; ++q) { const int t = (t1 + q < NTOK) ? t1 + q : NTOK - 1;
#pragma unroll
                for (int j = 0; j < 4; ++j) vq[q][j] = *(const u32x2*)(X1 + (size_t)t * X1P + j * 256 + lane * 4); } }
        __syncthreads();
        { f32x4 acc = (f32x4){0.f, 0.f, 0.f, 0.f};
          const LAS unsigned char* ah_p = lds + RT_AHI + (16 * tm + vloc) * RT_ROW + rq * 16; const LAS unsigned char* al_p = lds + RT_ALO + (16 * tm + vloc) * RT_ROW + rq * 16;
          const bf16_t* bh_p = Whi + (size_t)(16 * tn + vloc) * 1024 + rq * 8; const bf16_t* bl_p = Wlo + (size_t)(16 * tn + vloc) * 1024 + rq * 8;
#pragma unroll 8
          for (int c = 0; c < 32; ++c) { const bf16x8 ah = *(const LAS bf16x8*)(ah_p + c * 64), al = *(const LAS bf16x8*)(al_p + c * 64);
              const bf16x8 bh = *(const bf16x8*)(bh_p + c * 32), bl = *(const bf16x8*)(bl_p + c * 32);
              acc = __builtin_amdgcn_mfma_f32_16x16x32_bf16(ah, bh, acc, 0, 0, 0); acc = __builtin_amdgcn_mfma_f32_16x16x32_bf16(al, bh, acc, 0, 0, 0); acc = __builtin_amdgcn_mfma_f32_16x16x32_bf16(ah, bl, acc, 0, 0, 0); }
          LAS float* lg = (LAS float*)(lds + RT_LG);
#pragma unroll
          for (int j = 0; j < 4; ++j) lg[(16 * tm + 4 * rq + j) * 64 + 16 * tn + vloc] = acc[j]; }
        __syncthreads();
#pragma unroll
        for (int q = 0; q < 4; ++q) { const int t = t0 + q; const float logit = ((const LAS float*)(lds + RT_LG))[(wid * 4 + q) * 64 + lane];
            if (t < NTOK && t < tb0 + TPB) {
                const float sc = 1.0f / (1.0f + __expf(-logit)), bs = sc + brl;
                float m1 = bs;
                m1 = fmaxf(m1, dpp_mov_<0xB1>(m1)); m1 = fmaxf(m1, dpp_mov_<0x4E>(m1)); m1 = fmaxf(m1, dpp_mov_<0x141>(m1));
                const unsigned long long ism = __ballot(bs == m1);
                const int gbase = lane & ~7; const unsigned gm = (unsigned)((ism >> gbase) & 0xffull);
                const int first = gbase + __builtin_ctz(gm);
                float m2 = (lane == first) ? -INFINITY : bs;
                m2 = fmaxf(m2, dpp_mov_<0xB1>(m2)); m2 = fmaxf(m2, dpp_mov_<0x4E>(m2)); m2 = fmaxf(m2, dpp_mov_<0x141>(m2));
                const float gs = m1 + m2; const int gid = lane >> 3;
                int grank = 0;
#pragma unroll
                for (int g2 = 0; g2 < 8; ++g2) { const float og = __int_as_float(__builtin_amdgcn_readlane(__float_as_int(gs), g2 * 8)); grank += (og > gs || (og == gs && g2 < gid)) ? 1 : 0; }
                const bool gok = grank < 4;
                const float mk = gok ? bs : -INFINITY;
                int rank = 0;
#pragma unroll
                for (int e2 = 0; e2 < 64; ++e2) { const float ov = __int_as_float(__builtin_amdgcn_readlane(__float_as_int(mk), e2)); rank += (ov > mk || (ov == mk && e2 < lane)) ? 1 : 0; }
                const bool sel = gok && rank < TOPK;
                const float wsum = wave_sum(sel ? sc : 0.f);
                if (sel) { const int lr = __hip_atomic_fetch_add(hist + lane, 1, __ATOMIC_RELAXED, __HIP_MEMORY_SCOPE_WORKGROUP);
                    eidx[t * 8 + rank] = lane; wts[t * 8 + rank] = sc / wsum * 2.5f; lrank[t * 8 + rank] = lr; lst[((size_t)blockIdx.x * 64 + lane) * 128 + lr] = t * 8 + rank; } } }
    }
    __syncthreads();
    if (tid < 64) ((int*)(p.ws + OFF_BCNT))[blockIdx.x * 64 + tid] = hist[tid];
    __syncthreads();
}

__device__ __forceinline__ void scatter_phase(const Params& p, LAS unsigned char* lds) {
    int tid = threadIdx.x; asm volatile("" : "+v"(tid));
    int* cnt = (int*)(p.ws + OFF_CNT); int* pstart = cnt + 128; int* nblk = cnt + 256; int* blk_e = (int*)(p.ws + OFF_BLKE);
    const int* bc = (const int*)(p.ws + OFF_BCNT);
    const int* eidx = (const int*)(p.ws + OFF_EIDX); int* apos = (int*)(p.ws + OFF_APOS); int* row_tok = (int*)(p.ws + OFF_ROWTOK);
    LAS int* tot = (LAS int*)lds; LAS int* ps = tot + 64; LAS int* ms = ps + 72;
    const int nb = (int)gridDim.x, bid = (int)blockIdx.x, TPB = (NTOK + nb - 1) / nb, tb0 = bid * TPB;
    LAS int* part = ms + 64;
    { const int e = tid & 63, pg = tid >> 6, per = (nb + 7) / 8; int t = 0, bl = 0;
#pragma unroll 8
      for (int wg = pg * per; wg < (pg + 1) * per; ++wg) if (wg < nb) { const int c = bc[wg * 64 + e]; if (wg < bid) bl += c; t += c; }
      part[(pg * 2 + 0) * 64 + e] = t; part[(pg * 2 + 1) * 64 + e] = bl; }
    __syncthreads();
    int below = 0;
    if (tid < 64) { int t = 0;
#pragma unroll
        for (int pg = 0; pg < 8; ++pg) { t += part[(pg * 2 + 0) * 64 + tid]; below += part[(pg * 2 + 1) * 64 + tid]; }
        tot[tid] = t; }
    __syncthreads();
    if (tid == 0) { int a = 0; for (int e = 0; e < 64; ++e) { ps[e] = a; a += (tot[e] + 255) / 256 * 256; } ps[64] = a; ps[65] = a + NTOK; }
    __syncthreads();
    if (tid < 64) ms[tid] = ps[tid] + below;
    __syncthreads();
    int* row_dst = (int*)(p.ws + OFF_ROWDST);
    for (int i = tid; i < TPB * 8; i += 512) { const int t = tb0 + (i >> 3); if (t < NTOK) { const int idx = t * 8 + (i & 7); const int e = eidx[idx]; const int pos = ms[e] + apos[idx]; row_tok[pos] = t; row_dst[pos] = idx; } }
    for (int e = bid; e < 64; e += nb) for (int j = tid; j < 256; j += 512) { const int pos = ps[e] + tot[e] + j; if (pos < ps[e + 1]) { row_tok[pos] = NTOK; row_dst[pos] = -1; } }
    for (int i = tid; i < TPB; i += 512) { const int t = tb0 + i; if (t < NTOK) row_tok[ps[64] + t] = t; }
    if (bid == 0) {
        if (tid < 66) pstart[tid] = ps[tid];
        if (tid == 0) *nblk = ps[65] / 256;
        for (int rb = tid; rb < ps[65] / 256; rb += 512) { int e = 0; while (e < 64 && rb * 256 >= ps[e + 1]) ++e; blk_e[rb] = e; }
    }
    __syncthreads();
}

__device__ __forceinline__ void combine_phase(const Params& p) {
    int tid = threadIdx.x; asm volatile("" : "+v"(tid));
    const int wid = tid >> 6, lane = tid & 63;
    const bf16_t* X1 = (const bf16_t*)(p.out); const float* mod = (const float*)(p.ws + OFF_MOD); const unsigned char* Y2 = (const unsigned char*)(p.ws + OFF_Y2);
    const unsigned char* Y2s = (const unsigned char*)(p.ws + OFF_Y2S);
    const float* wts = (const float*)(p.ws + OFF_WTS); float* out = (float*)p.out;
    f32x4 gf[4];
#pragma unroll
    for (int j = 0; j < 4; ++j) gf[j] = *(const f32x4*)(p.final_g + lane * 16 + 4 * j);
    const int stride = gridDim.x * 8;
    int t = blockIdx.x * 8 + wid;
    u32x4 yv[8]; float wk[8]; u32x4 xb[2]; u32x4 sv;
    if (t < NTOK) {
#pragma unroll
        for (int k = 0; k < TOPK; ++k) { wk[k] = wts[t * 8 + k]; yv[k] = *(const u32x4*)(Y2 + (size_t)(t * 8 + k) * 1024 + lane * 16); }
        xb[0] = *(const u32x4*)(X1 + (size_t)t * X1P + lane * 16); xb[1] = *(const u32x4*)(X1 + (size_t)t * X1P + lane * 16 + 8);
        sv = *(const u32x4*)(Y2s + (size_t)t * 1024 + lane * 16); }
    for (; t < NTOK; t += stride) {
        const float* g2 = mod + (size_t)(t / SEQ) * NIN + 5120 + lane * 16;
        f32x4 a[4];
#pragma unroll
        for (int j = 0; j < 4; ++j) { const int wd = (int)sv[j]; const f32x2 lo = __builtin_amdgcn_cvt_pk_f32_fp8(wd, false), hi = __builtin_amdgcn_cvt_pk_f32_fp8(wd, true); a[j] = (f32x4){lo.x, lo.y, hi.x, hi.y}; }
#pragma unroll
        for (int k = 0; k < TOPK; ++k) {
#pragma unroll
            for (int j = 0; j < 4; ++j) { const int wd = (int)yv[k][j]; const f32x2 lo = __builtin_amdgcn_cvt_pk_f32_fp8(wd, false), hi = __builtin_amdgcn_cvt_pk_f32_fp8(wd, true);
                a[j][0] += wk[k] * lo.x; a[j][1] += wk[k] * lo.y; a[j][2] += wk[k] * hi.x; a[j][3] += wk[k] * hi.y; } }
        f32x4 xo[4]; float ss = 0.f;
#pragma unroll
        for (int j = 0; j < 4; ++j) { const f32x4 gv = *(const f32x4*)(g2 + 4 * j); const unsigned w0 = xb[j >> 1][(j & 1) * 2], w1 = xb[j >> 1][(j & 1) * 2 + 1];
            const f32x4 xv = (f32x4){bf_lo(w0), bf_hi(w0), bf_lo(w1), bf_hi(w1)}; xo[j] = xv + gv * a[j]; ss += xo[j][0] * xo[j][0] + xo[j][1] * xo[j][1] + xo[j][2] * xo[j][2] + xo[j][3] * xo[j][3]; }
        asm volatile("" : "+v"(xo[0]), "+v"(xo[1]), "+v"(xo[2]), "+v"(xo[3]));
        const int t2 = t + stride;
        if (t2 < NTOK) {
#pragma unroll
            for (int k = 0; k < TOPK; ++k) { wk[k] = wts[t2 * 8 + k]; yv[k] = *(const u32x4*)(Y2 + (size_t)(t2 * 8 + k) * 1024 + lane * 16); }
            xb[0] = *(const u32x4*)(X1 + (size_t)t2 * X1P + lane * 16); xb[1] = *(const u32x4*)(X1 + (size_t)t2 * X1P + lane * 16 + 8);
            sv = *(const u32x4*)(Y2s + (size_t)t2 * 1024 + lane * 16); }
        ss = wave_sum(ss); const float rstd = rsqrtf(ss * (1.0f / 1024.0f) + EPSF);
        float* op = out + (size_t)t * 1024 + lane * 16;
#pragma unroll
        for (int j = 0; j < 4; ++j) *(f32x4*)(op + 4 * j) = xo[j] * rstd * gf[j];
    }
}
constexpr int FUSED_LDS = 144 * 1024;
constexpr int PROBE_DUP = 0;
constexpr int PROBE_PHASE = -1;

template <int PA, int PB> __global__ __launch_bounds__(512, 2) void k_fwd(Params p) {
    extern __shared__ __attribute__((aligned(16))) unsigned char shm[];
    LAS unsigned char* lds = (LAS unsigned char*)shm;
    LAS unsigned* xbw = (LAS unsigned*)(lds + FUSED_LDS - 1024);
    if (threadIdx.x == 0) { xbw[0] = 0u; xbw[1] = 0u; xbw[2] = 0u; xbw[3] = 0u; }
    __syncthreads();
    XcdBarrier bar = xcd_barrier_post((unsigned*)(p.ws + OFF_BAR), (volatile LAS unsigned*)xbw);
    const int nb = (int)gridDim.x, bid = (int)blockIdx.x;
    unsigned long long t_start = 0, t_mark = 0, w_acc = 0; if constexpr (PROBE_PHASE >= 0) t_start = __builtin_amdgcn_s_memrealtime();
    const int* cnt = (const int*)(p.ws + OFF_CNT);
#define PH(k) if constexpr (PA <= (k) && (k) < PB)
#define BARRIER(k) if constexpr (PROBE_PHASE == 100) { if ((k) == 13 && threadIdx.x == 0) atomicAdd((unsigned long long*)(p.ws + OFF_PAIR), w_acc); const unsigned long long t_a = __builtin_amdgcn_s_memrealtime(); xcd_barrier(bar); w_acc += __builtin_amdgcn_s_memrealtime() - t_a; if ((k) == 13) t_mark = *(volatile unsigned long long*)(p.ws + OFF_PAIR) / gridDim.x; } else { if constexpr (PA <= (k) && (k) + 1 < PB) xcd_barrier(bar); if constexpr ((k) == PROBE_PHASE) t_mark = __builtin_amdgcn_s_memrealtime() - t_start; }
    PH(0) { if (bid == 0 && threadIdx.x < 128) ((int*)(p.ws + OFF_CNT))[threadIdx.x] = 0;
            ada_phase(p, lds); s5_tab1_phase(p); }
    BARRIER(0);
    PH(1) { cvt_dense_phase(p, lds); if constexpr (PROBE_DUP == 15) cvt_dense_phase(p, lds); norm1_phase(p); if constexpr (PROBE_DUP == 1) norm1_phase(p); s5_tab2_phase(p, bid, nb); router_w_phase(p); }
    BARRIER(1);
    PH(2) { EpiZ2 E{(bf16_t*)(p.ws + OFF_AEXT), (bf16_t*)(p.out + DO_UC), (bf16_t*)(p.ws + OFF_Z)};
      if constexpr (Z_FP8) { { ZSchedF8 S; S.init(p.out + DO_H8, p.out + DO_W8); ge::gemm_phase_f8<EpiZ2, ZSchedF8, true>(lds, 512, 512, 512, S, E); }
 }
      else { PlainSched S; S.init(p.ws + OFF_H, 1024, p.ws + OFF_WINT, 1024, NROWS / 256, NIN / 256); ge::gemm_phase<EpiZ2, PlainSched, false>(lds, 1024, 1024, 1024, S, E); } }
    BARRIER(2);
    PH(3) { if (bid < 32) s5a_phase(p, lds, bid, 32);
            else for (int u = bid - 32; u < 48 * GLA_SLOTS; u += nb - 32) gla_pass1_unit(p, lds, u >> 4, u & 15);
            s5_wfill_phase(p, bid, nb); if constexpr (PROBE_DUP == 12) s5_wfill_phase(p, bid, nb); }
    BARRIER(3);
    PH(4) { if (nb == 256) {
                if (bid < 240) { const int chain = bid / 5, q = bid % 5; gla_unit<false>(p, lds, chain, 24 * q, 24, 3 * q + 1);
                    const int r = q * 48 + chain; if (r < 128) s5b_phase(p, lds, r, 128); }
                else for (int k = 0; k < 3; ++k) gla_unit<false>(p, lds, (bid - 240) * 3 + k, 120, 8, 16);
            } else {
                for (int u = bid; u < 48 * 6; u += nb) { const int chain = u / 6, q = u % 6; gla_unit<false>(p, lds, chain, 24 * q, q < 5 ? 24 : 8, 3 * q + 1); }
                s5b_phase(p, lds, bid, nb);
            } }
    BARRIER(4);
    PH(5) { for (int item = bid; item < (NTOK / 256) * 2; item += nb) { const int pm = item >> 1, half = item & 1;
                yb_rows(p, pm * 256, 256);
                { OneUnitSched S{(const char*)(p.ws + OFF_YS5), (const char*)(p.ws + OFF_GLUT), pm};
                  EpiYa E{(const bf16_t*)(p.ws + OFF_YS5), (bf16_t*)(p.ws + OFF_YA)};
                  ge::gemm_phase<EpiYa, OneUnitSched, false>(lds, 256, 256, 256, S, E); }
                { PanelMergeSched S{(const char*)(p.ws + OFF_YA), (const char*)(p.ws + OFF_YB), (const char*)(p.ws + OFF_PAT), (const char*)(p.ws + OFF_PBT), pm, 2 * half};
                  EpiMergeF<false> E{(const bf16_t*)(p.ws + OFF_Z), (bf16_t*)(p.ws + OFF_Z), ZC};
                  ge::gemm_phase_v<EpiMergeF<false>, PanelMergeSched>(lds, S, E); } } }
    BARRIER(5);
    PH(6) { }
    PH(7) { }
    PH(8) { if (bid & 1) cvt_moe_phase(p, lds);
      { PlainSched S; S.init(p.ws + OFF_Z, ZC, p.ws + OFF_WOUTT, 1024, NTOK / 256, 4);
        EpiX1b E{p.x, (const float*)(p.ws + OFF_MOD), (bf16_t*)(p.out)};
        ge::gemm_phase<EpiX1b, PlainSched, false>(lds, 1024, ZC, 1024, S, E); }
      if (!(bid & 1)) cvt_moe_phase(p, lds); }
    BARRIER(8);
    PH(9) { route_phase(p, lds); if constexpr (PROBE_DUP == 5) route_phase(p, lds); }
    BARRIER(9);
    PH(10) { }
    PH(11) { }
    PH(12) { moe_pull_prep(p, lds);
      MoeSched1P S{lds, (const char*)(p.ws + OFF_H2), (const char*)(p.ws + OFF_BT1)};
      EpiHid E{p.ws, p.out};
      ge::gemm_phase_f8<EpiHid, MoeSched1P, true>(lds, 512, 512, 512, S, E); }
    BARRIER(12);
    PH(13) { MoeSched2 S{(const int*)(p.ws + OFF_BLKE), cnt + 256, p.ws, p.out, (const char*)(p.ws + OFF_BT2), nb, bid};
      EpiY2 E{(unsigned char*)(p.ws + OFF_Y2), (unsigned char*)(p.ws + OFF_Y2S), cnt + 128, (const int*)(p.ws + OFF_ROWDST)};
      ge::gemm_phase_f8<EpiY2, MoeSched2, true>(lds, 128, 128, 128, S, E); }
    if constexpr (PROBE_DUP == 6) { MoeSched2R S{(const int*)(p.ws + OFF_BLKE), cnt + 128, p.ws, p.out, (const char*)(p.ws + OFF_BT2), nb, bid};
      EpiY2 E{(unsigned char*)(p.ws + OFF_Y2), (unsigned char*)(p.ws + OFF_Y2S), cnt + 128, (const int*)(p.ws + OFF_ROWDST)};
      ge::gemm_phase<EpiY2, MoeSched2R, false>(lds, 256, 256, 256, S, E); }
    if constexpr (PROBE_DUP == 7) { MoeSched2R S{(const int*)(p.ws + OFF_BLKE), cnt + 128, p.ws, p.out, (const char*)(p.ws + OFF_BT2), nb, bid};
      EpiNull E{(float*)(p.ws + OFF_BCNT)};
      ge::gemm_phase<EpiNull, MoeSched2R, false>(lds, 256, 256, 256, S, E); }
    BARRIER(13);
    PH(14) { combine_phase(p); if constexpr (PROBE_DUP == 3) combine_phase(p); if constexpr (PROBE_DUP == 4) { for (int r = 0; r < 10; ++r) xcd_barrier(bar); } }
#undef PH
#undef BARRIER
    if constexpr (PROBE_PHASE >= 0) { if (bid == 0 && threadIdx.x == 0) { const unsigned long long t0 = __builtin_amdgcn_s_memrealtime(); while (__builtin_amdgcn_s_memrealtime() - t0 < t_mark) __builtin_amdgcn_s_sleep(8); } }
}


static Params make_params(void* const* d_in, void* d_out, void* d_ws) {
    Params p{};
    const float** f = (const float**)&p;
    for (int i = 0; i < 32; ++i) f[i] = (const float*)d_in[i];
    p.ws = (unsigned char*)d_ws; p.out = (unsigned char*)d_out;
    return p;
}

extern "C" void kernel_launch(void* const* d_in, const int* in_sizes, int n_in, void* d_out, int out_size, void* d_ws, size_t ws_size, hipStream_t stream) {
    (void)in_sizes; (void)n_in; (void)out_size; (void)ws_size;
    static int grid = 0;
    if (!grid) {
        (void)hipFuncSetAttribute((const void*)k_fwd<0, 17>, hipFuncAttributeMaxDynamicSharedMemorySize, FUSED_LDS);
        int dev = 0, cus = 0, per_cu = 0;
        (void)hipGetDevice(&dev);
        (void)hipDeviceGetAttribute(&cus, hipDeviceAttributeMultiprocessorCount, dev);
        (void)hipOccupancyMaxActiveBlocksPerMultiprocessor(&per_cu, (const void*)k_fwd<0, 17>, 512, FUSED_LDS);
        if (per_cu < 1) { fprintf(stderr, "k_fwd: occupancy query says 0 blocks per CU\n"); per_cu = 1; }
        grid = cus;
    }
    const Params p = make_params(d_in, d_out, d_ws);
    (void)hipMemsetAsync((unsigned char*)d_ws + OFF_BAR, 0, XCD_BAR_WORDS * sizeof(unsigned), stream);
    if (PROBE_PHASE == 100) (void)hipMemsetAsync((unsigned char*)d_ws + OFF_PAIR, 0, 256, stream);
    hipLaunchKernelGGL((k_fwd<0, 17>), dim3(grid), dim3(512), FUSED_LDS, stream, p);
}
```
